# Optimizing an MI355X kernel written in HIP

```python
import math
import jax, jax.numpy as jnp
from jax import lax
import numpy as np

D_MODEL = 2048
BATCH = 1
SEQ = 8192
DEPTH = 2

N_MIXERS = 2
NORM_EPS = 1e-6

GLA_HEADS = 4
GLA_QK = D_MODEL // 2
GLA_V = D_MODEL
GLA_DK = GLA_QK // GLA_HEADS
GLA_DV = GLA_V // GLA_HEADS
GLA_GATE_RANK = 16
GLA_GATE_TAU = 16.0
GLA_CHUNK = 64
GLA_IN = 2 * GLA_QK + 2 * GLA_V + GLA_GATE_RANK

MLA_HEADS = 16
MLA_Q_RANK = 512
MLA_KV_RANK = 512
MLA_NOPE = 128
MLA_ROPE = 64
MLA_V = 128
MLA_WIDTH = MLA_HEADS * MLA_V
MLA_IN = MLA_Q_RANK + MLA_KV_RANK + MLA_ROPE + MLA_WIDTH
ROPE_THETA = 10000.0
Q_BLOCK = 128

kernel_name = "hybrid_gla_mla_sandwich"


def rms_norm(x, g, eps=NORM_EPS):
    xf = x.astype(jnp.float32)
    y = xf * lax.rsqrt(jnp.mean(xf * xf, axis=-1, keepdims=True) + eps)
    return (y * g.astype(jnp.float32)).astype(x.dtype)


def _to_chunks(t, n_chunks):
    B, S, H, D = t.shape
    return t.reshape(B, n_chunks, S // n_chunks, H, D).transpose(0, 3, 1, 2, 4)


def gla_mixer(h, w_in, w_gk2, b_gk, g_onorm, w_out):
    B, S, _ = h.shape
    nC = S // GLA_CHUNK
    proj = h @ w_in
    q, k, v, gate, gk_low = jnp.split(
        proj, [GLA_QK, 2 * GLA_QK, 2 * GLA_QK + GLA_V, 2 * GLA_QK + 2 * GLA_V], axis=-1)
    gk = gk_low @ w_gk2 + b_gk
    log_a = jax.nn.log_sigmoid(gk.astype(jnp.float32)) / GLA_GATE_TAU

    q = _to_chunks(q.reshape(B, S, GLA_HEADS, GLA_DK), nC) * (GLA_DK ** -0.5)
    k = _to_chunks(k.reshape(B, S, GLA_HEADS, GLA_DK), nC)
    v = _to_chunks(v.reshape(B, S, GLA_HEADS, GLA_DV), nC)
    log_a = _to_chunks(log_a.reshape(B, S, GLA_HEADS, GLA_DK), nC)

    b = jnp.cumsum(log_a, axis=3)
    b_last = b[..., -1:, :]
    q_e = q * jnp.exp(b)
    k_e = k * jnp.exp(-b)
    k_last = k * jnp.exp(b_last - b)

    A = jnp.einsum('bhncd,bhnsd->bhncs', q_e, k_e)
    causal = jnp.tril(jnp.ones((GLA_CHUNK, GLA_CHUNK), dtype=bool))
    A = jnp.where(causal, A, 0.0)
    o_intra = jnp.einsum('bhncs,bhnsv->bhncv', A, v.astype(A.dtype))

    def step(state, xs):
        q_c, kl_c, v_c, dl_c = xs
        o_c = jnp.einsum('bhcd,bhdv->bhcv', q_c, state)
        state = state * dl_c[..., :, None] + jnp.einsum('bhcd,bhcv->bhdv', kl_c, v_c)
        return state, o_c

    state0 = jnp.zeros((B, GLA_HEADS, GLA_DK, GLA_DV), dtype=jnp.float32)
    xs = (jnp.moveaxis(q_e, 2, 0).astype(jnp.float32),
          jnp.moveaxis(k_last, 2, 0).astype(jnp.float32),
          jnp.moveaxis(v, 2, 0).astype(jnp.float32),
          jnp.moveaxis(jnp.exp(b_last[..., 0, :]), 2, 0).astype(jnp.float32))
    _, o_inter = lax.scan(step, state0, xs)
    o = o_intra + jnp.moveaxis(o_inter, 0, 2)

    o = o.transpose(0, 2, 3, 1, 4).reshape(B, S, GLA_HEADS, GLA_DV).astype(h.dtype)
    o = rms_norm(o, g_onorm).reshape(B, S, GLA_V)
    return (o * jax.nn.silu(gate)) @ w_out


def _rope(t, cos, sin):
    half = t.shape[-1] // 2
    t1, t2 = t[..., :half], t[..., half:]
    return jnp.concatenate([t1 * cos - t2 * sin, t2 * cos + t1 * sin], axis=-1)


def mla_mixer(h, positions, w_in, g_qa, w_qb, g_kva, w_kvb, w_out):
    B, S, _ = h.shape
    proj = h @ w_in
    c_q, c_kv, k_rope, gate = jnp.split(
        proj, [MLA_Q_RANK, MLA_Q_RANK + MLA_KV_RANK, MLA_Q_RANK + MLA_KV_RANK + MLA_ROPE], axis=-1)
    q = (rms_norm(c_q, g_qa) @ w_qb).reshape(B, S, MLA_HEADS, MLA_NOPE + MLA_ROPE)
    kv = (rms_norm(c_kv, g_kva) @ w_kvb).reshape(B, S, MLA_HEADS, MLA_NOPE + MLA_V)
    q_nope, q_rope = q[..., :MLA_NOPE], q[..., MLA_NOPE:]
    k_nope, v = kv[..., :MLA_NOPE], kv[..., MLA_NOPE:]

    inv_freq = ROPE_THETA ** (-jnp.arange(0, MLA_ROPE, 2, dtype=jnp.float32) / MLA_ROPE)
    ang = positions.astype(jnp.float32)[..., None] * inv_freq
    cos, sin = jnp.cos(ang), jnp.sin(ang)
    q_rope = _rope(q_rope, cos[:, :, None, :], sin[:, :, None, :]).astype(h.dtype)
    k_rope = _rope(k_rope, cos, sin).astype(h.dtype)
    q = jnp.concatenate([q_nope, q_rope], axis=-1)
    k = jnp.concatenate(
        [k_nope, jnp.broadcast_to(k_rope[:, :, None, :], (B, S, MLA_HEADS, MLA_ROPE))], axis=-1)
    scale = (MLA_NOPE + MLA_ROPE) ** -0.5

    n_blocks = S // Q_BLOCK
    q_blocks = q.reshape(B, n_blocks, Q_BLOCK, MLA_HEADS, -1).transpose(1, 0, 2, 3, 4)
    starts = jnp.arange(n_blocks, dtype=jnp.int32) * Q_BLOCK
    k_idx = jnp.arange(S, dtype=jnp.int32)

    def attend(args):
        qb, start = args
        s = jnp.einsum('bqhd,bkhd->bhqk', qb, k).astype(jnp.float32) * scale
        q_idx = start + jnp.arange(Q_BLOCK, dtype=jnp.int32)
        s = jnp.where(k_idx[None, :] <= q_idx[:, None], s, jnp.finfo(jnp.float32).min)
        p = jax.nn.softmax(s, axis=-1).astype(v.dtype)
        return jnp.einsum('bhqk,bkhv->bqhv', p, v)

    o = lax.map(attend, (q_blocks, starts))
    o = o.transpose(1, 0, 2, 3, 4).reshape(B, S, MLA_WIDTH)
    return (o * jax.nn.silu(gate)) @ w_out


def setup_inputs(seed: int = 0) -> dict:
    key = jax.random.key(seed)
    ks = jax.random.split(key, 16)

    def w(k, shape):
        return jax.random.normal(k, shape, jnp.float32) * (shape[0] ** -0.5)

    def gain(k, n):
        return 1.0 + 0.05 * jax.random.normal(k, (n,), jnp.float32)

    x = jax.random.normal(ks[0], (BATCH, SEQ, D_MODEL), jnp.float32)
    positions = jnp.broadcast_to(jnp.arange(SEQ, dtype=jnp.int32)[None, :], (BATCH, SEQ))
    return {
        "x": x,
        "positions": positions,
        "l0_pre_norm": gain(ks[1], D_MODEL),
        "l0_gla_w_in": w(ks[2], (D_MODEL, GLA_IN)),
        "l0_gla_w_gk2": w(ks[3], (GLA_GATE_RANK, GLA_QK)),
        "l0_gla_b_gk": 0.1 * jax.random.normal(ks[4], (GLA_QK,), jnp.float32),
        "l0_gla_g_onorm": gain(ks[5], GLA_DV),
        "l0_gla_w_out": w(ks[6], (GLA_V, D_MODEL)),
        "l0_post_norm": gain(ks[7], D_MODEL),
        "l1_pre_norm": gain(ks[8], D_MODEL),
        "l1_mla_w_in": w(ks[9], (D_MODEL, MLA_IN)),
        "l1_mla_g_qa": gain(ks[10], MLA_Q_RANK),
        "l1_mla_w_qb": w(ks[11], (MLA_Q_RANK, MLA_HEADS * (MLA_NOPE + MLA_ROPE))),
        "l1_mla_g_kva": gain(ks[12], MLA_KV_RANK),
        "l1_mla_w_kvb": w(ks[13], (MLA_KV_RANK, MLA_HEADS * (MLA_NOPE + MLA_V))),
        "l1_mla_w_out": w(ks[14], (MLA_WIDTH, D_MODEL)),
        "l1_post_norm": gain(ks[15], D_MODEL),
    }


def reference(x, positions,
              l0_pre_norm, l0_gla_w_in, l0_gla_w_gk2, l0_gla_b_gk, l0_gla_g_onorm, l0_gla_w_out,
              l0_post_norm,
              l1_pre_norm, l1_mla_w_in, l1_mla_g_qa, l1_mla_w_qb, l1_mla_g_kva, l1_mla_w_kvb,
              l1_mla_w_out, l1_post_norm):
    layers = [
        (l0_pre_norm, (l0_gla_w_in, l0_gla_w_gk2, l0_gla_b_gk, l0_gla_g_onorm, l0_gla_w_out),
         l0_post_norm),
        (l1_pre_norm, (l1_mla_w_in, l1_mla_g_qa, l1_mla_w_qb, l1_mla_g_kva, l1_mla_w_kvb,
                       l1_mla_w_out), l1_post_norm),
    ]
    for i in range(DEPTH):
        g_pre, params, g_post = layers[i]
        h = rms_norm(x, g_pre)
        if i % N_MIXERS == 0:
            y = gla_mixer(h, *params)
        else:
            y = mla_mixer(h, positions, *params)
        x = x + rms_norm(y, g_post)
    return x
```

```cpp
#include <hip/hip_runtime.h>
#include <hip/hip_cooperative_groups.h>
#include <stdint.h>
#include <math.h>
#include <stdio.h>
namespace cg = cooperative_groups;

#ifndef MEGA
#define MEGA 1
#endif

typedef __attribute__((ext_vector_type(8))) short bf16x8;
typedef __attribute__((ext_vector_type(4))) short s16x4;
typedef __attribute__((ext_vector_type(16))) float f32x16;
typedef unsigned short bf16_t;
#define DI __device__ __forceinline__
#define MFMA32(a, b, c) __builtin_amdgcn_mfma_f32_32x32x16_bf16((a), (b), (c), 0, 0, 0)

constexpr int S_ = 8192;
constexpr size_t MiB = (size_t)1 << 20;
constexpr size_t OFF_WIN0T = 0;
constexpr size_t OFF_WOUT0T = 25 * MiB;
constexpr size_t OFF_WIN1T = 33 * MiB;
constexpr size_t OFF_WQBT = 46 * MiB;
constexpr size_t OFF_WKVBT = 49 * MiB;
constexpr size_t OFF_WOUT1T = 53 * MiB;
constexpr size_t OFF_GKLOW = 61 * MiB;
constexpr size_t OFF_DECAY = 61 * MiB + 512 * 1024;
constexpr size_t OFF_CS = 62 * MiB;
constexpr size_t OFF_H = 64 * MiB;
constexpr size_t OFF_QK0 = 96 * MiB;
constexpr size_t OFF_V0T = 128 * MiB;
constexpr size_t OFF_G0 = 160 * MiB;
constexpr size_t OFF_Y = 128 * MiB;
constexpr size_t OFF_QE = 192 * MiB;
constexpr size_t OFF_KLT = 208 * MiB;
constexpr size_t OFF_AM = 224 * MiB;
constexpr size_t OFF_CQ = 0;
constexpr size_t OFF_CKV = 8 * MiB;
constexpr size_t OFF_KR = 16 * MiB;
constexpr size_t OFF_RINVQ = 17 * MiB;
constexpr size_t OFF_RINVKV = 17 * MiB + 64 * 1024;
constexpr size_t OFF_KRRAW = 18 * MiB;
constexpr size_t OFF_CTR = 20 * MiB;
constexpr size_t OFF_BAR = 255 * MiB;
constexpr size_t OFF_SL = 64 * MiB;
constexpr size_t OFF_DC = 80 * MiB;
constexpr size_t OFF_Q = 128 * MiB;
constexpr size_t OFF_KN = 176 * MiB;
constexpr size_t OFF_VT = 208 * MiB;

struct Params {
  const float* x; const int* pos; const float* l0_pre; const float* w_in0; const float* w_gk2; const float* b_gk;
  const float* g_onorm; const float* w_out0; const float* l0_post; const float* l1_pre; const float* w_in1;
  const float* g_qa; const float* w_qb; const float* g_kva; const float* w_kvb; const float* w_out1; const float* l1_post;
  float* out; char* ws;
  float invf[32];
};

DI int tid_opaque() { int t = threadIdx.x; asm volatile("" : "+v"(t)); return t; }
#define TID tid_opaque()
typedef __attribute__((address_space(1))) char gchar_t;
DI char* opaque_ptr(char* q) {
  unsigned long long v = (unsigned long long)q;
  unsigned lo = __builtin_amdgcn_readfirstlane((unsigned)v), hi = __builtin_amdgcn_readfirstlane((unsigned)(v >> 32));
  asm volatile("" : "+s"(lo), "+s"(hi));
  return (char*)(gchar_t*)(((unsigned long long)hi << 32) | lo);
}
typedef __bf16 hbf16x2 __attribute__((ext_vector_type(2)));
typedef float hf32x2 __attribute__((ext_vector_type(2)));
DI unsigned pack2(float a, float b) { hf32x2 f = {a, b}; return __builtin_bit_cast(unsigned, __builtin_convertvector(f, hbf16x2)); }
DI unsigned f2bf(float f) { return (unsigned)__builtin_bit_cast(unsigned short, (__bf16)f); }
DI float bf2f(unsigned h) { return __uint_as_float(h << 16); }
DI float bflo(unsigned u) { return __uint_as_float(u << 16); }
DI float bfhi(unsigned u) { return __uint_as_float(u & 0xffff0000u); }
DI int crow(int i, int h) { return (i & 3) + 8 * (i >> 2) + 4 * h; }
DI float silu(float v) { return v / (1.f + __expf(-v)); }
DI float wave_sum(float v) { for (int o = 32; o > 0; o >>= 1) v += __shfl_xor(v, o); return v; }
DI float block_sum(float v, float* red) {
  v = wave_sum(v);
  __syncthreads();
  if ((TID & 63) == 0) red[TID >> 6] = v;
  __syncthreads();
  return red[0] + red[1] + red[2] + red[3];
}
DI bf16x8 pack8(const f32x16& x, int s) {
  union { unsigned u[4]; bf16x8 v; } p;
  p.u[0] = pack2(x[8 * s + 0], x[8 * s + 1]); p.u[1] = pack2(x[8 * s + 2], x[8 * s + 3]);
  p.u[2] = pack2(x[8 * s + 4], x[8 * s + 5]); p.u[3] = pack2(x[8 * s + 6], x[8 * s + 7]);
  return p.v;
}

DI void transpose_tile4(const float* __restrict__ W, int K, int N, int ntN, const float* __restrict__ gain, bf16_t* __restrict__ WT,
                        int id0, char* smem) {
  const int t = TID;
  float v[4][16];
#pragma unroll
  for (int q = 0; q < 4; q++) {
    const int id = id0 + q, k0 = (id / ntN) * 64, n0 = (id % ntN) * 64;
#pragma unroll
    for (int i = 0; i < 16; i++) {
      const int kk = i * 4 + (t >> 6), n = n0 + (t & 63);
      float x = (n < N) ? W[(size_t)(k0 + kk) * N + n] : 0.f;
      if (gain) x *= gain[k0 + kk];
      v[q][i] = x;
    }
  }
#pragma unroll
  for (int q = 0; q < 4; q++) {
    unsigned short (*tile)[72] = (unsigned short (*)[72])(smem + q * 9216);
#pragma unroll
    for (int i = 0; i < 16; i++) tile[t & 63][i * 4 + (t >> 6)] = (unsigned short)f2bf(v[q][i]);
  }
  __syncthreads();
#pragma unroll
  for (int q = 0; q < 4; q++) {
    unsigned short (*tile)[72] = (unsigned short (*)[72])(smem + q * 9216);
    const int id = id0 + q, k0 = (id / ntN) * 64, n0 = (id % ntN) * 64;
    const int nn = t >> 2, kg = (t & 3) * 16;
    uint4 a = *(const uint4*)&tile[nn][kg];
    uint4 b = *(const uint4*)&tile[nn][kg + 8];
    bf16_t* dst = WT + (size_t)(n0 + nn) * K + k0 + kg;
    *(uint4*)dst = a; *(uint4*)(dst + 8) = b;
  }
  __syncthreads();
}

DI void phase_prep(const Params& p, char* smem, int bid, int nblk) {
  const int t = TID;
  char* ws = opaque_ptr(p.ws);
  for (int task = bid; task < 1920 + 3072; task += nblk) {
    if (task < 1920) {
      const int tile0 = task * 4;
      const float* W; const float* gain = nullptr; bf16_t* WT; int K, N, ntN, id;
      if (tile0 < 3136) { id = tile0; W = p.w_in0; K = 2048; N = 6160; ntN = 98; WT = (bf16_t*)(ws + OFF_WIN0T); }
      else if (tile0 < 4160) { id = tile0 - 3136; W = p.w_out0; K = 2048; N = 2048; ntN = 32; WT = (bf16_t*)(ws + OFF_WOUT0T); }
      else if (tile0 < 5760) { id = tile0 - 4160; W = p.w_in1; K = 2048; N = 3136; ntN = 50; WT = (bf16_t*)(ws + OFF_WIN1T); }
      else if (tile0 < 6144) { id = tile0 - 5760; W = p.w_qb; K = 512; N = 3072; ntN = 48; WT = (bf16_t*)(ws + OFF_WQBT); gain = p.g_qa; }
      else if (tile0 < 6656) { id = tile0 - 6144; W = p.w_kvb; K = 512; N = 4096; ntN = 64; WT = (bf16_t*)(ws + OFF_WKVBT); gain = p.g_kva; }
      else { id = tile0 - 6656; W = p.w_out1; K = 2048; N = 2048; ntN = 32; WT = (bf16_t*)(ws + OFF_WOUT1T); }
      transpose_tile4(W, K, N, ntN, gain, WT, id, smem);
    } else if (task < 1920 + 2048) {
      const int lane = t & 63, row = (task - 1920) * 4 + (t >> 6);
      const float4* xr = (const float4*)(p.x + (size_t)row * 2048) + lane;
      const float4* gr = (const float4*)p.l0_pre + lane;
      float4 xv[8];
#pragma unroll
      for (int j = 0; j < 8; j++) xv[j] = xr[j * 64];
      float ss = 0.f;
#pragma unroll
      for (int j = 0; j < 8; j++) ss += xv[j].x * xv[j].x + xv[j].y * xv[j].y + xv[j].z * xv[j].z + xv[j].w * xv[j].w;
      ss = wave_sum(ss);
      const float rinv = rsqrtf(ss * (1.f / 2048.f) + 1e-6f);
      uint2* hr = (uint2*)(ws + OFF_H + (size_t)row * 4096) + lane;
#pragma unroll
      for (int j = 0; j < 8; j++) {
        const float4 g = gr[j * 64];
        uint2 o; o.x = pack2(xv[j].x * rinv * g.x, xv[j].y * rinv * g.y); o.y = pack2(xv[j].z * rinv * g.z, xv[j].w * rinv * g.w);
        hr[j * 64] = o;
      }
    } else {
      const int idx = (task - 3968) * 256 + t;
      const int token = idx >> 5, i = idx & 31;
      double ang = (double)p.pos[token] * (double)p.invf[i];
      double tt = ang * 0.15915494309189535;
      tt -= floor(tt + 0.5);
      float f = (float)tt;
      float* cs = (float*)(ws + OFF_CS);
      cs[token * 64 + i] = __builtin_amdgcn_cosf(f);
      cs[token * 64 + 32 + i] = __builtin_amdgcn_sinf(f);
    }
  }
}

DI float sq8(const uint4& v) {
  return bflo(v.x) * bflo(v.x) + bfhi(v.x) * bfhi(v.x) + bflo(v.y) * bflo(v.y) + bfhi(v.y) * bfhi(v.y) + bflo(v.z) * bflo(v.z) + bfhi(v.z) * bfhi(v.z) +
         bflo(v.w) * bflo(v.w) + bfhi(v.w) * bfhi(v.w);
}
template <bool SWAP, bool SUMSQ = false>
DI void gemm_main(f32x16 (&acc)[4][2], const bf16_t* A, int lda, const bf16_t* B, int ldb, int K,
                  int m0, int n0, char* smem) {
  const int t = TID, lane = t & 63, w = t >> 6, wm = w >> 1, wn = w & 1, r = lane & 31, h = lane >> 5;
#pragma unroll
  for (int a = 0; a < 4; a++)
#pragma unroll
    for (int b = 0; b < 2; b++)
#pragma unroll
      for (int i = 0; i < 16; i++) acc[a][b][i] = 0.f;
  const int lrow = t >> 2, kc = t & 3;
  const bf16_t* ag = A + (size_t)(m0 + lrow) * lda + kc * 8;
  const bf16_t* bg = B + (size_t)(n0 + lrow) * ldb + kc * 8;
  const int lds_w = lrow * 64 + ((kc ^ ((lrow >> 2) & 3)) << 4);
  uint4 pa0, pa1, pa2, pa3, pb0, pb1;
  bf16x8 fa0, fa1, fa2, fa3, fa4, fa5, fb0, fb1, fb2, fb3, fb4, fb5;
#define G_LOAD(X, ko_)                                                                                   \
  X##a0 = *(const uint4*)(ag + (ko_)); X##a1 = *(const uint4*)(ag + (size_t)64 * lda + (ko_));           \
  X##a2 = *(const uint4*)(ag + (size_t)128 * lda + (ko_)); X##a3 = *(const uint4*)(ag + (size_t)192 * lda + (ko_)); \
  X##b0 = *(const uint4*)(bg + (ko_)); X##b1 = *(const uint4*)(bg + (size_t)64 * ldb + (ko_));
#define L_STORE(X, base_)                                                                                \
  *(uint4*)((base_) + lds_w) = X##a0; *(uint4*)((base_) + lds_w + 4096) = X##a1;                         \
  *(uint4*)((base_) + lds_w + 8192) = X##a2; *(uint4*)((base_) + lds_w + 12288) = X##a3;                 \
  *(uint4*)((base_) + 16384 + lds_w) = X##b0; *(uint4*)((base_) + 16384 + lds_w + 4096) = X##b1;         \
  if (SUMSQ) { q0 += sq8(X##a0); q1 += sq8(X##a1); q2 += sq8(X##a2); q3 += sq8(X##a3); }
#define G_READ(F, base_, c_)                                                                             \
  F##0 = *(const bf16x8*)((base_) + a_off + (c_)); F##1 = *(const bf16x8*)((base_) + a_off + 32 * 64 + (c_));              \
  F##2 = *(const bf16x8*)((base_) + a_off + 64 * 64 + (c_)); F##3 = *(const bf16x8*)((base_) + a_off + 96 * 64 + (c_));    \
  F##4 = *(const bf16x8*)((base_) + b_off + (c_)); F##5 = *(const bf16x8*)((base_) + b_off + 32 * 64 + (c_));
#define G_MMA(a0, a1, a2, a3, b0, b1)                                                                    \
    if (SWAP) {                                                                                          \
      acc[0][0] = MFMA32(b0, a0, acc[0][0]); acc[0][1] = MFMA32(b1, a0, acc[0][1]);                      \
      acc[1][0] = MFMA32(b0, a1, acc[1][0]); acc[1][1] = MFMA32(b1, a1, acc[1][1]);                      \
      acc[2][0] = MFMA32(b0, a2, acc[2][0]); acc[2][1] = MFMA32(b1, a2, acc[2][1]);                      \
      acc[3][0] = MFMA32(b0, a3, acc[3][0]); acc[3][1] = MFMA32(b1, a3, acc[3][1]);                      \
    } else {                                                                                             \
      acc[0][0] = MFMA32(a0, b0, acc[0][0]); acc[0][1] = MFMA32(a0, b1, acc[0][1]);                      \
      acc[1][0] = MFMA32(a1, b0, acc[1][0]); acc[1][1] = MFMA32(a1, b1, acc[1][1]);                      \
      acc[2][0] = MFMA32(a2, b0, acc[2][0]); acc[2][1] = MFMA32(a2, b1, acc[2][1]);                      \
      acc[3][0] = MFMA32(a3, b0, acc[3][0]); acc[3][1] = MFMA32(a3, b1, acc[3][1]);                      \
    }
#define G_MMA6(F) G_MMA(F##0, F##1, F##2, F##3, F##4, F##5)
  float q0 = 0.f, q1 = 0.f, q2 = 0.f, q3 = 0.f;
  const int sw = (r >> 2) & 3;
  const int a_off = (wm * 128 + r) * 64, b_off = 16384 + (wn * 64 + r) * 64;
  const int c0 = (h ^ sw) << 4, c1 = ((2 + h) ^ sw) << 4;
  const int nk = K >> 5;
  G_LOAD(p, 0)
  L_STORE(p, smem)
  G_LOAD(p, 32)
  __syncthreads();
  G_READ(fa, smem, c0)
  G_READ(fb, smem, c1)
  G_MMA6(fa)
  asm volatile("" ::: "memory");
  __builtin_amdgcn_sched_barrier(0);
  L_STORE(p, smem + 24576)
  {
    const int kn = ((2 < nk) ? 2 : (nk - 1)) * 32;
    G_LOAD(p, kn)
  }
  __syncthreads();
  for (int kt = 0; kt < nk - 1; kt++) {
    const char* nb = smem + ((kt + 1) & 1) * 24576;
    G_READ(fa, nb, c0)
    G_MMA6(fb)
    G_READ(fb, nb, c1)
    G_MMA6(fa)
    __builtin_amdgcn_sched_group_barrier(0x100, 6, 0);
    __builtin_amdgcn_sched_group_barrier(0x008, 8, 0);
    __builtin_amdgcn_sched_group_barrier(0x100, 6, 0);
    __builtin_amdgcn_sched_group_barrier(0x008, 8, 0);
    asm volatile("" ::: "memory");
    __builtin_amdgcn_sched_barrier(0);
    if (kt + 2 < nk) {
      L_STORE(p, smem + (kt & 1) * 24576)
    }
    {
      const int kn = ((kt + 3 < nk) ? (kt + 3) : (nk - 1)) * 32;
      G_LOAD(p, kn)
    }
    __syncthreads();
  }
  G_MMA6(fb)
#undef G_LOAD
#undef L_STORE
#undef G_READ
#undef G_MMA
#undef G_MMA6
  if (SUMSQ) {
    q0 += __shfl_xor(q0, 1); q1 += __shfl_xor(q1, 1); q2 += __shfl_xor(q2, 1); q3 += __shfl_xor(q3, 1);
    q0 += __shfl_xor(q0, 2); q1 += __shfl_xor(q1, 2); q2 += __shfl_xor(q2, 2); q3 += __shfl_xor(q3, 2);
    if (kc == 0) {
      float* rf = (float*)(smem + 49152);
      const float ik = 1.f / (float)K;
      rf[lrow] = rsqrtf(q0 * ik + 1e-6f); rf[lrow + 64] = rsqrtf(q1 * ik + 1e-6f);
      rf[lrow + 128] = rsqrtf(q2 * ik + 1e-6f); rf[lrow + 192] = rsqrtf(q3 * ik + 1e-6f);
    }
    __syncthreads();
  }
}

#define EPI_LOOP_BEGIN                                                                                           \
  {                                                                                                              \
    const int lane_ = TID & 63, w_ = TID >> 6, wm_ = w_ >> 1, wn_ = w_ & 1, r_ = lane_ & 31, h_ = lane_ >> 5; \
    _Pragma("unroll") for (int mt = 0; mt < 4; mt++) _Pragma("unroll") for (int nt = 0; nt < 2; nt++)          \
        _Pragma("unroll") for (int i = 0; i < 16; i++) {                                                         \
      const float v = acc[mt][nt][i];
#define EPI_COORD_NS const int row = m0 + wm_ * 128 + mt * 32 + crow(i, h_); const int col = n0 + wn_ * 64 + nt * 32 + r_;
#define EPI_COORD_SW const int row = m0 + wm_ * 128 + mt * 32 + r_; const int col = n0 + wn_ * 64 + nt * 32 + crow(i, h_);
#define EPI_LOOP_END }}

DI void phase_gemm_in0(const Params& p, char* smem, int bid, int nblk) {
  char* ws = opaque_ptr(p.ws);
  const bf16_t* A = (const bf16_t*)(ws + OFF_H);
  const bf16_t* B = (const bf16_t*)(ws + OFF_WIN0T);
  bf16_t* QK = (bf16_t*)(ws + OFF_QK0);
  bf16_t* V0T = (bf16_t*)(ws + OFF_V0T);
  bf16_t* G0 = (bf16_t*)(ws + OFF_G0);
  float* GKL = (float*)(ws + OFF_GKLOW);
  for (int tile = bid; tile < 32 * 49; tile += nblk) {
    const int mi = tile & 31, ni = tile >> 5;
    const int m0 = mi * 256, n0 = ni * 128;
    f32x16 acc[4][2];
    if (ni >= 16 && ni < 32) {
      gemm_main<true>(acc, A, 2048, B, 2048, 2048, m0, n0, smem);
      EPI_LOOP_BEGIN EPI_COORD_SW
        V0T[(size_t)(col - 2048) * S_ + row] = (bf16_t)f2bf(v);
      EPI_LOOP_END
    } else {
      gemm_main<false>(acc, A, 2048, B, 2048, 2048, m0, n0, smem);
      if (ni < 16) {
        EPI_LOOP_BEGIN EPI_COORD_NS
          QK[(size_t)row * 2048 + col] = (bf16_t)f2bf(v);
        EPI_LOOP_END
      } else if (ni < 48) {
        EPI_LOOP_BEGIN EPI_COORD_NS
          G0[(size_t)row * 2048 + (col - 4096)] = (bf16_t)f2bf(silu(v));
        EPI_LOOP_END
      } else {
        EPI_LOOP_BEGIN EPI_COORD_NS
          if (col < 6160) GKL[(size_t)row * 16 + (col - 6144)] = v;
        EPI_LOOP_END
      }
    }
  }
}

DI void phase_gla_prep(const Params& p, char* smem, int bid, int nblk) {
  char* ws = opaque_ptr(p.ws);
  const int t = TID, lane = t & 63, w = t >> 6, r = lane & 31, h = lane >> 5;
  const bf16_t* QK = (const bf16_t*)(ws + OFF_QK0);
  const float* GKL = (const float*)(ws + OFF_GKLOW);
  bf16_t* QE = (bf16_t*)(ws + OFF_QE);
  bf16_t* KLT = (bf16_t*)(ws + OFF_KLT);
  bf16_t* AM = (bf16_t*)(ws + OFF_AM);
  float* DEC = (float*)(ws + OFF_DECAY);
  if (bid == 0 && t == 0) { ((int*)(ws + OFF_CTR))[0] = 0; ((int*)(ws + OFF_CTR))[1] = 0; }
  char* lq = smem;
  char* lk = smem + 32768;
  for (int tile = bid; tile < 512; tile += nblk) {
    const int n = tile >> 2, head = tile & 3, t0 = n * 64, d = t, col = head * 256 + d;
    float w2[16];
#pragma unroll
    for (int j = 0; j < 16; j++) w2[j] = p.w_gk2[j * 1024 + col];
    const float bias = p.b_gk[col];
    float b = 0.f;
#pragma unroll 8
    for (int c = 0; c < 64; c++) {
      const float4* gl = (const float4*)(GKL + (size_t)(t0 + c) * 16);
      float4 g0 = gl[0], g1 = gl[1], g2 = gl[2], g3 = gl[3];
      float gk = bias + g0.x * w2[0] + g0.y * w2[1] + g0.z * w2[2] + g0.w * w2[3] + g1.x * w2[4] + g1.y * w2[5] + g1.z * w2[6] + g1.w * w2[7]
               + g2.x * w2[8] + g2.y * w2[9] + g2.z * w2[10] + g2.w * w2[11] + g3.x * w2[12] + g3.y * w2[13] + g3.z * w2[14] + g3.w * w2[15];
      float la = (fminf(gk, 0.f) - __logf(1.f + __expf(-fabsf(gk)))) * (1.f / 16.f);
      b += la;
    }
    const float blast = b;
    DEC[(size_t)(n * 4 + head) * 256 + d] = __expf(blast);
    b = 0.f;
    const int dperm = (d & ~15) | ((d & 3) | ((d & 4) << 1) | ((d & 8) >> 1));
    for (int c8 = 0; c8 < 8; c8++) {
      float bj[8], qv[8], kv[8];
#pragma unroll
      for (int j = 0; j < 8; j++) {
        const int c = c8 * 8 + j;
        const float4* gl = (const float4*)(GKL + (size_t)(t0 + c) * 16);
        float4 g0 = gl[0], g1 = gl[1], g2 = gl[2], g3 = gl[3];
        float gk = bias + g0.x * w2[0] + g0.y * w2[1] + g0.z * w2[2] + g0.w * w2[3] + g1.x * w2[4] + g1.y * w2[5] + g1.z * w2[6] + g1.w * w2[7]
                 + g2.x * w2[8] + g2.y * w2[9] + g2.z * w2[10] + g2.w * w2[11] + g3.x * w2[12] + g3.y * w2[13] + g3.z * w2[14] + g3.w * w2[15];
        float la = (fminf(gk, 0.f) - __logf(1.f + __expf(-fabsf(gk)))) * (1.f / 16.f);
        b += la;
        bj[j] = b;
        qv[j] = bf2f(QK[(size_t)(t0 + c) * 2048 + col]);
        kv[j] = bf2f(QK[(size_t)(t0 + c) * 2048 + 1024 + col]);
      }
      unsigned klp[4];
#pragma unroll
      for (int j = 0; j < 8; j++) {
        const int c = c8 * 8 + j;
        const float qe = qv[j] * 0.0625f * __expf(bj[j]);
        const float ke = kv[j] * __expf(-bj[j]);
        const float kl = kv[j] * __expf(blast - bj[j]);
        const unsigned qeb = f2bf(qe), keb = f2bf(ke), klb = f2bf(kl);
        const int lo = c * 512 + ((((d >> 3) ^ (c & 15))) << 4) + (d & 7) * 2;
        *(unsigned short*)(lq + lo) = (unsigned short)qeb;
        *(unsigned short*)(lk + lo) = (unsigned short)keb;
        QE[(size_t)(t0 + c) * 1024 + head * 256 + dperm] = (bf16_t)qeb;
        if (j & 1) klp[j >> 1] |= klb << 16; else klp[j >> 1] = klb;
      }
      uint4 o; o.x = klp[0]; o.y = klp[1]; o.z = klp[2]; o.w = klp[3];
      *(uint4*)(KLT + (size_t)(head * 256 + d) * S_ + t0 + c8 * 8) = o;
    }
    __syncthreads();
    {
      const int ct = w >> 1, st = w & 1;
      f32x16 acc;
#pragma unroll
      for (int i = 0; i < 16; i++) acc[i] = 0.f;
      if (!(ct == 0 && st == 1)) {
        const int ra = ct * 32 + r, rb = st * 32 + r;
#pragma unroll
        for (int s = 0; s < 16; s++) {
          bf16x8 a = *(const bf16x8*)(lq + ra * 512 + (((2 * s + h) ^ (ra & 15)) << 4));
          bf16x8 bb = *(const bf16x8*)(lk + rb * 512 + (((2 * s + h) ^ (rb & 15)) << 4));
          acc = MFMA32(a, bb, acc);
        }
      }
      bf16_t* ap = AM + (size_t)(n * 4 + head) * 4096;
#pragma unroll
      for (int i = 0; i < 16; i++) {
        const int c = ct * 32 + crow(i, h), s = st * 32 + r;
        ap[c * 64 + s] = (bf16_t)f2bf(s <= c ? acc[i] : 0.f);
      }
    }
    __syncthreads();
  }
}

constexpr int SCAN_NG = 8, SCAN_GC = 16;
DI void phase_gla_local(const Params& p, char* smem, int bid, int nblk) {
  char* ws = opaque_ptr(p.ws);
  const int t = TID, lane = t & 63, w = t >> 6, r = lane & 31, h = lane >> 5;
  for (int item = bid; item < 64 * (SCAN_NG - 1); item += nblk) {
    const int grp = item >> 6, head = (item >> 4) & 3, dvt = item & 15, dv0 = dvt * 32;
    const int nb = grp * SCAN_GC;
    const bf16_t* v_p = (const bf16_t*)(ws + OFF_V0T) + (size_t)(head * 512 + dv0 + r) * S_ + nb * 64 + 8 * h;
    const bf16_t* kl_p = (const bf16_t*)(ws + OFF_KLT) + (size_t)(head * 256 + 64 * w + r) * S_ + nb * 64 + 8 * h;
    const float* dec_p = (const float*)(ws + OFF_DECAY) + (size_t)nb * 1024 + head * 256 + 64 * w + 4 * h;
    f32x16 St[2];
#pragma unroll
    for (int i = 0; i < 16; i++) { St[0][i] = 0.f; St[1][i] = 0.f; }
    bf16x8 klA[2][4], vfA[4], klB[2][4], vfB[4];
    float4 dcA[2][4], dcB[2][4];
#define LOC_LOAD(KL, VF, DC, n_)                                                                                 \
    {                                                                                                            \
      _Pragma("unroll") for (int s = 0; s < 4; s++) VF[s] = *(const bf16x8*)(v_p + (n_) * 64 + 16 * s);        \
      _Pragma("unroll") for (int dt = 0; dt < 2; dt++) {                                                         \
        _Pragma("unroll") for (int s = 0; s < 4; s++) KL[dt][s] = *(const bf16x8*)(kl_p + (size_t)dt * 32 * S_ + (n_) * 64 + 16 * s); \
        _Pragma("unroll") for (int g4 = 0; g4 < 4; g4++) DC[dt][g4] = *(const float4*)(dec_p + (size_t)(n_) * 1024 + dt * 32 + 8 * g4); \
      }                                                                                                          \
    }
#define LOC_STEP(KL, VF, DC)                                                                                     \
    {                                                                                                            \
      _Pragma("unroll") for (int dt = 0; dt < 2; dt++) {                                                         \
        _Pragma("unroll") for (int g4 = 0; g4 < 4; g4++) {                                                       \
          St[dt][4 * g4 + 0] *= DC[dt][g4].x; St[dt][4 * g4 + 1] *= DC[dt][g4].y;                                \
          St[dt][4 * g4 + 2] *= DC[dt][g4].z; St[dt][4 * g4 + 3] *= DC[dt][g4].w;                                \
        }                                                                                                        \
        _Pragma("unroll") for (int s = 0; s < 4; s++) St[dt] = MFMA32(KL[dt][s], VF[s], St[dt]);                 \
      }                                                                                                          \
    }
    LOC_LOAD(klA, vfA, dcA, 0)
    for (int n = 0; n < SCAN_GC; n += 2) {
      LOC_LOAD(klB, vfB, dcB, n + 1)
      LOC_STEP(klA, vfA, dcA)
      if (n + 2 < SCAN_GC) LOC_LOAD(klA, vfA, dcA, n + 2)
      LOC_STEP(klB, vfB, dcB)
    }
#undef LOC_LOAD
#undef LOC_STEP
    float* sl = (float*)(ws + OFF_SL) + ((size_t)((grp * 4 + head) * 16 + dvt) * 4 + w) * 2048 + lane;
#pragma unroll
    for (int dt = 0; dt < 2; dt++)
#pragma unroll
      for (int i = 0; i < 16; i++) sl[(dt * 16 + i) * 64] = St[dt][i];
    if (dvt == 0) {
      const float* dg = (const float*)(ws + OFF_DECAY) + (size_t)nb * 1024 + head * 256 + t;
      float pr = 1.f;
#pragma unroll 4
      for (int n = 0; n < SCAN_GC; n++) pr *= dg[(size_t)n * 1024];
      ((float*)(ws + OFF_DC))[(grp * 4 + head) * 256 + t] = pr;
    }
  }
}

DI void phase_gla_scan(const Params& p, char* smem, int bid, int nblk) {
  char* ws = opaque_ptr(p.ws);
  const int t = TID, lane = t & 63, w = t >> 6, r = lane & 31, h = lane >> 5;
  float* lo = (float*)smem;
  for (int item = bid; item < 64 * SCAN_NG; item += nblk) {
    const int grp = item >> 6, head = (item >> 4) & 3, dvt = item & 15, dv0 = dvt * 32;
    const int nb = grp * SCAN_GC, ne = nb + SCAN_GC;
    const bf16_t* qe_p = (const bf16_t*)(ws + OFF_QE) + (size_t)r * 1024 + head * 256 + 64 * w + 8 * h;
    const bf16_t* a_p = (const bf16_t*)(ws + OFF_AM) + (size_t)head * 4096 + (size_t)r * 64 + 16 * w + 8 * h;
    const bf16_t* v_p = (const bf16_t*)(ws + OFF_V0T) + (size_t)(head * 512 + dv0 + r) * S_ + 8 * h;
    const bf16_t* kl_p = (const bf16_t*)(ws + OFF_KLT) + (size_t)(head * 256 + 64 * w + r) * S_ + 8 * h;
    bf16_t* o_p = (bf16_t*)(ws + OFF_QK0) + (size_t)(t >> 2) * 2048 + head * 512 + dv0 + (t & 3) * 8;
    f32x16 St[2];
#pragma unroll
    for (int i = 0; i < 16; i++) { St[0][i] = 0.f; St[1][i] = 0.f; }
    for (int j = 0; j < grp; j++) {
      const float* slj = (const float*)(ws + OFF_SL) + ((size_t)((j * 4 + head) * 16 + dvt) * 4 + w) * 2048 + lane;
      const float* dcj = (const float*)(ws + OFF_DC) + (j * 4 + head) * 256 + 64 * w + 4 * h;
#pragma unroll
      for (int dt = 0; dt < 2; dt++)
#pragma unroll
        for (int g4 = 0; g4 < 4; g4++) {
          const float4 dv = *(const float4*)(dcj + 32 * dt + 8 * g4);
          St[dt][4 * g4 + 0] = St[dt][4 * g4 + 0] * dv.x + slj[(dt * 16 + 4 * g4 + 0) * 64];
          St[dt][4 * g4 + 1] = St[dt][4 * g4 + 1] * dv.y + slj[(dt * 16 + 4 * g4 + 1) * 64];
          St[dt][4 * g4 + 2] = St[dt][4 * g4 + 2] * dv.z + slj[(dt * 16 + 4 * g4 + 2) * 64];
          St[dt][4 * g4 + 3] = St[dt][4 * g4 + 3] * dv.w + slj[(dt * 16 + 4 * g4 + 3) * 64];
        }
    }
    qe_p += (size_t)nb * 64 * 1024; a_p += (size_t)nb * 4 * 4096; v_p += nb * 64; kl_p += nb * 64; o_p += (size_t)nb * 64 * 2048;
    bf16x8 qe[2][4], af[2], vf[4], kl[2][4];
    float* ldec = (float*)(smem + 32768);
    const float* dec_g = (const float*)(ws + OFF_DECAY) + (size_t)nb * 1024 + head * 256 + t;
#pragma unroll
    for (int ct = 0; ct < 2; ct++) {
#pragma unroll
      for (int s = 0; s < 4; s++) qe[ct][s] = *(const bf16x8*)(qe_p + (size_t)ct * 32 * 1024 + 16 * s);
      af[ct] = *(const bf16x8*)(a_p + ct * 32 * 64);
    }
#pragma unroll
    for (int s = 0; s < 4; s++) vf[s] = *(const bf16x8*)(v_p + 16 * s);
#pragma unroll
    for (int dt = 0; dt < 2; dt++) {
#pragma unroll
      for (int s = 0; s < 4; s++) kl[dt][s] = *(const bf16x8*)(kl_p + (size_t)dt * 32 * S_ + 16 * s);
    }
    __syncthreads();
    ldec[t] = dec_g[0];
    __syncthreads();
    for (int n = 0; n < SCAN_GC; n++) {
      const bool more = (n + 1 < SCAN_GC);
      float decn = 0.f;
      if (more) decn = dec_g[(size_t)(n + 1) * 1024];
      f32x16 o[2];
#pragma unroll
      for (int i = 0; i < 16; i++) { o[0][i] = 0.f; o[1][i] = 0.f; }
#pragma unroll
      for (int s = 0; s < 4; s++) {
        bf16x8 sb = pack8(St[s >> 1], s & 1);
        o[0] = MFMA32(qe[0][s], sb, o[0]);
        o[1] = MFMA32(qe[1][s], sb, o[1]);
      }
      if (more) {
        const bf16_t* q2 = qe_p + (size_t)(n + 1) * 64 * 1024;
#pragma unroll
        for (int ct = 0; ct < 2; ct++)
#pragma unroll
          for (int s = 0; s < 4; s++) qe[ct][s] = *(const bf16x8*)(q2 + (size_t)ct * 32 * 1024 + 16 * s);
      }
      {
        bf16x8 vw = (w == 0) ? vf[0] : (w == 1) ? vf[1] : (w == 2) ? vf[2] : vf[3];
        o[0] = MFMA32(af[0], vw, o[0]);
        o[1] = MFMA32(af[1], vw, o[1]);
      }
      if (more) {
        const bf16_t* a2 = a_p + (size_t)(n + 1) * 4 * 4096;
        af[0] = *(const bf16x8*)(a2); af[1] = *(const bf16x8*)(a2 + 32 * 64);
      }
#pragma unroll
      for (int dt = 0; dt < 2; dt++) {
#pragma unroll
        for (int g = 0; g < 4; g++) {
          const float4 dv = *(const float4*)(ldec + (n & 1) * 256 + 64 * w + 32 * dt + 8 * g + 4 * h);
          St[dt][4 * g + 0] *= dv.x; St[dt][4 * g + 1] *= dv.y;
          St[dt][4 * g + 2] *= dv.z; St[dt][4 * g + 3] *= dv.w;
        }
#pragma unroll
        for (int s = 0; s < 4; s++) St[dt] = MFMA32(kl[dt][s], vf[s], St[dt]);
      }
      if (more) {
        const int tn = (n + 1) * 64;
#pragma unroll
        for (int s = 0; s < 4; s++) vf[s] = *(const bf16x8*)(v_p + tn + 16 * s);
#pragma unroll
        for (int dt = 0; dt < 2; dt++) {
#pragma unroll
          for (int s = 0; s < 4; s++) kl[dt][s] = *(const bf16x8*)(kl_p + (size_t)dt * 32 * S_ + tn + 16 * s);
        }
      }
      ldec[((n + 1) & 1) * 256 + t] = decn;
#pragma unroll
      for (int ct = 0; ct < 2; ct++)
#pragma unroll
        for (int i = 0; i < 16; i++) lo[(w * 64 + ct * 32 + crow(i, h)) * 32 + r] = o[ct][i];
      __syncthreads();
      {
        const int c = t >> 2, vg = (t & 3) * 8;
        float4 s0 = *(const float4*)(lo + c * 32 + vg), s1 = *(const float4*)(lo + c * 32 + vg + 4);
#pragma unroll
        for (int ww = 1; ww < 4; ww++) {
          float4 x0 = *(const float4*)(lo + (ww * 64 + c) * 32 + vg), x1 = *(const float4*)(lo + (ww * 64 + c) * 32 + vg + 4);
          s0.x += x0.x; s0.y += x0.y; s0.z += x0.z; s0.w += x0.w; s1.x += x1.x; s1.y += x1.y; s1.z += x1.z; s1.w += x1.w;
        }
        uint4 ov; ov.x = pack2(s0.x, s0.y); ov.y = pack2(s0.z, s0.w); ov.z = pack2(s1.x, s1.y); ov.w = pack2(s1.z, s1.w);
        *(uint4*)(o_p + (size_t)n * 64 * 2048) = ov;
      }
      __syncthreads();
    }
  }
}

DI void phase_og(const Params& p, char* smem, int bid, int nblk) {
  char* ws = opaque_ptr(p.ws);
  const int t = TID, lane = t & 63, w = t >> 6;
  const bf16_t* O0 = (const bf16_t*)(ws + OFF_QK0);
  const bf16_t* G0 = (const bf16_t*)(ws + OFF_G0);
  bf16_t* OG = (bf16_t*)(ws + OFF_H);
  const float4* gp = (const float4*)(p.g_onorm + lane * 8);
  const float4 ga = gp[0], gb = gp[1];
  for (int token = bid; token < S_; token += nblk) {
    const size_t off = (size_t)token * 2048 + w * 512 + lane * 8;
    uint4 ov = *(const uint4*)(O0 + off);
    uint4 gv = *(const uint4*)(G0 + off);
    float f[8] = {bflo(ov.x), bfhi(ov.x), bflo(ov.y), bfhi(ov.y), bflo(ov.z), bfhi(ov.z), bflo(ov.w), bfhi(ov.w)};
    float ss = 0.f;
#pragma unroll
    for (int j = 0; j < 8; j++) ss += f[j] * f[j];
    ss = wave_sum(ss);
    const float rinv = rsqrtf(ss * (1.f / 512.f) + 1e-6f);
    uint4 o;
    o.x = pack2(f[0] * rinv * ga.x * bflo(gv.x), f[1] * rinv * ga.y * bfhi(gv.x));
    o.y = pack2(f[2] * rinv * ga.z * bflo(gv.y), f[3] * rinv * ga.w * bfhi(gv.y));
    o.z = pack2(f[4] * rinv * gb.x * bflo(gv.z), f[5] * rinv * gb.y * bfhi(gv.z));
    o.w = pack2(f[6] * rinv * gb.z * bflo(gv.w), f[7] * rinv * gb.w * bfhi(gv.w));
    *(uint4*)(OG + off) = o;
  }
}

DI void phase_gemm_out(const Params& p, char* smem, int bid, int nblk, size_t off_w) {
  char* ws = opaque_ptr(p.ws);
  const bf16_t* A = (const bf16_t*)(ws + OFF_H);
  const bf16_t* B = (const bf16_t*)(ws + off_w);
  bf16_t* Y = (bf16_t*)(ws + OFF_Y);
  for (int tile = bid; tile < 32 * 16; tile += nblk) {
    const int mi = tile & 31, ni = tile >> 5;
    const int m0 = mi * 256, n0 = ni * 128;
    f32x16 acc[4][2];
    gemm_main<false>(acc, A, 2048, B, 2048, 2048, m0, n0, smem);
    EPI_LOOP_BEGIN EPI_COORD_NS
      Y[(size_t)row * 2048 + col] = (bf16_t)f2bf(v);
    EPI_LOOP_END
  }
}

DI void phase_post0(const Params& p, char* smem, int bid, int nblk) {
  char* ws = opaque_ptr(p.ws);
  const int t = TID, lane = t & 63, w = t >> 6;
  const bf16_t* Y = (const bf16_t*)(ws + OFF_Y);
  const float4* gpo = (const float4*)p.l0_post + lane;
  const float4* gpr = (const float4*)p.l1_pre + lane;
  for (int row = bid * 4 + w; row < S_; row += nblk * 4) {
    const uint2* yr = (const uint2*)(Y + (size_t)row * 2048) + lane;
    const float4* xr = (const float4*)(p.x + (size_t)row * 2048) + lane;
    float4 yv[8], xv[8];
#pragma unroll
    for (int j = 0; j < 8; j++) { const uint2 u = yr[j * 64]; yv[j].x = bflo(u.x); yv[j].y = bfhi(u.x); yv[j].z = bflo(u.y); yv[j].w = bfhi(u.y); xv[j] = xr[j * 64]; }
    float ss = 0.f;
#pragma unroll
    for (int j = 0; j < 8; j++) ss += yv[j].x * yv[j].x + yv[j].y * yv[j].y + yv[j].z * yv[j].z + yv[j].w * yv[j].w;
    ss = wave_sum(ss);
    const float rinv = rsqrtf(ss * (1.f / 2048.f) + 1e-6f);
    float4* outr = (float4*)(p.out + (size_t)row * 2048) + lane;
    float s2 = 0.f;
#pragma unroll
    for (int j = 0; j < 8; j++) {
      const float4 g = gpo[j * 64];
      xv[j].x += yv[j].x * rinv * g.x; xv[j].y += yv[j].y * rinv * g.y; xv[j].z += yv[j].z * rinv * g.z; xv[j].w += yv[j].w * rinv * g.w;
      outr[j * 64] = xv[j];
      s2 += xv[j].x * xv[j].x + xv[j].y * xv[j].y + xv[j].z * xv[j].z + xv[j].w * xv[j].w;
    }
    s2 = wave_sum(s2);
    const float r2 = rsqrtf(s2 * (1.f / 2048.f) + 1e-6f);
    uint2* hr = (uint2*)(ws + OFF_H + (size_t)row * 4096) + lane;
#pragma unroll
    for (int j = 0; j < 8; j++) {
      const float4 g = gpr[j * 64];
      uint2 o; o.x = pack2(xv[j].x * r2 * g.x, xv[j].y * r2 * g.y); o.y = pack2(xv[j].z * r2 * g.z, xv[j].w * r2 * g.w);
      hr[j * 64] = o;
    }
  }
}

DI void phase_gemm_in1(const Params& p, char* smem, int bid, int nblk) {
  char* ws = opaque_ptr(p.ws);
  const bf16_t* A = (const bf16_t*)(ws + OFF_H);
  const bf16_t* B = (const bf16_t*)(ws + OFF_WIN1T);
  bf16_t* CQ = (bf16_t*)(ws + OFF_CQ);
  bf16_t* CKV = (bf16_t*)(ws + OFF_CKV);
  bf16_t* KR = (bf16_t*)(ws + OFF_KR);
  const float* cs = (const float*)(ws + OFF_CS);
  bf16_t* G1 = (bf16_t*)(ws + OFF_QK0);
  for (int tile = bid; tile < 32 * 25; tile += nblk) {
    const int mi = tile & 31, ni = tile >> 5;
    const int m0 = mi * 256, n0 = ni * 128;
    f32x16 acc[4][2];
    gemm_main<false>(acc, A, 2048, B, 2048, 2048, m0, n0, smem);
    if (ni < 4) {
      EPI_LOOP_BEGIN EPI_COORD_NS
        CQ[(size_t)row * 512 + col] = (bf16_t)f2bf(v);
      EPI_LOOP_END
    } else if (ni < 8) {
      EPI_LOOP_BEGIN EPI_COORD_NS
        CKV[(size_t)row * 512 + (col - 512)] = (bf16_t)f2bf(v);
      EPI_LOOP_END
    } else if (ni == 8 && ((TID >> 6) & 1) == 0) {
      const int lane_ = TID & 63, w_ = TID >> 6, wm_ = w_ >> 1, r_ = lane_ & 31, h_ = lane_ >> 5;
#pragma unroll
      for (int mt = 0; mt < 4; mt++)
#pragma unroll
        for (int i = 0; i < 16; i++) {
          const int row = m0 + wm_ * 128 + mt * 32 + crow(i, h_);
          const float t1 = acc[mt][0][i], t2 = acc[mt][1][i];
          const float c = cs[row * 64 + r_], sn = cs[row * 64 + 32 + r_];
          KR[(size_t)row * 64 + r_] = (bf16_t)f2bf(t1 * c - t2 * sn);
          KR[(size_t)row * 64 + 32 + r_] = (bf16_t)f2bf(t2 * c + t1 * sn);
        }
    } else {
      EPI_LOOP_BEGIN EPI_COORD_NS
        if (col < 3136) G1[(size_t)row * 2048 + (col - 1088)] = (bf16_t)f2bf(silu(v));
      EPI_LOOP_END
    }
  }
}

DI void phase_gemm_qkv(const Params& p, char* smem, int bid, int nblk) {
  char* ws = opaque_ptr(p.ws);
  const bf16_t* CQ = (const bf16_t*)(ws + OFF_CQ);
  const bf16_t* CKV = (const bf16_t*)(ws + OFF_CKV);
  const bf16_t* WQ = (const bf16_t*)(ws + OFF_WQBT);
  const bf16_t* WKV = (const bf16_t*)(ws + OFF_WKVBT);
  const float* cs = (const float*)(ws + OFF_CS);
  bf16_t* Q = (bf16_t*)(ws + OFF_Q);
  bf16_t* KN = (bf16_t*)(ws + OFF_KN);
  bf16_t* VT = (bf16_t*)(ws + OFF_VT);
  const float qscale = 0.07216878364870322f * 1.4426950408889634f;
  const int ntq = 32 * 24, ntkv = 32 * 32;
  for (int tile = bid; tile < ntq + ntkv; tile += nblk) {
    f32x16 acc[4][2];
    if (tile < ntq) {
      const int mi = tile & 31, ni = tile >> 5;
      const int m0 = mi * 256, n0 = ni * 128;
      gemm_main<false, true>(acc, CQ, 512, WQ, 512, 512, m0, n0, smem);
      const float* rf = (const float*)(smem + 49152);
      const int lane_ = TID & 63, w_ = TID >> 6, wm_ = w_ >> 1, wn_ = w_ & 1, r_ = lane_ & 31, h_ = lane_ >> 5;
      const int cb = n0 + wn_ * 64;
      const int head = cb / 192, jb = cb - head * 192;
      if (jb == 128) {
#pragma unroll
        for (int mt = 0; mt < 4; mt++)
#pragma unroll
          for (int i = 0; i < 16; i++) {
            const int row = m0 + wm_ * 128 + mt * 32 + crow(i, h_);
            const float sc = rf[row - m0] * qscale;
            const float t1 = acc[mt][0][i] * sc, t2 = acc[mt][1][i] * sc;
            const float c = cs[row * 64 + r_], s = cs[row * 64 + 32 + r_];
            bf16_t* qp = Q + ((size_t)head * S_ + row) * 192 + 128;
            qp[r_] = (bf16_t)f2bf(t1 * c - t2 * s);
            qp[32 + r_] = (bf16_t)f2bf(t2 * c + t1 * s);
          }
      } else {
#pragma unroll
        for (int mt = 0; mt < 4; mt++)
#pragma unroll
          for (int nt = 0; nt < 2; nt++)
#pragma unroll
            for (int i = 0; i < 16; i++) {
              const int row = m0 + wm_ * 128 + mt * 32 + crow(i, h_);
              const float sc = rf[row - m0] * qscale;
              Q[((size_t)head * S_ + row) * 192 + jb + nt * 32 + r_] = (bf16_t)f2bf(acc[mt][nt][i] * sc);
            }
      }
    } else {
      const int tl = tile - ntq;
      const int mi = tl & 31, ni = tl >> 5;
      const int m0 = mi * 256, n0 = ni * 128;
      const int head = ni >> 1;
      if (ni & 1) {
        gemm_main<true, true>(acc, CKV, 512, WKV, 512, 512, m0, n0, smem);
        const float* rf = (const float*)(smem + 49152);
        EPI_LOOP_BEGIN EPI_COORD_SW
          const int j = col - head * 256 - 128;
          VT[((size_t)head * 128 + j) * S_ + row] = (bf16_t)f2bf(v * rf[row - m0]);
        EPI_LOOP_END
      } else {
        gemm_main<false, true>(acc, CKV, 512, WKV, 512, 512, m0, n0, smem);
        const float* rf = (const float*)(smem + 49152);
        EPI_LOOP_BEGIN EPI_COORD_NS
          const int j = col - head * 256;
          KN[((size_t)head * S_ + row) * 128 + j] = (bf16_t)f2bf(v * rf[row - m0]);
        EPI_LOOP_END
      }
    }
  }
}

DI void phase_attn(const Params& p, char* smem, int bid, int nblk, int rep) {
  char* ws = opaque_ptr(p.ws);
  const int t = TID, lane = t & 63, w = t >> 6, r = lane & 31, h = lane >> 5;
  const bf16_t* Q = (const bf16_t*)(ws + OFF_Q);
  const bf16_t* KN = (const bf16_t*)(ws + OFF_KN);
  const bf16_t* KR = (const bf16_t*)(ws + OFF_KR);
  const bf16_t* VT = (const bf16_t*)(ws + OFF_VT);
  const bf16_t* G1 = (const bf16_t*)(ws + OFF_QK0);
  bf16_t* OG = (bf16_t*)(ws + OFF_H);
  int* ctr = (int*)(ws + OFF_CTR) + rep;
  char* lk = smem;
  char* lv = smem + 25600;
  int* s_item = (int*)(smem + 43008);
  const int k_row = t >> 2, k_c0 = t & 3;
  const int v_row0 = t >> 3, v_kc = t & 7;
  for (;;) {
    __syncthreads();
    if (t == 0) *s_item = atomicAdd(ctr, 1);
    __syncthreads();
    const int item = *s_item;
    if (item >= 1024) break;
    const int qb = 63 - (item >> 4), head = item & 15;
    const int q0w = qb * 128 + w * 32;
    const int ntile = 2 * qb + 2;
    bf16x8 qf[12];
    {
      const bf16_t* qp = Q + ((size_t)head * S_ + q0w + r) * 192 + 8 * h;
#pragma unroll
      for (int s = 0; s < 12; s++) qf[s] = *(const bf16x8*)(qp + 16 * s);
    }
    f32x16 oacc[4];
#pragma unroll
    for (int vt = 0; vt < 4; vt++)
#pragma unroll
      for (int i = 0; i < 16; i++) oacc[vt][i] = 0.f;
    float m_run = -INFINITY, l_run = 0.f;
    uint4 kg0, kg1, kg2, kg3, kg4, kg5, vg0, vg1, vg2, vg3;
    const bf16_t* knp = KN + (size_t)head * S_ * 128;
    const bf16_t* vtp = VT + ((size_t)head * 128 + v_row0) * S_ + v_kc * 8;
#define ATT_LOAD(k0_)                                                                                         \
    {                                                                                                         \
      const bf16_t* kn_ = knp + (size_t)((k0_) + k_row) * 128 + k_c0 * 8;                                     \
      const bf16_t* kr_ = KR + (size_t)((k0_) + k_row) * 64 + k_c0 * 8;                                       \
      const bf16_t* vp_ = vtp + (k0_);                                                                        \
      kg0 = *(const uint4*)(kn_); kg1 = *(const uint4*)(kn_ + 32); kg2 = *(const uint4*)(kn_ + 64); kg3 = *(const uint4*)(kn_ + 96); \
      kg4 = *(const uint4*)(kr_); kg5 = *(const uint4*)(kr_ + 32);                                            \
      vg0 = *(const uint4*)(vp_); vg1 = *(const uint4*)(vp_ + (size_t)32 * S_);                               \
      vg2 = *(const uint4*)(vp_ + (size_t)64 * S_); vg3 = *(const uint4*)(vp_ + (size_t)96 * S_);             \
    }
    ATT_LOAD(0)
    for (int kt = 0; kt < ntile; kt++) {
      const int k0 = kt * 64;
      __syncthreads();
      {
        char* kd = lk + k_row * 400 + k_c0 * 16;
        *(uint4*)(kd) = kg0; *(uint4*)(kd + 64) = kg1; *(uint4*)(kd + 128) = kg2; *(uint4*)(kd + 192) = kg3;
        *(uint4*)(kd + 256) = kg4; *(uint4*)(kd + 320) = kg5;
        char* vd = lv + v_row0 * 136 + v_kc * 16;
#define VST(o_, v_) { uint2 u0, u1; u0.x = v_.x; u0.y = v_.y; u1.x = v_.z; u1.y = v_.w; *(uint2*)(vd + (o_)) = u0; *(uint2*)(vd + (o_) + 8) = u1; }
        VST(0, vg0) VST(32 * 136, vg1) VST(64 * 136, vg2) VST(96 * 136, vg3)
#undef VST
      }
      __syncthreads();
      { const int knext = (kt + 1 < ntile) ? k0 + 64 : k0; ATT_LOAD(knext) }
      if (k0 <= q0w + 31) {
        f32x16 sc[2];
#pragma unroll
        for (int i = 0; i < 16; i++) { sc[0][i] = 0.f; sc[1][i] = 0.f; }
#pragma unroll
        for (int s = 0; s < 12; s++) {
          bf16x8 a0 = *(const bf16x8*)(lk + r * 400 + h * 16 + s * 32);
          bf16x8 a1 = *(const bf16x8*)(lk + r * 400 + h * 16 + 32 * 400 + s * 32);
          sc[0] = MFMA32(a0, qf[s], sc[0]);
          sc[1] = MFMA32(a1, qf[s], sc[1]);
        }
        if (k0 + 63 > q0w) {
          const int qg = q0w + r;
#pragma unroll
          for (int mt = 0; mt < 2; mt++)
#pragma unroll
            for (int i = 0; i < 16; i++) {
              const int key = k0 + mt * 32 + crow(i, h);
              if (key > qg) sc[mt][i] = -INFINITY;
            }
        }
        float mx = sc[0][0];
#pragma unroll
        for (int i = 1; i < 16; i++) mx = fmaxf(mx, sc[0][i]);
#pragma unroll
        for (int i = 0; i < 16; i++) mx = fmaxf(mx, sc[1][i]);
        mx = fmaxf(mx, __shfl_xor(mx, 32));
        const float m_new = (mx > m_run + 8.f) ? mx : m_run;
        const bool resc = __any(m_new != m_run);
        const float alpha = __builtin_amdgcn_exp2f(m_run - m_new);
        m_run = m_new;
        float ls = 0.f;
#pragma unroll
        for (int mt = 0; mt < 2; mt++)
#pragma unroll
          for (int i = 0; i < 16; i++) { const float pv = __builtin_amdgcn_exp2f(sc[mt][i] - m_new); sc[mt][i] = pv; ls += pv; }
        l_run = l_run * alpha + ls;
        if (resc) {
#pragma unroll
          for (int vt = 0; vt < 4; vt++)
#pragma unroll
            for (int i = 0; i < 16; i++) oacc[vt][i] *= alpha;
        }
#pragma unroll
        for (int s = 0; s < 4; s++) {
          const bf16x8 pb = pack8(sc[s >> 1], s & 1);
#pragma unroll
          for (int vt = 0; vt < 4; vt++) {
            const char* vrow = lv + r * 136 + h * 8 + vt * 32 * 136 + s * 32;
            s16x4 lo4 = *(const s16x4*)(vrow);
            s16x4 hi4 = *(const s16x4*)(vrow + 16);
            bf16x8 a = __builtin_shufflevector(lo4, hi4, 0, 1, 2, 3, 4, 5, 6, 7);
            oacc[vt] = MFMA32(a, pb, oacc[vt]);
          }
        }
      }
    }
#undef ATT_LOAD
    const float l_tot = l_run + __shfl_xor(l_run, 32);
    const float inv = 1.f / l_tot;
    const size_t obase = (size_t)(q0w + r) * 2048 + head * 128;
#pragma unroll
    for (int vt = 0; vt < 4; vt++)
#pragma unroll
      for (int g = 0; g < 4; g++) {
        const int v = vt * 32 + 8 * g + 4 * h;
        uint2 gg = *(const uint2*)(G1 + obase + v);
        uint2 o;
        o.x = pack2(oacc[vt][4 * g + 0] * inv * bflo(gg.x), oacc[vt][4 * g + 1] * inv * bfhi(gg.x));
        o.y = pack2(oacc[vt][4 * g + 2] * inv * bflo(gg.y), oacc[vt][4 * g + 3] * inv * bfhi(gg.y));
        *(uint2*)(OG + obase + v) = o;
      }
  }
}

DI void phase_final(const Params& p, char* smem, int bid, int nblk) {
  char* ws = opaque_ptr(p.ws);
  const int t = TID, lane = t & 63, w = t >> 6;
  const bf16_t* Y = (const bf16_t*)(ws + OFF_Y);
  const float4* gpo = (const float4*)p.l1_post + lane;
  for (int row = bid * 4 + w; row < S_; row += nblk * 4) {
    const uint2* yr = (const uint2*)(Y + (size_t)row * 2048) + lane;
    float4* outr = (float4*)(p.out + (size_t)row * 2048) + lane;
    float4 yv[8], xv[8];
#pragma unroll
    for (int j = 0; j < 8; j++) { const uint2 u = yr[j * 64]; yv[j].x = bflo(u.x); yv[j].y = bfhi(u.x); yv[j].z = bflo(u.y); yv[j].w = bfhi(u.y); xv[j] = outr[j * 64]; }
    float ss = 0.f;
#pragma unroll
    for (int j = 0; j < 8; j++) ss += yv[j].x * yv[j].x + yv[j].y * yv[j].y + yv[j].z * yv[j].z + yv[j].w * yv[j].w;
    ss = wave_sum(ss);
    const float rinv = rsqrtf(ss * (1.f / 2048.f) + 1e-6f);
#pragma unroll
    for (int j = 0; j < 8; j++) {
      const float4 g = gpo[j * 64];
      xv[j].x += yv[j].x * rinv * g.x; xv[j].y += yv[j].y * rinv * g.y; xv[j].z += yv[j].z * rinv * g.z; xv[j].w += yv[j].w * rinv * g.w;
      outr[j * 64] = xv[j];
    }
  }
}

constexpr int NPHASE = 13;
constexpr unsigned DUP_MASK = 0u;
DI void run_phase(int ph, const Params& p, char* smem, int bid, int nblk, int rep) {
  switch (ph) {
    case 0: phase_prep(p, smem, bid, nblk); break;
    case 1: phase_gemm_in0(p, smem, bid, nblk); break;
    case 2: phase_gla_prep(p, smem, bid, nblk); break;
    case 3: phase_gla_local(p, smem, bid, nblk); break;
    case 4: phase_gla_scan(p, smem, bid, nblk); break;
    case 5: phase_og(p, smem, bid, nblk); break;
    case 6: phase_gemm_out(p, smem, bid, nblk, OFF_WOUT0T); break;
    case 7: phase_post0(p, smem, bid, nblk); break;
    case 8: phase_gemm_in1(p, smem, bid, nblk); break;
    case 9: phase_gemm_qkv(p, smem, bid, nblk); break;
    case 10: phase_attn(p, smem, bid, nblk, rep); break;
    case 11: phase_gemm_out(p, smem, bid, nblk, OFF_WOUT1T); break;
    case 12: phase_final(p, smem, bid, nblk); break;
  }
}

#define XB_TMO      128
#define XB_XCNT(j)  (256  + 64 * (j))
#define XB_XSUB(j)  (1280 + 64 * (j))
#define XB_XGEN(j)  (2304 + 64 * (j))
#define XB_TOP      3328
#define XB_TOPGEN   3392
#define XCD_BAR_WORDS 3456
#define XB_SPIN_CAP (1u << 20)
#define LAS __attribute__((address_space(3)))
DI unsigned xb_ld(unsigned* p) { return __hip_atomic_load(p, __ATOMIC_RELAXED, __HIP_MEMORY_SCOPE_AGENT); }
DI unsigned xb_add(unsigned* p, unsigned v) { return __hip_atomic_fetch_add(p, v, __ATOMIC_RELAXED, __HIP_MEMORY_SCOPE_AGENT); }
DI unsigned xb_xcc_id() { return (unsigned)__builtin_amdgcn_s_getreg((3 << 11) | 20) & 0xFu; }
#define XB_SPIN(cond, bar) do { unsigned _sp = 0; while (cond) { __builtin_amdgcn_s_sleep(1); \
    if ((++_sp & 255u) == 0u) { if (xb_ld(&(bar)[XB_TMO])) break; if (_sp > XB_SPIN_CAP) { atomicAdd(&(bar)[XB_TMO], 1u); break; } } } } while (0)
struct XcdBarrier { unsigned* bar; unsigned x; volatile LAS unsigned* st; };
DI XcdBarrier xcd_barrier_post(unsigned* bar, volatile LAS unsigned* st) {
  XcdBarrier b; b.bar = bar; b.x = xb_xcc_id(); b.st = st;
  if (threadIdx.x == 0) (void)xb_add(&bar[XB_XCNT(b.x)], 1u);
  return b;
}
DI void xcd_barrier_complete(unsigned* bar, unsigned x, unsigned& nloc, unsigned& nx) {
  const unsigned G = gridDim.x * gridDim.y * gridDim.z;
  unsigned sum, cnt, mine, sp = 0u;
  for (;;) {
    sum = 0u; cnt = 0u; mine = 0u;
#pragma unroll
    for (unsigned j = 0; j < 16; ++j) { const unsigned c = xb_ld(&bar[XB_XCNT(j)]); sum += c; cnt += (c > 0u) ? 1u : 0u; mine = (j == x) ? c : mine; }
    if (sum == G) break;
    __builtin_amdgcn_s_sleep(1);
    if ((++sp & 255u) == 0u) { if (xb_ld(&bar[XB_TMO])) break; if (sp > XB_SPIN_CAP) { atomicAdd(&bar[XB_TMO], 1u); break; } }
  }
  nloc = mine > 0u ? mine : 1u; nx = cnt > 0u ? cnt : 1u;
}
DI void xcd_barrier(const XcdBarrier& b) {
  asm volatile("s_waitcnt vmcnt(0)" ::: "memory");
  __syncthreads();
  if (threadIdx.x == 0) {
    unsigned* bar = b.bar;
    __builtin_amdgcn_s_waitcnt(0);
    unsigned nloc, nx;
    xcd_barrier_complete(bar, b.x, nloc, nx);
    const unsigned old = xb_add(&bar[XB_XSUB(b.x)], 1u);
    const unsigned gen = old / nloc;
    if (old + 1u == (gen + 1u) * nloc) {
      __builtin_amdgcn_fence(__ATOMIC_RELEASE, "agent");
      asm volatile("s_waitcnt vmcnt(0)" ::: "memory");
      const unsigned og = xb_add(&bar[XB_TOP], 1u);
      const unsigned tg = og / nx;
      if (og + 1u == (tg + 1u) * nx) xb_add(&bar[XB_TOPGEN], 1u);
      else XB_SPIN(xb_ld(&bar[XB_TOPGEN]) == tg, bar);
      __builtin_amdgcn_fence(__ATOMIC_ACQUIRE, "agent");
      xb_add(&bar[XB_XGEN(b.x)], 1u);
      asm volatile("s_waitcnt vmcnt(0)" ::: "memory");
    } else {
      XB_SPIN(xb_ld(&bar[XB_XGEN(b.x)]) == gen, bar);
      __builtin_amdgcn_fence(__ATOMIC_ACQUIRE, "agent");
      asm volatile("s_waitcnt vmcnt(0)" ::: "memory");
    }
  }
  __syncthreads();
}

#if MEGA
__global__ void __launch_bounds__(256, 2) mega_kernel(Params p) {
  __shared__ __attribute__((aligned(16))) char smem[65536];
  cg::grid_group grid = cg::this_grid();
  const int bid = blockIdx.x, nblk = gridDim.x;
  (void)xcd_barrier_post((unsigned*)(p.ws + OFF_BAR), (volatile LAS unsigned*)0);
#pragma nounroll
  for (int ph = 0; ph < NPHASE; ph++) {
    int phv = ph;
    asm volatile("" : "+s"(phv));
    run_phase(phv, p, smem, bid, nblk, 0);
    if (p.ws == nullptr) grid.sync();
    { XcdBarrier xb; xb.bar = (unsigned*)(opaque_ptr(p.ws) + OFF_BAR); xb.x = xb_xcc_id(); xb.st = (volatile LAS unsigned*)0; xcd_barrier(xb); }
    if ((DUP_MASK >> ph) & 1u) {
      run_phase(phv, p, smem, bid, nblk, 1);
      { XcdBarrier xb; xb.bar = (unsigned*)(opaque_ptr(p.ws) + OFF_BAR); xb.x = xb_xcc_id(); xb.st = (volatile LAS unsigned*)0; xcd_barrier(xb); }
    }
  }
}
#endif

#if !MEGA
template <int PH>
__global__ void __launch_bounds__(256, 2) phase_kernel_t(Params p) {
  __shared__ __attribute__((aligned(16))) char smem[65536];
  run_phase(PH, p, smem, blockIdx.x, gridDim.x, 0);
}
#endif

extern "C" void kernel_launch(void* const* d_in, const int* in_sizes, int n_in, void* d_out, int out_size, void* d_ws,
                              size_t ws_size, hipStream_t stream) {
  Params p{};
  p.x = (const float*)d_in[0]; p.pos = (const int*)d_in[1]; p.l0_pre = (const float*)d_in[2]; p.w_in0 = (const float*)d_in[3];
  p.w_gk2 = (const float*)d_in[4]; p.b_gk = (const float*)d_in[5]; p.g_onorm = (const float*)d_in[6]; p.w_out0 = (const float*)d_in[7];
  p.l0_post = (const float*)d_in[8]; p.l1_pre = (const float*)d_in[9]; p.w_in1 = (const float*)d_in[10]; p.g_qa = (const float*)d_in[11];
  p.w_qb = (const float*)d_in[12]; p.g_kva = (const float*)d_in[13]; p.w_kvb = (const float*)d_in[14]; p.w_out1 = (const float*)d_in[15];
  p.l1_post = (const float*)d_in[16];
  p.out = (float*)d_out; p.ws = (char*)d_ws;
  for (int i = 0; i < 32; i++) p.invf[i] = (float)pow(10000.0, -(double)i / 32.0);
#if MEGA
  static int grid_blocks = 0;
  if (!grid_blocks) {
    int dev = 0, cus = 0, per_cu = 0;
    hipGetDevice(&dev);
    hipDeviceGetAttribute(&cus, hipDeviceAttributeMultiprocessorCount, dev);
    hipOccupancyMaxActiveBlocksPerMultiprocessor(&per_cu, mega_kernel, 256, 0);
    if (per_cu > 2) per_cu = 2;
    if (per_cu < 1) per_cu = 1;
    grid_blocks = cus * per_cu;
  }
  hipMemsetAsync((char*)d_ws + OFF_BAR, 0, XCD_BAR_WORDS * 4, stream);
  void* args[] = {&p};
  hipError_t e = hipLaunchCooperativeKernel((void*)mega_kernel, dim3(grid_blocks), dim3(256), args, 0, stream);
  if (e != hipSuccess) fprintf(stderr, "cooperative launch failed: %s (grid %d)\n", hipGetErrorString(e), grid_blocks);
#else
#define LPH(N) hipLaunchKernelGGL(phase_kernel_t<N>, dim3(512), dim3(256), 0, stream, p);
  LPH(0) LPH(1) LPH(2) LPH(3) LPH(4) LPH(5) LPH(6) LPH(7) LPH(8) LPH(9) LPH(10) LPH(11) LPH(12)
#undef LPH
#endif
}
```

```cpp
#include <hip/hip_runtime.h>
#include <hip/hip_cooperative_groups.h>
#include <stdint.h>
#include <math.h>
#include <stdio.h>
namespace cg = cooperative_groups;

#ifndef MEGA
#define MEGA 1
#endif

typedef __attribute__((ext_vector_type(8))) short bf16x8;
typedef __attribute__((ext_vector_type(4))) short s16x4;
typedef __attribute__((ext_vector_type(16))) float f32x16;
typedef unsigned short bf16_t;
#define DI __device__ __forceinline__
#define MFMA32(a, b, c) __builtin_amdgcn_mfma_f32_32x32x16_bf16((a), (b), (c), 0, 0, 0)

constexpr int S_ = 8192;
constexpr size_t MiB = (size_t)1 << 20;
constexpr size_t OFF_WIN0T = 0;
constexpr size_t OFF_WOUT0T = 25 * MiB;
constexpr size_t OFF_WIN1T = 33 * MiB;
constexpr size_t OFF_WQBT = 46 * MiB;
constexpr size_t OFF_WKVBT = 49 * MiB;
constexpr size_t OFF_WOUT1T = 53 * MiB;
constexpr size_t OFF_GKLOW = 61 * MiB;
constexpr size_t OFF_DECAY = 61 * MiB + 512 * 1024;
constexpr size_t OFF_CS = 62 * MiB;
constexpr size_t OFF_H = 64 * MiB;
constexpr size_t OFF_QK0 = 96 * MiB;
constexpr size_t OFF_V0T = 128 * MiB;
constexpr size_t OFF_G0 = 160 * MiB;
constexpr size_t OFF_Y = 128 * MiB;
constexpr size_t OFF_QE = 192 * MiB;
constexpr size_t OFF_KLT = 208 * MiB;
constexpr size_t OFF_AM = 224 * MiB;
constexpr size_t OFF_CQ = 0;
constexpr size_t OFF_CKV = 8 * MiB;
constexpr size_t OFF_KR = 16 * MiB;
constexpr size_t OFF_RINVQ = 17 * MiB;
constexpr size_t OFF_RINVKV = 17 * MiB + 64 * 1024;
constexpr size_t OFF_KRRAW = 18 * MiB;
constexpr size_t OFF_CTR = 20 * MiB;
constexpr size_t OFF_BAR = 255 * MiB;
constexpr size_t OFF_SL = 64 * MiB;
constexpr size_t OFF_DC = 80 * MiB;
constexpr size_t OFF_Q = 128 * MiB;
constexpr size_t OFF_KN = 176 * MiB;
constexpr size_t OFF_VT = 208 * MiB;

struct Params {
  const float* x; const int* pos; const float* l0_pre; const float* w_in0; const float* w_gk2; const float* b_gk;
  const float* g_onorm; const float* w_out0; const float* l0_post; const float* l1_pre; const float* w_in1;
  const float* g_qa; const float* w_qb; const float* g_kva; const float* w_kvb; const float* w_out1; const float* l1_post;
  float* out; char* ws;
  float invf[32];
};

DI int tid_opaque() { int t = threadIdx.x; asm volatile("" : "+v"(t)); return t; }
#define TID tid_opaque()
typedef __attribute__((address_space(1))) char gchar_t;
DI char* opaque_ptr(char* q) {
  unsigned long long v = (unsigned long long)q;
  unsigned lo = __builtin_amdgcn_readfirstlane((unsigned)v), hi = __builtin_amdgcn_readfirstlane((unsigned)(v >> 32));
  asm volatile("" : "+s"(lo), "+s"(hi));
  return (char*)(gchar_t*)(((unsigned long long)hi << 32) | lo);
}
typedef __bf16 hbf16x2 __attribute__((ext_vector_type(2)));
typedef float hf32x2 __attribute__((ext_vector_type(2)));
DI unsigned pack2(float a, float b) { hf32x2 f = {a, b}; return __builtin_bit_cast(unsigned, __builtin_convertvector(f, hbf16x2)); }
DI unsigned f2bf(float f) { return (unsigned)__builtin_bit_cast(unsigned short, (__bf16)f); }
DI float bf2f(unsigned h) { return __uint_as_float(h << 16); }
DI float bflo(unsigned u) { return __uint_as_float(u << 16); }
DI float bfhi(unsigned u) { return __uint_as_float(u & 0xffff0000u); }
DI int crow(int i, int h) { return (i & 3) + 8 * (i >> 2) + 4 * h; }
DI float silu(float v) { return v / (1.f + __expf(-v)); }
DI float wave_sum(float v) { for (int o = 32; o > 0; o >>= 1) v += __shfl_xor(v, o); return v; }
DI float block_sum(float v, float* red) {
  v = wave_sum(v);
  __syncthreads();
  if ((TID & 63) == 0) red[TID >> 6] = v;
  __syncthreads();
  return red[0] + red[1] + red[2] + red[3];
}
DI bf16x8 pack8(const f32x16& x, int s) {
  union { unsigned u[4]; bf16x8 v; } p;
  p.u[0] = pack2(x[8 * s + 0], x[8 * s + 1]); p.u[1] = pack2(x[8 * s + 2], x[8 * s + 3]);
  p.u[2] = pack2(x[8 * s + 4], x[8 * s + 5]); p.u[3] = pack2(x[8 * s + 6], x[8 * s + 7]);
  return p.v;
}

DI void transpose_tile4(const float* __restrict__ W, int K, int N, int ntN, const float* __restrict__ gain, bf16_t* __restrict__ WT,
                        int id0, char* smem) {
  const int t = TID;
  float v[4][16];
#pragma unroll
  for (int q = 0; q < 4; q++) {
    const int id = id0 + q, k0 = (id / ntN) * 64, n0 = (id % ntN) * 64;
#pragma unroll
    for (int i = 0; i < 16; i++) {
      const int kk = i * 4 + (t >> 6), n = n0 + (t & 63);
      float x = (n < N) ? W[(size_t)(k0 + kk) * N + n] : 0.f;
      if (gain) x *= gain[k0 + kk];
      v[q][i] = x;
    }
  }
#pragma unroll
  for (int q = 0; q < 4; q++) {
    unsigned short (*tile)[72] = (unsigned short (*)[72])(smem + q * 9216);
#pragma unroll
    for (int i = 0; i < 16; i++) tile[t & 63][i * 4 + (t >> 6)] = (unsigned short)f2bf(v[q][i]);
  }
  __syncthreads();
#pragma unroll
  for (int q = 0; q < 4; q++) {
    unsigned short (*tile)[72] = (unsigned short (*)[72])(smem + q * 9216);
    const int id = id0 + q, k0 = (id / ntN) * 64, n0 = (id % ntN) * 64;
    const int nn = t >> 2, kg = (t & 3) * 16;
    uint4 a = *(const uint4*)&tile[nn][kg];
    uint4 b = *(const uint4*)&tile[nn][kg + 8];
    bf16_t* dst = WT + (size_t)(n0 + nn) * K + k0 + kg;
    *(uint4*)dst = a; *(uint4*)(dst + 8) = b;
  }
  __syncthreads();
}

DI void phase_prep(const Params& p, char* smem, int bid, int nblk) {
  const int t = TID;
  char* ws = opaque_ptr(p.ws);
  for (int task = bid; task < 1920 + 3072; task += nblk) {
    if (task < 1920) {
      const int tile0 = task * 4;
      const float* W; const float* gain = nullptr; bf16_t* WT; int K, N, ntN, id;
      if (tile0 < 3136) { id = tile0; W = p.w_in0; K = 2048; N = 6160; ntN = 98; WT = (bf16_t*)(ws + OFF_WIN0T); }
      else if (tile0 < 4160) { id = tile0 - 3136; W = p.w_out0; K = 2048; N = 2048; ntN = 32; WT = (bf16_t*)(ws + OFF_WOUT0T); }
      else if (tile0 < 5760) { id = tile0 - 4160; W = p.w_in1; K = 2048; N = 3136; ntN = 50; WT = (bf16_t*)(ws + OFF_WIN1T); }
      else if (tile0 < 6144) { id = tile0 - 5760; W = p.w_qb; K = 512; N = 3072; ntN = 48; WT = (bf16_t*)(ws + OFF_WQBT); gain = p.g_qa; }
      else if (tile0 < 6656) { id = tile0 - 6144; W = p.w_kvb; K = 512; N = 4096; ntN = 64; WT = (bf16_t*)(ws + OFF_WKVBT); gain = p.g_kva; }
      else { id = tile0 - 6656; W = p.w_out1; K = 2048; N = 2048; ntN = 32; WT = (bf16_t*)(ws + OFF_WOUT1T); }
      transpose_tile4(W, K, N, ntN, gain, WT, id, smem);
    } else if (task < 1920 + 2048) {
      const int lane = t & 63, row = (task - 1920) * 4 + (t >> 6);
      const float4* xr = (const float4*)(p.x + (size_t)row * 2048) + lane;
      const float4* gr = (const float4*)p.l0_pre + lane;
      float4 xv[8];
#pragma unroll
      for (int j = 0; j < 8; j++) xv[j] = xr[j * 64];
      float ss = 0.f;
#pragma unroll
      for (int j = 0; j < 8; j++) ss += xv[j].x * xv[j].x + xv[j].y * xv[j].y + xv[j].z * xv[j].z + xv[j].w * xv[j].w;
      ss = wave_sum(ss);
      const float rinv = rsqrtf(ss * (1.f / 2048.f) + 1e-6f);
      uint2* hr = (uint2*)(ws + OFF_H + (size_t)row * 4096) + lane;
#pragma unroll
      for (int j = 0; j < 8; j++) {
        const float4 g = gr[j * 64];
        uint2 o; o.x = pack2(xv[j].x * rinv * g.x, xv[j].y * rinv * g.y); o.y = pack2(xv[j].z * rinv * g.z, xv[j].w * rinv * g.w);
        hr[j * 64] = o;
      }
    } else {
      const int idx = (task - 3968) * 256 + t;
      const int token = idx >> 5, i = idx & 31;
      double ang = (double)p.pos[token] * (double)p.invf[i];
      double tt = ang * 0.15915494309189535;
      tt -= floor(tt + 0.5);
      float f = (float)tt;
      float* cs = (float*)(ws + OFF_CS);
      cs[token * 64 + i] = __builtin_amdgcn_cosf(f);
      cs[token * 64 + 32 + i] = __builtin_amdgcn_sinf(f);
    }
  }
}

DI float sq8(const uint4& v) {
  return bflo(v.x) * bflo(v.x) + bfhi(v.x) * bfhi(v.x) + bflo(v.y) * bflo(v.y) + bfhi(v.y) * bfhi(v.y) + bflo(v.z) * bflo(v.z) + bfhi(v.z) * bfhi(v.z) +
         bflo(v.w) * bflo(v.w) + bfhi(v.w) * bfhi(v.w);
}
template <bool SWAP, bool SUMSQ = false>
DI void gemm_main(f32x16 (&acc)[4][2], const bf16_t* A, int lda, const bf16_t* B, int ldb, int K,
                  int m0, int n0, char* smem) {
  const int t = TID, lane = t & 63, w = t >> 6, wm = w >> 1, wn = w & 1, r = lane & 31, h = lane >> 5;
#pragma unroll
  for (int a = 0; a < 4; a++)
#pragma unroll
    for (int b = 0; b < 2; b++)
#pragma unroll
      for (int i = 0; i < 16; i++) acc[a][b][i] = 0.f;
  const int lrow = t >> 2, kc = t & 3;
  const bf16_t* ag = A + (size_t)(m0 + lrow) * lda + kc * 8;
  const bf16_t* bg = B + (size_t)(n0 + lrow) * ldb + kc * 8;
  const int lds_w = lrow * 64 + ((kc ^ ((lrow >> 2) & 3)) << 4);
  uint4 pa0, pa1, pa2, pa3, pb0, pb1;
  bf16x8 fa0, fa1, fa2, fa3, fa4, fa5, fb0, fb1, fb2, fb3, fb4, fb5;
#define G_LOAD(X, ko_)                                                                                   \
  X##a0 = *(const uint4*)(ag + (ko_)); X##a1 = *(const uint4*)(ag + (size_t)64 * lda + (ko_));           \
  X##a2 = *(const uint4*)(ag + (size_t)128 * lda + (ko_)); X##a3 = *(const uint4*)(ag + (size_t)192 * lda + (ko_)); \
  X##b0 = *(const uint4*)(bg + (ko_)); X##b1 = *(const uint4*)(bg + (size_t)64 * ldb + (ko_));
#define L_STORE(X, base_)                                                                                \
  *(uint4*)((base_) + lds_w) = X##a0; *(uint4*)((base_) + lds_w + 4096) = X##a1;                         \
  *(uint4*)((base_) + lds_w + 8192) = X##a2; *(uint4*)((base_) + lds_w + 12288) = X##a3;                 \
  *(uint4*)((base_) + 16384 + lds_w) = X##b0; *(uint4*)((base_) + 16384 + lds_w + 4096) = X##b1;         \
  if (SUMSQ) { q0 += sq8(X##a0); q1 += sq8(X##a1); q2 += sq8(X##a2); q3 += sq8(X##a3); }
#define G_READ(F, base_, c_)                                                                             \
  F##0 = *(const bf16x8*)((base_) + a_off + (c_)); F##1 = *(const bf16x8*)((base_) + a_off + 32 * 64 + (c_));              \
  F##2 = *(const bf16x8*)((base_) + a_off + 64 * 64 + (c_)); F##3 = *(const bf16x8*)((base_) + a_off + 96 * 64 + (c_));    \
  F##4 = *(const bf16x8*)((base_) + b_off + (c_)); F##5 = *(const bf16x8*)((base_) + b_off + 32 * 64 + (c_));
#define G_MMA(a0, a1, a2, a3, b0, b1)                                                                    \
    if (SWAP) {                                                                                          \
      acc[0][0] = MFMA32(b0, a0, acc[0][0]); acc[0][1] = MFMA32(b1, a0, acc[0][1]);                      \
      acc[1][0] = MFMA32(b0, a1, acc[1][0]); acc[1][1] = MFMA32(b1, a1, acc[1][1]);                      \
      acc[2][0] = MFMA32(b0, a2, acc[2][0]); acc[2][1] = MFMA32(b1, a2, acc[2][1]);                      \
      acc[3][0] = MFMA32(b0, a3, acc[3][0]); acc[3][1] = MFMA32(b1, a3, acc[3][1]);                      \
    } else {                                                                                             \
      acc[0][0] = MFMA32(a0, b0, acc[0][0]); acc[0][1] = MFMA32(a0, b1, acc[0][1]);                      \
      acc[1][0] = MFMA32(a1, b0, acc[1][0]); acc[1][1] = MFMA32(a1, b1, acc[1][1]);                      \
      acc[2][0] = MFMA32(a2, b0, acc[2][0]); acc[2][1] = MFMA32(a2, b1, acc[2][1]);                      \
      acc[3][0] = MFMA32(a3, b0, acc[3][0]); acc[3][1] = MFMA32(a3, b1, acc[3][1]);                      \
    }
#define G_MMA6(F) G_MMA(F##0, F##1, F##2, F##3, F##4, F##5)
  float q0 = 0.f, q1 = 0.f, q2 = 0.f, q3 = 0.f;
  const int sw = (r >> 2) & 3;
  const int a_off = (wm * 128 + r) * 64, b_off = 16384 + (wn * 64 + r) * 64;
  const int c0 = (h ^ sw) << 4, c1 = ((2 + h) ^ sw) << 4;
  const int nk = K >> 5;
  G_LOAD(p, 0)
  L_STORE(p, smem)
  G_LOAD(p, 32)
  __syncthreads();
  G_READ(fa, smem, c0)
  G_READ(fb, smem, c1)
  G_MMA6(fa)
  asm volatile("" ::: "memory");
  __builtin_amdgcn_sched_barrier(0);
  L_STORE(p, smem + 24576)
  {
    const int kn = ((2 < nk) ? 2 : (nk - 1)) * 32;
    G_LOAD(p, kn)
  }
  __syncthreads();
  for (int kt = 0; kt < nk - 1; kt++) {
    const char* nb = smem + ((kt + 1) & 1) * 24576;
    G_READ(fa, nb, c0)
    G_MMA6(fb)
    G_READ(fb, nb, c1)
    G_MMA6(fa)
    __builtin_amdgcn_sched_group_barrier(0x100, 6, 0);
    __builtin_amdgcn_sched_group_barrier(0x008, 8, 0);
    __builtin_amdgcn_sched_group_barrier(0x100, 6, 0);
    __builtin_amdgcn_sched_group_barrier(0x008, 8, 0);
    asm volatile("" ::: "memory");
    __builtin_amdgcn_sched_barrier(0);
    if (kt + 2 < nk) {
      L_STORE(p, smem + (kt & 1) * 24576)
    }
    {
      const int kn = ((kt + 3 < nk) ? (kt + 3) : (nk - 1)) * 32;
      G_LOAD(p, kn)
    }
    __syncthreads();
  }
  G_MMA6(fb)
#undef G_LOAD
#undef L_STORE
#undef G_READ
#undef G_MMA
#undef G_MMA6
  if (SUMSQ) {
    q0 += __shfl_xor(q0, 1); q1 += __shfl_xor(q1, 1); q2 += __shfl_xor(q2, 1); q3 += __shfl_xor(q3, 1);
    q0 += __shfl_xor(q0, 2); q1 += __shfl_xor(q1, 2); q2 += __shfl_xor(q2, 2); q3 += __shfl_xor(q3, 2);
    if (kc == 0) {
      float* rf = (float*)(smem + 49152);
      const float ik = 1.f / (float)K;
      rf[lrow] = rsqrtf(q0 * ik + 1e-6f); rf[lrow + 64] = rsqrtf(q1 * ik + 1e-6f);
      rf[lrow + 128] = rsqrtf(q2 * ik + 1e-6f); rf[lrow + 192] = rsqrtf(q3 * ik + 1e-6f);
    }
    __syncthreads();
  }
}

#define EPI_LOOP_BEGIN                                                                                           \
  {                                                                                                              \
    const int lane_ = TID & 63, w_ = TID >> 6, wm_ = w_ >> 1, wn_ = w_ & 1, r_ = lane_ & 31, h_ = lane_ >> 5; \
    _Pragma("unroll") for (int mt = 0; mt < 4; mt++) _Pragma("unroll") for (int nt = 0; nt < 2; nt++)          \
        _Pragma("unroll") for (int i = 0; i < 16; i++) {                                                         \
      const float v = acc[mt][nt][i];
#define EPI_COORD_NS const int row = m0 + wm_ * 128 + mt * 32 + crow(i, h_); const int col = n0 + wn_ * 64 + nt * 32 + r_;
#define EPI_COORD_SW const int row = m0 + wm_ * 128 + mt * 32 + r_; const int col = n0 + wn_ * 64 + nt * 32 + crow(i, h_);
#define EPI_LOOP_END }}

DI void phase_gemm_in0(const Params& p, char* smem, int bid, int nblk) {
  char* ws = opaque_ptr(p.ws);
  const bf16_t* A = (const bf16_t*)(ws + OFF_H);
  const bf16_t* B = (const bf16_t*)(ws + OFF_WIN0T);
  bf16_t* QK = (bf16_t*)(ws + OFF_QK0);
  bf16_t* V0T = (bf16_t*)(ws + OFF_V0T);
  bf16_t* G0 = (bf16_t*)(ws + OFF_G0);
  float* GKL = (float*)(ws + OFF_GKLOW);
  for (int tile = bid; tile < 32 * 48; tile += nblk) {
    const int mi = tile & 31, ni = tile >> 5;
    const int m0 = mi * 256, n0 = ni * 128;
    f32x16 acc[4][2];
    if (ni >= 16) {
      if (ni < 32) {
        gemm_main<true>(acc, A, 2048, B, 2048, 2048, m0, n0, smem);
        EPI_LOOP_BEGIN EPI_COORD_SW
          V0T[(size_t)(col - 2048) * S_ + row] = (bf16_t)f2bf(v);
        EPI_LOOP_END
      } else {
        gemm_main<false>(acc, A, 2048, B, 2048, 2048, m0, n0, smem);
        EPI_LOOP_BEGIN EPI_COORD_NS
          G0[(size_t)row * 2048 + (col - 4096)] = (bf16_t)f2bf(silu(v));
        EPI_LOOP_END
      }
    } else {
      gemm_main<false>(acc, A, 2048, B, 2048, 2048, m0, n0, smem);
      EPI_LOOP_BEGIN EPI_COORD_NS
        QK[(size_t)row * 2048 + col] = (bf16_t)f2bf(v);
      EPI_LOOP_END
    }
  }
  {
    typedef __attribute__((ext_vector_type(4))) float f32x4_t;
    const int t = TID, lane = t & 63, w = t >> 6, l15 = lane & 15, quad = lane >> 4;
    float* red = (float*)smem;
    for (int item = bid; item < 512; item += nblk) {
      const bf16_t* ap = A + (size_t)(item * 16 + l15) * 2048 + 512 * w + 8 * quad;
      const bf16_t* bp = B + (size_t)(6144 + l15) * 2048 + 512 * w + 8 * quad;
      f32x4_t c = {0.f, 0.f, 0.f, 0.f};
#pragma unroll
      for (int s = 0; s < 16; s++) {
        const bf16x8 a = *(const bf16x8*)(ap + 32 * s);
        const bf16x8 b = *(const bf16x8*)(bp + 32 * s);
        c = __builtin_amdgcn_mfma_f32_16x16x32_bf16(a, b, c, 0, 0, 0);
      }
      __syncthreads();
#pragma unroll
      for (int j = 0; j < 4; j++) red[(w * 16 + quad * 4 + j) * 16 + l15] = c[j];
      __syncthreads();
      const float v = red[t] + red[256 + t] + red[512 + t] + red[768 + t];
      GKL[(size_t)item * 256 + t] = v;
    }
  }
}

DI void phase_gla_prep(const Params& p, char* smem, int bid, int nblk) {
  char* ws = opaque_ptr(p.ws);
  const int t = TID, lane = t & 63, w = t >> 6, r = lane & 31, h = lane >> 5;
  const bf16_t* QK = (const bf16_t*)(ws + OFF_QK0);
  const float* GKL = (const float*)(ws + OFF_GKLOW);
  bf16_t* QE = (bf16_t*)(ws + OFF_QE);
  bf16_t* KLT = (bf16_t*)(ws + OFF_KLT);
  bf16_t* AM = (bf16_t*)(ws + OFF_AM);
  float* DEC = (float*)(ws + OFF_DECAY);
  if (bid == 0 && t == 0) { ((int*)(ws + OFF_CTR))[0] = 0; ((int*)(ws + OFF_CTR))[1] = 0; }
  char* lq = smem;
  char* lk = smem + 32768;
  for (int tile = bid; tile < 512; tile += nblk) {
    const int n = tile >> 2, head = tile & 3, t0 = n * 64, d = t, col = head * 256 + d;
    float w2[16];
#pragma unroll
    for (int j = 0; j < 16; j++) w2[j] = p.w_gk2[j * 1024 + col];
    const float bias = p.b_gk[col];
    float b = 0.f;
#pragma unroll 8
    for (int c = 0; c < 64; c++) {
      const float4* gl = (const float4*)(GKL + (size_t)(t0 + c) * 16);
      float4 g0 = gl[0], g1 = gl[1], g2 = gl[2], g3 = gl[3];
      float gk = bias + g0.x * w2[0] + g0.y * w2[1] + g0.z * w2[2] + g0.w * w2[3] + g1.x * w2[4] + g1.y * w2[5] + g1.z * w2[6] + g1.w * w2[7]
               + g2.x * w2[8] + g2.y * w2[9] + g2.z * w2[10] + g2.w * w2[11] + g3.x * w2[12] + g3.y * w2[13] + g3.z * w2[14] + g3.w * w2[15];
      float la = (fminf(gk, 0.f) - __logf(1.f + __expf(-fabsf(gk)))) * (1.f / 16.f);
      b += la;
    }
    const float blast = b;
    DEC[(size_t)(n * 4 + head) * 256 + d] = __expf(blast);
    b = 0.f;
    const int dperm = (d & ~15) | ((d & 3) | ((d & 4) << 1) | ((d & 8) >> 1));
    for (int c8 = 0; c8 < 8; c8++) {
      float bj[8], qv[8], kv[8];
#pragma unroll
      for (int j = 0; j < 8; j++) {
        const int c = c8 * 8 + j;
        const float4* gl = (const float4*)(GKL + (size_t)(t0 + c) * 16);
        float4 g0 = gl[0], g1 = gl[1], g2 = gl[2], g3 = gl[3];
        float gk = bias + g0.x * w2[0] + g0.y * w2[1] + g0.z * w2[2] + g0.w * w2[3] + g1.x * w2[4] + g1.y * w2[5] + g1.z * w2[6] + g1.w * w2[7]
                 + g2.x * w2[8] + g2.y * w2[9] + g2.z * w2[10] + g2.w * w2[11] + g3.x * w2[12] + g3.y * w2[13] + g3.z * w2[14] + g3.w * w2[15];
        float la = (fminf(gk, 0.f) - __logf(1.f + __expf(-fabsf(gk)))) * (1.f / 16.f);
        b += la;
        bj[j] = b;
        qv[j] = bf2f(QK[(size_t)(t0 + c) * 2048 + col]);
        kv[j] = bf2f(QK[(size_t)(t0 + c) * 2048 + 1024 + col]);
      }
      unsigned klp[4];
#pragma unroll
      for (int j = 0; j < 8; j++) {
        const int c = c8 * 8 + j;
        const float qe = qv[j] * 0.0625f * __expf(bj[j]);
        const float ke = kv[j] * __expf(-bj[j]);
        const float kl = kv[j] * __expf(blast - bj[j]);
        const unsigned qeb = f2bf(qe), keb = f2bf(ke), klb = f2bf(kl);
        const int lo = c * 512 + ((((d >> 3) ^ (c & 15))) << 4) + (d & 7) * 2;
        *(unsigned short*)(lq + lo) = (unsigned short)qeb;
        *(unsigned short*)(lk + lo) = (unsigned short)keb;
        QE[(size_t)(t0 + c) * 1024 + head * 256 + dperm] = (bf16_t)qeb;
        if (j & 1) klp[j >> 1] |= klb << 16; else klp[j >> 1] = klb;
      }
      uint4 o; o.x = klp[0]; o.y = klp[1]; o.z = klp[2]; o.w = klp[3];
      *(uint4*)(KLT + (size_t)(head * 256 + d) * S_ + t0 + c8 * 8) = o;
    }
    __syncthreads();
    {
      const int ct = w >> 1, st = w & 1;
      f32x16 acc;
#pragma unroll
      for (int i = 0; i < 16; i++) acc[i] = 0.f;
      if (!(ct == 0 && st == 1)) {
        const int ra = ct * 32 + r, rb = st * 32 + r;
#pragma unroll
        for (int s = 0; s < 16; s++) {
          bf16x8 a = *(const bf16x8*)(lq + ra * 512 + (((2 * s + h) ^ (ra & 15)) << 4));
          bf16x8 bb = *(const bf16x8*)(lk + rb * 512 + (((2 * s + h) ^ (rb & 15)) << 4));
          acc = MFMA32(a, bb, acc);
        }
      }
      bf16_t* ap = AM + (size_t)(n * 4 + head) * 4096;
#pragma unroll
      for (int i = 0; i < 16; i++) {
        const int c = ct * 32 + crow(i, h), s = st * 32 + r;
        ap[c * 64 + s] = (bf16_t)f2bf(s <= c ? acc[i] : 0.f);
      }
    }
    __syncthreads();
  }
}

constexpr int SCAN_NG = 8, SCAN_GC = 16;
DI void phase_gla_local(const Params& p, char* smem, int bid, int nblk) {
  char* ws = opaque_ptr(p.ws);
  const int t = TID, lane = t & 63, w = t >> 6, r = lane & 31, h = lane >> 5;
  for (int item = bid; item < 64 * (SCAN_NG - 1); item += nblk) {
    const int grp = item >> 6, head = (item >> 4) & 3, dvt = item & 15, dv0 = dvt * 32;
    const int nb = grp * SCAN_GC;
    const bf16_t* v_p = (const bf16_t*)(ws + OFF_V0T) + (size_t)(head * 512 + dv0 + r) * S_ + nb * 64 + 8 * h;
    const bf16_t* kl_p = (const bf16_t*)(ws + OFF_KLT) + (size_t)(head * 256 + 64 * w + r) * S_ + nb * 64 + 8 * h;
    const float* dec_p = (const float*)(ws + OFF_DECAY) + (size_t)nb * 1024 + head * 256 + 64 * w + 4 * h;
    f32x16 St[2];
#pragma unroll
    for (int i = 0; i < 16; i++) { St[0][i] = 0.f; St[1][i] = 0.f; }
    bf16x8 klA[2][4], vfA[4], klB[2][4], vfB[4];
    float4 dcA[2][4], dcB[2][4];
#define LOC_LOAD(KL, VF, DC, n_)                                                                                 \
    {                                                                                                            \
      _Pragma("unroll") for (int s = 0; s < 4; s++) VF[s] = *(const bf16x8*)(v_p + (n_) * 64 + 16 * s);        \
      _Pragma("unroll") for (int dt = 0; dt < 2; dt++) {                                                         \
        _Pragma("unroll") for (int s = 0; s < 4; s++) KL[dt][s] = *(const bf16x8*)(kl_p + (size_t)dt * 32 * S_ + (n_) * 64 + 16 * s); \
        _Pragma("unroll") for (int g4 = 0; g4 < 4; g4++) DC[dt][g4] = *(const float4*)(dec_p + (size_t)(n_) * 1024 + dt * 32 + 8 * g4); \
      }                                                                                                          \
    }
#define LOC_STEP(KL, VF, DC)                                                                                     \
    {                                                                                                            \
      _Pragma("unroll") for (int dt = 0; dt < 2; dt++) {                                                         \
        _Pragma("unroll") for (int g4 = 0; g4 < 4; g4++) {                                                       \
          St[dt][4 * g4 + 0] *= DC[dt][g4].x; St[dt][4 * g4 + 1] *= DC[dt][g4].y;                                \
          St[dt][4 * g4 + 2] *= DC[dt][g4].z; St[dt][4 * g4 + 3] *= DC[dt][g4].w;                                \
        }                                                                                                        \
        _Pragma("unroll") for (int s = 0; s < 4; s++) St[dt] = MFMA32(KL[dt][s], VF[s], St[dt]);                 \
      }                                                                                                          \
    }
    LOC_LOAD(klA, vfA, dcA, 0)
    for (int n = 0; n < SCAN_GC; n += 2) {
      LOC_LOAD(klB, vfB, dcB, n + 1)
      LOC_STEP(klA, vfA, dcA)
      if (n + 2 < SCAN_GC) LOC_LOAD(klA, vfA, dcA, n + 2)
      LOC_STEP(klB, vfB, dcB)
    }
#undef LOC_LOAD
#undef LOC_STEP
    float* sl = (float*)(ws + OFF_SL) + ((size_t)((grp * 4 + head) * 16 + dvt) * 4 + w) * 2048 + lane;
#pragma unroll
    for (int dt = 0; dt < 2; dt++)
#pragma unroll
      for (int i = 0; i < 16; i++) sl[(dt * 16 + i) * 64] = St[dt][i];
    if (dvt == 0) {
      const float* dg = (const float*)(ws + OFF_DECAY) + (size_t)nb * 1024 + head * 256 + t;
      float pr = 1.f;
#pragma unroll 4
      for (int n = 0; n < SCAN_GC; n++) pr *= dg[(size_t)n * 1024];
      ((float*)(ws + OFF_DC))[(grp * 4 + head) * 256 + t] = pr;
    }
  }
}

DI void phase_gla_scan(const Params& p, char* smem, int bid, int nblk) {
  char* ws = opaque_ptr(p.ws);
  const int t = TID, lane = t & 63, w = t >> 6, r = lane & 31, h = lane >> 5;
  float* lo = (float*)smem;
  for (int item = bid; item < 64 * SCAN_NG; item += nblk) {
    const int grp = item >> 6, head = (item >> 4) & 3, dvt = item & 15, dv0 = dvt * 32;
    const int nb = grp * SCAN_GC, ne = nb + SCAN_GC;
    const bf16_t* qe_p = (const bf16_t*)(ws + OFF_QE) + (size_t)r * 1024 + head * 256 + 64 * w + 8 * h;
    const bf16_t* a_p = (const bf16_t*)(ws + OFF_AM) + (size_t)head * 4096 + (size_t)r * 64 + 16 * w + 8 * h;
    const bf16_t* v_p = (const bf16_t*)(ws + OFF_V0T) + (size_t)(head * 512 + dv0 + r) * S_ + 8 * h;
    const bf16_t* kl_p = (const bf16_t*)(ws + OFF_KLT) + (size_t)(head * 256 + 64 * w + r) * S_ + 8 * h;
    bf16_t* o_p = (bf16_t*)(ws + OFF_QK0) + (size_t)(t >> 2) * 2048 + head * 512 + dv0 + (t & 3) * 8;
    f32x16 St[2];
#pragma unroll
    for (int i = 0; i < 16; i++) { St[0][i] = 0.f; St[1][i] = 0.f; }
    for (int j = 0; j < grp; j++) {
      const float* slj = (const float*)(ws + OFF_SL) + ((size_t)((j * 4 + head) * 16 + dvt) * 4 + w) * 2048 + lane;
      const float* dcj = (const float*)(ws + OFF_DC) + (j * 4 + head) * 256 + 64 * w + 4 * h;
#pragma unroll
      for (int dt = 0; dt < 2; dt++)
#pragma unroll
        for (int g4 = 0; g4 < 4; g4++) {
          const float4 dv = *(const float4*)(dcj + 32 * dt + 8 * g4);
          St[dt][4 * g4 + 0] = St[dt][4 * g4 + 0] * dv.x + slj[(dt * 16 + 4 * g4 + 0) * 64];
          St[dt][4 * g4 + 1] = St[dt][4 * g4 + 1] * dv.y + slj[(dt * 16 + 4 * g4 + 1) * 64];
          St[dt][4 * g4 + 2] = St[dt][4 * g4 + 2] * dv.z + slj[(dt * 16 + 4 * g4 + 2) * 64];
          St[dt][4 * g4 + 3] = St[dt][4 * g4 + 3] * dv.w + slj[(dt * 16 + 4 * g4 + 3) * 64];
        }
    }
    qe_p += (size_t)nb * 64 * 1024; a_p += (size_t)nb * 4 * 4096; v_p += nb * 64; kl_p += nb * 64; o_p += (size_t)nb * 64 * 2048;
    bf16x8 qe[2][4], af[2], vf[4], kl[2][4];
    float* ldec = (float*)(smem + 32768);
    const float* dec_g = (const float*)(ws + OFF_DECAY) + (size_t)nb * 1024 + head * 256 + t;
#pragma unroll
    for (int ct = 0; ct < 2; ct++) {
#pragma unroll
      for (int s = 0; s < 4; s++) qe[ct][s] = *(const bf16x8*)(qe_p + (size_t)ct * 32 * 1024 + 16 * s);
      af[ct] = *(const bf16x8*)(a_p + ct * 32 * 64);
    }
#pragma unroll
    for (int s = 0; s < 4; s++) vf[s] = *(const bf16x8*)(v_p + 16 * s);
#pragma unroll
    for (int dt = 0; dt < 2; dt++) {
#pragma unroll
      for (int s = 0; s < 4; s++) kl[dt][s] = *(const bf16x8*)(kl_p + (size_t)dt * 32 * S_ + 16 * s);
    }
    __syncthreads();
    ldec[t] = dec_g[0];
    __syncthreads();
    for (int n = 0; n < SCAN_GC; n++) {
      const bool more = (n + 1 < SCAN_GC);
      float decn = 0.f;
      if (more) decn = dec_g[(size_t)(n + 1) * 1024];
      f32x16 o[2];
#pragma unroll
      for (int i = 0; i < 16; i++) { o[0][i] = 0.f; o[1][i] = 0.f; }
#pragma unroll
      for (int s = 0; s < 4; s++) {
        bf16x8 sb = pack8(St[s >> 1], s & 1);
        o[0] = MFMA32(qe[0][s], sb, o[0]);
        o[1] = MFMA32(qe[1][s], sb, o[1]);
      }
      if (more) {
        const bf16_t* q2 = qe_p + (size_t)(n + 1) * 64 * 1024;
#pragma unroll
        for (int ct = 0; ct < 2; ct++)
#pragma unroll
          for (int s = 0; s < 4; s++) qe[ct][s] = *(const bf16x8*)(q2 + (size_t)ct * 32 * 1024 + 16 * s);
      }
      {
        bf16x8 vw = (w == 0) ? vf[0] : (w == 1) ? vf[1] : (w == 2) ? vf[2] : vf[3];
        o[0] = MFMA32(af[0], vw, o[0]);
        o[1] = MFMA32(af[1], vw, o[1]);
      }
      if (more) {
        const bf16_t* a2 = a_p + (size_t)(n + 1) * 4 * 4096;
        af[0] = *(const bf16x8*)(a2); af[1] = *(const bf16x8*)(a2 + 32 * 64);
      }
#pragma unroll
      for (int dt = 0; dt < 2; dt++) {
#pragma unroll
        for (int g = 0; g < 4; g++) {
          const float4 dv = *(const float4*)(ldec + (n & 1) * 256 + 64 * w + 32 * dt + 8 * g + 4 * h);
          St[dt][4 * g + 0] *= dv.x; St[dt][4 * g + 1] *= dv.y;
          St[dt][4 * g + 2] *= dv.z; St[dt][4 * g + 3] *= dv.w;
        }
#pragma unroll
        for (int s = 0; s < 4; s++) St[dt] = MFMA32(kl[dt][s], vf[s], St[dt]);
      }
      if (more) {
        const int tn = (n + 1) * 64;
#pragma unroll
        for (int s = 0; s < 4; s++) vf[s] = *(const bf16x8*)(v_p + tn + 16 * s);
#pragma unroll
        for (int dt = 0; dt < 2; dt++) {
#pragma unroll
          for (int s = 0; s < 4; s++) kl[dt][s] = *(const bf16x8*)(kl_p + (size_t)dt * 32 * S_ + tn + 16 * s);
        }
      }
      ldec[((n + 1) & 1) * 256 + t] = decn;
#pragma unroll
      for (int ct = 0; ct < 2; ct++)
#pragma unroll
        for (int i = 0; i < 16; i++) lo[(w * 64 + ct * 32 + crow(i, h)) * 32 + r] = o[ct][i];
      __syncthreads();
      {
        const int c = t >> 2, vg = (t & 3) * 8;
        float4 s0 = *(const float4*)(lo + c * 32 + vg), s1 = *(const float4*)(lo + c * 32 + vg + 4);
#pragma unroll
        for (int ww = 1; ww < 4; ww++) {
          float4 x0 = *(const float4*)(lo + (ww * 64 + c) * 32 + vg), x1 = *(const float4*)(lo + (ww * 64 + c) * 32 + vg + 4);
          s0.x += x0.x; s0.y += x0.y; s0.z += x0.z; s0.w += x0.w; s1.x += x1.x; s1.y += x1.y; s1.z += x1.z; s1.w += x1.w;
        }
        uint4 ov; ov.x = pack2(s0.x, s0.y); ov.y = pack2(s0.z, s0.w); ov.z = pack2(s1.x, s1.y); ov.w = pack2(s1.z, s1.w);
        *(uint4*)(o_p + (size_t)n * 64 * 2048) = ov;
      }
      __syncthreads();
    }
  }
}

DI void phase_og(const Params& p, char* smem, int bid, int nblk) {
  char* ws = opaque_ptr(p.ws);
  const int t = TID, lane = t & 63, w = t >> 6;
  const bf16_t* O0 = (const bf16_t*)(ws + OFF_QK0);
  const bf16_t* G0 = (const bf16_t*)(ws + OFF_G0);
  bf16_t* OG = (bf16_t*)(ws + OFF_H);
  const float4* gp = (const float4*)(p.g_onorm + lane * 8);
  const float4 ga = gp[0], gb = gp[1];
  for (int token = bid; token < S_; token += nblk) {
    const size_t off = (size_t)token * 2048 + w * 512 + lane * 8;
    uint4 ov = *(const uint4*)(O0 + off);
    uint4 gv = *(const uint4*)(G0 + off);
    float f[8] = {bflo(ov.x), bfhi(ov.x), bflo(ov.y), bfhi(ov.y), bflo(ov.z), bfhi(ov.z), bflo(ov.w), bfhi(ov.w)};
    float ss = 0.f;
#pragma unroll
    for (int j = 0; j < 8; j++) ss += f[j] * f[j];
    ss = wave_sum(ss);
    const float rinv = rsqrtf(ss * (1.f / 512.f) + 1e-6f);
    uint4 o;
    o.x = pack2(f[0] * rinv * ga.x * bflo(gv.x), f[1] * rinv * ga.y * bfhi(gv.x));
    o.y = pack2(f[2] * rinv * ga.z * bflo(gv.y), f[3] * rinv * ga.w * bfhi(gv.y));
    o.z = pack2(f[4] * rinv * gb.x * bflo(gv.z), f[5] * rinv * gb.y * bfhi(gv.z));
    o.w = pack2(f[6] * rinv * gb.z * bflo(gv.w), f[7] * rinv * gb.w * bfhi(gv.w));
    *(uint4*)(OG + off) = o;
  }
}

DI void phase_gemm_out(const Params& p, char* smem, int bid, int nblk, size_t off_w) {
  char* ws = opaque_ptr(p.ws);
  const bf16_t* A = (const bf16_t*)(ws + OFF_H);
  const bf16_t* B = (const bf16_t*)(ws + off_w);
  bf16_t* Y = (bf16_t*)(ws + OFF_Y);
  for (int tile = bid; tile < 32 * 16; tile += nblk) {
    const int mi = tile & 31, ni = tile >> 5;
    const int m0 = mi * 256, n0 = ni * 128;
    f32x16 acc[4][2];
    gemm_main<false>(acc, A, 2048, B, 2048, 2048, m0, n0, smem);
    EPI_LOOP_BEGIN EPI_COORD_NS
      Y[(size_t)row * 2048 + col] = (bf16_t)f2bf(v);
    EPI_LOOP_END
  }
}

DI void phase_post0(const Params& p, char* smem, int bid, int nblk) {
  char* ws = opaque_ptr(p.ws);
  const int t = TID, lane = t & 63, w = t >> 6;
  const bf16_t* Y = (const bf16_t*)(ws + OFF_Y);
  const float4* gpo = (const float4*)p.l0_post + lane;
  const float4* gpr = (const float4*)p.l1_pre + lane;
  for (int row = bid * 4 + w; row < S_; row += nblk * 4) {
    const uint2* yr = (const uint2*)(Y + (size_t)row * 2048) + lane;
    const float4* xr = (const float4*)(p.x + (size_t)row * 2048) + lane;
    float4 yv[8], xv[8];
#pragma unroll
    for (int j = 0; j < 8; j++) { const uint2 u = yr[j * 64]; yv[j].x = bflo(u.x); yv[j].y = bfhi(u.x); yv[j].z = bflo(u.y); yv[j].w = bfhi(u.y); xv[j] = xr[j * 64]; }
    float ss = 0.f;
#pragma unroll
    for (int j = 0; j < 8; j++) ss += yv[j].x * yv[j].x + yv[j].y * yv[j].y + yv[j].z * yv[j].z + yv[j].w * yv[j].w;
    ss = wave_sum(ss);
    const float rinv = rsqrtf(ss * (1.f / 2048.f) + 1e-6f);
    float4* outr = (float4*)(p.out + (size_t)row * 2048) + lane;
    float s2 = 0.f;
#pragma unroll
    for (int j = 0; j < 8; j++) {
      const float4 g = gpo[j * 64];
      xv[j].x += yv[j].x * rinv * g.x; xv[j].y += yv[j].y * rinv * g.y; xv[j].z += yv[j].z * rinv * g.z; xv[j].w += yv[j].w * rinv * g.w;
      outr[j * 64] = xv[j];
      s2 += xv[j].x * xv[j].x + xv[j].y * xv[j].y + xv[j].z * xv[j].z + xv[j].w * xv[j].w;
    }
    s2 = wave_sum(s2);
    const float r2 = rsqrtf(s2 * (1.f / 2048.f) + 1e-6f);
    uint2* hr = (uint2*)(ws + OFF_H + (size_t)row * 4096) + lane;
#pragma unroll
    for (int j = 0; j < 8; j++) {
      const float4 g = gpr[j * 64];
      uint2 o; o.x = pack2(xv[j].x * r2 * g.x, xv[j].y * r2 * g.y); o.y = pack2(xv[j].z * r2 * g.z, xv[j].w * r2 * g.w);
      hr[j * 64] = o;
    }
  }
}

DI void phase_gemm_in1(const Params& p, char* smem, int bid, int nblk) {
  char* ws = opaque_ptr(p.ws);
  const bf16_t* A = (const bf16_t*)(ws + OFF_H);
  const bf16_t* B = (const bf16_t*)(ws + OFF_WIN1T);
  bf16_t* CQ = (bf16_t*)(ws + OFF_CQ);
  bf16_t* CKV = (bf16_t*)(ws + OFF_CKV);
  bf16_t* KR = (bf16_t*)(ws + OFF_KR);
  const float* cs = (const float*)(ws + OFF_CS);
  bf16_t* G1 = (bf16_t*)(ws + OFF_QK0);
  for (int tile = bid; tile < 32 * 25; tile += nblk) {
    const int mi = tile & 31, ni = tile >> 5;
    const int m0 = mi * 256, n0 = ni * 128;
    f32x16 acc[4][2];
    gemm_main<false>(acc, A, 2048, B, 2048, 2048, m0, n0, smem);
    if (ni < 4) {
      EPI_LOOP_BEGIN EPI_COORD_NS
        CQ[(size_t)row * 512 + col] = (bf16_t)f2bf(v);
      EPI_LOOP_END
    } else if (ni < 8) {
      EPI_LOOP_BEGIN EPI_COORD_NS
        CKV[(size_t)row * 512 + (col - 512)] = (bf16_t)f2bf(v);
      EPI_LOOP_END
    } else if (ni == 8 && ((TID >> 6) & 1) == 0) {
      const int lane_ = TID & 63, w_ = TID >> 6, wm_ = w_ >> 1, r_ = lane_ & 31, h_ = lane_ >> 5;
#pragma unroll
      for (int mt = 0; mt < 4; mt++)
#pragma unroll
        for (int i = 0; i < 16; i++) {
          const int row = m0 + wm_ * 128 + mt * 32 + crow(i, h_);
          const float t1 = acc[mt][0][i], t2 = acc[mt][1][i];
          const float c = cs[row * 64 + r_], sn = cs[row * 64 + 32 + r_];
          KR[(size_t)row * 64 + r_] = (bf16_t)f2bf(t1 * c - t2 * sn);
          KR[(size_t)row * 64 + 32 + r_] = (bf16_t)f2bf(t2 * c + t1 * sn);
        }
    } else {
      EPI_LOOP_BEGIN EPI_COORD_NS
        if (col < 3136) G1[(size_t)row * 2048 + (col - 1088)] = (bf16_t)f2bf(silu(v));
      EPI_LOOP_END
    }
  }
}

DI void phase_gemm_qkv(const Params& p, char* smem, int bid, int nblk) {
  char* ws = opaque_ptr(p.ws);
  const bf16_t* CQ = (const bf16_t*)(ws + OFF_CQ);
  const bf16_t* CKV = (const bf16_t*)(ws + OFF_CKV);
  const bf16_t* WQ = (const bf16_t*)(ws + OFF_WQBT);
  const bf16_t* WKV = (const bf16_t*)(ws + OFF_WKVBT);
  const float* cs = (const float*)(ws + OFF_CS);
  bf16_t* Q = (bf16_t*)(ws + OFF_Q);
  bf16_t* KN = (bf16_t*)(ws + OFF_KN);
  bf16_t* VT = (bf16_t*)(ws + OFF_VT);
  const float qscale = 0.07216878364870322f * 1.4426950408889634f;
  const int ntq = 32 * 24, ntkv = 32 * 32;
  for (int tile = bid; tile < ntq + ntkv; tile += nblk) {
    f32x16 acc[4][2];
    if (tile < ntq) {
      const int mi = tile & 31, ni = tile >> 5;
      const int m0 = mi * 256, n0 = ni * 128;
      gemm_main<false, true>(acc, CQ, 512, WQ, 512, 512, m0, n0, smem);
      const float* rf = (const float*)(smem + 49152);
      const int lane_ = TID & 63, w_ = TID >> 6, wm_ = w_ >> 1, wn_ = w_ & 1, r_ = lane_ & 31, h_ = lane_ >> 5;
      const int cb = n0 + wn_ * 64;
      const int head = cb / 192, jb = cb - head * 192;
      if (jb == 128) {
#pragma unroll
        for (int mt = 0; mt < 4; mt++)
#pragma unroll
          for (int i = 0; i < 16; i++) {
            const int row = m0 + wm_ * 128 + mt * 32 + crow(i, h_);
            const float sc = rf[row - m0] * qscale;
            const float t1 = acc[mt][0][i] * sc, t2 = acc[mt][1][i] * sc;
            const float c = cs[row * 64 + r_], s = cs[row * 64 + 32 + r_];
            bf16_t* qp = Q + ((size_t)head * S_ + row) * 192 + 128;
            qp[r_] = (bf16_t)f2bf(t1 * c - t2 * s);
            qp[32 + r_] = (bf16_t)f2bf(t2 * c + t1 * s);
          }
      } else {
#pragma unroll
        for (int mt = 0; mt < 4; mt++)
#pragma unroll
          for (int nt = 0; nt < 2; nt++)
#pragma unroll
            for (int i = 0; i < 16; i++) {
              const int row = m0 + wm_ * 128 + mt * 32 + crow(i, h_);
              const float sc = rf[row - m0] * qscale;
              Q[((size_t)head * S_ + row) * 192 + jb + nt * 32 + r_] = (bf16_t)f2bf(acc[mt][nt][i] * sc);
            }
      }
    } else {
      const int tl = tile - ntq;
      const int mi = tl & 31, ni = tl >> 5;
      const int m0 = mi * 256, n0 = ni * 128;
      const int head = ni >> 1;
      if (ni & 1) {
        gemm_main<true, true>(acc, CKV, 512, WKV, 512, 512, m0, n0, smem);
        const float* rf = (const float*)(smem + 49152);
        EPI_LOOP_BEGIN EPI_COORD_SW
          const int j = col - head * 256 - 128;
          VT[((size_t)head * 128 + j) * S_ + row] = (bf16_t)f2bf(v * rf[row - m0]);
        EPI_LOOP_END
      } else {
        gemm_main<false, true>(acc, CKV, 512, WKV, 512, 512, m0, n0, smem);
        const float* rf = (const float*)(smem + 49152);
        EPI_LOOP_BEGIN EPI_COORD_NS
          const int j = col - head * 256;
          KN[((size_t)head * S_ + row) * 128 + j] = (bf16_t)f2bf(v * rf[row - m0]);
        EPI_LOOP_END
      }
    }
  }
}

DI void phase_attn(const Params& p, char* smem, int bid, int nblk, int rep) {
  char* ws = opaque_ptr(p.ws);
  const int t = TID, lane = t & 63, w = t >> 6, r = lane & 31, h = lane >> 5;
  const bf16_t* Q = (const bf16_t*)(ws + OFF_Q);
  const bf16_t* KN = (const bf16_t*)(ws + OFF_KN);
  const bf16_t* KR = (const bf16_t*)(ws + OFF_KR);
  const bf16_t* VT = (const bf16_t*)(ws + OFF_VT);
  const bf16_t* G1 = (const bf16_t*)(ws + OFF_QK0);
  bf16_t* OG = (bf16_t*)(ws + OFF_H);
  int* ctr = (int*)(ws + OFF_CTR) + rep;
  char* lk = smem;
  char* lv = smem + 25600;
  int* s_item = (int*)(smem + 43008);
  const int k_row = t >> 2, k_c0 = t & 3;
  const int v_row0 = t >> 3, v_kc = t & 7;
  for (;;) {
    __syncthreads();
    if (t == 0) *s_item = atomicAdd(ctr, 1);
    __syncthreads();
    const int item = *s_item;
    if (item >= 1024) break;
    const int qb = 63 - (item >> 4), head = item & 15;
    const int q0w = qb * 128 + w * 32;
    const int ntile = 2 * qb + 2;
    bf16x8 qf[12];
    {
      const bf16_t* qp = Q + ((size_t)head * S_ + q0w + r) * 192 + 8 * h;
#pragma unroll
      for (int s = 0; s < 12; s++) qf[s] = *(const bf16x8*)(qp + 16 * s);
    }
    f32x16 oacc[4];
#pragma unroll
    for (int vt = 0; vt < 4; vt++)
#pragma unroll
      for (int i = 0; i < 16; i++) oacc[vt][i] = 0.f;
    float m_run = -INFINITY, l_run = 0.f;
    uint4 kg0, kg1, kg2, kg3, kg4, kg5, vg0, vg1, vg2, vg3;
    const bf16_t* knp = KN + (size_t)head * S_ * 128;
    const bf16_t* vtp = VT + ((size_t)head * 128 + v_row0) * S_ + v_kc * 8;
#define ATT_LOAD(k0_)                                                                                         \
    {                                                                                                         \
      const bf16_t* kn_ = knp + (size_t)((k0_) + k_row) * 128 + k_c0 * 8;                                     \
      const bf16_t* kr_ = KR + (size_t)((k0_) + k_row) * 64 + k_c0 * 8;                                       \
      const bf16_t* vp_ = vtp + (k0_);                                                                        \
      kg0 = *(const uint4*)(kn_); kg1 = *(const uint4*)(kn_ + 32); kg2 = *(const uint4*)(kn_ + 64); kg3 = *(const uint4*)(kn_ + 96); \
      kg4 = *(const uint4*)(kr_); kg5 = *(const uint4*)(kr_ + 32);                                            \
      vg0 = *(const uint4*)(vp_); vg1 = *(const uint4*)(vp_ + (size_t)32 * S_);                               \
      vg2 = *(const uint4*)(vp_ + (size_t)64 * S_); vg3 = *(const uint4*)(vp_ + (size_t)96 * S_);             \
    }
    ATT_LOAD(0)
    for (int kt = 0; kt < ntile; kt++) {
      const int k0 = kt * 64;
      __syncthreads();
      {
        char* kd = lk + k_row * 400 + k_c0 * 16;
        *(uint4*)(kd) = kg0; *(uint4*)(kd + 64) = kg1; *(uint4*)(kd + 128) = kg2; *(uint4*)(kd + 192) = kg3;
        *(uint4*)(kd + 256) = kg4; *(uint4*)(kd + 320) = kg5;
        char* vd = lv + v_row0 * 136 + v_kc * 16;
#define VST(o_, v_) { uint2 u0, u1; u0.x = v_.x; u0.y = v_.y; u1.x = v_.z; u1.y = v_.w; *(uint2*)(vd + (o_)) = u0; *(uint2*)(vd + (o_) + 8) = u1; }
        VST(0, vg0) VST(32 * 136, vg1) VST(64 * 136, vg2) VST(96 * 136, vg3)
#undef VST
      }
      __syncthreads();
      { const int knext = (kt + 1 < ntile) ? k0 + 64 : k0; ATT_LOAD(knext) }
      if (k0 <= q0w + 31) {
        f32x16 sc[2];
#pragma unroll
        for (int i = 0; i < 16; i++) { sc[0][i] = 0.f; sc[1][i] = 0.f; }
#pragma unroll
        for (int s = 0; s < 12; s++) {
          bf16x8 a0 = *(const bf16x8*)(lk + r * 400 + h * 16 + s * 32);
          bf16x8 a1 = *(const bf16x8*)(lk + r * 400 + h * 16 + 32 * 400 + s * 32);
          sc[0] = MFMA32(a0, qf[s], sc[0]);
          sc[1] = MFMA32(a1, qf[s], sc[1]);
        }
        if (k0 + 63 > q0w) {
          const int qg = q0w + r;
#pragma unroll
          for (int mt = 0; mt < 2; mt++)
#pragma unroll
            for (int i = 0; i < 16; i++) {
              const int key = k0 + mt * 32 + crow(i, h);
              if (key > qg) sc[mt][i] = -INFINITY;
            }
        }
        float mx = sc[0][0];
#pragma unroll
        for (int i = 1; i < 16; i++) mx = fmaxf(mx, sc[0][i]);
#pragma unroll
        for (int i = 0; i < 16; i++) mx = fmaxf(mx, sc[1][i]);
        mx = fmaxf(mx, __shfl_xor(mx, 32));
        const float m_new = (mx > m_run + 8.f) ? mx : m_run;
        const bool resc = __any(m_new != m_run);
        const float alpha = __builtin_amdgcn_exp2f(m_run - m_new);
        m_run = m_new;
        float ls = 0.f;
#pragma unroll
        for (int mt = 0; mt < 2; mt++)
#pragma unroll
          for (int i = 0; i < 16; i++) { const float pv = __builtin_amdgcn_exp2f(sc[mt][i] - m_new); sc[mt][i] = pv; ls += pv; }
        l_run = l_run * alpha + ls;
        if (resc) {
#pragma unroll
          for (int vt = 0; vt < 4; vt++)
#pragma unroll
            for (int i = 0; i < 16; i++) oacc[vt][i] *= alpha;
        }
#pragma unroll
        for (int s = 0; s < 4; s++) {
          const bf16x8 pb = pack8(sc[s >> 1], s & 1);
#pragma unroll
          for (int vt = 0; vt < 4; vt++) {
            const char* vrow = lv + r * 136 + h * 8 + vt * 32 * 136 + s * 32;
            s16x4 lo4 = *(const s16x4*)(vrow);
            s16x4 hi4 = *(const s16x4*)(vrow + 16);
            bf16x8 a = __builtin_shufflevector(lo4, hi4, 0, 1, 2, 3, 4, 5, 6, 7);
            oacc[vt] = MFMA32(a, pb, oacc[vt]);
          }
        }
      }
    }
#undef ATT_LOAD
    const float l_tot = l_run + __shfl_xor(l_run, 32);
    const float inv = 1.f / l_tot;
    const size_t obase = (size_t)(q0w + r) * 2048 + head * 128;
#pragma unroll
    for (int vt = 0; vt < 4; vt++)
#pragma unroll
      for (int g = 0; g < 4; g++) {
        const int v = vt * 32 + 8 * g + 4 * h;
        uint2 gg = *(const uint2*)(G1 + obase + v);
        uint2 o;
        o.x = pack2(oacc[vt][4 * g + 0] * inv * bflo(gg.x), oacc[vt][4 * g + 1] * inv * bfhi(gg.x));
        o.y = pack2(oacc[vt][4 * g + 2] * inv * bflo(gg.y), oacc[vt][4 * g + 3] * inv * bfhi(gg.y));
        *(uint2*)(OG + obase + v) = o;
      }
  }
}

DI void phase_final(const Params& p, char* smem, int bid, int nblk) {
  char* ws = opaque_ptr(p.ws);
  const int t = TID, lane = t & 63, w = t >> 6;
  const bf16_t* Y = (const bf16_t*)(ws + OFF_Y);
  const float4* gpo = (const float4*)p.l1_post + lane;
  for (int row = bid * 4 + w; row < S_; row += nblk * 4) {
    const uint2* yr = (const uint2*)(Y + (size_t)row * 2048) + lane;
    float4* outr = (float4*)(p.out + (size_t)row * 2048) + lane;
    float4 yv[8], xv[8];
#pragma unroll
    for (int j = 0; j < 8; j++) { const uint2 u = yr[j * 64]; yv[j].x = bflo(u.x); yv[j].y = bfhi(u.x); yv[j].z = bflo(u.y); yv[j].w = bfhi(u.y); xv[j] = outr[j * 64]; }
    float ss = 0.f;
#pragma unroll
    for (int j = 0; j < 8; j++) ss += yv[j].x * yv[j].x + yv[j].y * yv[j].y + yv[j].z * yv[j].z + yv[j].w * yv[j].w;
    ss = wave_sum(ss);
    const float rinv = rsqrtf(ss * (1.f / 2048.f) + 1e-6f);
#pragma unroll
    for (int j = 0; j < 8; j++) {
      const float4 g = gpo[j * 64];
      xv[j].x += yv[j].x * rinv * g.x; xv[j].y += yv[j].y * rinv * g.y; xv[j].z += yv[j].z * rinv * g.z; xv[j].w += yv[j].w * rinv * g.w;
      outr[j * 64] = xv[j];
    }
  }
}

constexpr int NPHASE = 13;
constexpr unsigned DUP_MASK = 0u;
DI void run_phase(int ph, const Params& p, char* smem, int bid, int nblk, int rep) {
  switch (ph) {
    case 0: phase_prep(p, smem, bid, nblk); break;
    case 1: phase_gemm_in0(p, smem, bid, nblk); break;
    case 2: phase_gla_prep(p, smem, bid, nblk); break;
    case 3: phase_gla_local(p, smem, bid, nblk); break;
    case 4: phase_gla_scan(p, smem, bid, nblk); break;
    case 5: phase_og(p, smem, bid, nblk); break;
    case 6: phase_gemm_out(p, smem, bid, nblk, OFF_WOUT0T); break;
    case 7: phase_post0(p, smem, bid, nblk); break;
    case 8: phase_gemm_in1(p, smem, bid, nblk); break;
    case 9: phase_gemm_qkv(p, smem, bid, nblk); break;
    case 10: phase_attn(p, smem, bid, nblk, rep); break;
    case 11: phase_gemm_out(p, smem, bid, nblk, OFF_WOUT1T); break;
    case 12: phase_final(p, smem, bid, nblk); break;
  }
}

#define XB_TMO      128
#define XB_XCNT(j)  (256  + 64 * (j))
#define XB_XSUB(j)  (1280 + 64 * (j))
#define XB_XGEN(j)  (2304 + 64 * (j))
#define XB_TOP      3328
#define XB_TOPGEN   3392
#define XCD_BAR_WORDS 3456
#define XB_SPIN_CAP (1u << 20)
#define LAS __attribute__((address_space(3)))
DI unsigned xb_ld(unsigned* p) { return __hip_atomic_load(p, __ATOMIC_RELAXED, __HIP_MEMORY_SCOPE_AGENT); }
DI unsigned xb_add(unsigned* p, unsigned v) { return __hip_atomic_fetch_add(p, v, __ATOMIC_RELAXED, __HIP_MEMORY_SCOPE_AGENT); }
DI unsigned xb_xcc_id() { return (unsigned)__builtin_amdgcn_s_getreg((3 << 11) | 20) & 0xFu; }
#define XB_SPIN(cond, bar) do { unsigned _sp = 0; while (cond) { __builtin_amdgcn_s_sleep(1); \
    if ((++_sp & 255u) == 0u) { if (xb_ld(&(bar)[XB_TMO])) break; if (_sp > XB_SPIN_CAP) { atomicAdd(&(bar)[XB_TMO], 1u); break; } } } } while (0)
struct XcdBarrier { unsigned* bar; unsigned x; volatile LAS unsigned* st; };
DI XcdBarrier xcd_barrier_post(unsigned* bar, volatile LAS unsigned* st) {
  XcdBarrier b; b.bar = bar; b.x = xb_xcc_id(); b.st = st;
  if (threadIdx.x == 0) (void)xb_add(&bar[XB_XCNT(b.x)], 1u);
  return b;
}
DI void xcd_barrier_complete(unsigned* bar, unsigned x, unsigned& nloc, unsigned& nx) {
  const unsigned G = gridDim.x * gridDim.y * gridDim.z;
  unsigned sum, cnt, mine, sp = 0u;
  for (;;) {
    sum = 0u; cnt = 0u; mine = 0u;
#pragma unroll
    for (unsigned j = 0; j < 16; ++j) { const unsigned c = xb_ld(&bar[XB_XCNT(j)]); sum += c; cnt += (c > 0u) ? 1u : 0u; mine = (j == x) ? c : mine; }
    if (sum == G) break;
    __builtin_amdgcn_s_sleep(1);
    if ((++sp & 255u) == 0u) { if (xb_ld(&bar[XB_TMO])) break; if (sp > XB_SPIN_CAP) { atomicAdd(&bar[XB_TMO], 1u); break; } }
  }
  nloc = mine > 0u ? mine : 1u; nx = cnt > 0u ? cnt : 1u;
}
DI void xcd_barrier(const XcdBarrier& b) {
  asm volatile("s_waitcnt vmcnt(0)" ::: "memory");
  __syncthreads();
  if (threadIdx.x == 0) {
    unsigned* bar = b.bar;
    __builtin_amdgcn_s_waitcnt(0);
    unsigned nloc, nx;
    xcd_barrier_complete(bar, b.x, nloc, nx);
    const unsigned old = xb_add(&bar[XB_XSUB(b.x)], 1u);
    const unsigned gen = old / nloc;
    if (old + 1u == (gen + 1u) * nloc) {
      __builtin_amdgcn_fence(__ATOMIC_RELEASE, "agent");
      asm volatile("s_waitcnt vmcnt(0)" ::: "memory");
      const unsigned og = xb_add(&bar[XB_TOP], 1u);
      const unsigned tg = og / nx;
      if (og + 1u == (tg + 1u) * nx) xb_add(&bar[XB_TOPGEN], 1u);
      else XB_SPIN(xb_ld(&bar[XB_TOPGEN]) == tg, bar);
      __builtin_amdgcn_fence(__ATOMIC_ACQUIRE, "agent");
      xb_add(&bar[XB_XGEN(b.x)], 1u);
      asm volatile("s_waitcnt vmcnt(0)" ::: "memory");
    } else {
      XB_SPIN(xb_ld(&bar[XB_XGEN(b.x)]) == gen, bar);
      __builtin_amdgcn_fence(__ATOMIC_ACQUIRE, "agent");
      asm volatile("s_waitcnt vmcnt(0)" ::: "memory");
    }
  }
  __syncthreads();
}

#if MEGA
__global__ void __launch_bounds__(256, 2) mega_kernel(Params p) {
  __shared__ __attribute__((aligned(16))) char smem[65536];
  cg::grid_group grid = cg::this_grid();
  const int bid = blockIdx.x, nblk = gridDim.x;
  (void)xcd_barrier_post((unsigned*)(p.ws + OFF_BAR), (volatile LAS unsigned*)0);
#pragma nounroll
  for (int ph = 0; ph < NPHASE; ph++) {
    int phv = ph;
    asm volatile("" : "+s"(phv));
    run_phase(phv, p, smem, bid, nblk, 0);
    if (p.ws == nullptr) grid.sync();
    { XcdBarrier xb; xb.bar = (unsigned*)(opaque_ptr(p.ws) + OFF_BAR); xb.x = xb_xcc_id(); xb.st = (volatile LAS unsigned*)0; xcd_barrier(xb); }
    if ((DUP_MASK >> ph) & 1u) {
      run_phase(phv, p, smem, bid, nblk, 1);
      { XcdBarrier xb; xb.bar = (unsigned*)(opaque_ptr(p.ws) + OFF_BAR); xb.x = xb_xcc_id(); xb.st = (volatile LAS unsigned*)0; xcd_barrier(xb); }
    }
  }
}
#endif

#if !MEGA
template <int PH>
__global__ void __launch_bounds__(256, 2) phase_kernel_t(Params p) {
  __shared__ __attribute__((aligned(16))) char smem[65536];
  run_phase(PH, p, smem, blockIdx.x, gridDim.x, 0);
}
#endif

extern "C" void kernel_launch(void* const* d_in, const int* in_sizes, int n_in, void* d_out, int out_size, void* d_ws,
                              size_t ws_size, hipStream_t stream) {
  Params p{};
  p.x = (const float*)d_in[0]; p.pos = (const int*)d_in[1]; p.l0_pre = (const float*)d_in[2]; p.w_in0 = (const float*)d_in[3];
  p.w_gk2 = (const float*)d_in[4]; p.b_gk = (const float*)d_in[5]; p.g_onorm = (const float*)d_in[6]; p.w_out0 = (const float*)d_in[7];
  p.l0_post = (const float*)d_in[8]; p.l1_pre = (const float*)d_in[9]; p.w_in1 = (const float*)d_in[10]; p.g_qa = (const float*)d_in[11];
  p.w_qb = (const float*)d_in[12]; p.g_kva = (const float*)d_in[13]; p.w_kvb = (const float*)d_in[14]; p.w_out1 = (const float*)d_in[15];
  p.l1_post = (const float*)d_in[16];
  p.out = (float*)d_out; p.ws = (char*)d_ws;
  for (int i = 0; i < 32; i++) p.invf[i] = (float)pow(10000.0, -(double)i / 32.0);
#if MEGA
  static int grid_blocks = 0;
  if (!grid_blocks) {
    int dev = 0, cus = 0, per_cu = 0;
    hipGetDevice(&dev);
    hipDeviceGetAttribute(&cus, hipDeviceAttributeMultiprocessorCount, dev);
    hipOccupancyMaxActiveBlocksPerMultiprocessor(&per_cu, mega_kernel, 256, 0);
    if (per_cu > 2) per_cu = 2;
    if (per_cu < 1) per_cu = 1;
    grid_blocks = cus * per_cu;
  }
  hipMemsetAsync((char*)d_ws + OFF_BAR, 0, XCD_BAR_WORDS * 4, stream);
  void* args[] = {&p};
  hipError_t e = hipLaunchCooperativeKernel((void*)mega_kernel, dim3(grid_blocks), dim3(256), args, 0, stream);
  if (e != hipSuccess) fprintf(stderr, "cooperative launch failed: %s (grid %d)\n", hipGetErrorString(e), grid_blocks);
#else
#define LPH(N) hipLaunchKernelGGL(phase_kernel_t<N>, dim3(512), dim3(256), 0, stream, p);
  LPH(0) LPH(1) LPH(2) LPH(3) LPH(4) LPH(5) LPH(6) LPH(7) LPH(8) LPH(9) LPH(10) LPH(11) LPH(12)
#undef LPH
#endif
}
```

```cpp
#include <hip/hip_runtime.h>
#include <hip/hip_cooperative_groups.h>
#include <stdint.h>
#include <math.h>
#include <stdio.h>
namespace cg = cooperative_groups;

#ifndef MEGA
#define MEGA 1
#endif

typedef __attribute__((ext_vector_type(8))) short bf16x8;
typedef __attribute__((ext_vector_type(4))) short s16x4;
typedef __attribute__((ext_vector_type(16))) float f32x16;
typedef unsigned short bf16_t;
#define DI __device__ __forceinline__
#define MFMA32(a, b, c) __builtin_amdgcn_mfma_f32_32x32x16_bf16((a), (b), (c), 0, 0, 0)

constexpr int S_ = 8192;
constexpr size_t MiB = (size_t)1 << 20;
constexpr size_t OFF_WIN0T = 0;
constexpr size_t OFF_WOUT0T = 25 * MiB;
constexpr size_t OFF_WIN1T = 33 * MiB;
constexpr size_t OFF_WQBT = 46 * MiB;
constexpr size_t OFF_WKVBT = 49 * MiB;
constexpr size_t OFF_WOUT1T = 53 * MiB;
constexpr size_t OFF_GKLOW = 61 * MiB;
constexpr size_t OFF_DECAY = 61 * MiB + 512 * 1024;
constexpr size_t OFF_CS = 62 * MiB;
constexpr size_t OFF_H = 64 * MiB;
constexpr size_t OFF_QK0 = 96 * MiB;
constexpr size_t OFF_V0T = 128 * MiB;
constexpr size_t OFF_G0 = 160 * MiB;
constexpr size_t OFF_Y = 128 * MiB;
constexpr size_t OFF_QE = 192 * MiB;
constexpr size_t OFF_KLT = 208 * MiB;
constexpr size_t OFF_AM = 224 * MiB;
constexpr size_t OFF_CQ = 0;
constexpr size_t OFF_CKV = 8 * MiB;
constexpr size_t OFF_KR = 16 * MiB;
constexpr size_t OFF_RINVQ = 17 * MiB;
constexpr size_t OFF_RINVKV = 17 * MiB + 64 * 1024;
constexpr size_t OFF_KRRAW = 18 * MiB;
constexpr size_t OFF_CTR = 20 * MiB;
constexpr size_t OFF_BAR = 255 * MiB;
constexpr size_t OFF_SL = 64 * MiB;
constexpr size_t OFF_DC = 80 * MiB;
constexpr size_t OFF_Q = 128 * MiB;
constexpr size_t OFF_KN = 176 * MiB;
constexpr size_t OFF_VT = 208 * MiB;

struct Params {
  const float* x; const int* pos; const float* l0_pre; const float* w_in0; const float* w_gk2; const float* b_gk;
  const float* g_onorm; const float* w_out0; const float* l0_post; const float* l1_pre; const float* w_in1;
  const float* g_qa; const float* w_qb; const float* g_kva; const float* w_kvb; const float* w_out1; const float* l1_post;
  float* out; char* ws;
  float invf[32];
};

DI int tid_opaque() { int t = threadIdx.x; asm volatile("" : "+v"(t)); return t; }
#define TID tid_opaque()
typedef __attribute__((address_space(1))) char gchar_t;
DI char* opaque_ptr(char* q) {
  unsigned long long v = (unsigned long long)q;
  unsigned lo = __builtin_amdgcn_readfirstlane((unsigned)v), hi = __builtin_amdgcn_readfirstlane((unsigned)(v >> 32));
  asm volatile("" : "+s"(lo), "+s"(hi));
  return (char*)(gchar_t*)(((unsigned long long)hi << 32) | lo);
}
typedef __bf16 hbf16x2 __attribute__((ext_vector_type(2)));
typedef float hf32x2 __attribute__((ext_vector_type(2)));
DI unsigned pack2(float a, float b) { hf32x2 f = {a, b}; return __builtin_bit_cast(unsigned, __builtin_convertvector(f, hbf16x2)); }
DI unsigned f2bf(float f) { return (unsigned)__builtin_bit_cast(unsigned short, (__bf16)f); }
DI float bf2f(unsigned h) { return __uint_as_float(h << 16); }
DI float bflo(unsigned u) { return __uint_as_float(u << 16); }
DI float bfhi(unsigned u) { return __uint_as_float(u & 0xffff0000u); }
DI int crow(int i, int h) { return (i & 3) + 8 * (i >> 2) + 4 * h; }
DI float silu(float v) { return v / (1.f + __expf(-v)); }
DI float wave_sum(float v) { for (int o = 32; o > 0; o >>= 1) v += __shfl_xor(v, o); return v; }
DI float block_sum(float v, float* red) {
  v = wave_sum(v);
  __syncthreads();
  if ((TID & 63) == 0) red[TID >> 6] = v;
  __syncthreads();
  return red[0] + red[1] + red[2] + red[3];
}
DI bf16x8 pack8(const f32x16& x, int s) {
  union { unsigned u[4]; bf16x8 v; } p;
  p.u[0] = pack2(x[8 * s + 0], x[8 * s + 1]); p.u[1] = pack2(x[8 * s + 2], x[8 * s + 3]);
  p.u[2] = pack2(x[8 * s + 4], x[8 * s + 5]); p.u[3] = pack2(x[8 * s + 6], x[8 * s + 7]);
  return p.v;
}

DI void transpose_tile4(const float* __restrict__ W, int K, int N, int ntN, const float* __restrict__ gain, bf16_t* __restrict__ WT,
                        int id0, char* smem) {
  const int t = TID;
  float v[4][16];
#pragma unroll
  for (int q = 0; q < 4; q++) {
    const int id = id0 + q, k0 = (id / ntN) * 64, n0 = (id % ntN) * 64;
#pragma unroll
    for (int i = 0; i < 16; i++) {
      const int kk = i * 4 + (t >> 6), n = n0 + (t & 63);
      float x = (n < N) ? W[(size_t)(k0 + kk) * N + n] : 0.f;
      if (gain) x *= gain[k0 + kk];
      v[q][i] = x;
    }
  }
#pragma unroll
  for (int q = 0; q < 4; q++) {
    unsigned short (*tile)[72] = (unsigned short (*)[72])(smem + q * 9216);
#pragma unroll
    for (int i = 0; i < 16; i++) tile[t & 63][i * 4 + (t >> 6)] = (unsigned short)f2bf(v[q][i]);
  }
  __syncthreads();
#pragma unroll
  for (int q = 0; q < 4; q++) {
    unsigned short (*tile)[72] = (unsigned short (*)[72])(smem + q * 9216);
    const int id = id0 + q, k0 = (id / ntN) * 64, n0 = (id % ntN) * 64;
    const int nn = t >> 2, kg = (t & 3) * 16;
    uint4 a = *(const uint4*)&tile[nn][kg];
    uint4 b = *(const uint4*)&tile[nn][kg + 8];
    bf16_t* dst = WT + (size_t)(n0 + nn) * K + k0 + kg;
    *(uint4*)dst = a; *(uint4*)(dst + 8) = b;
  }
  __syncthreads();
}

DI void phase_prep(const Params& p, char* smem, int bid, int nblk) {
  const int t = TID;
  char* ws = opaque_ptr(p.ws);
  for (int task = bid; task < 1920 + 3072; task += nblk) {
    if (task < 1920) {
      const int tile0 = task * 4;
      const float* W; const float* gain = nullptr; bf16_t* WT; int K, N, ntN, id;
      if (tile0 < 3136) { id = tile0; W = p.w_in0; K = 2048; N = 6160; ntN = 98; WT = (bf16_t*)(ws + OFF_WIN0T); }
      else if (tile0 < 4160) { id = tile0 - 3136; W = p.w_out0; K = 2048; N = 2048; ntN = 32; WT = (bf16_t*)(ws + OFF_WOUT0T); }
      else if (tile0 < 5760) { id = tile0 - 4160; W = p.w_in1; K = 2048; N = 3136; ntN = 50; WT = (bf16_t*)(ws + OFF_WIN1T); }
      else if (tile0 < 6144) { id = tile0 - 5760; W = p.w_qb; K = 512; N = 3072; ntN = 48; WT = (bf16_t*)(ws + OFF_WQBT); gain = p.g_qa; }
      else if (tile0 < 6656) { id = tile0 - 6144; W = p.w_kvb; K = 512; N = 4096; ntN = 64; WT = (bf16_t*)(ws + OFF_WKVBT); gain = p.g_kva; }
      else { id = tile0 - 6656; W = p.w_out1; K = 2048; N = 2048; ntN = 32; WT = (bf16_t*)(ws + OFF_WOUT1T); }
      transpose_tile4(W, K, N, ntN, gain, WT, id, smem);
    } else if (task < 1920 + 2048) {
      const int lane = t & 63, row = (task - 1920) * 4 + (t >> 6);
      const float4* xr = (const float4*)(p.x + (size_t)row * 2048) + lane;
      const float4* gr = (const float4*)p.l0_pre + lane;
      float4 xv[8];
#pragma unroll
      for (int j = 0; j < 8; j++) xv[j] = xr[j * 64];
      float ss = 0.f;
#pragma unroll
      for (int j = 0; j < 8; j++) ss += xv[j].x * xv[j].x + xv[j].y * xv[j].y + xv[j].z * xv[j].z + xv[j].w * xv[j].w;
      ss = wave_sum(ss);
      const float rinv = rsqrtf(ss * (1.f / 2048.f) + 1e-6f);
      uint2* hr = (uint2*)(ws + OFF_H + (size_t)row * 4096) + lane;
#pragma unroll
      for (int j = 0; j < 8; j++) {
        const float4 g = gr[j * 64];
        uint2 o; o.x = pack2(xv[j].x * rinv * g.x, xv[j].y * rinv * g.y); o.y = pack2(xv[j].z * rinv * g.z, xv[j].w * rinv * g.w);
        hr[j * 64] = o;
      }
    } else {
      const int idx = (task - 3968) * 256 + t;
      const int token = idx >> 5, i = idx & 31;
      double ang = (double)p.pos[token] * (double)p.invf[i];
      double tt = ang * 0.15915494309189535;
      tt -= floor(tt + 0.5);
      float f = (float)tt;
      float* cs = (float*)(ws + OFF_CS);
      cs[token * 64 + i] = __builtin_amdgcn_cosf(f);
      cs[token * 64 + 32 + i] = __builtin_amdgcn_sinf(f);
    }
  }
}

DI float sq8(const uint4& v) {
  return bflo(v.x) * bflo(v.x) + bfhi(v.x) * bfhi(v.x) + bflo(v.y) * bflo(v.y) + bfhi(v.y) * bfhi(v.y) + bflo(v.z) * bflo(v.z) + bfhi(v.z) * bfhi(v.z) +
         bflo(v.w) * bflo(v.w) + bfhi(v.w) * bfhi(v.w);
}
template <bool SWAP, bool SUMSQ = false>
DI void gemm_main(f32x16 (&acc)[4][2], const bf16_t* A, int lda, const bf16_t* B, int ldb, int K,
                  int m0, int n0, char* smem) {
  const int t = TID, lane = t & 63, w = t >> 6, wm = w >> 1, wn = w & 1, r = lane & 31, h = lane >> 5;
#pragma unroll
  for (int a = 0; a < 4; a++)
#pragma unroll
    for (int b = 0; b < 2; b++)
#pragma unroll
      for (int i = 0; i < 16; i++) acc[a][b][i] = 0.f;
  const int lrow = t >> 2, kc = t & 3;
  const bf16_t* ag = A + (size_t)(m0 + lrow) * lda + kc * 8;
  const bf16_t* bg = B + (size_t)(n0 + lrow) * ldb + kc * 8;
  const int lds_w = lrow * 64 + ((kc ^ ((lrow >> 2) & 3)) << 4);
  uint4 pa0, pa1, pa2, pa3, pb0, pb1;
  bf16x8 fa0, fa1, fa2, fa3, fa4, fa5, fb0, fb1, fb2, fb3, fb4, fb5;
#define G_LOAD(X, ko_)                                                                                   \
  X##a0 = *(const uint4*)(ag + (ko_)); X##a1 = *(const uint4*)(ag + (size_t)64 * lda + (ko_));           \
  X##a2 = *(const uint4*)(ag + (size_t)128 * lda + (ko_)); X##a3 = *(const uint4*)(ag + (size_t)192 * lda + (ko_)); \
  X##b0 = *(const uint4*)(bg + (ko_)); X##b1 = *(const uint4*)(bg + (size_t)64 * ldb + (ko_));
#define L_STORE(X, base_)                                                                                \
  *(uint4*)((base_) + lds_w) = X##a0; *(uint4*)((base_) + lds_w + 4096) = X##a1;                         \
  *(uint4*)((base_) + lds_w + 8192) = X##a2; *(uint4*)((base_) + lds_w + 12288) = X##a3;                 \
  *(uint4*)((base_) + 16384 + lds_w) = X##b0; *(uint4*)((base_) + 16384 + lds_w + 4096) = X##b1;         \
  if (SUMSQ) { q0 += sq8(X##a0); q1 += sq8(X##a1); q2 += sq8(X##a2); q3 += sq8(X##a3); }
#define G_READ(F, base_, c_)                                                                             \
  F##0 = *(const bf16x8*)((base_) + a_off + (c_)); F##1 = *(const bf16x8*)((base_) + a_off + 32 * 64 + (c_));              \
  F##2 = *(const bf16x8*)((base_) + a_off + 64 * 64 + (c_)); F##3 = *(const bf16x8*)((base_) + a_off + 96 * 64 + (c_));    \
  F##4 = *(const bf16x8*)((base_) + b_off + (c_)); F##5 = *(const bf16x8*)((base_) + b_off + 32 * 64 + (c_));
#define G_MMA(a0, a1, a2, a3, b0, b1)                                                                    \
    if (SWAP) {                                                                                          \
      acc[0][0] = MFMA32(b0, a0, acc[0][0]); acc[0][1] = MFMA32(b1, a0, acc[0][1]);                      \
      acc[1][0] = MFMA32(b0, a1, acc[1][0]); acc[1][1] = MFMA32(b1, a1, acc[1][1]);                      \
      acc[2][0] = MFMA32(b0, a2, acc[2][0]); acc[2][1] = MFMA32(b1, a2, acc[2][1]);                      \
      acc[3][0] = MFMA32(b0, a3, acc[3][0]); acc[3][1] = MFMA32(b1, a3, acc[3][1]);                      \
    } else {                                                                                             \
      acc[0][0] = MFMA32(a0, b0, acc[0][0]); acc[0][1] = MFMA32(a0, b1, acc[0][1]);                      \
      acc[1][0] = MFMA32(a1, b0, acc[1][0]); acc[1][1] = MFMA32(a1, b1, acc[1][1]);                      \
      acc[2][0] = MFMA32(a2, b0, acc[2][0]); acc[2][1] = MFMA32(a2, b1, acc[2][1]);                      \
      acc[3][0] = MFMA32(a3, b0, acc[3][0]); acc[3][1] = MFMA32(a3, b1, acc[3][1]);                      \
    }
#define G_MMA6(F) G_MMA(F##0, F##1, F##2, F##3, F##4, F##5)
  float q0 = 0.f, q1 = 0.f, q2 = 0.f, q3 = 0.f;
  const int sw = (r >> 2) & 3;
  const int a_off = (wm * 128 + r) * 64, b_off = 16384 + (wn * 64 + r) * 64;
  const int c0 = (h ^ sw) << 4, c1 = ((2 + h) ^ sw) << 4;
  const int nk = K >> 5;
  G_LOAD(p, 0)
  L_STORE(p, smem)
  G_LOAD(p, 32)
  __syncthreads();
  G_READ(fa, smem, c0)
  G_READ(fb, smem, c1)
  G_MMA6(fa)
  asm volatile("" ::: "memory");
  __builtin_amdgcn_sched_barrier(0);
  L_STORE(p, smem + 24576)
  {
    const int kn = ((2 < nk) ? 2 : (nk - 1)) * 32;
    G_LOAD(p, kn)
  }
  __syncthreads();
  for (int kt = 0; kt < nk - 1; kt++) {
    const char* nb = smem + ((kt + 1) & 1) * 24576;
    G_READ(fa, nb, c0)
    G_MMA6(fb)
    G_READ(fb, nb, c1)
    G_MMA6(fa)
    __builtin_amdgcn_sched_group_barrier(0x100, 6, 0);
    __builtin_amdgcn_sched_group_barrier(0x008, 8, 0);
    __builtin_amdgcn_sched_group_barrier(0x100, 6, 0);
    __builtin_amdgcn_sched_group_barrier(0x008, 8, 0);
    asm volatile("" ::: "memory");
    __builtin_amdgcn_sched_barrier(0);
    if (kt + 2 < nk) {
      L_STORE(p, smem + (kt & 1) * 24576)
    }
    {
      const int kn = ((kt + 3 < nk) ? (kt + 3) : (nk - 1)) * 32;
      G_LOAD(p, kn)
    }
    __syncthreads();
  }
  G_MMA6(fb)
#undef G_LOAD
#undef L_STORE
#undef G_READ
#undef G_MMA
#undef G_MMA6
  if (SUMSQ) {
    q0 += __shfl_xor(q0, 1); q1 += __shfl_xor(q1, 1); q2 += __shfl_xor(q2, 1); q3 += __shfl_xor(q3, 1);
    q0 += __shfl_xor(q0, 2); q1 += __shfl_xor(q1, 2); q2 += __shfl_xor(q2, 2); q3 += __shfl_xor(q3, 2);
    if (kc == 0) {
      float* rf = (float*)(smem + 49152);
      const float ik = 1.f / (float)K;
      rf[lrow] = rsqrtf(q0 * ik + 1e-6f); rf[lrow + 64] = rsqrtf(q1 * ik + 1e-6f);
      rf[lrow + 128] = rsqrtf(q2 * ik + 1e-6f); rf[lrow + 192] = rsqrtf(q3 * ik + 1e-6f);
    }
    __syncthreads();
  }
}

#define EPI_LOOP_BEGIN                                                                                           \
  {                                                                                                              \
    const int lane_ = TID & 63, w_ = TID >> 6, wm_ = w_ >> 1, wn_ = w_ & 1, r_ = lane_ & 31, h_ = lane_ >> 5; \
    _Pragma("unroll") for (int mt = 0; mt < 4; mt++) _Pragma("unroll") for (int nt = 0; nt < 2; nt++)          \
        _Pragma("unroll") for (int i = 0; i < 16; i++) {                                                         \
      const float v = acc[mt][nt][i];
#define EPI_COORD_NS const int row = m0 + wm_ * 128 + mt * 32 + crow(i, h_); const int col = n0 + wn_ * 64 + nt * 32 + r_;
#define EPI_COORD_SW const int row = m0 + wm_ * 128 + mt * 32 + r_; const int col = n0 + wn_ * 64 + nt * 32 + crow(i, h_);
#define EPI_LOOP_END }}

DI void phase_gemm_in0(const Params& p, char* smem, int bid, int nblk) {
  char* ws = opaque_ptr(p.ws);
  const bf16_t* A = (const bf16_t*)(ws + OFF_H);
  const bf16_t* B = (const bf16_t*)(ws + OFF_WIN0T);
  bf16_t* QK = (bf16_t*)(ws + OFF_QK0);
  bf16_t* V0T = (bf16_t*)(ws + OFF_V0T);
  bf16_t* G0 = (bf16_t*)(ws + OFF_G0);
  float* GKL = (float*)(ws + OFF_GKLOW);
  for (int tile = bid; tile < 32 * 48; tile += nblk) {
    const int mi = tile & 31, ni = tile >> 5;
    const int m0 = mi * 256, n0 = ni * 128;
    f32x16 acc[4][2];
    if (ni >= 16) {
      if (ni < 32) {
        gemm_main<true>(acc, A, 2048, B, 2048, 2048, m0, n0, smem);
        EPI_LOOP_BEGIN EPI_COORD_SW
          V0T[(size_t)(col - 2048) * S_ + row] = (bf16_t)f2bf(v);
        EPI_LOOP_END
      } else {
        gemm_main<false>(acc, A, 2048, B, 2048, 2048, m0, n0, smem);
        EPI_LOOP_BEGIN EPI_COORD_NS
          G0[(size_t)row * 2048 + (col - 4096)] = (bf16_t)f2bf(silu(v));
        EPI_LOOP_END
      }
    } else {
      gemm_main<false>(acc, A, 2048, B, 2048, 2048, m0, n0, smem);
      EPI_LOOP_BEGIN EPI_COORD_NS
        QK[(size_t)row * 2048 + col] = (bf16_t)f2bf(v);
      EPI_LOOP_END
    }
  }
  {
    typedef __attribute__((ext_vector_type(4))) float f32x4_t;
    const int t = TID, lane = t & 63, w = t >> 6, l15 = lane & 15, quad = lane >> 4;
    float* red = (float*)smem;
    for (int item = bid; item < 512; item += nblk) {
      const bf16_t* ap = A + (size_t)(item * 16 + l15) * 2048 + 512 * w + 8 * quad;
      const bf16_t* bp = B + (size_t)(6144 + l15) * 2048 + 512 * w + 8 * quad;
      f32x4_t c = {0.f, 0.f, 0.f, 0.f};
#pragma unroll
      for (int s = 0; s < 16; s++) {
        const bf16x8 a = *(const bf16x8*)(ap + 32 * s);
        const bf16x8 b = *(const bf16x8*)(bp + 32 * s);
        c = __builtin_amdgcn_mfma_f32_16x16x32_bf16(a, b, c, 0, 0, 0);
      }
      __syncthreads();
#pragma unroll
      for (int j = 0; j < 4; j++) red[(w * 16 + quad * 4 + j) * 16 + l15] = c[j];
      __syncthreads();
      const float v = red[t] + red[256 + t] + red[512 + t] + red[768 + t];
      GKL[(size_t)item * 256 + t] = v;
    }
  }
}

DI void phase_gla_prep(const Params& p, char* smem, int bid, int nblk) {
  char* ws = opaque_ptr(p.ws);
  const int t = TID, lane = t & 63, w = t >> 6, r = lane & 31, h = lane >> 5;
  const bf16_t* QK = (const bf16_t*)(ws + OFF_QK0);
  const float* GKL = (const float*)(ws + OFF_GKLOW);
  bf16_t* QE = (bf16_t*)(ws + OFF_QE);
  bf16_t* KLT = (bf16_t*)(ws + OFF_KLT);
  bf16_t* AM = (bf16_t*)(ws + OFF_AM);
  float* DEC = (float*)(ws + OFF_DECAY);
  if (bid == 0 && t == 0) { ((int*)(ws + OFF_CTR))[0] = 0; ((int*)(ws + OFF_CTR))[1] = 0; }
  char* lq = smem;
  char* lk = smem + 32768;
  for (int tile = bid; tile < 512; tile += nblk) {
    const int n = tile >> 2, head = tile & 3, t0 = n * 64, d = t, col = head * 256 + d;
    float w2[16];
#pragma unroll
    for (int j = 0; j < 16; j++) w2[j] = p.w_gk2[j * 1024 + col];
    const float bias = p.b_gk[col];
    float b = 0.f;
    const int dperm = (d & ~15) | ((d & 3) | ((d & 4) << 1) | ((d & 8) >> 1));
    for (int c8 = 0; c8 < 8; c8++) {
      float bj[8], qv[8], kv[8];
#pragma unroll
      for (int j = 0; j < 8; j++) {
        const int c = c8 * 8 + j;
        const float4* gl = (const float4*)(GKL + (size_t)(t0 + c) * 16);
        float4 g0 = gl[0], g1 = gl[1], g2 = gl[2], g3 = gl[3];
        float gk = bias + g0.x * w2[0] + g0.y * w2[1] + g0.z * w2[2] + g0.w * w2[3] + g1.x * w2[4] + g1.y * w2[5] + g1.z * w2[6] + g1.w * w2[7]
                 + g2.x * w2[8] + g2.y * w2[9] + g2.z * w2[10] + g2.w * w2[11] + g3.x * w2[12] + g3.y * w2[13] + g3.z * w2[14] + g3.w * w2[15];
        float la = (fminf(gk, 0.f) - __logf(1.f + __expf(-fabsf(gk)))) * (1.f / 16.f);
        b += la;
        bj[j] = b;
        qv[j] = bf2f(QK[(size_t)(t0 + c) * 2048 + col]);
        kv[j] = bf2f(QK[(size_t)(t0 + c) * 2048 + 1024 + col]);
      }
      unsigned klp[4];
#pragma unroll
      for (int j = 0; j < 8; j++) {
        const int c = c8 * 8 + j;
        const float qe = qv[j] * 0.0625f * __expf(bj[j]);
        const float ke = kv[j] * __expf(-bj[j]);
        const unsigned qeb = f2bf(qe), keb = f2bf(ke), klb = keb;
        const int lo = c * 512 + ((((d >> 3) ^ (c & 15))) << 4) + (d & 7) * 2;
        *(unsigned short*)(lq + lo) = (unsigned short)qeb;
        *(unsigned short*)(lk + lo) = (unsigned short)keb;
        QE[(size_t)(t0 + c) * 1024 + head * 256 + dperm] = (bf16_t)qeb;
        if (j & 1) klp[j >> 1] |= klb << 16; else klp[j >> 1] = klb;
      }
      uint4 o; o.x = klp[0]; o.y = klp[1]; o.z = klp[2]; o.w = klp[3];
      *(uint4*)(KLT + (size_t)(head * 256 + d) * S_ + t0 + c8 * 8) = o;
    }
    DEC[(size_t)(n * 4 + head) * 256 + d] = __expf(b);
    __syncthreads();
    {
      const int ct = w >> 1, st = w & 1;
      f32x16 acc;
#pragma unroll
      for (int i = 0; i < 16; i++) acc[i] = 0.f;
      if (!(ct == 0 && st == 1)) {
        const int ra = ct * 32 + r, rb = st * 32 + r;
#pragma unroll
        for (int s = 0; s < 16; s++) {
          bf16x8 a = *(const bf16x8*)(lq + ra * 512 + (((2 * s + h) ^ (ra & 15)) << 4));
          bf16x8 bb = *(const bf16x8*)(lk + rb * 512 + (((2 * s + h) ^ (rb & 15)) << 4));
          acc = MFMA32(a, bb, acc);
        }
      }
      bf16_t* ap = AM + (size_t)(n * 4 + head) * 4096;
#pragma unroll
      for (int i = 0; i < 16; i++) {
        const int c = ct * 32 + crow(i, h), s = st * 32 + r;
        ap[c * 64 + s] = (bf16_t)f2bf(s <= c ? acc[i] : 0.f);
      }
    }
    __syncthreads();
  }
}

constexpr int SCAN_NG = 8, SCAN_GC = 16;
DI void phase_gla_local(const Params& p, char* smem, int bid, int nblk) {
  char* ws = opaque_ptr(p.ws);
  const int t = TID, lane = t & 63, w = t >> 6, r = lane & 31, h = lane >> 5;
  for (int item = bid; item < 64 * (SCAN_NG - 1); item += nblk) {
    const int grp = item >> 6, head = (item >> 4) & 3, dvt = item & 15, dv0 = dvt * 32;
    const int nb = grp * SCAN_GC;
    const bf16_t* v_p = (const bf16_t*)(ws + OFF_V0T) + (size_t)(head * 512 + dv0 + r) * S_ + nb * 64 + 8 * h;
    const bf16_t* kl_p = (const bf16_t*)(ws + OFF_KLT) + (size_t)(head * 256 + 64 * w + r) * S_ + nb * 64 + 8 * h;
    const float* dec_p = (const float*)(ws + OFF_DECAY) + (size_t)nb * 1024 + head * 256 + 64 * w + 4 * h;
    f32x16 St[2];
#pragma unroll
    for (int i = 0; i < 16; i++) { St[0][i] = 0.f; St[1][i] = 0.f; }
    bf16x8 klA[2][4], vfA[4], klB[2][4], vfB[4];
    float4 dcA[2][4], dcB[2][4];
#define LOC_LOAD(KL, VF, DC, n_)                                                                                 \
    {                                                                                                            \
      _Pragma("unroll") for (int s = 0; s < 4; s++) VF[s] = *(const bf16x8*)(v_p + (n_) * 64 + 16 * s);        \
      _Pragma("unroll") for (int dt = 0; dt < 2; dt++) {                                                         \
        _Pragma("unroll") for (int s = 0; s < 4; s++) KL[dt][s] = *(const bf16x8*)(kl_p + (size_t)dt * 32 * S_ + (n_) * 64 + 16 * s); \
        _Pragma("unroll") for (int g4 = 0; g4 < 4; g4++) DC[dt][g4] = *(const float4*)(dec_p + (size_t)(n_) * 1024 + dt * 32 + 8 * g4); \
      }                                                                                                          \
    }
#define LOC_STEP(KL, VF, DC)                                                                                     \
    {                                                                                                            \
      _Pragma("unroll") for (int dt = 0; dt < 2; dt++) {                                                         \
        _Pragma("unroll") for (int s = 0; s < 4; s++) St[dt] = MFMA32(KL[dt][s], VF[s], St[dt]);                 \
        _Pragma("unroll") for (int g4 = 0; g4 < 4; g4++) {                                                       \
          St[dt][4 * g4 + 0] *= DC[dt][g4].x; St[dt][4 * g4 + 1] *= DC[dt][g4].y;                                \
          St[dt][4 * g4 + 2] *= DC[dt][g4].z; St[dt][4 * g4 + 3] *= DC[dt][g4].w;                                \
        }                                                                                                        \
      }                                                                                                          \
    }
    LOC_LOAD(klA, vfA, dcA, 0)
    for (int n = 0; n < SCAN_GC; n += 2) {
      LOC_LOAD(klB, vfB, dcB, n + 1)
      LOC_STEP(klA, vfA, dcA)
      if (n + 2 < SCAN_GC) LOC_LOAD(klA, vfA, dcA, n + 2)
      LOC_STEP(klB, vfB, dcB)
    }
#undef LOC_LOAD
#undef LOC_STEP
    float* sl = (float*)(ws + OFF_SL) + ((size_t)((grp * 4 + head) * 16 + dvt) * 4 + w) * 2048 + lane;
#pragma unroll
    for (int dt = 0; dt < 2; dt++)
#pragma unroll
      for (int i = 0; i < 16; i++) sl[(dt * 16 + i) * 64] = St[dt][i];
    if (dvt == 0) {
      const float* dg = (const float*)(ws + OFF_DECAY) + (size_t)nb * 1024 + head * 256 + t;
      float pr = 1.f;
#pragma unroll 4
      for (int n = 0; n < SCAN_GC; n++) pr *= dg[(size_t)n * 1024];
      ((float*)(ws + OFF_DC))[(grp * 4 + head) * 256 + t] = pr;
    }
  }
}

DI void phase_gla_scan(const Params& p, char* smem, int bid, int nblk) {
  char* ws = opaque_ptr(p.ws);
  const int t = TID, lane = t & 63, w = t >> 6, r = lane & 31, h = lane >> 5;
  float* lo = (float*)smem;
  for (int item = bid; item < 64 * SCAN_NG; item += nblk) {
    const int grp = item >> 6, head = (item >> 4) & 3, dvt = item & 15, dv0 = dvt * 32;
    const int nb = grp * SCAN_GC, ne = nb + SCAN_GC;
    const bf16_t* qe_p = (const bf16_t*)(ws + OFF_QE) + (size_t)r * 1024 + head * 256 + 64 * w + 8 * h;
    const bf16_t* a_p = (const bf16_t*)(ws + OFF_AM) + (size_t)head * 4096 + (size_t)r * 64 + 16 * w + 8 * h;
    const bf16_t* v_p = (const bf16_t*)(ws + OFF_V0T) + (size_t)(head * 512 + dv0 + r) * S_ + 8 * h;
    const bf16_t* kl_p = (const bf16_t*)(ws + OFF_KLT) + (size_t)(head * 256 + 64 * w + r) * S_ + 8 * h;
    bf16_t* o_p = (bf16_t*)(ws + OFF_QK0) + (size_t)(t >> 2) * 2048 + head * 512 + dv0 + (t & 3) * 8;
    f32x16 St[2];
#pragma unroll
    for (int i = 0; i < 16; i++) { St[0][i] = 0.f; St[1][i] = 0.f; }
    for (int j = 0; j < grp; j++) {
      const float* slj = (const float*)(ws + OFF_SL) + ((size_t)((j * 4 + head) * 16 + dvt) * 4 + w) * 2048 + lane;
      const float* dcj = (const float*)(ws + OFF_DC) + (j * 4 + head) * 256 + 64 * w + 4 * h;
#pragma unroll
      for (int dt = 0; dt < 2; dt++)
#pragma unroll
        for (int g4 = 0; g4 < 4; g4++) {
          const float4 dv = *(const float4*)(dcj + 32 * dt + 8 * g4);
          St[dt][4 * g4 + 0] = St[dt][4 * g4 + 0] * dv.x + slj[(dt * 16 + 4 * g4 + 0) * 64];
          St[dt][4 * g4 + 1] = St[dt][4 * g4 + 1] * dv.y + slj[(dt * 16 + 4 * g4 + 1) * 64];
          St[dt][4 * g4 + 2] = St[dt][4 * g4 + 2] * dv.z + slj[(dt * 16 + 4 * g4 + 2) * 64];
          St[dt][4 * g4 + 3] = St[dt][4 * g4 + 3] * dv.w + slj[(dt * 16 + 4 * g4 + 3) * 64];
        }
    }
    qe_p += (size_t)nb * 64 * 1024; a_p += (size_t)nb * 4 * 4096; v_p += nb * 64; kl_p += nb * 64; o_p += (size_t)nb * 64 * 2048;
    bf16x8 qe[2][4], af[2], vf[4], kl[2][4];
    float* ldec = (float*)(smem + 32768);
    const float* dec_g = (const float*)(ws + OFF_DECAY) + (size_t)nb * 1024 + head * 256 + t;
#pragma unroll
    for (int ct = 0; ct < 2; ct++) {
#pragma unroll
      for (int s = 0; s < 4; s++) qe[ct][s] = *(const bf16x8*)(qe_p + (size_t)ct * 32 * 1024 + 16 * s);
      af[ct] = *(const bf16x8*)(a_p + ct * 32 * 64);
    }
#pragma unroll
    for (int s = 0; s < 4; s++) vf[s] = *(const bf16x8*)(v_p + 16 * s);
#pragma unroll
    for (int dt = 0; dt < 2; dt++) {
#pragma unroll
      for (int s = 0; s < 4; s++) kl[dt][s] = *(const bf16x8*)(kl_p + (size_t)dt * 32 * S_ + 16 * s);
    }
    __syncthreads();
    ldec[t] = dec_g[0];
    __syncthreads();
    for (int n = 0; n < SCAN_GC; n++) {
      const bool more = (n + 1 < SCAN_GC);
      float decn = 0.f;
      if (more) decn = dec_g[(size_t)(n + 1) * 1024];
      f32x16 o[2];
#pragma unroll
      for (int i = 0; i < 16; i++) { o[0][i] = 0.f; o[1][i] = 0.f; }
#pragma unroll
      for (int s = 0; s < 4; s++) {
        bf16x8 sb = pack8(St[s >> 1], s & 1);
        o[0] = MFMA32(qe[0][s], sb, o[0]);
        o[1] = MFMA32(qe[1][s], sb, o[1]);
      }
      if (more) {
        const bf16_t* q2 = qe_p + (size_t)(n + 1) * 64 * 1024;
#pragma unroll
        for (int ct = 0; ct < 2; ct++)
#pragma unroll
          for (int s = 0; s < 4; s++) qe[ct][s] = *(const bf16x8*)(q2 + (size_t)ct * 32 * 1024 + 16 * s);
      }
      {
        bf16x8 vw = (w == 0) ? vf[0] : (w == 1) ? vf[1] : (w == 2) ? vf[2] : vf[3];
        o[0] = MFMA32(af[0], vw, o[0]);
        o[1] = MFMA32(af[1], vw, o[1]);
      }
      if (more) {
        const bf16_t* a2 = a_p + (size_t)(n + 1) * 4 * 4096;
        af[0] = *(const bf16x8*)(a2); af[1] = *(const bf16x8*)(a2 + 32 * 64);
      }
#pragma unroll
      for (int dt = 0; dt < 2; dt++) {
#pragma unroll
        for (int s = 0; s < 4; s++) St[dt] = MFMA32(kl[dt][s], vf[s], St[dt]);
#pragma unroll
        for (int g = 0; g < 4; g++) {
          const float4 dv = *(const float4*)(ldec + (n & 1) * 256 + 64 * w + 32 * dt + 8 * g + 4 * h);
          St[dt][4 * g + 0] *= dv.x; St[dt][4 * g + 1] *= dv.y;
          St[dt][4 * g + 2] *= dv.z; St[dt][4 * g + 3] *= dv.w;
        }
      }
      if (more) {
        const int tn = (n + 1) * 64;
#pragma unroll
        for (int s = 0; s < 4; s++) vf[s] = *(const bf16x8*)(v_p + tn + 16 * s);
#pragma unroll
        for (int dt = 0; dt < 2; dt++) {
#pragma unroll
          for (int s = 0; s < 4; s++) kl[dt][s] = *(const bf16x8*)(kl_p + (size_t)dt * 32 * S_ + tn + 16 * s);
        }
      }
      ldec[((n + 1) & 1) * 256 + t] = decn;
#pragma unroll
      for (int ct = 0; ct < 2; ct++)
#pragma unroll
        for (int i = 0; i < 16; i++) lo[(w * 64 + ct * 32 + crow(i, h)) * 32 + r] = o[ct][i];
      __syncthreads();
      {
        const int c = t >> 2, vg = (t & 3) * 8;
        float4 s0 = *(const float4*)(lo + c * 32 + vg), s1 = *(const float4*)(lo + c * 32 + vg + 4);
#pragma unroll
        for (int ww = 1; ww < 4; ww++) {
          float4 x0 = *(const float4*)(lo + (ww * 64 + c) * 32 + vg), x1 = *(const float4*)(lo + (ww * 64 + c) * 32 + vg + 4);
          s0.x += x0.x; s0.y += x0.y; s0.z += x0.z; s0.w += x0.w; s1.x += x1.x; s1.y += x1.y; s1.z += x1.z; s1.w += x1.w;
        }
        uint4 ov; ov.x = pack2(s0.x, s0.y); ov.y = pack2(s0.z, s0.w); ov.z = pack2(s1.x, s1.y); ov.w = pack2(s1.z, s1.w);
        *(uint4*)(o_p + (size_t)n * 64 * 2048) = ov;
      }
      __syncthreads();
    }
  }
}

DI void phase_og(const Params& p, char* smem, int bid, int nblk) {
  char* ws = opaque_ptr(p.ws);
  const int t = TID, lane = t & 63, w = t >> 6;
  const bf16_t* O0 = (const bf16_t*)(ws + OFF_QK0);
  const bf16_t* G0 = (const bf16_t*)(ws + OFF_G0);
  bf16_t* OG = (bf16_t*)(ws + OFF_H);
  const float4* gp = (const float4*)(p.g_onorm + lane * 8);
  const float4 ga = gp[0], gb = gp[1];
  for (int token = bid; token < S_; token += nblk) {
    const size_t off = (size_t)token * 2048 + w * 512 + lane * 8;
    uint4 ov = *(const uint4*)(O0 + off);
    uint4 gv = *(const uint4*)(G0 + off);
    float f[8] = {bflo(ov.x), bfhi(ov.x), bflo(ov.y), bfhi(ov.y), bflo(ov.z), bfhi(ov.z), bflo(ov.w), bfhi(ov.w)};
    float ss = 0.f;
#pragma unroll
    for (int j = 0; j < 8; j++) ss += f[j] * f[j];
    ss = wave_sum(ss);
    const float rinv = rsqrtf(ss * (1.f / 512.f) + 1e-6f);
    uint4 o;
    o.x = pack2(f[0] * rinv * ga.x * bflo(gv.x), f[1] * rinv * ga.y * bfhi(gv.x));
    o.y = pack2(f[2] * rinv * ga.z * bflo(gv.y), f[3] * rinv * ga.w * bfhi(gv.y));
    o.z = pack2(f[4] * rinv * gb.x * bflo(gv.z), f[5] * rinv * gb.y * bfhi(gv.z));
    o.w = pack2(f[6] * rinv * gb.z * bflo(gv.w), f[7] * rinv * gb.w * bfhi(gv.w));
    *(uint4*)(OG + off) = o;
  }
}

DI void phase_gemm_out(const Params& p, char* smem, int bid, int nblk, size_t off_w) {
  char* ws = opaque_ptr(p.ws);
  const bf16_t* A = (const bf16_t*)(ws + OFF_H);
  const bf16_t* B = (const bf16_t*)(ws + off_w);
  bf16_t* Y = (bf16_t*)(ws + OFF_Y);
  for (int tile = bid; tile < 32 * 16; tile += nblk) {
    const int mi = tile & 31, ni = tile >> 5;
    const int m0 = mi * 256, n0 = ni * 128;
    f32x16 acc[4][2];
    gemm_main<false>(acc, A, 2048, B, 2048, 2048, m0, n0, smem);
    EPI_LOOP_BEGIN EPI_COORD_NS
      Y[(size_t)row * 2048 + col] = (bf16_t)f2bf(v);
    EPI_LOOP_END
  }
}

DI void phase_post0(const Params& p, char* smem, int bid, int nblk) {
  char* ws = opaque_ptr(p.ws);
  const int t = TID, lane = t & 63, w = t >> 6;
  const bf16_t* Y = (const bf16_t*)(ws + OFF_Y);
  const float4* gpo = (const float4*)p.l0_post + lane;
  const float4* gpr = (const float4*)p.l1_pre + lane;
  for (int row = bid * 4 + w; row < S_; row += nblk * 4) {
    const uint2* yr = (const uint2*)(Y + (size_t)row * 2048) + lane;
    const float4* xr = (const float4*)(p.x + (size_t)row * 2048) + lane;
    float4 yv[8], xv[8];
#pragma unroll
    for (int j = 0; j < 8; j++) { const uint2 u = yr[j * 64]; yv[j].x = bflo(u.x); yv[j].y = bfhi(u.x); yv[j].z = bflo(u.y); yv[j].w = bfhi(u.y); xv[j] = xr[j * 64]; }
    float ss = 0.f;
#pragma unroll
    for (int j = 0; j < 8; j++) ss += yv[j].x * yv[j].x + yv[j].y * yv[j].y + yv[j].z * yv[j].z + yv[j].w * yv[j].w;
    ss = wave_sum(ss);
    const float rinv = rsqrtf(ss * (1.f / 2048.f) + 1e-6f);
    float4* outr = (float4*)(p.out + (size_t)row * 2048) + lane;
    float s2 = 0.f;
#pragma unroll
    for (int j = 0; j < 8; j++) {
      const float4 g = gpo[j * 64];
      xv[j].x += yv[j].x * rinv * g.x; xv[j].y += yv[j].y * rinv * g.y; xv[j].z += yv[j].z * rinv * g.z; xv[j].w += yv[j].w * rinv * g.w;
      outr[j * 64] = xv[j];
      s2 += xv[j].x * xv[j].x + xv[j].y * xv[j].y + xv[j].z * xv[j].z + xv[j].w * xv[j].w;
    }
    s2 = wave_sum(s2);
    const float r2 = rsqrtf(s2 * (1.f / 2048.f) + 1e-6f);
    uint2* hr = (uint2*)(ws + OFF_H + (size_t)row * 4096) + lane;
#pragma unroll
    for (int j = 0; j < 8; j++) {
      const float4 g = gpr[j * 64];
      uint2 o; o.x = pack2(xv[j].x * r2 * g.x, xv[j].y * r2 * g.y); o.y = pack2(xv[j].z * r2 * g.z, xv[j].w * r2 * g.w);
      hr[j * 64] = o;
    }
  }
}

DI void phase_gemm_in1(const Params& p, char* smem, int bid, int nblk) {
  char* ws = opaque_ptr(p.ws);
  const bf16_t* A = (const bf16_t*)(ws + OFF_H);
  const bf16_t* B = (const bf16_t*)(ws + OFF_WIN1T);
  bf16_t* CQ = (bf16_t*)(ws + OFF_CQ);
  bf16_t* CKV = (bf16_t*)(ws + OFF_CKV);
  bf16_t* KR = (bf16_t*)(ws + OFF_KR);
  const float* cs = (const float*)(ws + OFF_CS);
  bf16_t* G1 = (bf16_t*)(ws + OFF_QK0);
  for (int tile = bid; tile < 32 * 25; tile += nblk) {
    const int mi = tile & 31, ni = tile >> 5;
    const int m0 = mi * 256, n0 = ni * 128;
    f32x16 acc[4][2];
    gemm_main<false>(acc, A, 2048, B, 2048, 2048, m0, n0, smem);
    if (ni < 4) {
      EPI_LOOP_BEGIN EPI_COORD_NS
        CQ[(size_t)row * 512 + col] = (bf16_t)f2bf(v);
      EPI_LOOP_END
    } else if (ni < 8) {
      EPI_LOOP_BEGIN EPI_COORD_NS
        CKV[(size_t)row * 512 + (col - 512)] = (bf16_t)f2bf(v);
      EPI_LOOP_END
    } else if (ni == 8 && ((TID >> 6) & 1) == 0) {
      const int lane_ = TID & 63, w_ = TID >> 6, wm_ = w_ >> 1, r_ = lane_ & 31, h_ = lane_ >> 5;
#pragma unroll
      for (int mt = 0; mt < 4; mt++)
#pragma unroll
        for (int i = 0; i < 16; i++) {
          const int row = m0 + wm_ * 128 + mt * 32 + crow(i, h_);
          const float t1 = acc[mt][0][i], t2 = acc[mt][1][i];
          const float c = cs[row * 64 + r_], sn = cs[row * 64 + 32 + r_];
          KR[(size_t)row * 64 + r_] = (bf16_t)f2bf(t1 * c - t2 * sn);
          KR[(size_t)row * 64 + 32 + r_] = (bf16_t)f2bf(t2 * c + t1 * sn);
        }
    } else {
      EPI_LOOP_BEGIN EPI_COORD_NS
        if (col < 3136) G1[(size_t)row * 2048 + (col - 1088)] = (bf16_t)f2bf(silu(v));
      EPI_LOOP_END
    }
  }
}

DI void phase_gemm_qkv(const Params& p, char* smem, int bid, int nblk) {
  char* ws = opaque_ptr(p.ws);
  const bf16_t* CQ = (const bf16_t*)(ws + OFF_CQ);
  const bf16_t* CKV = (const bf16_t*)(ws + OFF_CKV);
  const bf16_t* WQ = (const bf16_t*)(ws + OFF_WQBT);
  const bf16_t* WKV = (const bf16_t*)(ws + OFF_WKVBT);
  const float* cs = (const float*)(ws + OFF_CS);
  bf16_t* Q = (bf16_t*)(ws + OFF_Q);
  bf16_t* KN = (bf16_t*)(ws + OFF_KN);
  bf16_t* VT = (bf16_t*)(ws + OFF_VT);
  const float qscale = 0.07216878364870322f * 1.4426950408889634f;
  const int ntq = 32 * 24, ntkv = 32 * 32;
  for (int tile = bid; tile < ntq + ntkv; tile += nblk) {
    f32x16 acc[4][2];
    if (tile < ntq) {
      const int mi = tile & 31, ni = tile >> 5;
      const int m0 = mi * 256, n0 = ni * 128;
      gemm_main<false, true>(acc, CQ, 512, WQ, 512, 512, m0, n0, smem);
      const float* rf = (const float*)(smem + 49152);
      const int lane_ = TID & 63, w_ = TID >> 6, wm_ = w_ >> 1, wn_ = w_ & 1, r_ = lane_ & 31, h_ = lane_ >> 5;
      const int cb = n0 + wn_ * 64;
      const int head = cb / 192, jb = cb - head * 192;
      if (jb == 128) {
#pragma unroll
        for (int mt = 0; mt < 4; mt++)
#pragma unroll
          for (int i = 0; i < 16; i++) {
            const int row = m0 + wm_ * 128 + mt * 32 + crow(i, h_);
            const float sc = rf[row - m0] * qscale;
            const float t1 = acc[mt][0][i] * sc, t2 = acc[mt][1][i] * sc;
            const float c = cs[row * 64 + r_], s = cs[row * 64 + 32 + r_];
            bf16_t* qp = Q + ((size_t)head * S_ + row) * 192 + 128;
            qp[r_] = (bf16_t)f2bf(t1 * c - t2 * s);
            qp[32 + r_] = (bf16_t)f2bf(t2 * c + t1 * s);
          }
      } else {
#pragma unroll
        for (int mt = 0; mt < 4; mt++)
#pragma unroll
          for (int nt = 0; nt < 2; nt++)
#pragma unroll
            for (int i = 0; i < 16; i++) {
              const int row = m0 + wm_ * 128 + mt * 32 + crow(i, h_);
              const float sc = rf[row - m0] * qscale;
              Q[((size_t)head * S_ + row) * 192 + jb + nt * 32 + r_] = (bf16_t)f2bf(acc[mt][nt][i] * sc);
            }
      }
    } else {
      const int tl = tile - ntq;
      const int mi = tl & 31, ni = tl >> 5;
      const int m0 = mi * 256, n0 = ni * 128;
      const int head = ni >> 1;
      if (ni & 1) {
        gemm_main<true, true>(acc, CKV, 512, WKV, 512, 512, m0, n0, smem);
        const float* rf = (const float*)(smem + 49152);
        EPI_LOOP_BEGIN EPI_COORD_SW
          const int j = col - head * 256 - 128;
          VT[((size_t)head * 128 + j) * S_ + row] = (bf16_t)f2bf(v * rf[row - m0]);
        EPI_LOOP_END
      } else {
        gemm_main<false, true>(acc, CKV, 512, WKV, 512, 512, m0, n0, smem);
        const float* rf = (const float*)(smem + 49152);
        EPI_LOOP_BEGIN EPI_COORD_NS
          const int j = col - head * 256;
          KN[((size_t)head * S_ + row) * 128 + j] = (bf16_t)f2bf(v * rf[row - m0]);
        EPI_LOOP_END
      }
    }
  }
}

DI void phase_attn(const Params& p, char* smem, int bid, int nblk, int rep) {
  char* ws = opaque_ptr(p.ws);
  const int t = TID, lane = t & 63, w = t >> 6, r = lane & 31, h = lane >> 5;
  const bf16_t* Q = (const bf16_t*)(ws + OFF_Q);
  const bf16_t* KN = (const bf16_t*)(ws + OFF_KN);
  const bf16_t* KR = (const bf16_t*)(ws + OFF_KR);
  const bf16_t* VT = (const bf16_t*)(ws + OFF_VT);
  const bf16_t* G1 = (const bf16_t*)(ws + OFF_QK0);
  bf16_t* OG = (bf16_t*)(ws + OFF_H);
  int* ctr = (int*)(ws + OFF_CTR) + rep;
  char* lk = smem;
  char* lv = smem + 25600;
  int* s_item = (int*)(smem + 44032);
  const int k_row = t >> 2, k_c0 = t & 3;
  const int v_row0 = t >> 3, v_kc = t & 7;
  for (;;) {
    __syncthreads();
    if (t == 0) *s_item = atomicAdd(ctr, 1);
    __syncthreads();
    const int item = *s_item;
    if (item >= 1024) break;
    const int qb = 63 - (item >> 4), head = item & 15;
    const int q0w = qb * 128 + w * 32;
    const int ntile = 2 * qb + 2;
    bf16x8 qf[12];
    {
      const bf16_t* qp = Q + ((size_t)head * S_ + q0w + r) * 192 + 8 * h;
#pragma unroll
      for (int s = 0; s < 12; s++) qf[s] = *(const bf16x8*)(qp + 16 * s);
    }
    f32x16 oacc[4];
#pragma unroll
    for (int vt = 0; vt < 4; vt++)
#pragma unroll
      for (int i = 0; i < 16; i++) oacc[vt][i] = 0.f;
    float m_run = -INFINITY, l_run = 0.f;
    uint4 kg0, kg1, kg2, kg3, kg4, kg5, vg0, vg1, vg2, vg3;
    const bf16_t* knp = KN + (size_t)head * S_ * 128;
    const bf16_t* vtp = VT + ((size_t)head * 128 + v_row0) * S_ + v_kc * 8;
#define ATT_LOAD(k0_)                                                                                         \
    {                                                                                                         \
      const bf16_t* kn_ = knp + (size_t)((k0_) + k_row) * 128 + k_c0 * 8;                                     \
      const bf16_t* kr_ = KR + (size_t)((k0_) + k_row) * 64 + k_c0 * 8;                                       \
      const bf16_t* vp_ = vtp + (k0_);                                                                        \
      kg0 = *(const uint4*)(kn_); kg1 = *(const uint4*)(kn_ + 32); kg2 = *(const uint4*)(kn_ + 64); kg3 = *(const uint4*)(kn_ + 96); \
      kg4 = *(const uint4*)(kr_); kg5 = *(const uint4*)(kr_ + 32);                                            \
      vg0 = *(const uint4*)(vp_); vg1 = *(const uint4*)(vp_ + (size_t)32 * S_);                               \
      vg2 = *(const uint4*)(vp_ + (size_t)64 * S_); vg3 = *(const uint4*)(vp_ + (size_t)96 * S_);             \
    }
    ATT_LOAD(0)
    for (int kt = 0; kt < ntile; kt++) {
      const int k0 = kt * 64;
      __syncthreads();
      {
        char* kd = lk + k_row * 400 + k_c0 * 16;
        *(uint4*)(kd) = kg0; *(uint4*)(kd + 64) = kg1; *(uint4*)(kd + 128) = kg2; *(uint4*)(kd + 192) = kg3;
        *(uint4*)(kd + 256) = kg4; *(uint4*)(kd + 320) = kg5;
        char* vd = lv + v_row0 * 144 + (v_kc >> 1) * 32 + (v_kc & 1) * 8;
#define VST(o_, v_) { uint2 u0, u1; u0.x = v_.x; u0.y = v_.y; u1.x = v_.z; u1.y = v_.w; *(uint2*)(vd + (o_)) = u0; *(uint2*)(vd + (o_) + 16) = u1; }
        VST(0, vg0) VST(32 * 144, vg1) VST(64 * 144, vg2) VST(96 * 144, vg3)
#undef VST
      }
      __syncthreads();
      { const int knext = (kt + 1 < ntile) ? k0 + 64 : k0; ATT_LOAD(knext) }
      if (k0 <= q0w + 31) {
        f32x16 sc[2];
#pragma unroll
        for (int i = 0; i < 16; i++) { sc[0][i] = 0.f; sc[1][i] = 0.f; }
#pragma unroll
        for (int s = 0; s < 12; s++) {
          bf16x8 a0 = *(const bf16x8*)(lk + r * 400 + h * 16 + s * 32);
          bf16x8 a1 = *(const bf16x8*)(lk + r * 400 + h * 16 + 32 * 400 + s * 32);
          sc[0] = MFMA32(a0, qf[s], sc[0]);
          sc[1] = MFMA32(a1, qf[s], sc[1]);
        }
        if (k0 + 63 > q0w) {
          const int qg = q0w + r;
#pragma unroll
          for (int mt = 0; mt < 2; mt++)
#pragma unroll
            for (int i = 0; i < 16; i++) {
              const int key = k0 + mt * 32 + crow(i, h);
              if (key > qg) sc[mt][i] = -INFINITY;
            }
        }
        float mx = sc[0][0];
#pragma unroll
        for (int i = 1; i < 16; i++) mx = fmaxf(mx, sc[0][i]);
#pragma unroll
        for (int i = 0; i < 16; i++) mx = fmaxf(mx, sc[1][i]);
        mx = fmaxf(mx, __shfl_xor(mx, 32));
        const float m_new = (mx > m_run + 8.f) ? mx : m_run;
        const bool resc = __any(m_new != m_run);
        const float alpha = __builtin_amdgcn_exp2f(m_run - m_new);
        m_run = m_new;
        float ls = 0.f;
#pragma unroll
        for (int mt = 0; mt < 2; mt++)
#pragma unroll
          for (int i = 0; i < 16; i++) { const float pv = __builtin_amdgcn_exp2f(sc[mt][i] - m_new); sc[mt][i] = pv; ls += pv; }
        l_run = l_run * alpha + ls;
        if (resc) {
#pragma unroll
          for (int vt = 0; vt < 4; vt++)
#pragma unroll
            for (int i = 0; i < 16; i++) oacc[vt][i] *= alpha;
        }
#pragma unroll
        for (int s = 0; s < 4; s++) {
          const bf16x8 pb = pack8(sc[s >> 1], s & 1);
#pragma unroll
          for (int vt = 0; vt < 4; vt++) {
            const bf16x8 a = *(const bf16x8*)(lv + r * 144 + h * 16 + vt * 32 * 144 + s * 32);
            oacc[vt] = MFMA32(a, pb, oacc[vt]);
          }
        }
      }
    }
#undef ATT_LOAD
    const float l_tot = l_run + __shfl_xor(l_run, 32);
    const float inv = 1.f / l_tot;
    const size_t obase = (size_t)(q0w + r) * 2048 + head * 128;
#pragma unroll
    for (int vt = 0; vt < 4; vt++)
#pragma unroll
      for (int g = 0; g < 4; g++) {
        const int v = vt * 32 + 8 * g + 4 * h;
        uint2 gg = *(const uint2*)(G1 + obase + v);
        uint2 o;
        o.x = pack2(oacc[vt][4 * g + 0] * inv * bflo(gg.x), oacc[vt][4 * g + 1] * inv * bfhi(gg.x));
        o.y = pack2(oacc[vt][4 * g + 2] * inv * bflo(gg.y), oacc[vt][4 * g + 3] * inv * bfhi(gg.y));
        *(uint2*)(OG + obase + v) = o;
      }
  }
}

DI void phase_final(const Params& p, char* smem, int bid, int nblk) {
  char* ws = opaque_ptr(p.ws);
  const int t = TID, lane = t & 63, w = t >> 6;
  const bf16_t* Y = (const bf16_t*)(ws + OFF_Y);
  const float4* gpo = (const float4*)p.l1_post + lane;
  for (int row = bid * 4 + w; row < S_; row += nblk * 4) {
    const uint2* yr = (const uint2*)(Y + (size_t)row * 2048) + lane;
    float4* outr = (float4*)(p.out + (size_t)row * 2048) + lane;
    float4 yv[8], xv[8];
#pragma unroll
    for (int j = 0; j < 8; j++) { const uint2 u = yr[j * 64]; yv[j].x = bflo(u.x); yv[j].y = bfhi(u.x); yv[j].z = bflo(u.y); yv[j].w = bfhi(u.y); xv[j] = outr[j * 64]; }
    float ss = 0.f;
#pragma unroll
    for (int j = 0; j < 8; j++) ss += yv[j].x * yv[j].x + yv[j].y * yv[j].y + yv[j].z * yv[j].z + yv[j].w * yv[j].w;
    ss = wave_sum(ss);
    const float rinv = rsqrtf(ss * (1.f / 2048.f) + 1e-6f);
#pragma unroll
    for (int j = 0; j < 8; j++) {
      const float4 g = gpo[j * 64];
      xv[j].x += yv[j].x * rinv * g.x; xv[j].y += yv[j].y * rinv * g.y; xv[j].z += yv[j].z * rinv * g.z; xv[j].w += yv[j].w * rinv * g.w;
      outr[j * 64] = xv[j];
    }
  }
}

constexpr int NPHASE = 13;
constexpr unsigned DUP_MASK = 0u;
DI void run_phase(int ph, const Params& p, char* smem, int bid, int nblk, int rep) {
  switch (ph) {
    case 0: phase_prep(p, smem, bid, nblk); break;
    case 1: phase_gemm_in0(p, smem, bid, nblk); break;
    case 2: phase_gla_prep(p, smem, bid, nblk); break;
    case 3: phase_gla_local(p, smem, bid, nblk); break;
    case 4: phase_gla_scan(p, smem, bid, nblk); break;
    case 5: phase_og(p, smem, bid, nblk); break;
    case 6: phase_gemm_out(p, smem, bid, nblk, OFF_WOUT0T); break;
    case 7: phase_post0(p, smem, bid, nblk); break;
    case 8: phase_gemm_in1(p, smem, bid, nblk); break;
    case 9: phase_gemm_qkv(p, smem, bid, nblk); break;
    case 10: phase_attn(p, smem, bid, nblk, rep); break;
    case 11: phase_gemm_out(p, smem, bid, nblk, OFF_WOUT1T); break;
    case 12: phase_final(p, smem, bid, nblk); break;
  }
}

#define XB_TMO      128
#define XB_XCNT(j)  (256  + 64 * (j))
#define XB_XSUB(j)  (1280 + 64 * (j))
#define XB_XGEN(j)  (2304 + 64 * (j))
#define XB_TOP      3328
#define XB_TOPGEN   3392
#define XCD_BAR_WORDS 3456
#define XB_SPIN_CAP (1u << 20)
#define LAS __attribute__((address_space(3)))
DI unsigned xb_ld(unsigned* p) { return __hip_atomic_load(p, __ATOMIC_RELAXED, __HIP_MEMORY_SCOPE_AGENT); }
DI unsigned xb_add(unsigned* p, unsigned v) { return __hip_atomic_fetch_add(p, v, __ATOMIC_RELAXED, __HIP_MEMORY_SCOPE_AGENT); }
DI unsigned xb_xcc_id() { return (unsigned)__builtin_amdgcn_s_getreg((3 << 11) | 20) & 0xFu; }
#define XB_SPIN(cond, bar) do { unsigned _sp = 0; while (cond) { __builtin_amdgcn_s_sleep(1); \
    if ((++_sp & 255u) == 0u) { if (xb_ld(&(bar)[XB_TMO])) break; if (_sp > XB_SPIN_CAP) { atomicAdd(&(bar)[XB_TMO], 1u); break; } } } } while (0)
struct XcdBarrier { unsigned* bar; unsigned x; volatile LAS unsigned* st; };
DI XcdBarrier xcd_barrier_post(unsigned* bar, volatile LAS unsigned* st) {
  XcdBarrier b; b.bar = bar; b.x = xb_xcc_id(); b.st = st;
  if (threadIdx.x == 0) (void)xb_add(&bar[XB_XCNT(b.x)], 1u);
  return b;
}
DI void xcd_barrier_complete(unsigned* bar, unsigned x, unsigned& nloc, unsigned& nx) {
  const unsigned G = gridDim.x * gridDim.y * gridDim.z;
  unsigned sum, cnt, mine, sp = 0u;
  for (;;) {
    sum = 0u; cnt = 0u; mine = 0u;
#pragma unroll
    for (unsigned j = 0; j < 16; ++j) { const unsigned c = xb_ld(&bar[XB_XCNT(j)]); sum += c; cnt += (c > 0u) ? 1u : 0u; mine = (j == x) ? c : mine; }
    if (sum == G) break;
    __builtin_amdgcn_s_sleep(1);
    if ((++sp & 255u) == 0u) { if (xb_ld(&bar[XB_TMO])) break; if (sp > XB_SPIN_CAP) { atomicAdd(&bar[XB_TMO], 1u); break; } }
  }
  nloc = mine > 0u ? mine : 1u; nx = cnt > 0u ? cnt : 1u;
}
DI void xcd_barrier(const XcdBarrier& b) {
  asm volatile("s_waitcnt vmcnt(0)" ::: "memory");
  __syncthreads();
  if (threadIdx.x == 0) {
    unsigned* bar = b.bar;
    __builtin_amdgcn_s_waitcnt(0);
    unsigned nloc, nx;
    xcd_barrier_complete(bar, b.x, nloc, nx);
    const unsigned old = xb_add(&bar[XB_XSUB(b.x)], 1u);
    const unsigned gen = old / nloc;
    if (old + 1u == (gen + 1u) * nloc) {
      __builtin_amdgcn_fence(__ATOMIC_RELEASE, "agent");
      asm volatile("s_waitcnt vmcnt(0)" ::: "memory");
      const unsigned og = xb_add(&bar[XB_TOP], 1u);
      const unsigned tg = og / nx;
      if (og + 1u == (tg + 1u) * nx) xb_add(&bar[XB_TOPGEN], 1u);
      else XB_SPIN(xb_ld(&bar[XB_TOPGEN]) == tg, bar);
      __builtin_amdgcn_fence(__ATOMIC_ACQUIRE, "agent");
      xb_add(&bar[XB_XGEN(b.x)], 1u);
      asm volatile("s_waitcnt vmcnt(0)" ::: "memory");
    } else {
      XB_SPIN(xb_ld(&bar[XB_XGEN(b.x)]) == gen, bar);
      __builtin_amdgcn_fence(__ATOMIC_ACQUIRE, "agent");
      asm volatile("s_waitcnt vmcnt(0)" ::: "memory");
    }
  }
  __syncthreads();
}

#if MEGA
__global__ void __launch_bounds__(256, 2) mega_kernel(Params p) {
  __shared__ __attribute__((aligned(16))) char smem[65536];
  cg::grid_group grid = cg::this_grid();
  const int bid = blockIdx.x, nblk = gridDim.x;
  (void)xcd_barrier_post((unsigned*)(p.ws + OFF_BAR), (volatile LAS unsigned*)0);
#pragma nounroll
  for (int ph = 0; ph < NPHASE; ph++) {
    int phv = ph;
    asm volatile("" : "+s"(phv));
    run_phase(phv, p, smem, bid, nblk, 0);
    if (p.ws == nullptr) grid.sync();
    { XcdBarrier xb; xb.bar = (unsigned*)(opaque_ptr(p.ws) + OFF_BAR); xb.x = xb_xcc_id(); xb.st = (volatile LAS unsigned*)0; xcd_barrier(xb); }
    if ((DUP_MASK >> ph) & 1u) {
      run_phase(phv, p, smem, bid, nblk, 1);
      { XcdBarrier xb; xb.bar = (unsigned*)(opaque_ptr(p.ws) + OFF_BAR); xb.x = xb_xcc_id(); xb.st = (volatile LAS unsigned*)0; xcd_barrier(xb); }
    }
  }
}
#endif

#if !MEGA
template <int PH>
__global__ void __launch_bounds__(256, 2) phase_kernel_t(Params p) {
  __shared__ __attribute__((aligned(16))) char smem[65536];
  run_phase(PH, p, smem, blockIdx.x, gridDim.x, 0);
}
#endif

extern "C" void kernel_launch(void* const* d_in, const int* in_sizes, int n_in, void* d_out, int out_size, void* d_ws,
                              size_t ws_size, hipStream_t stream) {
  Params p{};
  p.x = (const float*)d_in[0]; p.pos = (const int*)d_in[1]; p.l0_pre = (const float*)d_in[2]; p.w_in0 = (const float*)d_in[3];
  p.w_gk2 = (const float*)d_in[4]; p.b_gk = (const float*)d_in[5]; p.g_onorm = (const float*)d_in[6]; p.w_out0 = (const float*)d_in[7];
  p.l0_post = (const float*)d_in[8]; p.l1_pre = (const float*)d_in[9]; p.w_in1 = (const float*)d_in[10]; p.g_qa = (const float*)d_in[11];
  p.w_qb = (const float*)d_in[12]; p.g_kva = (const float*)d_in[13]; p.w_kvb = (const float*)d_in[14]; p.w_out1 = (const float*)d_in[15];
  p.l1_post = (const float*)d_in[16];
  p.out = (float*)d_out; p.ws = (char*)d_ws;
  for (int i = 0; i < 32; i++) p.invf[i] = (float)pow(10000.0, -(double)i / 32.0);
#if MEGA
  static int grid_blocks = 0;
  if (!grid_blocks) {
    int dev = 0, cus = 0, per_cu = 0;
    hipGetDevice(&dev);
    hipDeviceGetAttribute(&cus, hipDeviceAttributeMultiprocessorCount, dev);
    hipOccupancyMaxActiveBlocksPerMultiprocessor(&per_cu, mega_kernel, 256, 0);
    if (per_cu > 2) per_cu = 2;
    if (per_cu < 1) per_cu = 1;
    grid_blocks = cus * per_cu;
  }
  hipMemsetAsync((char*)d_ws + OFF_BAR, 0, XCD_BAR_WORDS * 4, stream);
  void* args[] = {&p};
  hipError_t e = hipLaunchCooperativeKernel((void*)mega_kernel, dim3(grid_blocks), dim3(256), args, 0, stream);
  if (e != hipSuccess) fprintf(stderr, "cooperative launch failed: %s (grid %d)\n", hipGetErrorString(e), grid_blocks);
#else
#define LPH(N) hipLaunchKernelGGL(phase_kernel_t<N>, dim3(512), dim3(256), 0, stream, p);
  LPH(0) LPH(1) LPH(2) LPH(3) LPH(4) LPH(5) LPH(6) LPH(7) LPH(8) LPH(9) LPH(10) LPH(11) LPH(12)
#undef LPH
#endif
}
```

```cpp
#include <hip/hip_runtime.h>
#include <hip/hip_cooperative_groups.h>
#include <stdint.h>
#include <math.h>
#include <stdio.h>
namespace cg = cooperative_groups;

#ifndef MEGA
#define MEGA 1
#endif

typedef __attribute__((ext_vector_type(8))) short bf16x8;
typedef __attribute__((ext_vector_type(4))) short s16x4;
typedef __attribute__((ext_vector_type(16))) float f32x16;
typedef unsigned short bf16_t;
#define DI __device__ __forceinline__
#define MFMA32(a, b, c) __builtin_amdgcn_mfma_f32_32x32x16_bf16((a), (b), (c), 0, 0, 0)

constexpr int S_ = 8192;
constexpr size_t MiB = (size_t)1 << 20;
constexpr size_t OFF_WIN0T = 0;
constexpr size_t OFF_WOUT0T = 25 * MiB;
constexpr size_t OFF_WIN1T = 33 * MiB;
constexpr size_t OFF_WQBT = 46 * MiB;
constexpr size_t OFF_WKVBT = 49 * MiB;
constexpr size_t OFF_WOUT1T = 53 * MiB;
constexpr size_t OFF_GKLOW = 61 * MiB;
constexpr size_t OFF_DECAY = 61 * MiB + 512 * 1024;
constexpr size_t OFF_CS = 62 * MiB;
constexpr size_t OFF_H = 64 * MiB;
constexpr size_t OFF_QK0 = 96 * MiB;
constexpr size_t OFF_V0T = 128 * MiB;
constexpr size_t OFF_G0 = 160 * MiB;
constexpr size_t OFF_Y = 128 * MiB;
constexpr size_t OFF_QE = 192 * MiB;
constexpr size_t OFF_KLT = 208 * MiB;
constexpr size_t OFF_AM = 224 * MiB;
constexpr size_t OFF_CQ = 0;
constexpr size_t OFF_CKV = 8 * MiB;
constexpr size_t OFF_KR = 16 * MiB;
constexpr size_t OFF_RINVQ = 17 * MiB;
constexpr size_t OFF_RINVKV = 17 * MiB + 64 * 1024;
constexpr size_t OFF_KRRAW = 18 * MiB;
constexpr size_t OFF_CTR = 20 * MiB;
constexpr size_t OFF_BAR = 255 * MiB;
constexpr size_t OFF_SL = 64 * MiB;
constexpr size_t OFF_DC = 80 * MiB;
constexpr size_t OFF_Q = 128 * MiB;
constexpr size_t OFF_KN = 176 * MiB;
constexpr size_t OFF_VT = 208 * MiB;

struct Params {
  const float* x; const int* pos; const float* l0_pre; const float* w_in0; const float* w_gk2; const float* b_gk;
  const float* g_onorm; const float* w_out0; const float* l0_post; const float* l1_pre; const float* w_in1;
  const float* g_qa; const float* w_qb; const float* g_kva; const float* w_kvb; const float* w_out1; const float* l1_post;
  float* out; char* ws;
  float invf[32];
};

DI int tid_opaque() { int t = threadIdx.x; asm volatile("" : "+v"(t)); return t; }
#define TID tid_opaque()
typedef __attribute__((address_space(1))) char gchar_t;
DI char* opaque_ptr(char* q) {
  unsigned long long v = (unsigned long long)q;
  unsigned lo = __builtin_amdgcn_readfirstlane((unsigned)v), hi = __builtin_amdgcn_readfirstlane((unsigned)(v >> 32));
  asm volatile("" : "+s"(lo), "+s"(hi));
  return (char*)(gchar_t*)(((unsigned long long)hi << 32) | lo);
}
typedef __bf16 hbf16x2 __attribute__((ext_vector_type(2)));
typedef float hf32x2 __attribute__((ext_vector_type(2)));
DI unsigned pack2(float a, float b) { hf32x2 f = {a, b}; return __builtin_bit_cast(unsigned, __builtin_convertvector(f, hbf16x2)); }
DI unsigned f2bf(float f) { return (unsigned)__builtin_bit_cast(unsigned short, (__bf16)f); }
DI float bf2f(unsigned h) { return __uint_as_float(h << 16); }
DI float bflo(unsigned u) { return __uint_as_float(u << 16); }
DI float bfhi(unsigned u) { return __uint_as_float(u & 0xffff0000u); }
DI int crow(int i, int h) { return (i & 3) + 8 * (i >> 2) + 4 * h; }
DI float silu(float v) { return v / (1.f + __expf(-v)); }
DI float wave_sum(float v) { for (int o = 32; o > 0; o >>= 1) v += __shfl_xor(v, o); return v; }
DI float block_sum(float v, float* red) {
  v = wave_sum(v);
  __syncthreads();
  if ((TID & 63) == 0) red[TID >> 6] = v;
  __syncthreads();
  return red[0] + red[1] + red[2] + red[3];
}
DI bf16x8 pack8(const f32x16& x, int s) {
  union { unsigned u[4]; bf16x8 v; } p;
  p.u[0] = pack2(x[8 * s + 0], x[8 * s + 1]); p.u[1] = pack2(x[8 * s + 2], x[8 * s + 3]);
  p.u[2] = pack2(x[8 * s + 4], x[8 * s + 5]); p.u[3] = pack2(x[8 * s + 6], x[8 * s + 7]);
  return p.v;
}

DI void transpose_tile4(const float* __restrict__ W, int K, int N, int ntN, const float* __restrict__ gain, bf16_t* __restrict__ WT,
                        int id0, char* smem) {
  const int t = TID;
  float v[4][16];
#pragma unroll
  for (int q = 0; q < 4; q++) {
    const int id = id0 + q, k0 = (id / ntN) * 64, n0 = (id % ntN) * 64;
#pragma unroll
    for (int i = 0; i < 16; i++) {
      const int kk = i * 4 + (t >> 6), n = n0 + (t & 63);
      float x = (n < N) ? W[(size_t)(k0 + kk) * N + n] : 0.f;
      if (gain) x *= gain[k0 + kk];
      v[q][i] = x;
    }
  }
#pragma unroll
  for (int q = 0; q < 4; q++) {
    unsigned short (*tile)[72] = (unsigned short (*)[72])(smem + q * 9216);
#pragma unroll
    for (int i = 0; i < 16; i++) tile[t & 63][i * 4 + (t >> 6)] = (unsigned short)f2bf(v[q][i]);
  }
  __syncthreads();
#pragma unroll
  for (int q = 0; q < 4; q++) {
    unsigned short (*tile)[72] = (unsigned short (*)[72])(smem + q * 9216);
    const int id = id0 + q, k0 = (id / ntN) * 64, n0 = (id % ntN) * 64;
    const int nn = t >> 2, kg = (t & 3) * 16;
    uint4 a = *(const uint4*)&tile[nn][kg];
    uint4 b = *(const uint4*)&tile[nn][kg + 8];
    bf16_t* dst = WT + (size_t)(n0 + nn) * K + k0 + kg;
    *(uint4*)dst = a; *(uint4*)(dst + 8) = b;
  }
  __syncthreads();
}

DI void phase_prep(const Params& p, char* smem, int bid, int nblk) {
  const int t = TID;
  char* ws = opaque_ptr(p.ws);
  for (int task = bid; task < 1920 + 3072; task += nblk) {
    if (task < 1920) {
      const int tile0 = task * 4;
      const float* W; const float* gain = nullptr; bf16_t* WT; int K, N, ntN, id;
      if (tile0 < 3136) { id = tile0; W = p.w_in0; K = 2048; N = 6160; ntN = 98; WT = (bf16_t*)(ws + OFF_WIN0T); }
      else if (tile0 < 4160) { id = tile0 - 3136; W = p.w_out0; K = 2048; N = 2048; ntN = 32; WT = (bf16_t*)(ws + OFF_WOUT0T); }
      else if (tile0 < 5760) { id = tile0 - 4160; W = p.w_in1; K = 2048; N = 3136; ntN = 50; WT = (bf16_t*)(ws + OFF_WIN1T); }
      else if (tile0 < 6144) { id = tile0 - 5760; W = p.w_qb; K = 512; N = 3072; ntN = 48; WT = (bf16_t*)(ws + OFF_WQBT); gain = p.g_qa; }
      else if (tile0 < 6656) { id = tile0 - 6144; W = p.w_kvb; K = 512; N = 4096; ntN = 64; WT = (bf16_t*)(ws + OFF_WKVBT); gain = p.g_kva; }
      else { id = tile0 - 6656; W = p.w_out1; K = 2048; N = 2048; ntN = 32; WT = (bf16_t*)(ws + OFF_WOUT1T); }
      transpose_tile4(W, K, N, ntN, gain, WT, id, smem);
    } else if (task < 1920 + 2048) {
      const int lane = t & 63, row = (task - 1920) * 4 + (t >> 6);
      const float4* xr = (const float4*)(p.x + (size_t)row * 2048) + lane;
      const float4* gr = (const float4*)p.l0_pre + lane;
      float4 xv[8];
#pragma unroll
      for (int j = 0; j < 8; j++) xv[j] = xr[j * 64];
      float ss = 0.f;
#pragma unroll
      for (int j = 0; j < 8; j++) ss += xv[j].x * xv[j].x + xv[j].y * xv[j].y + xv[j].z * xv[j].z + xv[j].w * xv[j].w;
      ss = wave_sum(ss);
      const float rinv = rsqrtf(ss * (1.f / 2048.f) + 1e-6f);
      uint2* hr = (uint2*)(ws + OFF_H + (size_t)row * 4096) + lane;
#pragma unroll
      for (int j = 0; j < 8; j++) {
        const float4 g = gr[j * 64];
        uint2 o; o.x = pack2(xv[j].x * rinv * g.x, xv[j].y * rinv * g.y); o.y = pack2(xv[j].z * rinv * g.z, xv[j].w * rinv * g.w);
        hr[j * 64] = o;
      }
    } else {
      const int idx = (task - 3968) * 256 + t;
      const int token = idx >> 5, i = idx & 31;
      double ang = (double)p.pos[token] * (double)p.invf[i];
      double tt = ang * 0.15915494309189535;
      tt -= floor(tt + 0.5);
      float f = (float)tt;
      float* cs = (float*)(ws + OFF_CS);
      cs[token * 64 + i] = __builtin_amdgcn_cosf(f);
      cs[token * 64 + 32 + i] = __builtin_amdgcn_sinf(f);
    }
  }
}

DI float sq8(const uint4& v) {
  return bflo(v.x) * bflo(v.x) + bfhi(v.x) * bfhi(v.x) + bflo(v.y) * bflo(v.y) + bfhi(v.y) * bfhi(v.y) + bflo(v.z) * bflo(v.z) + bfhi(v.z) * bfhi(v.z) +
         bflo(v.w) * bflo(v.w) + bfhi(v.w) * bfhi(v.w);
}
template <bool SWAP, bool SUMSQ = false>
DI void gemm_main(f32x16 (&acc)[4][2], const bf16_t* A, int lda, const bf16_t* B, int ldb, int K,
                  int m0, int n0, char* smem) {
  const int t = TID, lane = t & 63, w = t >> 6, wm = w >> 1, wn = w & 1, r = lane & 31, h = lane >> 5;
#pragma unroll
  for (int a = 0; a < 4; a++)
#pragma unroll
    for (int b = 0; b < 2; b++)
#pragma unroll
      for (int i = 0; i < 16; i++) acc[a][b][i] = 0.f;
  const int lrow = t >> 2, kc = t & 3;
  const bf16_t* ag = A + (size_t)(m0 + lrow) * lda + kc * 8;
  const bf16_t* bg = B + (size_t)(n0 + lrow) * ldb + kc * 8;
  const int lds_w = lrow * 64 + ((kc ^ ((lrow >> 2) & 3)) << 4);
  uint4 pa0, pa1, pa2, pa3, pb0, pb1;
  bf16x8 fa0, fa1, fa2, fa3, fa4, fa5, fb0, fb1, fb2, fb3, fb4, fb5;
#define G_LOAD(X, ko_)                                                                                   \
  X##a0 = *(const uint4*)(ag + (ko_)); X##a1 = *(const uint4*)(ag + (size_t)64 * lda + (ko_));           \
  X##a2 = *(const uint4*)(ag + (size_t)128 * lda + (ko_)); X##a3 = *(const uint4*)(ag + (size_t)192 * lda + (ko_)); \
  X##b0 = *(const uint4*)(bg + (ko_)); X##b1 = *(const uint4*)(bg + (size_t)64 * ldb + (ko_));
#define L_STORE(X, base_)                                                                                \
  *(uint4*)((base_) + lds_w) = X##a0; *(uint4*)((base_) + lds_w + 4096) = X##a1;                         \
  *(uint4*)((base_) + lds_w + 8192) = X##a2; *(uint4*)((base_) + lds_w + 12288) = X##a3;                 \
  *(uint4*)((base_) + 16384 + lds_w) = X##b0; *(uint4*)((base_) + 16384 + lds_w + 4096) = X##b1;         \
  if (SUMSQ) { q0 += sq8(X##a0); q1 += sq8(X##a1); q2 += sq8(X##a2); q3 += sq8(X##a3); }
#define G_READ(F, base_, c_)                                                                             \
  F##0 = *(const bf16x8*)((base_) + a_off + (c_)); F##1 = *(const bf16x8*)((base_) + a_off + 32 * 64 + (c_));              \
  F##2 = *(const bf16x8*)((base_) + a_off + 64 * 64 + (c_)); F##3 = *(const bf16x8*)((base_) + a_off + 96 * 64 + (c_));    \
  F##4 = *(const bf16x8*)((base_) + b_off + (c_)); F##5 = *(const bf16x8*)((base_) + b_off + 32 * 64 + (c_));
#define G_MMA(a0, a1, a2, a3, b0, b1)                                                                    \
    if (SWAP) {                                                                                          \
      acc[0][0] = MFMA32(b0, a0, acc[0][0]); acc[0][1] = MFMA32(b1, a0, acc[0][1]);                      \
      acc[1][0] = MFMA32(b0, a1, acc[1][0]); acc[1][1] = MFMA32(b1, a1, acc[1][1]);                      \
      acc[2][0] = MFMA32(b0, a2, acc[2][0]); acc[2][1] = MFMA32(b1, a2, acc[2][1]);                      \
      acc[3][0] = MFMA32(b0, a3, acc[3][0]); acc[3][1] = MFMA32(b1, a3, acc[3][1]);                      \
    } else {                                                                                             \
      acc[0][0] = MFMA32(a0, b0, acc[0][0]); acc[0][1] = MFMA32(a0, b1, acc[0][1]);                      \
      acc[1][0] = MFMA32(a1, b0, acc[1][0]); acc[1][1] = MFMA32(a1, b1, acc[1][1]);                      \
      acc[2][0] = MFMA32(a2, b0, acc[2][0]); acc[2][1] = MFMA32(a2, b1, acc[2][1]);                      \
      acc[3][0] = MFMA32(a3, b0, acc[3][0]); acc[3][1] = MFMA32(a3, b1, acc[3][1]);                      \
    }
#define G_MMA6(F) G_MMA(F##0, F##1, F##2, F##3, F##4, F##5)
  float q0 = 0.f, q1 = 0.f, q2 = 0.f, q3 = 0.f;
  const int sw = (r >> 2) & 3;
  const int a_off = (wm * 128 + r) * 64, b_off = 16384 + (wn * 64 + r) * 64;
  const int c0 = (h ^ sw) << 4, c1 = ((2 + h) ^ sw) << 4;
  const int nk = K >> 5;
  G_LOAD(p, 0)
  L_STORE(p, smem)
  G_LOAD(p, 32)
  __syncthreads();
  G_READ(fa, smem, c0)
  G_READ(fb, smem, c1)
  G_MMA6(fa)
  asm volatile("" ::: "memory");
  __builtin_amdgcn_sched_barrier(0);
  L_STORE(p, smem + 24576)
  {
    const int kn = ((2 < nk) ? 2 : (nk - 1)) * 32;
    G_LOAD(p, kn)
  }
  __syncthreads();
  for (int kt = 0; kt < nk - 1; kt++) {
    const char* nb = smem + ((kt + 1) & 1) * 24576;
    G_READ(fa, nb, c0)
    G_MMA6(fb)
    G_READ(fb, nb, c1)
    G_MMA6(fa)
    __builtin_amdgcn_sched_group_barrier(0x100, 6, 0);
    __builtin_amdgcn_sched_group_barrier(0x008, 8, 0);
    __builtin_amdgcn_sched_group_barrier(0x100, 6, 0);
    __builtin_amdgcn_sched_group_barrier(0x008, 8, 0);
    asm volatile("" ::: "memory");
    __builtin_amdgcn_sched_barrier(0);
    if (kt + 2 < nk) {
      L_STORE(p, smem + (kt & 1) * 24576)
    }
    {
      const int kn = ((kt + 3 < nk) ? (kt + 3) : (nk - 1)) * 32;
      G_LOAD(p, kn)
    }
    __syncthreads();
  }
  G_MMA6(fb)
#undef G_LOAD
#undef L_STORE
#undef G_READ
#undef G_MMA
#undef G_MMA6
  if (SUMSQ) {
    q0 += __shfl_xor(q0, 1); q1 += __shfl_xor(q1, 1); q2 += __shfl_xor(q2, 1); q3 += __shfl_xor(q3, 1);
    q0 += __shfl_xor(q0, 2); q1 += __shfl_xor(q1, 2); q2 += __shfl_xor(q2, 2); q3 += __shfl_xor(q3, 2);
    if (kc == 0) {
      float* rf = (float*)(smem + 49152);
      const float ik = 1.f / (float)K;
      rf[lrow] = rsqrtf(q0 * ik + 1e-6f); rf[lrow + 64] = rsqrtf(q1 * ik + 1e-6f);
      rf[lrow + 128] = rsqrtf(q2 * ik + 1e-6f); rf[lrow + 192] = rsqrtf(q3 * ik + 1e-6f);
    }
    __syncthreads();
  }
}

#define EPI_LOOP_BEGIN                                                                                           \
  {                                                                                                              \
    const int lane_ = TID & 63, w_ = TID >> 6, wm_ = w_ >> 1, wn_ = w_ & 1, r_ = lane_ & 31, h_ = lane_ >> 5; \
    _Pragma("unroll") for (int mt = 0; mt < 4; mt++) _Pragma("unroll") for (int nt = 0; nt < 2; nt++)          \
        _Pragma("unroll") for (int i = 0; i < 16; i++) {                                                         \
      const float v = acc[mt][nt][i];
#define EPI_COORD_NS const int row = m0 + wm_ * 128 + mt * 32 + crow(i, h_); const int col = n0 + wn_ * 64 + nt * 32 + r_;
#define EPI_COORD_SW const int row = m0 + wm_ * 128 + mt * 32 + r_; const int col = n0 + wn_ * 64 + nt * 32 + crow(i, h_);
#define EPI_LOOP_END }}

DI void phase_gemm_in0(const Params& p, char* smem, int bid, int nblk) {
  char* ws = opaque_ptr(p.ws);
  const bf16_t* A = (const bf16_t*)(ws + OFF_H);
  const bf16_t* B = (const bf16_t*)(ws + OFF_WIN0T);
  bf16_t* QK = (bf16_t*)(ws + OFF_QK0);
  bf16_t* V0T = (bf16_t*)(ws + OFF_V0T);
  bf16_t* G0 = (bf16_t*)(ws + OFF_G0);
  float* GKL = (float*)(ws + OFF_GKLOW);
  for (int tile = bid; tile < 32 * 48; tile += nblk) {
    const int mi = tile & 31, ni = tile >> 5;
    const int m0 = mi * 256, n0 = ni * 128;
    f32x16 acc[4][2];
    if (ni >= 16) {
      if (ni < 32) {
        gemm_main<true>(acc, A, 2048, B, 2048, 2048, m0, n0, smem);
        EPI_LOOP_BEGIN EPI_COORD_SW
          V0T[(size_t)(col - 2048) * S_ + row] = (bf16_t)f2bf(v);
        EPI_LOOP_END
      } else {
        gemm_main<false>(acc, A, 2048, B, 2048, 2048, m0, n0, smem);
        EPI_LOOP_BEGIN EPI_COORD_NS
          G0[(size_t)row * 2048 + (col - 4096)] = (bf16_t)f2bf(silu(v));
        EPI_LOOP_END
      }
    } else {
      gemm_main<false>(acc, A, 2048, B, 2048, 2048, m0, n0, smem);
      EPI_LOOP_BEGIN EPI_COORD_NS
        QK[(size_t)row * 2048 + col] = (bf16_t)f2bf(v);
      EPI_LOOP_END
    }
  }
  {
    typedef __attribute__((ext_vector_type(4))) float f32x4_t;
    const int t = TID, lane = t & 63, w = t >> 6, l15 = lane & 15, quad = lane >> 4;
    float* red = (float*)smem;
    for (int item = bid; item < 512; item += nblk) {
      const bf16_t* ap = A + (size_t)(item * 16 + l15) * 2048 + 512 * w + 8 * quad;
      const bf16_t* bp = B + (size_t)(6144 + l15) * 2048 + 512 * w + 8 * quad;
      f32x4_t c = {0.f, 0.f, 0.f, 0.f};
#pragma unroll
      for (int s = 0; s < 16; s++) {
        const bf16x8 a = *(const bf16x8*)(ap + 32 * s);
        const bf16x8 b = *(const bf16x8*)(bp + 32 * s);
        c = __builtin_amdgcn_mfma_f32_16x16x32_bf16(a, b, c, 0, 0, 0);
      }
      __syncthreads();
#pragma unroll
      for (int j = 0; j < 4; j++) red[(w * 16 + quad * 4 + j) * 16 + l15] = c[j];
      __syncthreads();
      const float v = red[t] + red[256 + t] + red[512 + t] + red[768 + t];
      GKL[(size_t)item * 256 + t] = v;
    }
  }
}

DI void phase_gla_prep(const Params& p, char* smem, int bid, int nblk) {
  char* ws = opaque_ptr(p.ws);
  const int t = TID, lane = t & 63, w = t >> 6, r = lane & 31, h = lane >> 5;
  const bf16_t* QK = (const bf16_t*)(ws + OFF_QK0);
  const float* GKL = (const float*)(ws + OFF_GKLOW);
  bf16_t* QE = (bf16_t*)(ws + OFF_QE);
  bf16_t* KLT = (bf16_t*)(ws + OFF_KLT);
  bf16_t* AM = (bf16_t*)(ws + OFF_AM);
  float* DEC = (float*)(ws + OFF_DECAY);
  if (bid == 0 && t == 0) { ((int*)(ws + OFF_CTR))[0] = 0; ((int*)(ws + OFF_CTR))[1] = 0; }
  char* lq = smem;
  char* lk = smem + 32768;
  for (int tile = bid; tile < 512; tile += nblk) {
    const int n = tile >> 2, head = tile & 3, t0 = n * 64, d = t, col = head * 256 + d;
    float w2[16];
#pragma unroll
    for (int j = 0; j < 16; j++) w2[j] = p.w_gk2[j * 1024 + col];
    const float bias = p.b_gk[col];
    float b = 0.f;
    const int dperm = (d & ~15) | ((d & 3) | ((d & 4) << 1) | ((d & 8) >> 1));
    for (int c8 = 0; c8 < 8; c8++) {
      float bj[8], qv[8], kv[8];
#pragma unroll
      for (int j = 0; j < 8; j++) {
        const int c = c8 * 8 + j;
        const float4* gl = (const float4*)(GKL + (size_t)(t0 + c) * 16);
        float4 g0 = gl[0], g1 = gl[1], g2 = gl[2], g3 = gl[3];
        float gk = bias + g0.x * w2[0] + g0.y * w2[1] + g0.z * w2[2] + g0.w * w2[3] + g1.x * w2[4] + g1.y * w2[5] + g1.z * w2[6] + g1.w * w2[7]
                 + g2.x * w2[8] + g2.y * w2[9] + g2.z * w2[10] + g2.w * w2[11] + g3.x * w2[12] + g3.y * w2[13] + g3.z * w2[14] + g3.w * w2[15];
        float la = (fminf(gk, 0.f) - __logf(1.f + __expf(-fabsf(gk)))) * (1.f / 16.f);
        b += la;
        bj[j] = b;
        qv[j] = bf2f(QK[(size_t)(t0 + c) * 2048 + col]);
        kv[j] = bf2f(QK[(size_t)(t0 + c) * 2048 + 1024 + col]);
      }
      unsigned klp[4];
#pragma unroll
      for (int j = 0; j < 8; j++) {
        const int c = c8 * 8 + j;
        const float qe = qv[j] * 0.0625f * __expf(bj[j]);
        const float ke = kv[j] * __expf(-bj[j]);
        const unsigned qeb = f2bf(qe), keb = f2bf(ke), klb = keb;
        const int lo = c * 512 + ((((d >> 3) ^ (c & 15))) << 4) + (d & 7) * 2;
        *(unsigned short*)(lq + lo) = (unsigned short)qeb;
        *(unsigned short*)(lk + lo) = (unsigned short)keb;
        QE[(size_t)(t0 + c) * 1024 + head * 256 + dperm] = (bf16_t)qeb;
        if (j & 1) klp[j >> 1] |= klb << 16; else klp[j >> 1] = klb;
      }
      uint4 o; o.x = klp[0]; o.y = klp[1]; o.z = klp[2]; o.w = klp[3];
      *(uint4*)(KLT + (size_t)(head * 256 + d) * S_ + t0 + c8 * 8) = o;
    }
    DEC[(size_t)(n * 4 + head) * 256 + d] = __expf(b);
    __syncthreads();
    {
      const int ct = w >> 1, st = w & 1;
      f32x16 acc;
#pragma unroll
      for (int i = 0; i < 16; i++) acc[i] = 0.f;
      if (!(ct == 0 && st == 1)) {
        const int ra = ct * 32 + r, rb = st * 32 + r;
#pragma unroll
        for (int s = 0; s < 16; s++) {
          bf16x8 a = *(const bf16x8*)(lq + ra * 512 + (((2 * s + h) ^ (ra & 15)) << 4));
          bf16x8 bb = *(const bf16x8*)(lk + rb * 512 + (((2 * s + h) ^ (rb & 15)) << 4));
          acc = MFMA32(a, bb, acc);
        }
      }
      bf16_t* ap = AM + (size_t)(n * 4 + head) * 4096;
#pragma unroll
      for (int i = 0; i < 16; i++) {
        const int c = ct * 32 + crow(i, h), s = st * 32 + r;
        ap[c * 64 + s] = (bf16_t)f2bf(s <= c ? acc[i] : 0.f);
      }
    }
    __syncthreads();
  }
}

constexpr int SCAN_NG = 8, SCAN_GC = 16;
DI void phase_gla_local(const Params& p, char* smem, int bid, int nblk) {
  char* ws = opaque_ptr(p.ws);
  const int t = TID, lane = t & 63, w = t >> 6, r = lane & 31, h = lane >> 5;
  for (int item = bid; item < 64 * (SCAN_NG - 1); item += nblk) {
    const int grp = item >> 6, head = (item >> 4) & 3, dvt = item & 15, dv0 = dvt * 32;
    const int nb = grp * SCAN_GC;
    const bf16_t* v_p = (const bf16_t*)(ws + OFF_V0T) + (size_t)(head * 512 + dv0 + r) * S_ + nb * 64 + 8 * h;
    const bf16_t* kl_p = (const bf16_t*)(ws + OFF_KLT) + (size_t)(head * 256 + 64 * w + r) * S_ + nb * 64 + 8 * h;
    const float* dec_p = (const float*)(ws + OFF_DECAY) + (size_t)nb * 1024 + head * 256 + 64 * w + 4 * h;
    f32x16 St[2];
#pragma unroll
    for (int i = 0; i < 16; i++) { St[0][i] = 0.f; St[1][i] = 0.f; }
    bf16x8 klA[2][4], vfA[4], klB[2][4], vfB[4];
    float4 dcA[2][4], dcB[2][4];
#define LOC_LOAD(KL, VF, DC, n_)                                                                                 \
    {                                                                                                            \
      _Pragma("unroll") for (int s = 0; s < 4; s++) VF[s] = *(const bf16x8*)(v_p + (n_) * 64 + 16 * s);        \
      _Pragma("unroll") for (int dt = 0; dt < 2; dt++) {                                                         \
        _Pragma("unroll") for (int s = 0; s < 4; s++) KL[dt][s] = *(const bf16x8*)(kl_p + (size_t)dt * 32 * S_ + (n_) * 64 + 16 * s); \
        _Pragma("unroll") for (int g4 = 0; g4 < 4; g4++) DC[dt][g4] = *(const float4*)(dec_p + (size_t)(n_) * 1024 + dt * 32 + 8 * g4); \
      }                                                                                                          \
    }
#define LOC_STEP(KL, VF, DC)                                                                                     \
    {                                                                                                            \
      _Pragma("unroll") for (int dt = 0; dt < 2; dt++) {                                                         \
        _Pragma("unroll") for (int s = 0; s < 4; s++) St[dt] = MFMA32(KL[dt][s], VF[s], St[dt]);                 \
        _Pragma("unroll") for (int g4 = 0; g4 < 4; g4++) {                                                       \
          St[dt][4 * g4 + 0] *= DC[dt][g4].x; St[dt][4 * g4 + 1] *= DC[dt][g4].y;                                \
          St[dt][4 * g4 + 2] *= DC[dt][g4].z; St[dt][4 * g4 + 3] *= DC[dt][g4].w;                                \
        }                                                                                                        \
      }                                                                                                          \
    }
    LOC_LOAD(klA, vfA, dcA, 0)
    for (int n = 0; n < SCAN_GC; n += 2) {
      LOC_LOAD(klB, vfB, dcB, n + 1)
      LOC_STEP(klA, vfA, dcA)
      if (n + 2 < SCAN_GC) LOC_LOAD(klA, vfA, dcA, n + 2)
      LOC_STEP(klB, vfB, dcB)
    }
#undef LOC_LOAD
#undef LOC_STEP
    float* sl = (float*)(ws + OFF_SL) + ((size_t)((grp * 4 + head) * 16 + dvt) * 4 + w) * 2048 + lane;
#pragma unroll
    for (int dt = 0; dt < 2; dt++)
#pragma unroll
      for (int i = 0; i < 16; i++) sl[(dt * 16 + i) * 64] = St[dt][i];
    if (dvt == 0) {
      const float* dg = (const float*)(ws + OFF_DECAY) + (size_t)nb * 1024 + head * 256 + t;
      float pr = 1.f;
#pragma unroll 4
      for (int n = 0; n < SCAN_GC; n++) pr *= dg[(size_t)n * 1024];
      ((float*)(ws + OFF_DC))[(grp * 4 + head) * 256 + t] = pr;
    }
  }
}

DI void phase_gla_scan(const Params& p, char* smem, int bid, int nblk) {
  char* ws = opaque_ptr(p.ws);
  const int t = TID, lane = t & 63, w = t >> 6, r = lane & 31, h = lane >> 5;
  float* lo = (float*)smem;
  for (int item = bid; item < 64 * SCAN_NG; item += nblk) {
    const int grp = item >> 6, head = (item >> 4) & 3, dvt = item & 15, dv0 = dvt * 32;
    const int nb = grp * SCAN_GC, ne = nb + SCAN_GC;
    const bf16_t* qe_p = (const bf16_t*)(ws + OFF_QE) + (size_t)r * 1024 + head * 256 + 64 * w + 8 * h;
    const bf16_t* a_p = (const bf16_t*)(ws + OFF_AM) + (size_t)head * 4096 + (size_t)r * 64 + 16 * w + 8 * h;
    const bf16_t* v_p = (const bf16_t*)(ws + OFF_V0T) + (size_t)(head * 512 + dv0 + r) * S_ + 8 * h;
    const bf16_t* kl_p = (const bf16_t*)(ws + OFF_KLT) + (size_t)(head * 256 + 64 * w + r) * S_ + 8 * h;
    bf16_t* o_p = (bf16_t*)(ws + OFF_QK0) + (size_t)(t >> 2) * 2048 + head * 512 + dv0 + (t & 3) * 8;
    f32x16 St[2];
#pragma unroll
    for (int i = 0; i < 16; i++) { St[0][i] = 0.f; St[1][i] = 0.f; }
    for (int j = 0; j < grp; j++) {
      const float* slj = (const float*)(ws + OFF_SL) + ((size_t)((j * 4 + head) * 16 + dvt) * 4 + w) * 2048 + lane;
      const float* dcj = (const float*)(ws + OFF_DC) + (j * 4 + head) * 256 + 64 * w + 4 * h;
#pragma unroll
      for (int dt = 0; dt < 2; dt++)
#pragma unroll
        for (int g4 = 0; g4 < 4; g4++) {
          const float4 dv = *(const float4*)(dcj + 32 * dt + 8 * g4);
          St[dt][4 * g4 + 0] = St[dt][4 * g4 + 0] * dv.x + slj[(dt * 16 + 4 * g4 + 0) * 64];
          St[dt][4 * g4 + 1] = St[dt][4 * g4 + 1] * dv.y + slj[(dt * 16 + 4 * g4 + 1) * 64];
          St[dt][4 * g4 + 2] = St[dt][4 * g4 + 2] * dv.z + slj[(dt * 16 + 4 * g4 + 2) * 64];
          St[dt][4 * g4 + 3] = St[dt][4 * g4 + 3] * dv.w + slj[(dt * 16 + 4 * g4 + 3) * 64];
        }
    }
    qe_p += (size_t)nb * 64 * 1024; a_p += (size_t)nb * 4 * 4096; v_p += nb * 64; kl_p += nb * 64; o_p += (size_t)nb * 64 * 2048;
    bf16x8 qe[2][4], af[2], vf[4], kl[2][4];
    float* ldec = (float*)(smem + 32768);
    const float* dec_g = (const float*)(ws + OFF_DECAY) + (size_t)nb * 1024 + head * 256 + t;
#pragma unroll
    for (int ct = 0; ct < 2; ct++) {
#pragma unroll
      for (int s = 0; s < 4; s++) qe[ct][s] = *(const bf16x8*)(qe_p + (size_t)ct * 32 * 1024 + 16 * s);
      af[ct] = *(const bf16x8*)(a_p + ct * 32 * 64);
    }
#pragma unroll
    for (int s = 0; s < 4; s++) vf[s] = *(const bf16x8*)(v_p + 16 * s);
#pragma unroll
    for (int dt = 0; dt < 2; dt++) {
#pragma unroll
      for (int s = 0; s < 4; s++) kl[dt][s] = *(const bf16x8*)(kl_p + (size_t)dt * 32 * S_ + 16 * s);
    }
    __syncthreads();
    ldec[t] = dec_g[0];
    __syncthreads();
    for (int n = 0; n < SCAN_GC; n++) {
      const bool more = (n + 1 < SCAN_GC);
      float decn = 0.f;
      if (more) decn = dec_g[(size_t)(n + 1) * 1024];
      f32x16 o[2];
#pragma unroll
      for (int i = 0; i < 16; i++) { o[0][i] = 0.f; o[1][i] = 0.f; }
#pragma unroll
      for (int s = 0; s < 4; s++) {
        bf16x8 sb = pack8(St[s >> 1], s & 1);
        o[0] = MFMA32(qe[0][s], sb, o[0]);
        o[1] = MFMA32(qe[1][s], sb, o[1]);
      }
      if (more) {
        const bf16_t* q2 = qe_p + (size_t)(n + 1) * 64 * 1024;
#pragma unroll
        for (int ct = 0; ct < 2; ct++)
#pragma unroll
          for (int s = 0; s < 4; s++) qe[ct][s] = *(const bf16x8*)(q2 + (size_t)ct * 32 * 1024 + 16 * s);
      }
      {
        bf16x8 vw = (w == 0) ? vf[0] : (w == 1) ? vf[1] : (w == 2) ? vf[2] : vf[3];
        o[0] = MFMA32(af[0], vw, o[0]);
        o[1] = MFMA32(af[1], vw, o[1]);
      }
      if (more) {
        const bf16_t* a2 = a_p + (size_t)(n + 1) * 4 * 4096;
        af[0] = *(const bf16x8*)(a2); af[1] = *(const bf16x8*)(a2 + 32 * 64);
      }
#pragma unroll
      for (int dt = 0; dt < 2; dt++) {
#pragma unroll
        for (int s = 0; s < 4; s++) St[dt] = MFMA32(kl[dt][s], vf[s], St[dt]);
#pragma unroll
        for (int g = 0; g < 4; g++) {
          const float4 dv = *(const float4*)(ldec + (n & 1) * 256 + 64 * w + 32 * dt + 8 * g + 4 * h);
          St[dt][4 * g + 0] *= dv.x; St[dt][4 * g + 1] *= dv.y;
          St[dt][4 * g + 2] *= dv.z; St[dt][4 * g + 3] *= dv.w;
        }
      }
      if (more) {
        const int tn = (n + 1) * 64;
#pragma unroll
        for (int s = 0; s < 4; s++) vf[s] = *(const bf16x8*)(v_p + tn + 16 * s);
#pragma unroll
        for (int dt = 0; dt < 2; dt++) {
#pragma unroll
          for (int s = 0; s < 4; s++) kl[dt][s] = *(const bf16x8*)(kl_p + (size_t)dt * 32 * S_ + tn + 16 * s);
        }
      }
      ldec[((n + 1) & 1) * 256 + t] = decn;
#pragma unroll
      for (int ct = 0; ct < 2; ct++)
#pragma unroll
        for (int i = 0; i < 16; i++) lo[(w * 64 + ct * 32 + crow(i, h)) * 32 + r] = o[ct][i];
      __syncthreads();
      {
        const int c = t >> 2, vg = (t & 3) * 8;
        float4 s0 = *(const float4*)(lo + c * 32 + vg), s1 = *(const float4*)(lo + c * 32 + vg + 4);
#pragma unroll
        for (int ww = 1; ww < 4; ww++) {
          float4 x0 = *(const float4*)(lo + (ww * 64 + c) * 32 + vg), x1 = *(const float4*)(lo + (ww * 64 + c) * 32 + vg + 4);
          s0.x += x0.x; s0.y += x0.y; s0.z += x0.z; s0.w += x0.w; s1.x += x1.x; s1.y += x1.y; s1.z += x1.z; s1.w += x1.w;
        }
        uint4 ov; ov.x = pack2(s0.x, s0.y); ov.y = pack2(s0.z, s0.w); ov.z = pack2(s1.x, s1.y); ov.w = pack2(s1.z, s1.w);
        *(uint4*)(o_p + (size_t)n * 64 * 2048) = ov;
      }
      __syncthreads();
    }
  }
}

DI void phase_og(const Params& p, char* smem, int bid, int nblk) {
  char* ws = opaque_ptr(p.ws);
  const int t = TID, lane = t & 63, w = t >> 6;
  const bf16_t* O0 = (const bf16_t*)(ws + OFF_QK0);
  const bf16_t* G0 = (const bf16_t*)(ws + OFF_G0);
  bf16_t* OG = (bf16_t*)(ws + OFF_H);
  const float4* gp = (const float4*)(p.g_onorm + lane * 8);
  const float4 ga = gp[0], gb = gp[1];
  for (int token = bid; token < S_; token += 4 * nblk) {
    uint4 ov[4], gv[4];
#pragma unroll
    for (int u = 0; u < 4; u++) {
      const int tk = token + u * nblk;
      const size_t off = (size_t)(tk < S_ ? tk : token) * 2048 + w * 512 + lane * 8;
      ov[u] = *(const uint4*)(O0 + off);
      gv[u] = *(const uint4*)(G0 + off);
    }
#pragma unroll
    for (int u = 0; u < 4; u++) {
      const int tk = token + u * nblk;
      const size_t off = (size_t)tk * 2048 + w * 512 + lane * 8;
      const float f0 = bflo(ov[u].x), f1 = bfhi(ov[u].x), f2 = bflo(ov[u].y), f3 = bfhi(ov[u].y);
      const float f4 = bflo(ov[u].z), f5 = bfhi(ov[u].z), f6 = bflo(ov[u].w), f7 = bfhi(ov[u].w);
      float ss = f0 * f0 + f1 * f1 + f2 * f2 + f3 * f3 + f4 * f4 + f5 * f5 + f6 * f6 + f7 * f7;
      ss = wave_sum(ss);
      const float rinv = rsqrtf(ss * (1.f / 512.f) + 1e-6f);
      uint4 o;
      o.x = pack2(f0 * rinv * ga.x * bflo(gv[u].x), f1 * rinv * ga.y * bfhi(gv[u].x));
      o.y = pack2(f2 * rinv * ga.z * bflo(gv[u].y), f3 * rinv * ga.w * bfhi(gv[u].y));
      o.z = pack2(f4 * rinv * gb.x * bflo(gv[u].z), f5 * rinv * gb.y * bfhi(gv[u].z));
      o.w = pack2(f6 * rinv * gb.z * bflo(gv[u].w), f7 * rinv * gb.w * bfhi(gv[u].w));
      if (tk < S_) *(uint4*)(OG + off) = o;
    }
  }
}

DI void phase_gemm_out(const Params& p, char* smem, int bid, int nblk, size_t off_w) {
  char* ws = opaque_ptr(p.ws);
  const bf16_t* A = (const bf16_t*)(ws + OFF_H);
  const bf16_t* B = (const bf16_t*)(ws + off_w);
  bf16_t* Y = (bf16_t*)(ws + OFF_Y);
  for (int tile = bid; tile < 32 * 16; tile += nblk) {
    const int mi = tile & 31, ni = tile >> 5;
    const int m0 = mi * 256, n0 = ni * 128;
    f32x16 acc[4][2];
    gemm_main<false>(acc, A, 2048, B, 2048, 2048, m0, n0, smem);
    EPI_LOOP_BEGIN EPI_COORD_NS
      Y[(size_t)row * 2048 + col] = (bf16_t)f2bf(v);
    EPI_LOOP_END
  }
}

DI void phase_post0(const Params& p, char* smem, int bid, int nblk) {
  char* ws = opaque_ptr(p.ws);
  const int t = TID, lane = t & 63, w = t >> 6;
  const bf16_t* Y = (const bf16_t*)(ws + OFF_Y);
  const float4* gpo = (const float4*)p.l0_post + lane;
  const float4* gpr = (const float4*)p.l1_pre + lane;
  for (int row = bid * 4 + w; row < S_; row += nblk * 4) {
    const uint2* yr = (const uint2*)(Y + (size_t)row * 2048) + lane;
    const float4* xr = (const float4*)(p.x + (size_t)row * 2048) + lane;
    float4 yv[8], xv[8];
#pragma unroll
    for (int j = 0; j < 8; j++) { const uint2 u = yr[j * 64]; yv[j].x = bflo(u.x); yv[j].y = bfhi(u.x); yv[j].z = bflo(u.y); yv[j].w = bfhi(u.y); xv[j] = xr[j * 64]; }
    float ss = 0.f;
#pragma unroll
    for (int j = 0; j < 8; j++) ss += yv[j].x * yv[j].x + yv[j].y * yv[j].y + yv[j].z * yv[j].z + yv[j].w * yv[j].w;
    ss = wave_sum(ss);
    const float rinv = rsqrtf(ss * (1.f / 2048.f) + 1e-6f);
    float4* outr = (float4*)(p.out + (size_t)row * 2048) + lane;
    float s2 = 0.f;
#pragma unroll
    for (int j = 0; j < 8; j++) {
      const float4 g = gpo[j * 64];
      xv[j].x += yv[j].x * rinv * g.x; xv[j].y += yv[j].y * rinv * g.y; xv[j].z += yv[j].z * rinv * g.z; xv[j].w += yv[j].w * rinv * g.w;
      outr[j * 64] = xv[j];
      s2 += xv[j].x * xv[j].x + xv[j].y * xv[j].y + xv[j].z * xv[j].z + xv[j].w * xv[j].w;
    }
    s2 = wave_sum(s2);
    const float r2 = rsqrtf(s2 * (1.f / 2048.f) + 1e-6f);
    uint2* hr = (uint2*)(ws + OFF_H + (size_t)row * 4096) + lane;
#pragma unroll
    for (int j = 0; j < 8; j++) {
      const float4 g = gpr[j * 64];
      uint2 o; o.x = pack2(xv[j].x * r2 * g.x, xv[j].y * r2 * g.y); o.y = pack2(xv[j].z * r2 * g.z, xv[j].w * r2 * g.w);
      hr[j * 64] = o;
    }
  }
}

DI void phase_gemm_in1(const Params& p, char* smem, int bid, int nblk) {
  char* ws = opaque_ptr(p.ws);
  const bf16_t* A = (const bf16_t*)(ws + OFF_H);
  const bf16_t* B = (const bf16_t*)(ws + OFF_WIN1T);
  bf16_t* CQ = (bf16_t*)(ws + OFF_CQ);
  bf16_t* CKV = (bf16_t*)(ws + OFF_CKV);
  bf16_t* KR = (bf16_t*)(ws + OFF_KR);
  const float* cs = (const float*)(ws + OFF_CS);
  bf16_t* G1 = (bf16_t*)(ws + OFF_QK0);
  for (int tile = bid; tile < 32 * 25; tile += nblk) {
    const int mi = tile & 31, ni = tile >> 5;
    const int m0 = mi * 256, n0 = ni * 128;
    f32x16 acc[4][2];
    gemm_main<false>(acc, A, 2048, B, 2048, 2048, m0, n0, smem);
    if (ni < 4) {
      EPI_LOOP_BEGIN EPI_COORD_NS
        CQ[(size_t)row * 512 + col] = (bf16_t)f2bf(v);
      EPI_LOOP_END
    } else if (ni < 8) {
      EPI_LOOP_BEGIN EPI_COORD_NS
        CKV[(size_t)row * 512 + (col - 512)] = (bf16_t)f2bf(v);
      EPI_LOOP_END
    } else if (ni == 8 && ((TID >> 6) & 1) == 0) {
      const int lane_ = TID & 63, w_ = TID >> 6, wm_ = w_ >> 1, r_ = lane_ & 31, h_ = lane_ >> 5;
#pragma unroll
      for (int mt = 0; mt < 4; mt++)
#pragma unroll
        for (int i = 0; i < 16; i++) {
          const int row = m0 + wm_ * 128 + mt * 32 + crow(i, h_);
          const float t1 = acc[mt][0][i], t2 = acc[mt][1][i];
          const float c = cs[row * 64 + r_], sn = cs[row * 64 + 32 + r_];
          KR[(size_t)row * 64 + r_] = (bf16_t)f2bf(t1 * c - t2 * sn);
          KR[(size_t)row * 64 + 32 + r_] = (bf16_t)f2bf(t2 * c + t1 * sn);
        }
    } else {
      EPI_LOOP_BEGIN EPI_COORD_NS
        if (col < 3136) G1[(size_t)row * 2048 + (col - 1088)] = (bf16_t)f2bf(silu(v));
      EPI_LOOP_END
    }
  }
}

DI void phase_gemm_qkv(const Params& p, char* smem, int bid, int nblk) {
  char* ws = opaque_ptr(p.ws);
  const bf16_t* CQ = (const bf16_t*)(ws + OFF_CQ);
  const bf16_t* CKV = (const bf16_t*)(ws + OFF_CKV);
  const bf16_t* WQ = (const bf16_t*)(ws + OFF_WQBT);
  const bf16_t* WKV = (const bf16_t*)(ws + OFF_WKVBT);
  const float* cs = (const float*)(ws + OFF_CS);
  bf16_t* Q = (bf16_t*)(ws + OFF_Q);
  bf16_t* KN = (bf16_t*)(ws + OFF_KN);
  bf16_t* VT = (bf16_t*)(ws + OFF_VT);
  const float qscale = 0.07216878364870322f * 1.4426950408889634f;
  const int ntq = 32 * 24, ntkv = 32 * 32;
  for (int tile = bid; tile < ntq + ntkv; tile += nblk) {
    f32x16 acc[4][2];
    if (tile < ntq) {
      const int mi = tile & 31, ni = tile >> 5;
      const int m0 = mi * 256, n0 = ni * 128;
      gemm_main<false, true>(acc, CQ, 512, WQ, 512, 512, m0, n0, smem);
      const float* rf = (const float*)(smem + 49152);
      const int lane_ = TID & 63, w_ = TID >> 6, wm_ = w_ >> 1, wn_ = w_ & 1, r_ = lane_ & 31, h_ = lane_ >> 5;
      const int cb = n0 + wn_ * 64;
      const int head = cb / 192, jb = cb - head * 192;
      if (jb == 128) {
#pragma unroll
        for (int mt = 0; mt < 4; mt++)
#pragma unroll
          for (int i = 0; i < 16; i++) {
            const int row = m0 + wm_ * 128 + mt * 32 + crow(i, h_);
            const float sc = rf[row - m0] * qscale;
            const float t1 = acc[mt][0][i] * sc, t2 = acc[mt][1][i] * sc;
            const float c = cs[row * 64 + r_], s = cs[row * 64 + 32 + r_];
            bf16_t* qp = Q + ((size_t)head * S_ + row) * 192 + 128;
            qp[r_] = (bf16_t)f2bf(t1 * c - t2 * s);
            qp[32 + r_] = (bf16_t)f2bf(t2 * c + t1 * s);
          }
      } else {
#pragma unroll
        for (int mt = 0; mt < 4; mt++)
#pragma unroll
          for (int nt = 0; nt < 2; nt++)
#pragma unroll
            for (int i = 0; i < 16; i++) {
              const int row = m0 + wm_ * 128 + mt * 32 + crow(i, h_);
              const float sc = rf[row - m0] * qscale;
              Q[((size_t)head * S_ + row) * 192 + jb + nt * 32 + r_] = (bf16_t)f2bf(acc[mt][nt][i] * sc);
            }
      }
    } else {
      const int tl = tile - ntq;
      const int mi = tl & 31, ni = tl >> 5;
      const int m0 = mi * 256, n0 = ni * 128;
      const int head = ni >> 1;
      if (ni & 1) {
        gemm_main<true, true>(acc, CKV, 512, WKV, 512, 512, m0, n0, smem);
        const float* rf = (const float*)(smem + 49152);
        EPI_LOOP_BEGIN EPI_COORD_SW
          const int j = col - head * 256 - 128;
          VT[((size_t)head * 128 + j) * S_ + row] = (bf16_t)f2bf(v * rf[row - m0]);
        EPI_LOOP_END
      } else {
        gemm_main<false, true>(acc, CKV, 512, WKV, 512, 512, m0, n0, smem);
        const float* rf = (const float*)(smem + 49152);
        EPI_LOOP_BEGIN EPI_COORD_NS
          const int j = col - head * 256;
          KN[((size_t)head * S_ + row) * 128 + j] = (bf16_t)f2bf(v * rf[row - m0]);
        EPI_LOOP_END
      }
    }
  }
}

DI void phase_attn(const Params& p, char* smem, int bid, int nblk, int rep) {
  char* ws = opaque_ptr(p.ws);
  const int t = TID, lane = t & 63, w = t >> 6, r = lane & 31, h = lane >> 5;
  const bf16_t* Q = (const bf16_t*)(ws + OFF_Q);
  const bf16_t* KN = (const bf16_t*)(ws + OFF_KN);
  const bf16_t* KR = (const bf16_t*)(ws + OFF_KR);
  const bf16_t* VT = (const bf16_t*)(ws + OFF_VT);
  const bf16_t* G1 = (const bf16_t*)(ws + OFF_QK0);
  bf16_t* OG = (bf16_t*)(ws + OFF_H);
  int* ctr = (int*)(ws + OFF_CTR) + rep;
  char* lk = smem;
  char* lv = smem + 25600;
  int* s_item = (int*)(smem + 44032);
  const int k_row = t >> 2, k_c0 = t & 3;
  const int v_row0 = t >> 3, v_kc = t & 7;
  for (;;) {
    __syncthreads();
    if (t == 0) *s_item = atomicAdd(ctr, 1);
    __syncthreads();
    const int item = *s_item;
    if (item >= 1024) break;
    const int qb = 63 - (item >> 4), head = item & 15;
    const int q0w = qb * 128 + w * 32;
    const int ntile = 2 * qb + 2;
    bf16x8 qf[12];
    {
      const bf16_t* qp = Q + ((size_t)head * S_ + q0w + r) * 192 + 8 * h;
#pragma unroll
      for (int s = 0; s < 12; s++) qf[s] = *(const bf16x8*)(qp + 16 * s);
    }
    f32x16 oacc[4];
#pragma unroll
    for (int vt = 0; vt < 4; vt++)
#pragma unroll
      for (int i = 0; i < 16; i++) oacc[vt][i] = 0.f;
    float m_run = -INFINITY, l_run = 0.f;
    uint4 kg0, kg1, kg2, kg3, kg4, kg5, vg0, vg1, vg2, vg3;
    const bf16_t* knp = KN + (size_t)head * S_ * 128;
    const bf16_t* vtp = VT + ((size_t)head * 128 + v_row0) * S_ + v_kc * 8;
#define ATT_LOAD(k0_)                                                                                         \
    {                                                                                                         \
      const bf16_t* kn_ = knp + (size_t)((k0_) + k_row) * 128 + k_c0 * 8;                                     \
      const bf16_t* kr_ = KR + (size_t)((k0_) + k_row) * 64 + k_c0 * 8;                                       \
      const bf16_t* vp_ = vtp + (k0_);                                                                        \
      kg0 = *(const uint4*)(kn_); kg1 = *(const uint4*)(kn_ + 32); kg2 = *(const uint4*)(kn_ + 64); kg3 = *(const uint4*)(kn_ + 96); \
      kg4 = *(const uint4*)(kr_); kg5 = *(const uint4*)(kr_ + 32);                                            \
      vg0 = *(const uint4*)(vp_); vg1 = *(const uint4*)(vp_ + (size_t)32 * S_);                               \
      vg2 = *(const uint4*)(vp_ + (size_t)64 * S_); vg3 = *(const uint4*)(vp_ + (size_t)96 * S_);             \
    }
    ATT_LOAD(0)
    for (int kt = 0; kt < ntile; kt++) {
      const int k0 = kt * 64;
      __syncthreads();
      {
        char* kd = lk + k_row * 400 + k_c0 * 16;
        *(uint4*)(kd) = kg0; *(uint4*)(kd + 64) = kg1; *(uint4*)(kd + 128) = kg2; *(uint4*)(kd + 192) = kg3;
        *(uint4*)(kd + 256) = kg4; *(uint4*)(kd + 320) = kg5;
        char* vd = lv + v_row0 * 144 + (v_kc >> 1) * 32 + (v_kc & 1) * 8;
#define VST(o_, v_) { uint2 u0, u1; u0.x = v_.x; u0.y = v_.y; u1.x = v_.z; u1.y = v_.w; *(uint2*)(vd + (o_)) = u0; *(uint2*)(vd + (o_) + 16) = u1; }
        VST(0, vg0) VST(32 * 144, vg1) VST(64 * 144, vg2) VST(96 * 144, vg3)
#undef VST
      }
      __syncthreads();
      { const int knext = (kt + 1 < ntile) ? k0 + 64 : k0; ATT_LOAD(knext) }
      if (k0 <= q0w + 31) {
        f32x16 sc[2];
#pragma unroll
        for (int i = 0; i < 16; i++) { sc[0][i] = 0.f; sc[1][i] = 0.f; }
#pragma unroll
        for (int s = 0; s < 12; s++) {
          bf16x8 a0 = *(const bf16x8*)(lk + r * 400 + h * 16 + s * 32);
          bf16x8 a1 = *(const bf16x8*)(lk + r * 400 + h * 16 + 32 * 400 + s * 32);
          sc[0] = MFMA32(a0, qf[s], sc[0]);
          sc[1] = MFMA32(a1, qf[s], sc[1]);
        }
        if (k0 + 63 > q0w) {
          const int qg = q0w + r;
#pragma unroll
          for (int mt = 0; mt < 2; mt++)
#pragma unroll
            for (int i = 0; i < 16; i++) {
              const int key = k0 + mt * 32 + crow(i, h);
              if (key > qg) sc[mt][i] = -INFINITY;
            }
        }
        float mx = sc[0][0];
#pragma unroll
        for (int i = 1; i < 16; i++) mx = fmaxf(mx, sc[0][i]);
#pragma unroll
        for (int i = 0; i < 16; i++) mx = fmaxf(mx, sc[1][i]);
        mx = fmaxf(mx, __shfl_xor(mx, 32));
        const float m_new = (mx > m_run + 8.f) ? mx : m_run;
        const bool resc = __any(m_new != m_run);
        const float alpha = __builtin_amdgcn_exp2f(m_run - m_new);
        m_run = m_new;
        float ls = 0.f;
#pragma unroll
        for (int mt = 0; mt < 2; mt++)
#pragma unroll
          for (int i = 0; i < 16; i++) { const float pv = __builtin_amdgcn_exp2f(sc[mt][i] - m_new); sc[mt][i] = pv; ls += pv; }
        l_run = l_run * alpha + ls;
        if (resc) {
#pragma unroll
          for (int vt = 0; vt < 4; vt++)
#pragma unroll
            for (int i = 0; i < 16; i++) oacc[vt][i] *= alpha;
        }
#pragma unroll
        for (int s = 0; s < 4; s++) {
          const bf16x8 pb = pack8(sc[s >> 1], s & 1);
#pragma unroll
          for (int vt = 0; vt < 4; vt++) {
            const bf16x8 a = *(const bf16x8*)(lv + r * 144 + h * 16 + vt * 32 * 144 + s * 32);
            oacc[vt] = MFMA32(a, pb, oacc[vt]);
          }
        }
      }
    }
#undef ATT_LOAD
    const float l_tot = l_run + __shfl_xor(l_run, 32);
    const float inv = 1.f / l_tot;
    const size_t obase = (size_t)(q0w + r) * 2048 + head * 128;
#pragma unroll
    for (int vt = 0; vt < 4; vt++)
#pragma unroll
      for (int g = 0; g < 4; g++) {
        const int v = vt * 32 + 8 * g + 4 * h;
        uint2 gg = *(const uint2*)(G1 + obase + v);
        uint2 o;
        o.x = pack2(oacc[vt][4 * g + 0] * inv * bflo(gg.x), oacc[vt][4 * g + 1] * inv * bfhi(gg.x));
        o.y = pack2(oacc[vt][4 * g + 2] * inv * bflo(gg.y), oacc[vt][4 * g + 3] * inv * bfhi(gg.y));
        *(uint2*)(OG + obase + v) = o;
      }
  }
}

DI void phase_final(const Params& p, char* smem, int bid, int nblk) {
  char* ws = opaque_ptr(p.ws);
  const int t = TID, lane = t & 63, w = t >> 6;
  const bf16_t* Y = (const bf16_t*)(ws + OFF_Y);
  const float4* gpo = (const float4*)p.l1_post + lane;
  for (int row0 = bid * 4 + w; row0 < S_; row0 += nblk * 8) {
    const int row1r = row0 + nblk * 4;
    const bool has1 = row1r < S_;
    const int row1 = has1 ? row1r : row0;
    const uint2* yr0 = (const uint2*)(Y + (size_t)row0 * 2048) + lane;
    const uint2* yr1 = (const uint2*)(Y + (size_t)row1 * 2048) + lane;
    float4* out0 = (float4*)(p.out + (size_t)row0 * 2048) + lane;
    float4* out1 = (float4*)(p.out + (size_t)row1 * 2048) + lane;
    uint2 ya[8], yb[8];
    float4 xa[8], xb[8];
#pragma unroll
    for (int j = 0; j < 8; j++) { ya[j] = yr0[j * 64]; xa[j] = out0[j * 64]; yb[j] = yr1[j * 64]; xb[j] = out1[j * 64]; }
    float sa = 0.f, sb = 0.f;
#pragma unroll
    for (int j = 0; j < 8; j++) {
      sa += bflo(ya[j].x) * bflo(ya[j].x) + bfhi(ya[j].x) * bfhi(ya[j].x) + bflo(ya[j].y) * bflo(ya[j].y) + bfhi(ya[j].y) * bfhi(ya[j].y);
      sb += bflo(yb[j].x) * bflo(yb[j].x) + bfhi(yb[j].x) * bfhi(yb[j].x) + bflo(yb[j].y) * bflo(yb[j].y) + bfhi(yb[j].y) * bfhi(yb[j].y);
    }
    sa = wave_sum(sa); sb = wave_sum(sb);
    const float ra = rsqrtf(sa * (1.f / 2048.f) + 1e-6f), rb = rsqrtf(sb * (1.f / 2048.f) + 1e-6f);
#pragma unroll
    for (int j = 0; j < 8; j++) {
      const float4 g = gpo[j * 64];
      float4 o = xa[j];
      o.x += bflo(ya[j].x) * ra * g.x; o.y += bfhi(ya[j].x) * ra * g.y; o.z += bflo(ya[j].y) * ra * g.z; o.w += bfhi(ya[j].y) * ra * g.w;
      out0[j * 64] = o;
      if (has1) {
        float4 q = xb[j];
        q.x += bflo(yb[j].x) * rb * g.x; q.y += bfhi(yb[j].x) * rb * g.y; q.z += bflo(yb[j].y) * rb * g.z; q.w += bfhi(yb[j].y) * rb * g.w;
        out1[j * 64] = q;
      }
    }
  }
}

constexpr int NPHASE = 13;
constexpr unsigned DUP_MASK = 0u;
DI void run_phase(int ph, const Params& p, char* smem, int bid, int nblk, int rep) {
  switch (ph) {
    case 0: phase_prep(p, smem, bid, nblk); break;
    case 1: phase_gemm_in0(p, smem, bid, nblk); break;
    case 2: phase_gla_prep(p, smem, bid, nblk); break;
    case 3: phase_gla_local(p, smem, bid, nblk); break;
    case 4: phase_gla_scan(p, smem, bid, nblk); break;
    case 5: phase_og(p, smem, bid, nblk); break;
    case 6: phase_gemm_out(p, smem, bid, nblk, OFF_WOUT0T); break;
    case 7: phase_post0(p, smem, bid, nblk); break;
    case 8: phase_gemm_in1(p, smem, bid, nblk); break;
    case 9: phase_gemm_qkv(p, smem, bid, nblk); break;
    case 10: phase_attn(p, smem, bid, nblk, rep); break;
    case 11: phase_gemm_out(p, smem, bid, nblk, OFF_WOUT1T); break;
    case 12: phase_final(p, smem, bid, nblk); break;
  }
}

#define XB_TMO      128
#define XB_XCNT(j)  (256  + 64 * (j))
#define XB_XSUB(j)  (1280 + 64 * (j))
#define XB_XGEN(j)  (2304 + 64 * (j))
#define XB_TOP      3328
#define XB_TOPGEN   3392
#define XCD_BAR_WORDS 3456
#define XB_SPIN_CAP (1u << 20)
#define LAS __attribute__((address_space(3)))
DI unsigned xb_ld(unsigned* p) { return __hip_atomic_load(p, __ATOMIC_RELAXED, __HIP_MEMORY_SCOPE_AGENT); }
DI unsigned xb_add(unsigned* p, unsigned v) { return __hip_atomic_fetch_add(p, v, __ATOMIC_RELAXED, __HIP_MEMORY_SCOPE_AGENT); }
DI unsigned xb_xcc_id() { return (unsigned)__builtin_amdgcn_s_getreg((3 << 11) | 20) & 0xFu; }
#define XB_SPIN(cond, bar) do { unsigned _sp = 0; while (cond) { __builtin_amdgcn_s_sleep(1); \
    if ((++_sp & 255u) == 0u) { if (xb_ld(&(bar)[XB_TMO])) break; if (_sp > XB_SPIN_CAP) { atomicAdd(&(bar)[XB_TMO], 1u); break; } } } } while (0)
struct XcdBarrier { unsigned* bar; unsigned x; volatile LAS unsigned* st; };
DI XcdBarrier xcd_barrier_post(unsigned* bar, volatile LAS unsigned* st) {
  XcdBarrier b; b.bar = bar; b.x = xb_xcc_id(); b.st = st;
  if (threadIdx.x == 0) (void)xb_add(&bar[XB_XCNT(b.x)], 1u);
  return b;
}
DI void xcd_barrier_complete(unsigned* bar, unsigned x, unsigned& nloc, unsigned& nx) {
  const unsigned G = gridDim.x * gridDim.y * gridDim.z;
  unsigned sum, cnt, mine, sp = 0u;
  for (;;) {
    sum = 0u; cnt = 0u; mine = 0u;
#pragma unroll
    for (unsigned j = 0; j < 16; ++j) { const unsigned c = xb_ld(&bar[XB_XCNT(j)]); sum += c; cnt += (c > 0u) ? 1u : 0u; mine = (j == x) ? c : mine; }
    if (sum == G) break;
    __builtin_amdgcn_s_sleep(1);
    if ((++sp & 255u) == 0u) { if (xb_ld(&bar[XB_TMO])) break; if (sp > XB_SPIN_CAP) { atomicAdd(&bar[XB_TMO], 1u); break; } }
  }
  nloc = mine > 0u ? mine : 1u; nx = cnt > 0u ? cnt : 1u;
}
DI void xcd_barrier(const XcdBarrier& b) {
  asm volatile("s_waitcnt vmcnt(0)" ::: "memory");
  __syncthreads();
  if (threadIdx.x == 0) {
    unsigned* bar = b.bar;
    __builtin_amdgcn_s_waitcnt(0);
    unsigned nloc, nx;
    xcd_barrier_complete(bar, b.x, nloc, nx);
    const unsigned old = xb_add(&bar[XB_XSUB(b.x)], 1u);
    const unsigned gen = old / nloc;
    if (old + 1u == (gen + 1u) * nloc) {
      __builtin_amdgcn_fence(__ATOMIC_RELEASE, "agent");
      asm volatile("s_waitcnt vmcnt(0)" ::: "memory");
      const unsigned og = xb_add(&bar[XB_TOP], 1u);
      const unsigned tg = og / nx;
      if (og + 1u == (tg + 1u) * nx) xb_add(&bar[XB_TOPGEN], 1u);
      else XB_SPIN(xb_ld(&bar[XB_TOPGEN]) == tg, bar);
      __builtin_amdgcn_fence(__ATOMIC_ACQUIRE, "agent");
      xb_add(&bar[XB_XGEN(b.x)], 1u);
      asm volatile("s_waitcnt vmcnt(0)" ::: "memory");
    } else {
      XB_SPIN(xb_ld(&bar[XB_XGEN(b.x)]) == gen, bar);
      __builtin_amdgcn_fence(__ATOMIC_ACQUIRE, "agent");
      asm volatile("s_waitcnt vmcnt(0)" ::: "memory");
    }
  }
  __syncthreads();
}

#if MEGA
__global__ void __launch_bounds__(256, 2) mega_kernel(Params p) {
  __shared__ __attribute__((aligned(16))) char smem[65536];
  cg::grid_group grid = cg::this_grid();
  const int bid = blockIdx.x, nblk = gridDim.x;
  (void)xcd_barrier_post((unsigned*)(p.ws + OFF_BAR), (volatile LAS unsigned*)0);
#pragma nounroll
  for (int ph = 0; ph < NPHASE; ph++) {
    int phv = ph;
    asm volatile("" : "+s"(phv));
    run_phase(phv, p, smem, bid, nblk, 0);
    if (p.ws == nullptr) grid.sync();
    { XcdBarrier xb; xb.bar = (unsigned*)(opaque_ptr(p.ws) + OFF_BAR); xb.x = xb_xcc_id(); xb.st = (volatile LAS unsigned*)0; xcd_barrier(xb); }
    if ((DUP_MASK >> ph) & 1u) {
      run_phase(phv, p, smem, bid, nblk, 1);
      { XcdBarrier xb; xb.bar = (unsigned*)(opaque_ptr(p.ws) + OFF_BAR); xb.x = xb_xcc_id(); xb.st = (volatile LAS unsigned*)0; xcd_barrier(xb); }
    }
  }
}
#endif

#if !MEGA
template <int PH>
__global__ void __launch_bounds__(256, 2) phase_kernel_t(Params p) {
  __shared__ __attribute__((aligned(16))) char smem[65536];
  run_phase(PH, p, smem, blockIdx.x, gridDim.x, 0);
}
#endif

extern "C" void kernel_launch(void* const* d_in, const int* in_sizes, int n_in, void* d_out, int out_size, void* d_ws,
                              size_t ws_size, hipStream_t stream) {
  Params p{};
  p.x = (const float*)d_in[0]; p.pos = (const int*)d_in[1]; p.l0_pre = (const float*)d_in[2]; p.w_in0 = (const float*)d_in[3];
  p.w_gk2 = (const float*)d_in[4]; p.b_gk = (const float*)d_in[5]; p.g_onorm = (const float*)d_in[6]; p.w_out0 = (const float*)d_in[7];
  p.l0_post = (const float*)d_in[8]; p.l1_pre = (const float*)d_in[9]; p.w_in1 = (const float*)d_in[10]; p.g_qa = (const float*)d_in[11];
  p.w_qb = (const float*)d_in[12]; p.g_kva = (const float*)d_in[13]; p.w_kvb = (const float*)d_in[14]; p.w_out1 = (const float*)d_in[15];
  p.l1_post = (const float*)d_in[16];
  p.out = (float*)d_out; p.ws = (char*)d_ws;
  for (int i = 0; i < 32; i++) p.invf[i] = (float)pow(10000.0, -(double)i / 32.0);
#if MEGA
  static int grid_blocks = 0;
  if (!grid_blocks) {
    int dev = 0, cus = 0, per_cu = 0;
    hipGetDevice(&dev);
    hipDeviceGetAttribute(&cus, hipDeviceAttributeMultiprocessorCount, dev);
    hipOccupancyMaxActiveBlocksPerMultiprocessor(&per_cu, mega_kernel, 256, 0);
    if (per_cu > 2) per_cu = 2;
    if (per_cu < 1) per_cu = 1;
    grid_blocks = cus * per_cu;
  }
  hipMemsetAsync((char*)d_ws + OFF_BAR, 0, XCD_BAR_WORDS * 4, stream);
  void* args[] = {&p};
  hipError_t e = hipLaunchCooperativeKernel((void*)mega_kernel, dim3(grid_blocks), dim3(256), args, 0, stream);
  if (e != hipSuccess) fprintf(stderr, "cooperative launch failed: %s (grid %d)\n", hipGetErrorString(e), grid_blocks);
#else
#define LPH(N) hipLaunchKernelGGL(phase_kernel_t<N>, dim3(512), dim3(256), 0, stream, p);
  LPH(0) LPH(1) LPH(2) LPH(3) LPH(4) LPH(5) LPH(6) LPH(7) LPH(8) LPH(9) LPH(10) LPH(11) LPH(12)
#undef LPH
#endif
}
```

```cpp
#include <hip/hip_runtime.h>
#include <hip/hip_cooperative_groups.h>
#include <stdint.h>
#include <math.h>
#include <stdio.h>
namespace cg = cooperative_groups;

#ifndef MEGA
#define MEGA 1
#endif

typedef __attribute__((ext_vector_type(8))) short bf16x8;
typedef __attribute__((ext_vector_type(4))) short s16x4;
typedef __attribute__((ext_vector_type(16))) float f32x16;
typedef unsigned short bf16_t;
#define DI __device__ __forceinline__
#define MFMA32(a, b, c) __builtin_amdgcn_mfma_f32_32x32x16_bf16((a), (b), (c), 0, 0, 0)

constexpr int S_ = 8192;
constexpr size_t MiB = (size_t)1 << 20;
constexpr size_t OFF_WIN0T = 0;
constexpr size_t OFF_WOUT0T = 25 * MiB;
constexpr size_t OFF_WIN1T = 33 * MiB;
constexpr size_t OFF_WQBT = 46 * MiB;
constexpr size_t OFF_WKVBT = 49 * MiB;
constexpr size_t OFF_WOUT1T = 53 * MiB;
constexpr size_t OFF_GKLOW = 61 * MiB;
constexpr size_t OFF_DECAY = 61 * MiB + 512 * 1024;
constexpr size_t OFF_CS = 62 * MiB;
constexpr size_t OFF_H = 64 * MiB;
constexpr size_t OFF_QK0 = 96 * MiB;
constexpr size_t OFF_V0T = 128 * MiB;
constexpr size_t OFF_G0 = 160 * MiB;
constexpr size_t OFF_Y = 128 * MiB;
constexpr size_t OFF_QE = 192 * MiB;
constexpr size_t OFF_KLT = 208 * MiB;
constexpr size_t OFF_AM = 224 * MiB;
constexpr size_t OFF_CQ = 0;
constexpr size_t OFF_CKV = 8 * MiB;
constexpr size_t OFF_KR = 16 * MiB;
constexpr size_t OFF_RINVQ = 17 * MiB;
constexpr size_t OFF_RINVKV = 17 * MiB + 64 * 1024;
constexpr size_t OFF_KRRAW = 18 * MiB;
constexpr size_t OFF_CTR = 20 * MiB;
constexpr size_t OFF_BAR = 255 * MiB;
constexpr size_t OFF_SL = 64 * MiB;
constexpr size_t OFF_DC = 80 * MiB;
constexpr size_t OFF_Q = 128 * MiB;
constexpr size_t OFF_KN = 176 * MiB;
constexpr size_t OFF_VT = 208 * MiB;

struct Params {
  const float* x; const int* pos; const float* l0_pre; const float* w_in0; const float* w_gk2; const float* b_gk;
  const float* g_onorm; const float* w_out0; const float* l0_post; const float* l1_pre; const float* w_in1;
  const float* g_qa; const float* w_qb; const float* g_kva; const float* w_kvb; const float* w_out1; const float* l1_post;
  float* out; char* ws;
  float invf[32];
};

DI int tid_opaque() { int t = threadIdx.x; asm volatile("" : "+v"(t)); return t; }
#define TID tid_opaque()
typedef __attribute__((address_space(1))) char gchar_t;
DI char* opaque_ptr(char* q) {
  unsigned long long v = (unsigned long long)q;
  unsigned lo = __builtin_amdgcn_readfirstlane((unsigned)v), hi = __builtin_amdgcn_readfirstlane((unsigned)(v >> 32));
  asm volatile("" : "+s"(lo), "+s"(hi));
  return (char*)(gchar_t*)(((unsigned long long)hi << 32) | lo);
}
typedef __bf16 hbf16x2 __attribute__((ext_vector_type(2)));
typedef float hf32x2 __attribute__((ext_vector_type(2)));
DI unsigned pack2(float a, float b) { hf32x2 f = {a, b}; return __builtin_bit_cast(unsigned, __builtin_convertvector(f, hbf16x2)); }
DI unsigned f2bf(float f) { return (unsigned)__builtin_bit_cast(unsigned short, (__bf16)f); }
DI float bf2f(unsigned h) { return __uint_as_float(h << 16); }
DI float bflo(unsigned u) { return __uint_as_float(u << 16); }
DI float bfhi(unsigned u) { return __uint_as_float(u & 0xffff0000u); }
DI int crow(int i, int h) { return (i & 3) + 8 * (i >> 2) + 4 * h; }
DI float silu(float v) { return v / (1.f + __expf(-v)); }
DI float wave_sum(float v) { for (int o = 32; o > 0; o >>= 1) v += __shfl_xor(v, o); return v; }
DI float block_sum(float v, float* red) {
  v = wave_sum(v);
  __syncthreads();
  if ((TID & 63) == 0) red[TID >> 6] = v;
  __syncthreads();
  return red[0] + red[1] + red[2] + red[3];
}
DI bf16x8 pack8(const f32x16& x, int s) {
  union { unsigned u[4]; bf16x8 v; } p;
  p.u[0] = pack2(x[8 * s + 0], x[8 * s + 1]); p.u[1] = pack2(x[8 * s + 2], x[8 * s + 3]);
  p.u[2] = pack2(x[8 * s + 4], x[8 * s + 5]); p.u[3] = pack2(x[8 * s + 6], x[8 * s + 7]);
  return p.v;
}

DI void transpose_tile4(const float* __restrict__ W, int K, int N, int ntN, const float* __restrict__ gain, bf16_t* __restrict__ WT,
                        int id0, char* smem) {
  const int t = TID;
  float v[4][16];
#pragma unroll
  for (int q = 0; q < 4; q++) {
    const int id = id0 + q, k0 = (id / ntN) * 64, n0 = (id % ntN) * 64;
#pragma unroll
    for (int i = 0; i < 16; i++) {
      const int kk = i * 4 + (t >> 6), n = n0 + (t & 63);
      float x = (n < N) ? W[(size_t)(k0 + kk) * N + n] : 0.f;
      if (gain) x *= gain[k0 + kk];
      v[q][i] = x;
    }
  }
#pragma unroll
  for (int q = 0; q < 4; q++) {
    unsigned short (*tile)[72] = (unsigned short (*)[72])(smem + q * 9216);
#pragma unroll
    for (int i = 0; i < 16; i++) tile[t & 63][i * 4 + (t >> 6)] = (unsigned short)f2bf(v[q][i]);
  }
  __syncthreads();
#pragma unroll
  for (int q = 0; q < 4; q++) {
    unsigned short (*tile)[72] = (unsigned short (*)[72])(smem + q * 9216);
    const int id = id0 + q, k0 = (id / ntN) * 64, n0 = (id % ntN) * 64;
    const int nn = t >> 2, kg = (t & 3) * 16;
    uint4 a = *(const uint4*)&tile[nn][kg];
    uint4 b = *(const uint4*)&tile[nn][kg + 8];
    bf16_t* dst = WT + (size_t)(n0 + nn) * K + k0 + kg;
    *(uint4*)dst = a; *(uint4*)(dst + 8) = b;
  }
  __syncthreads();
}

DI void phase_prep(const Params& p, char* smem, int bid, int nblk) {
  const int t = TID;
  char* ws = opaque_ptr(p.ws);
  for (int task = bid; task < 1920 + 3072; task += nblk) {
    if (task < 1920) {
      const int tile0 = task * 4;
      const float* W; const float* gain = nullptr; bf16_t* WT; int K, N, ntN, id;
      if (tile0 < 3136) { id = tile0; W = p.w_in0; K = 2048; N = 6160; ntN = 98; WT = (bf16_t*)(ws + OFF_WIN0T); }
      else if (tile0 < 4160) { id = tile0 - 3136; W = p.w_out0; K = 2048; N = 2048; ntN = 32; WT = (bf16_t*)(ws + OFF_WOUT0T); }
      else if (tile0 < 5760) { id = tile0 - 4160; W = p.w_in1; K = 2048; N = 3136; ntN = 50; WT = (bf16_t*)(ws + OFF_WIN1T); }
      else if (tile0 < 6144) { id = tile0 - 5760; W = p.w_qb; K = 512; N = 3072; ntN = 48; WT = (bf16_t*)(ws + OFF_WQBT); gain = p.g_qa; }
      else if (tile0 < 6656) { id = tile0 - 6144; W = p.w_kvb; K = 512; N = 4096; ntN = 64; WT = (bf16_t*)(ws + OFF_WKVBT); gain = p.g_kva; }
      else { id = tile0 - 6656; W = p.w_out1; K = 2048; N = 2048; ntN = 32; WT = (bf16_t*)(ws + OFF_WOUT1T); }
      transpose_tile4(W, K, N, ntN, gain, WT, id, smem);
    } else if (task < 1920 + 2048) {
      const int lane = t & 63, row = (task - 1920) * 4 + (t >> 6);
      const float4* xr = (const float4*)(p.x + (size_t)row * 2048) + lane;
      const float4* gr = (const float4*)p.l0_pre + lane;
      float4 xv[8];
#pragma unroll
      for (int j = 0; j < 8; j++) xv[j] = xr[j * 64];
      float ss = 0.f;
#pragma unroll
      for (int j = 0; j < 8; j++) ss += xv[j].x * xv[j].x + xv[j].y * xv[j].y + xv[j].z * xv[j].z + xv[j].w * xv[j].w;
      ss = wave_sum(ss);
      const float rinv = rsqrtf(ss * (1.f / 2048.f) + 1e-6f);
      uint2* hr = (uint2*)(ws + OFF_H + (size_t)row * 4096) + lane;
#pragma unroll
      for (int j = 0; j < 8; j++) {
        const float4 g = gr[j * 64];
        uint2 o; o.x = pack2(xv[j].x * rinv * g.x, xv[j].y * rinv * g.y); o.y = pack2(xv[j].z * rinv * g.z, xv[j].w * rinv * g.w);
        hr[j * 64] = o;
      }
    } else {
      const int idx = (task - 3968) * 256 + t;
      const int token = idx >> 5, i = idx & 31;
      double ang = (double)p.pos[token] * (double)p.invf[i];
      double tt = ang * 0.15915494309189535;
      tt -= floor(tt + 0.5);
      float f = (float)tt;
      float* cs = (float*)(ws + OFF_CS);
      cs[token * 64 + i] = __builtin_amdgcn_cosf(f);
      cs[token * 64 + 32 + i] = __builtin_amdgcn_sinf(f);
    }
  }
}

DI float sq8(const uint4& v) {
  return bflo(v.x) * bflo(v.x) + bfhi(v.x) * bfhi(v.x) + bflo(v.y) * bflo(v.y) + bfhi(v.y) * bfhi(v.y) + bflo(v.z) * bflo(v.z) + bfhi(v.z) * bfhi(v.z) +
         bflo(v.w) * bflo(v.w) + bfhi(v.w) * bfhi(v.w);
}
template <bool SWAP, bool SUMSQ = false>
DI void gemm_main(f32x16 (&acc)[4][2], const bf16_t* A, int lda, const bf16_t* B, int ldb, int K,
                  int m0, int n0, char* smem) {
  const int t = TID, lane = t & 63, w = t >> 6, wm = w >> 1, wn = w & 1, r = lane & 31, h = lane >> 5;
#pragma unroll
  for (int a = 0; a < 4; a++)
#pragma unroll
    for (int b = 0; b < 2; b++)
#pragma unroll
      for (int i = 0; i < 16; i++) acc[a][b][i] = 0.f;
  const int lrow = t >> 2, kc = t & 3;
  const bf16_t* ag = A + (size_t)(m0 + lrow) * lda + kc * 8;
  const bf16_t* bg = B + (size_t)(n0 + lrow) * ldb + kc * 8;
  const int lds_w = lrow * 64 + ((kc ^ ((lrow >> 2) & 3)) << 4);
  uint4 pa0, pa1, pa2, pa3, pb0, pb1;
  bf16x8 fa0, fa1, fa2, fa3, fa4, fa5, fb0, fb1, fb2, fb3, fb4, fb5;
#define G_LOAD(X, ko_)                                                                                   \
  X##a0 = *(const uint4*)(ag + (ko_)); X##a1 = *(const uint4*)(ag + (size_t)64 * lda + (ko_));           \
  X##a2 = *(const uint4*)(ag + (size_t)128 * lda + (ko_)); X##a3 = *(const uint4*)(ag + (size_t)192 * lda + (ko_)); \
  X##b0 = *(const uint4*)(bg + (ko_)); X##b1 = *(const uint4*)(bg + (size_t)64 * ldb + (ko_));
#define L_STORE(X, base_)                                                                                \
  *(uint4*)((base_) + lds_w) = X##a0; *(uint4*)((base_) + lds_w + 4096) = X##a1;                         \
  *(uint4*)((base_) + lds_w + 8192) = X##a2; *(uint4*)((base_) + lds_w + 12288) = X##a3;                 \
  *(uint4*)((base_) + 16384 + lds_w) = X##b0; *(uint4*)((base_) + 16384 + lds_w + 4096) = X##b1;         \
  if (SUMSQ) { q0 += sq8(X##a0); q1 += sq8(X##a1); q2 += sq8(X##a2); q3 += sq8(X##a3); }
#define G_READ(F, base_, c_)                                                                             \
  F##0 = *(const bf16x8*)((base_) + a_off + (c_)); F##1 = *(const bf16x8*)((base_) + a_off + 32 * 64 + (c_));              \
  F##2 = *(const bf16x8*)((base_) + a_off + 64 * 64 + (c_)); F##3 = *(const bf16x8*)((base_) + a_off + 96 * 64 + (c_));    \
  F##4 = *(const bf16x8*)((base_) + b_off + (c_)); F##5 = *(const bf16x8*)((base_) + b_off + 32 * 64 + (c_));
#define G_MMA(a0, a1, a2, a3, b0, b1)                                                                    \
    if (SWAP) {                                                                                          \
      acc[0][0] = MFMA32(b0, a0, acc[0][0]); acc[0][1] = MFMA32(b1, a0, acc[0][1]);                      \
      acc[1][0] = MFMA32(b0, a1, acc[1][0]); acc[1][1] = MFMA32(b1, a1, acc[1][1]);                      \
      acc[2][0] = MFMA32(b0, a2, acc[2][0]); acc[2][1] = MFMA32(b1, a2, acc[2][1]);                      \
      acc[3][0] = MFMA32(b0, a3, acc[3][0]); acc[3][1] = MFMA32(b1, a3, acc[3][1]);                      \
    } else {                                                                                             \
      acc[0][0] = MFMA32(a0, b0, acc[0][0]); acc[0][1] = MFMA32(a0, b1, acc[0][1]);                      \
      acc[1][0] = MFMA32(a1, b0, acc[1][0]); acc[1][1] = MFMA32(a1, b1, acc[1][1]);                      \
      acc[2][0] = MFMA32(a2, b0, acc[2][0]); acc[2][1] = MFMA32(a2, b1, acc[2][1]);                      \
      acc[3][0] = MFMA32(a3, b0, acc[3][0]); acc[3][1] = MFMA32(a3, b1, acc[3][1]);                      \
    }
#define G_MMA6(F) G_MMA(F##0, F##1, F##2, F##3, F##4, F##5)
  float q0 = 0.f, q1 = 0.f, q2 = 0.f, q3 = 0.f;
  const int sw = (r >> 2) & 3;
  const int a_off = (wm * 128 + r) * 64, b_off = 16384 + (wn * 64 + r) * 64;
  const int c0 = (h ^ sw) << 4, c1 = ((2 + h) ^ sw) << 4;
  const int nk = K >> 5;
  G_LOAD(p, 0)
  L_STORE(p, smem)
  G_LOAD(p, 32)
  __syncthreads();
  G_READ(fa, smem, c0)
  G_READ(fb, smem, c1)
  G_MMA6(fa)
  asm volatile("" ::: "memory");
  __builtin_amdgcn_sched_barrier(0);
  L_STORE(p, smem + 24576)
  {
    const int kn = ((2 < nk) ? 2 : (nk - 1)) * 32;
    G_LOAD(p, kn)
  }
  __syncthreads();
  for (int kt = 0; kt < nk - 1; kt++) {
    const char* nb = smem + ((kt + 1) & 1) * 24576;
    G_READ(fa, nb, c0)
    G_MMA6(fb)
    G_READ(fb, nb, c1)
    G_MMA6(fa)
    __builtin_amdgcn_sched_group_barrier(0x100, 6, 0);
    __builtin_amdgcn_sched_group_barrier(0x008, 8, 0);
    __builtin_amdgcn_sched_group_barrier(0x100, 6, 0);
    __builtin_amdgcn_sched_group_barrier(0x008, 8, 0);
    asm volatile("" ::: "memory");
    __builtin_amdgcn_sched_barrier(0);
    if (kt + 2 < nk) {
      L_STORE(p, smem + (kt & 1) * 24576)
    }
    {
      const int kn = ((kt + 3 < nk) ? (kt + 3) : (nk - 1)) * 32;
      G_LOAD(p, kn)
    }
    __syncthreads();
  }
  G_MMA6(fb)
#undef G_LOAD
#undef L_STORE
#undef G_READ
#undef G_MMA
#undef G_MMA6
  if (SUMSQ) {
    q0 += __shfl_xor(q0, 1); q1 += __shfl_xor(q1, 1); q2 += __shfl_xor(q2, 1); q3 += __shfl_xor(q3, 1);
    q0 += __shfl_xor(q0, 2); q1 += __shfl_xor(q1, 2); q2 += __shfl_xor(q2, 2); q3 += __shfl_xor(q3, 2);
    if (kc == 0) {
      float* rf = (float*)(smem + 49152);
      const float ik = 1.f / (float)K;
      rf[lrow] = rsqrtf(q0 * ik + 1e-6f); rf[lrow + 64] = rsqrtf(q1 * ik + 1e-6f);
      rf[lrow + 128] = rsqrtf(q2 * ik + 1e-6f); rf[lrow + 192] = rsqrtf(q3 * ik + 1e-6f);
    }
    __syncthreads();
  }
}

#define EPI_LOOP_BEGIN                                                                                           \
  {                                                                                                              \
    const int lane_ = TID & 63, w_ = TID >> 6, wm_ = w_ >> 1, wn_ = w_ & 1, r_ = lane_ & 31, h_ = lane_ >> 5; \
    _Pragma("unroll") for (int mt = 0; mt < 4; mt++) _Pragma("unroll") for (int nt = 0; nt < 2; nt++)          \
        _Pragma("unroll") for (int i = 0; i < 16; i++) {                                                         \
      const float v = acc[mt][nt][i];
#define EPI_COORD_NS const int row = m0 + wm_ * 128 + mt * 32 + crow(i, h_); const int col = n0 + wn_ * 64 + nt * 32 + r_;
#define EPI_COORD_SW const int row = m0 + wm_ * 128 + mt * 32 + r_; const int col = n0 + wn_ * 64 + nt * 32 + crow(i, h_);
#define EPI_LOOP_END }}

DI void phase_gemm_in0(const Params& p, char* smem, int bid, int nblk) {
  char* ws = opaque_ptr(p.ws);
  const bf16_t* A = (const bf16_t*)(ws + OFF_H);
  const bf16_t* B = (const bf16_t*)(ws + OFF_WIN0T);
  bf16_t* QK = (bf16_t*)(ws + OFF_QK0);
  bf16_t* V0T = (bf16_t*)(ws + OFF_V0T);
  bf16_t* G0 = (bf16_t*)(ws + OFF_G0);
  float* GKL = (float*)(ws + OFF_GKLOW);
  for (int tile = bid; tile < 32 * 48; tile += nblk) {
    const int mi = tile & 31, ni = tile >> 5;
    const int m0 = mi * 256, n0 = ni * 128;
    f32x16 acc[4][2];
    if (ni >= 16) {
      if (ni < 32) {
        gemm_main<true>(acc, A, 2048, B, 2048, 2048, m0, n0, smem);
        EPI_LOOP_BEGIN EPI_COORD_SW
          V0T[(size_t)(col - 2048) * S_ + row] = (bf16_t)f2bf(v);
        EPI_LOOP_END
      } else {
        gemm_main<false>(acc, A, 2048, B, 2048, 2048, m0, n0, smem);
        EPI_LOOP_BEGIN EPI_COORD_NS
          G0[(size_t)row * 2048 + (col - 4096)] = (bf16_t)f2bf(silu(v));
        EPI_LOOP_END
      }
    } else {
      gemm_main<false>(acc, A, 2048, B, 2048, 2048, m0, n0, smem);
      EPI_LOOP_BEGIN EPI_COORD_NS
        QK[(size_t)row * 2048 + col] = (bf16_t)f2bf(v);
      EPI_LOOP_END
    }
  }
  {
    typedef __attribute__((ext_vector_type(4))) float f32x4_t;
    const int t = TID, lane = t & 63, w = t >> 6, l15 = lane & 15, quad = lane >> 4;
    float* red = (float*)smem;
    for (int item = bid; item < 512; item += nblk) {
      const bf16_t* ap = A + (size_t)(item * 16 + l15) * 2048 + 512 * w + 8 * quad;
      const bf16_t* bp = B + (size_t)(6144 + l15) * 2048 + 512 * w + 8 * quad;
      f32x4_t c = {0.f, 0.f, 0.f, 0.f};
#pragma unroll
      for (int s = 0; s < 16; s++) {
        const bf16x8 a = *(const bf16x8*)(ap + 32 * s);
        const bf16x8 b = *(const bf16x8*)(bp + 32 * s);
        c = __builtin_amdgcn_mfma_f32_16x16x32_bf16(a, b, c, 0, 0, 0);
      }
      __syncthreads();
#pragma unroll
      for (int j = 0; j < 4; j++) red[(w * 16 + quad * 4 + j) * 16 + l15] = c[j];
      __syncthreads();
      const float v = red[t] + red[256 + t] + red[512 + t] + red[768 + t];
      GKL[(size_t)item * 256 + t] = v;
    }
  }
}

DI void phase_gla_prep(const Params& p, char* smem, int bid, int nblk) {
  char* ws = opaque_ptr(p.ws);
  const int t = TID, lane = t & 63, w = t >> 6, r = lane & 31, h = lane >> 5;
  const bf16_t* QK = (const bf16_t*)(ws + OFF_QK0);
  const float* GKL = (const float*)(ws + OFF_GKLOW);
  bf16_t* QE = (bf16_t*)(ws + OFF_QE);
  bf16_t* KLT = (bf16_t*)(ws + OFF_KLT);
  bf16_t* AM = (bf16_t*)(ws + OFF_AM);
  float* DEC = (float*)(ws + OFF_DECAY);
  if (bid == 0 && t == 0) { ((int*)(ws + OFF_CTR))[0] = 0; ((int*)(ws + OFF_CTR))[1] = 0; }
  char* lq = smem;
  char* lk = smem + 32768;
  for (int tile = bid; tile < 512; tile += nblk) {
    const int n = tile >> 2, head = tile & 3, t0 = n * 64, d = t, col = head * 256 + d;
    float w2[16];
#pragma unroll
    for (int j = 0; j < 16; j++) w2[j] = p.w_gk2[j * 1024 + col];
    const float bias = p.b_gk[col];
    float b = 0.f;
    const int dperm = (d & ~15) | ((d & 3) | ((d & 4) << 1) | ((d & 8) >> 1));
    for (int c8 = 0; c8 < 8; c8++) {
      float bj[8], qv[8], kv[8];
#pragma unroll
      for (int j = 0; j < 8; j++) {
        const int c = c8 * 8 + j;
        const float4* gl = (const float4*)(GKL + (size_t)(t0 + c) * 16);
        float4 g0 = gl[0], g1 = gl[1], g2 = gl[2], g3 = gl[3];
        float gk = bias + g0.x * w2[0] + g0.y * w2[1] + g0.z * w2[2] + g0.w * w2[3] + g1.x * w2[4] + g1.y * w2[5] + g1.z * w2[6] + g1.w * w2[7]
                 + g2.x * w2[8] + g2.y * w2[9] + g2.z * w2[10] + g2.w * w2[11] + g3.x * w2[12] + g3.y * w2[13] + g3.z * w2[14] + g3.w * w2[15];
        float la = (fminf(gk, 0.f) - __logf(1.f + __expf(-fabsf(gk)))) * (1.f / 16.f);
        b += la;
        bj[j] = b;
        qv[j] = bf2f(QK[(size_t)(t0 + c) * 2048 + col]);
        kv[j] = bf2f(QK[(size_t)(t0 + c) * 2048 + 1024 + col]);
      }
      unsigned klp[4];
#pragma unroll
      for (int j = 0; j < 8; j++) {
        const int c = c8 * 8 + j;
        const float qe = qv[j] * 0.0625f * __expf(bj[j]);
        const float ke = kv[j] * __expf(-bj[j]);
        const unsigned qeb = f2bf(qe), keb = f2bf(ke), klb = keb;
        const int lo = c * 512 + ((((d >> 3) ^ (c & 15))) << 4) + (d & 7) * 2;
        *(unsigned short*)(lq + lo) = (unsigned short)qeb;
        *(unsigned short*)(lk + lo) = (unsigned short)keb;
        QE[(size_t)(t0 + c) * 1024 + head * 256 + dperm] = (bf16_t)qeb;
        if (j & 1) klp[j >> 1] |= klb << 16; else klp[j >> 1] = klb;
      }
      uint4 o; o.x = klp[0]; o.y = klp[1]; o.z = klp[2]; o.w = klp[3];
      *(uint4*)(KLT + (size_t)(head * 256 + d) * S_ + t0 + c8 * 8) = o;
    }
    DEC[(size_t)(n * 4 + head) * 256 + d] = __expf(b);
    __syncthreads();
    {
      const int ct = w >> 1, st = w & 1;
      f32x16 acc;
#pragma unroll
      for (int i = 0; i < 16; i++) acc[i] = 0.f;
      if (!(ct == 0 && st == 1)) {
        const int ra = ct * 32 + r, rb = st * 32 + r;
#pragma unroll
        for (int s = 0; s < 16; s++) {
          bf16x8 a = *(const bf16x8*)(lq + ra * 512 + (((2 * s + h) ^ (ra & 15)) << 4));
          bf16x8 bb = *(const bf16x8*)(lk + rb * 512 + (((2 * s + h) ^ (rb & 15)) << 4));
          acc = MFMA32(a, bb, acc);
        }
      }
      bf16_t* ap = AM + (size_t)(n * 4 + head) * 4096;
#pragma unroll
      for (int i = 0; i < 16; i++) {
        const int c = ct * 32 + crow(i, h), s = st * 32 + r;
        ap[c * 64 + s] = (bf16_t)f2bf(s <= c ? acc[i] : 0.f);
      }
    }
    __syncthreads();
  }
}

constexpr int SCAN_NG = 8, SCAN_GC = 16;
DI void phase_gla_local(const Params& p, char* smem, int bid, int nblk) {
  char* ws = opaque_ptr(p.ws);
  const int t = TID, lane = t & 63, w = t >> 6, r = lane & 31, h = lane >> 5;
  for (int item = bid; item < 64 * (SCAN_NG - 1); item += nblk) {
    const int grp = item >> 6, head = (item >> 4) & 3, dvt = item & 15, dv0 = dvt * 32;
    const int nb = grp * SCAN_GC;
    const bf16_t* v_p = (const bf16_t*)(ws + OFF_V0T) + (size_t)(head * 512 + dv0 + r) * S_ + nb * 64 + 8 * h;
    const bf16_t* kl_p = (const bf16_t*)(ws + OFF_KLT) + (size_t)(head * 256 + 64 * w + r) * S_ + nb * 64 + 8 * h;
    const float* dec_p = (const float*)(ws + OFF_DECAY) + (size_t)nb * 1024 + head * 256 + 64 * w + 4 * h;
    f32x16 St[2];
#pragma unroll
    for (int i = 0; i < 16; i++) { St[0][i] = 0.f; St[1][i] = 0.f; }
    bf16x8 klA[2][4], vfA[4], klB[2][4], vfB[4];
    float4 dcA[2][4], dcB[2][4];
#define LOC_LOAD(KL, VF, DC, n_)                                                                                 \
    {                                                                                                            \
      _Pragma("unroll") for (int s = 0; s < 4; s++) VF[s] = *(const bf16x8*)(v_p + (n_) * 64 + 16 * s);        \
      _Pragma("unroll") for (int dt = 0; dt < 2; dt++) {                                                         \
        _Pragma("unroll") for (int s = 0; s < 4; s++) KL[dt][s] = *(const bf16x8*)(kl_p + (size_t)dt * 32 * S_ + (n_) * 64 + 16 * s); \
        _Pragma("unroll") for (int g4 = 0; g4 < 4; g4++) DC[dt][g4] = *(const float4*)(dec_p + (size_t)(n_) * 1024 + dt * 32 + 8 * g4); \
      }                                                                                                          \
    }
#define LOC_STEP(KL, VF, DC)                                                                                     \
    {                                                                                                            \
      _Pragma("unroll") for (int dt = 0; dt < 2; dt++) {                                                         \
        _Pragma("unroll") for (int s = 0; s < 4; s++) St[dt] = MFMA32(KL[dt][s], VF[s], St[dt]);                 \
        _Pragma("unroll") for (int g4 = 0; g4 < 4; g4++) {                                                       \
          St[dt][4 * g4 + 0] *= DC[dt][g4].x; St[dt][4 * g4 + 1] *= DC[dt][g4].y;                                \
          St[dt][4 * g4 + 2] *= DC[dt][g4].z; St[dt][4 * g4 + 3] *= DC[dt][g4].w;                                \
        }                                                                                                        \
      }                                                                                                          \
    }
    LOC_LOAD(klA, vfA, dcA, 0)
    for (int n = 0; n < SCAN_GC; n += 2) {
      LOC_LOAD(klB, vfB, dcB, n + 1)
      LOC_STEP(klA, vfA, dcA)
      if (n + 2 < SCAN_GC) LOC_LOAD(klA, vfA, dcA, n + 2)
      LOC_STEP(klB, vfB, dcB)
    }
#undef LOC_LOAD
#undef LOC_STEP
    float* sl = (float*)(ws + OFF_SL) + ((size_t)((grp * 4 + head) * 16 + dvt) * 4 + w) * 2048 + lane;
#pragma unroll
    for (int dt = 0; dt < 2; dt++)
#pragma unroll
      for (int i = 0; i < 16; i++) sl[(dt * 16 + i) * 64] = St[dt][i];
    if (dvt == 0) {
      const float* dg = (const float*)(ws + OFF_DECAY) + (size_t)nb * 1024 + head * 256 + t;
      float pr = 1.f;
#pragma unroll 4
      for (int n = 0; n < SCAN_GC; n++) pr *= dg[(size_t)n * 1024];
      ((float*)(ws + OFF_DC))[(grp * 4 + head) * 256 + t] = pr;
    }
  }
}

DI void phase_gla_scan(const Params& p, char* smem, int bid, int nblk) {
  char* ws = opaque_ptr(p.ws);
  const int t = TID, lane = t & 63, w = t >> 6, r = lane & 31, h = lane >> 5;
  float* lo = (float*)smem;
  for (int item = bid; item < 64 * SCAN_NG; item += nblk) {
    const int grp = item >> 6, head = (item >> 4) & 3, dvt = item & 15, dv0 = dvt * 32;
    const int nb = grp * SCAN_GC, ne = nb + SCAN_GC;
    const bf16_t* qe_p = (const bf16_t*)(ws + OFF_QE) + (size_t)r * 1024 + head * 256 + 64 * w + 8 * h;
    const bf16_t* a_p = (const bf16_t*)(ws + OFF_AM) + (size_t)head * 4096 + (size_t)r * 64 + 16 * w + 8 * h;
    const bf16_t* v_p = (const bf16_t*)(ws + OFF_V0T) + (size_t)(head * 512 + dv0 + r) * S_ + 8 * h;
    const bf16_t* kl_p = (const bf16_t*)(ws + OFF_KLT) + (size_t)(head * 256 + 64 * w + r) * S_ + 8 * h;
    bf16_t* o_p = (bf16_t*)(ws + OFF_QK0) + (size_t)(t >> 2) * 2048 + head * 512 + dv0 + (t & 3) * 8;
    f32x16 St[2];
#pragma unroll
    for (int i = 0; i < 16; i++) { St[0][i] = 0.f; St[1][i] = 0.f; }
    for (int j = 0; j < grp; j++) {
      const float* slj = (const float*)(ws + OFF_SL) + ((size_t)((j * 4 + head) * 16 + dvt) * 4 + w) * 2048 + lane;
      const float* dcj = (const float*)(ws + OFF_DC) + (j * 4 + head) * 256 + 64 * w + 4 * h;
#pragma unroll
      for (int dt = 0; dt < 2; dt++)
#pragma unroll
        for (int g4 = 0; g4 < 4; g4++) {
          const float4 dv = *(const float4*)(dcj + 32 * dt + 8 * g4);
          St[dt][4 * g4 + 0] = St[dt][4 * g4 + 0] * dv.x + slj[(dt * 16 + 4 * g4 + 0) * 64];
          St[dt][4 * g4 + 1] = St[dt][4 * g4 + 1] * dv.y + slj[(dt * 16 + 4 * g4 + 1) * 64];
          St[dt][4 * g4 + 2] = St[dt][4 * g4 + 2] * dv.z + slj[(dt * 16 + 4 * g4 + 2) * 64];
          St[dt][4 * g4 + 3] = St[dt][4 * g4 + 3] * dv.w + slj[(dt * 16 + 4 * g4 + 3) * 64];
        }
    }
    qe_p += (size_t)nb * 64 * 1024; a_p += (size_t)nb * 4 * 4096; v_p += nb * 64; kl_p += nb * 64; o_p += (size_t)nb * 64 * 2048;
    bf16x8 qe[2][4], af[2], vf[4], kl[2][4];
    float* ldec = (float*)(smem + 32768);
    const float* dec_g = (const float*)(ws + OFF_DECAY) + (size_t)nb * 1024 + head * 256 + t;
#pragma unroll
    for (int ct = 0; ct < 2; ct++) {
#pragma unroll
      for (int s = 0; s < 4; s++) qe[ct][s] = *(const bf16x8*)(qe_p + (size_t)ct * 32 * 1024 + 16 * s);
      af[ct] = *(const bf16x8*)(a_p + ct * 32 * 64);
    }
#pragma unroll
    for (int s = 0; s < 4; s++) vf[s] = *(const bf16x8*)(v_p + 16 * s);
#pragma unroll
    for (int dt = 0; dt < 2; dt++) {
#pragma unroll
      for (int s = 0; s < 4; s++) kl[dt][s] = *(const bf16x8*)(kl_p + (size_t)dt * 32 * S_ + 16 * s);
    }
    __syncthreads();
    ldec[t] = dec_g[0];
    __syncthreads();
    for (int n = 0; n < SCAN_GC; n++) {
      const bool more = (n + 1 < SCAN_GC);
      float decn = 0.f;
      if (more) decn = dec_g[(size_t)(n + 1) * 1024];
      f32x16 o[2];
#pragma unroll
      for (int i = 0; i < 16; i++) { o[0][i] = 0.f; o[1][i] = 0.f; }
#pragma unroll
      for (int s = 0; s < 4; s++) {
        bf16x8 sb = pack8(St[s >> 1], s & 1);
        o[0] = MFMA32(qe[0][s], sb, o[0]);
        o[1] = MFMA32(qe[1][s], sb, o[1]);
      }
      if (more) {
        const bf16_t* q2 = qe_p + (size_t)(n + 1) * 64 * 1024;
#pragma unroll
        for (int ct = 0; ct < 2; ct++)
#pragma unroll
          for (int s = 0; s < 4; s++) qe[ct][s] = *(const bf16x8*)(q2 + (size_t)ct * 32 * 1024 + 16 * s);
      }
      {
        bf16x8 vw = (w == 0) ? vf[0] : (w == 1) ? vf[1] : (w == 2) ? vf[2] : vf[3];
        o[0] = MFMA32(af[0], vw, o[0]);
        o[1] = MFMA32(af[1], vw, o[1]);
      }
      if (more) {
        const bf16_t* a2 = a_p + (size_t)(n + 1) * 4 * 4096;
        af[0] = *(const bf16x8*)(a2); af[1] = *(const bf16x8*)(a2 + 32 * 64);
      }
#pragma unroll
      for (int dt = 0; dt < 2; dt++) {
#pragma unroll
        for (int s = 0; s < 4; s++) St[dt] = MFMA32(kl[dt][s], vf[s], St[dt]);
#pragma unroll
        for (int g = 0; g < 4; g++) {
          const float4 dv = *(const float4*)(ldec + (n & 1) * 256 + 64 * w + 32 * dt + 8 * g + 4 * h);
          St[dt][4 * g + 0] *= dv.x; St[dt][4 * g + 1] *= dv.y;
          St[dt][4 * g + 2] *= dv.z; St[dt][4 * g + 3] *= dv.w;
        }
      }
      if (more) {
        const int tn = (n + 1) * 64;
#pragma unroll
        for (int s = 0; s < 4; s++) vf[s] = *(const bf16x8*)(v_p + tn + 16 * s);
#pragma unroll
        for (int dt = 0; dt < 2; dt++) {
#pragma unroll
          for (int s = 0; s < 4; s++) kl[dt][s] = *(const bf16x8*)(kl_p + (size_t)dt * 32 * S_ + tn + 16 * s);
        }
      }
      ldec[((n + 1) & 1) * 256 + t] = decn;
#pragma unroll
      for (int ct = 0; ct < 2; ct++)
#pragma unroll
        for (int i = 0; i < 16; i++) lo[(w * 64 + ct * 32 + crow(i, h)) * 32 + r] = o[ct][i];
      __syncthreads();
      {
        const int c = t >> 2, vg = (t & 3) * 8;
        float4 s0 = *(const float4*)(lo + c * 32 + vg), s1 = *(const float4*)(lo + c * 32 + vg + 4);
#pragma unroll
        for (int ww = 1; ww < 4; ww++) {
          float4 x0 = *(const float4*)(lo + (ww * 64 + c) * 32 + vg), x1 = *(const float4*)(lo + (ww * 64 + c) * 32 + vg + 4);
          s0.x += x0.x; s0.y += x0.y; s0.z += x0.z; s0.w += x0.w; s1.x += x1.x; s1.y += x1.y; s1.z += x1.z; s1.w += x1.w;
        }
        uint4 ov; ov.x = pack2(s0.x, s0.y); ov.y = pack2(s0.z, s0.w); ov.z = pack2(s1.x, s1.y); ov.w = pack2(s1.z, s1.w);
        *(uint4*)(o_p + (size_t)n * 64 * 2048) = ov;
      }
      __syncthreads();
    }
  }
}

DI void phase_og(const Params& p, char* smem, int bid, int nblk) {
  char* ws = opaque_ptr(p.ws);
  const int t = TID, lane = t & 63, w = t >> 6;
  const bf16_t* O0 = (const bf16_t*)(ws + OFF_QK0);
  const bf16_t* G0 = (const bf16_t*)(ws + OFF_G0);
  bf16_t* OG = (bf16_t*)(ws + OFF_H);
  const float4* gp = (const float4*)(p.g_onorm + lane * 8);
  const float4 ga = gp[0], gb = gp[1];
  for (int token = bid; token < S_; token += 4 * nblk) {
    uint4 ov[4], gv[4];
#pragma unroll
    for (int u = 0; u < 4; u++) {
      const int tk = token + u * nblk;
      const size_t off = (size_t)(tk < S_ ? tk : token) * 2048 + w * 512 + lane * 8;
      ov[u] = *(const uint4*)(O0 + off);
      gv[u] = *(const uint4*)(G0 + off);
    }
#pragma unroll
    for (int u = 0; u < 4; u++) {
      const int tk = token + u * nblk;
      const size_t off = (size_t)tk * 2048 + w * 512 + lane * 8;
      const float f0 = bflo(ov[u].x), f1 = bfhi(ov[u].x), f2 = bflo(ov[u].y), f3 = bfhi(ov[u].y);
      const float f4 = bflo(ov[u].z), f5 = bfhi(ov[u].z), f6 = bflo(ov[u].w), f7 = bfhi(ov[u].w);
      float ss = f0 * f0 + f1 * f1 + f2 * f2 + f3 * f3 + f4 * f4 + f5 * f5 + f6 * f6 + f7 * f7;
      ss = wave_sum(ss);
      const float rinv = rsqrtf(ss * (1.f / 512.f) + 1e-6f);
      uint4 o;
      o.x = pack2(f0 * rinv * ga.x * bflo(gv[u].x), f1 * rinv * ga.y * bfhi(gv[u].x));
      o.y = pack2(f2 * rinv * ga.z * bflo(gv[u].y), f3 * rinv * ga.w * bfhi(gv[u].y));
      o.z = pack2(f4 * rinv * gb.x * bflo(gv[u].z), f5 * rinv * gb.y * bfhi(gv[u].z));
      o.w = pack2(f6 * rinv * gb.z * bflo(gv[u].w), f7 * rinv * gb.w * bfhi(gv[u].w));
      if (tk < S_) *(uint4*)(OG + off) = o;
    }
  }
}

DI void phase_gemm_out(const Params& p, char* smem, int bid, int nblk, size_t off_w) {
  char* ws = opaque_ptr(p.ws);
  const bf16_t* A = (const bf16_t*)(ws + OFF_H);
  const bf16_t* B = (const bf16_t*)(ws + off_w);
  bf16_t* Y = (bf16_t*)(ws + OFF_Y);
  for (int tile = bid; tile < 32 * 16; tile += nblk) {
    const int mi = tile & 31, ni = tile >> 5;
    const int m0 = mi * 256, n0 = ni * 128;
    f32x16 acc[4][2];
    gemm_main<false>(acc, A, 2048, B, 2048, 2048, m0, n0, smem);
    EPI_LOOP_BEGIN EPI_COORD_NS
      Y[(size_t)row * 2048 + col] = (bf16_t)f2bf(v);
    EPI_LOOP_END
  }
}

DI void phase_post0(const Params& p, char* smem, int bid, int nblk) {
  char* ws = opaque_ptr(p.ws);
  const int t = TID, lane = t & 63, w = t >> 6;
  const bf16_t* Y = (const bf16_t*)(ws + OFF_Y);
  const float4* gpo = (const float4*)p.l0_post + lane;
  const float4* gpr = (const float4*)p.l1_pre + lane;
  for (int row = bid * 4 + w; row < S_; row += nblk * 4) {
    const uint2* yr = (const uint2*)(Y + (size_t)row * 2048) + lane;
    const float4* xr = (const float4*)(p.x + (size_t)row * 2048) + lane;
    float4 yv[8], xv[8];
#pragma unroll
    for (int j = 0; j < 8; j++) { const uint2 u = yr[j * 64]; yv[j].x = bflo(u.x); yv[j].y = bfhi(u.x); yv[j].z = bflo(u.y); yv[j].w = bfhi(u.y); xv[j] = xr[j * 64]; }
    float ss = 0.f;
#pragma unroll
    for (int j = 0; j < 8; j++) ss += yv[j].x * yv[j].x + yv[j].y * yv[j].y + yv[j].z * yv[j].z + yv[j].w * yv[j].w;
    ss = wave_sum(ss);
    const float rinv = rsqrtf(ss * (1.f / 2048.f) + 1e-6f);
    float4* outr = (float4*)(p.out + (size_t)row * 2048) + lane;
    float s2 = 0.f;
#pragma unroll
    for (int j = 0; j < 8; j++) {
      const float4 g = gpo[j * 64];
      xv[j].x += yv[j].x * rinv * g.x; xv[j].y += yv[j].y * rinv * g.y; xv[j].z += yv[j].z * rinv * g.z; xv[j].w += yv[j].w * rinv * g.w;
      outr[j * 64] = xv[j];
      s2 += xv[j].x * xv[j].x + xv[j].y * xv[j].y + xv[j].z * xv[j].z + xv[j].w * xv[j].w;
    }
    s2 = wave_sum(s2);
    const float r2 = rsqrtf(s2 * (1.f / 2048.f) + 1e-6f);
    uint2* hr = (uint2*)(ws + OFF_H + (size_t)row * 4096) + lane;
#pragma unroll
    for (int j = 0; j < 8; j++) {
      const float4 g = gpr[j * 64];
      uint2 o; o.x = pack2(xv[j].x * r2 * g.x, xv[j].y * r2 * g.y); o.y = pack2(xv[j].z * r2 * g.z, xv[j].w * r2 * g.w);
      hr[j * 64] = o;
    }
  }
}

DI void phase_gemm_in1(const Params& p, char* smem, int bid, int nblk) {
  char* ws = opaque_ptr(p.ws);
  const bf16_t* A = (const bf16_t*)(ws + OFF_H);
  const bf16_t* B = (const bf16_t*)(ws + OFF_WIN1T);
  bf16_t* CQ = (bf16_t*)(ws + OFF_CQ);
  bf16_t* CKV = (bf16_t*)(ws + OFF_CKV);
  bf16_t* KR = (bf16_t*)(ws + OFF_KR);
  const float* cs = (const float*)(ws + OFF_CS);
  bf16_t* G1 = (bf16_t*)(ws + OFF_QK0);
  for (int tile = bid; tile < 32 * 25; tile += nblk) {
    const int mi = tile & 31, ni = tile >> 5;
    const int m0 = mi * 256, n0 = ni * 128;
    f32x16 acc[4][2];
    gemm_main<false>(acc, A, 2048, B, 2048, 2048, m0, n0, smem);
    if (ni < 4) {
      EPI_LOOP_BEGIN EPI_COORD_NS
        CQ[(size_t)row * 512 + col] = (bf16_t)f2bf(v);
      EPI_LOOP_END
    } else if (ni < 8) {
      EPI_LOOP_BEGIN EPI_COORD_NS
        CKV[(size_t)row * 512 + (col - 512)] = (bf16_t)f2bf(v);
      EPI_LOOP_END
    } else if (ni == 8 && ((TID >> 6) & 1) == 0) {
      const int lane_ = TID & 63, w_ = TID >> 6, wm_ = w_ >> 1, r_ = lane_ & 31, h_ = lane_ >> 5;
#pragma unroll
      for (int mt = 0; mt < 4; mt++)
#pragma unroll
        for (int i = 0; i < 16; i++) {
          const int row = m0 + wm_ * 128 + mt * 32 + crow(i, h_);
          const float t1 = acc[mt][0][i], t2 = acc[mt][1][i];
          const float c = cs[row * 64 + r_], sn = cs[row * 64 + 32 + r_];
          KR[(size_t)row * 64 + r_] = (bf16_t)f2bf(t1 * c - t2 * sn);
          KR[(size_t)row * 64 + 32 + r_] = (bf16_t)f2bf(t2 * c + t1 * sn);
        }
    } else {
      EPI_LOOP_BEGIN EPI_COORD_NS
        if (col < 3136) G1[(size_t)row * 2048 + (col - 1088)] = (bf16_t)f2bf(silu(v));
      EPI_LOOP_END
    }
  }
}

DI void phase_gemm_qkv(const Params& p, char* smem, int bid, int nblk) {
  char* ws = opaque_ptr(p.ws);
  const bf16_t* CQ = (const bf16_t*)(ws + OFF_CQ);
  const bf16_t* CKV = (const bf16_t*)(ws + OFF_CKV);
  const bf16_t* WQ = (const bf16_t*)(ws + OFF_WQBT);
  const bf16_t* WKV = (const bf16_t*)(ws + OFF_WKVBT);
  const float* cs = (const float*)(ws + OFF_CS);
  bf16_t* Q = (bf16_t*)(ws + OFF_Q);
  bf16_t* KN = (bf16_t*)(ws + OFF_KN);
  bf16_t* VT = (bf16_t*)(ws + OFF_VT);
  const float qscale = 0.07216878364870322f * 1.4426950408889634f;
  const int ntq = 32 * 24, ntkv = 32 * 32;
  for (int tile = bid; tile < ntq + ntkv; tile += nblk) {
    f32x16 acc[4][2];
    if (tile < ntq) {
      const int mi = tile & 31, ni = tile >> 5;
      const int m0 = mi * 256, n0 = ni * 128;
      gemm_main<false, true>(acc, CQ, 512, WQ, 512, 512, m0, n0, smem);
      const float* rf = (const float*)(smem + 49152);
      const int lane_ = TID & 63, w_ = TID >> 6, wm_ = w_ >> 1, wn_ = w_ & 1, r_ = lane_ & 31, h_ = lane_ >> 5;
      const int cb = n0 + wn_ * 64;
      const int head = cb / 192, jb = cb - head * 192;
      if (jb == 128) {
#pragma unroll
        for (int mt = 0; mt < 4; mt++)
#pragma unroll
          for (int i = 0; i < 16; i++) {
            const int row = m0 + wm_ * 128 + mt * 32 + crow(i, h_);
            const float sc = rf[row - m0] * qscale;
            const float t1 = acc[mt][0][i] * sc, t2 = acc[mt][1][i] * sc;
            const float c = cs[row * 64 + r_], s = cs[row * 64 + 32 + r_];
            bf16_t* qp = Q + ((size_t)head * S_ + row) * 192 + 128;
            qp[r_] = (bf16_t)f2bf(t1 * c - t2 * s);
            qp[32 + r_] = (bf16_t)f2bf(t2 * c + t1 * s);
          }
      } else {
#pragma unroll
        for (int mt = 0; mt < 4; mt++)
#pragma unroll
          for (int nt = 0; nt < 2; nt++)
#pragma unroll
            for (int i = 0; i < 16; i++) {
              const int row = m0 + wm_ * 128 + mt * 32 + crow(i, h_);
              const float sc = rf[row - m0] * qscale;
              Q[((size_t)head * S_ + row) * 192 + jb + nt * 32 + r_] = (bf16_t)f2bf(acc[mt][nt][i] * sc);
            }
      }
    } else {
      const int tl = tile - ntq;
      const int mi = tl & 31, ni = tl >> 5;
      const int m0 = mi * 256, n0 = ni * 128;
      const int head = ni >> 1;
      if (ni & 1) {
        gemm_main<true, true>(acc, CKV, 512, WKV, 512, 512, m0, n0, smem);
        const float* rf = (const float*)(smem + 49152);
        EPI_LOOP_BEGIN EPI_COORD_SW
          const int j = col - head * 256 - 128;
          VT[((size_t)head * 128 + j) * S_ + row] = (bf16_t)f2bf(v * rf[row - m0]);
        EPI_LOOP_END
      } else {
        gemm_main<false, true>(acc, CKV, 512, WKV, 512, 512, m0, n0, smem);
        const float* rf = (const float*)(smem + 49152);
        EPI_LOOP_BEGIN EPI_COORD_NS
          const int j = col - head * 256;
          KN[((size_t)head * S_ + row) * 128 + j] = (bf16_t)f2bf(v * rf[row - m0]);
        EPI_LOOP_END
      }
    }
  }
}

DI void phase_attn(const Params& p, char* smem, int bid, int nblk, int rep) {
  char* ws = opaque_ptr(p.ws);
  const int t = TID, lane = t & 63, w = t >> 6, r = lane & 31, h = lane >> 5;
  const bf16_t* Q = (const bf16_t*)(ws + OFF_Q);
  const bf16_t* KN = (const bf16_t*)(ws + OFF_KN);
  const bf16_t* KR = (const bf16_t*)(ws + OFF_KR);
  const bf16_t* VT = (const bf16_t*)(ws + OFF_VT);
  const bf16_t* G1 = (const bf16_t*)(ws + OFF_QK0);
  bf16_t* OG = (bf16_t*)(ws + OFF_H);
  int* ctr = (int*)(ws + OFF_CTR) + rep;
  char* lk = smem;
  char* lv = smem + 25600;
  int* s_item = (int*)(smem + 44032);
  const int k_row = t >> 2, k_c0 = t & 3;
  const int v_row0 = t >> 3, v_kc = t & 7;
  for (;;) {
    __syncthreads();
    if (t == 0) *s_item = atomicAdd(ctr, 1);
    __syncthreads();
    const int item = *s_item;
    if (item >= 1024) break;
    const int qb = 63 - (item >> 4), head = item & 15;
    const int q0w = qb * 128 + w * 32;
    const int ntile = 2 * qb + 2;
    bf16x8 qf[12];
    {
      const bf16_t* qp = Q + ((size_t)head * S_ + q0w + r) * 192 + 8 * h;
#pragma unroll
      for (int s = 0; s < 12; s++) qf[s] = *(const bf16x8*)(qp + 16 * s);
    }
    f32x16 oacc[4];
#pragma unroll
    for (int vt = 0; vt < 4; vt++)
#pragma unroll
      for (int i = 0; i < 16; i++) oacc[vt][i] = 0.f;
    float m_run = -INFINITY, l_run = 0.f;
    uint4 kg0, kg1, kg2, kg3, kg4, kg5, vg0, vg1, vg2, vg3;
    const bf16_t* knp = KN + (size_t)head * S_ * 128;
    const bf16_t* vtp = VT + ((size_t)head * 128 + v_row0) * S_ + v_kc * 8;
#define ATT_LOAD(k0_)                                                                                         \
    {                                                                                                         \
      const bf16_t* kn_ = knp + (size_t)((k0_) + k_row) * 128 + k_c0 * 8;                                     \
      const bf16_t* kr_ = KR + (size_t)((k0_) + k_row) * 64 + k_c0 * 8;                                       \
      const bf16_t* vp_ = vtp + (k0_);                                                                        \
      kg0 = *(const uint4*)(kn_); kg1 = *(const uint4*)(kn_ + 32); kg2 = *(const uint4*)(kn_ + 64); kg3 = *(const uint4*)(kn_ + 96); \
      kg4 = *(const uint4*)(kr_); kg5 = *(const uint4*)(kr_ + 32);                                            \
      vg0 = *(const uint4*)(vp_); vg1 = *(const uint4*)(vp_ + (size_t)32 * S_);                               \
      vg2 = *(const uint4*)(vp_ + (size_t)64 * S_); vg3 = *(const uint4*)(vp_ + (size_t)96 * S_);             \
    }
    ATT_LOAD(0)
    for (int kt = 0; kt < ntile; kt++) {
      const int k0 = kt * 64;
      __syncthreads();
      {
        char* kd = lk + k_row * 400 + k_c0 * 16;
        *(uint4*)(kd) = kg0; *(uint4*)(kd + 64) = kg1; *(uint4*)(kd + 128) = kg2; *(uint4*)(kd + 192) = kg3;
        *(uint4*)(kd + 256) = kg4; *(uint4*)(kd + 320) = kg5;
        char* vd = lv + v_row0 * 144 + (v_kc >> 1) * 32 + (v_kc & 1) * 8;
#define VST(o_, v_) { uint2 u0, u1; u0.x = v_.x; u0.y = v_.y; u1.x = v_.z; u1.y = v_.w; *(uint2*)(vd + (o_)) = u0; *(uint2*)(vd + (o_) + 16) = u1; }
        VST(0, vg0) VST(32 * 144, vg1) VST(64 * 144, vg2) VST(96 * 144, vg3)
#undef VST
      }
      __syncthreads();
      { const int knext = (kt + 1 < ntile) ? k0 + 64 : k0; ATT_LOAD(knext) }
      if (k0 <= q0w + 31) {
        f32x16 sc[2];
#pragma unroll
        for (int i = 0; i < 16; i++) { sc[0][i] = 0.f; sc[1][i] = 0.f; }
        __builtin_amdgcn_s_setprio(1);
#pragma unroll
        for (int s = 0; s < 12; s++) {
          bf16x8 a0 = *(const bf16x8*)(lk + r * 400 + h * 16 + s * 32);
          bf16x8 a1 = *(const bf16x8*)(lk + r * 400 + h * 16 + 32 * 400 + s * 32);
          sc[0] = MFMA32(a0, qf[s], sc[0]);
          sc[1] = MFMA32(a1, qf[s], sc[1]);
        }
        __builtin_amdgcn_s_setprio(0);
        if (k0 + 63 > q0w) {
          const int qg = q0w + r;
#pragma unroll
          for (int mt = 0; mt < 2; mt++)
#pragma unroll
            for (int i = 0; i < 16; i++) {
              const int key = k0 + mt * 32 + crow(i, h);
              if (key > qg) sc[mt][i] = -INFINITY;
            }
        }
        float mx = sc[0][0];
#pragma unroll
        for (int i = 1; i < 16; i++) mx = fmaxf(mx, sc[0][i]);
#pragma unroll
        for (int i = 0; i < 16; i++) mx = fmaxf(mx, sc[1][i]);
        mx = fmaxf(mx, __shfl_xor(mx, 32));
        const float m_new = (mx > m_run + 8.f) ? mx : m_run;
        const bool resc = __any(m_new != m_run);
        const float alpha = __builtin_amdgcn_exp2f(m_run - m_new);
        m_run = m_new;
        float ls = 0.f;
#pragma unroll
        for (int mt = 0; mt < 2; mt++)
#pragma unroll
          for (int i = 0; i < 16; i++) { const float pv = __builtin_amdgcn_exp2f(sc[mt][i] - m_new); sc[mt][i] = pv; ls += pv; }
        l_run = l_run * alpha + ls;
        if (resc) {
#pragma unroll
          for (int vt = 0; vt < 4; vt++)
#pragma unroll
            for (int i = 0; i < 16; i++) oacc[vt][i] *= alpha;
        }
        __builtin_amdgcn_s_setprio(1);
#pragma unroll
        for (int s = 0; s < 4; s++) {
          const bf16x8 pb = pack8(sc[s >> 1], s & 1);
#pragma unroll
          for (int vt = 0; vt < 4; vt++) {
            const bf16x8 a = *(const bf16x8*)(lv + r * 144 + h * 16 + vt * 32 * 144 + s * 32);
            oacc[vt] = MFMA32(a, pb, oacc[vt]);
          }
        }
        __builtin_amdgcn_s_setprio(0);
      }
    }
#undef ATT_LOAD
    const float l_tot = l_run + __shfl_xor(l_run, 32);
    const float inv = 1.f / l_tot;
    const size_t obase = (size_t)(q0w + r) * 2048 + head * 128;
#pragma unroll
    for (int vt = 0; vt < 4; vt++)
#pragma unroll
      for (int g = 0; g < 4; g++) {
        const int v = vt * 32 + 8 * g + 4 * h;
        uint2 gg = *(const uint2*)(G1 + obase + v);
        uint2 o;
        o.x = pack2(oacc[vt][4 * g + 0] * inv * bflo(gg.x), oacc[vt][4 * g + 1] * inv * bfhi(gg.x));
        o.y = pack2(oacc[vt][4 * g + 2] * inv * bflo(gg.y), oacc[vt][4 * g + 3] * inv * bfhi(gg.y));
        *(uint2*)(OG + obase + v) = o;
      }
  }
}

DI void phase_final(const Params& p, char* smem, int bid, int nblk) {
  char* ws = opaque_ptr(p.ws);
  const int t = TID, lane = t & 63, w = t >> 6;
  const bf16_t* Y = (const bf16_t*)(ws + OFF_Y);
  const float4* gpo = (const float4*)p.l1_post + lane;
  for (int row0 = bid * 4 + w; row0 < S_; row0 += nblk * 8) {
    const int row1r = row0 + nblk * 4;
    const bool has1 = row1r < S_;
    const int row1 = has1 ? row1r : row0;
    const uint2* yr0 = (const uint2*)(Y + (size_t)row0 * 2048) + lane;
    const uint2* yr1 = (const uint2*)(Y + (size_t)row1 * 2048) + lane;
    float4* out0 = (float4*)(p.out + (size_t)row0 * 2048) + lane;
    float4* out1 = (float4*)(p.out + (size_t)row1 * 2048) + lane;
    uint2 ya[8], yb[8];
    float4 xa[8], xb[8];
#pragma unroll
    for (int j = 0; j < 8; j++) { ya[j] = yr0[j * 64]; xa[j] = out0[j * 64]; yb[j] = yr1[j * 64]; xb[j] = out1[j * 64]; }
    float sa = 0.f, sb = 0.f;
#pragma unroll
    for (int j = 0; j < 8; j++) {
      sa += bflo(ya[j].x) * bflo(ya[j].x) + bfhi(ya[j].x) * bfhi(ya[j].x) + bflo(ya[j].y) * bflo(ya[j].y) + bfhi(ya[j].y) * bfhi(ya[j].y);
      sb += bflo(yb[j].x) * bflo(yb[j].x) + bfhi(yb[j].x) * bfhi(yb[j].x) + bflo(yb[j].y) * bflo(yb[j].y) + bfhi(yb[j].y) * bfhi(yb[j].y);
    }
    sa = wave_sum(sa); sb = wave_sum(sb);
    const float ra = rsqrtf(sa * (1.f / 2048.f) + 1e-6f), rb = rsqrtf(sb * (1.f / 2048.f) + 1e-6f);
#pragma unroll
    for (int j = 0; j < 8; j++) {
      const float4 g = gpo[j * 64];
      float4 o = xa[j];
      o.x += bflo(ya[j].x) * ra * g.x; o.y += bfhi(ya[j].x) * ra * g.y; o.z += bflo(ya[j].y) * ra * g.z; o.w += bfhi(ya[j].y) * ra * g.w;
      out0[j * 64] = o;
      if (has1) {
        float4 q = xb[j];
        q.x += bflo(yb[j].x) * rb * g.x; q.y += bfhi(yb[j].x) * rb * g.y; q.z += bflo(yb[j].y) * rb * g.z; q.w += bfhi(yb[j].y) * rb * g.w;
        out1[j * 64] = q;
      }
    }
  }
}

constexpr int NPHASE = 13;
constexpr unsigned DUP_MASK = 0u;
DI void run_phase(int ph, const Params& p, char* smem, int bid, int nblk, int rep) {
  switch (ph) {
    case 0: phase_prep(p, smem, bid, nblk); break;
    case 1: phase_gemm_in0(p, smem, bid, nblk); break;
    case 2: phase_gla_prep(p, smem, bid, nblk); break;
    case 3: phase_gla_local(p, smem, bid, nblk); break;
    case 4: phase_gla_scan(p, smem, bid, nblk); break;
    case 5: phase_og(p, smem, bid, nblk); break;
    case 6: phase_gemm_out(p, smem, bid, nblk, OFF_WOUT0T); break;
    case 7: phase_post0(p, smem, bid, nblk); break;
    case 8: phase_gemm_in1(p, smem, bid, nblk); break;
    case 9: phase_gemm_qkv(p, smem, bid, nblk); break;
    case 10: phase_attn(p, smem, bid, nblk, rep); break;
    case 11: phase_gemm_out(p, smem, bid, nblk, OFF_WOUT1T); break;
    case 12: phase_final(p, smem, bid, nblk); break;
  }
}

#define XB_TMO      128
#define XB_XCNT(j)  (256  + 64 * (j))
#define XB_XSUB(j)  (1280 + 64 * (j))
#define XB_XGEN(j)  (2304 + 64 * (j))
#define XB_TOP      3328
#define XB_TOPGEN   3392
#define XCD_BAR_WORDS 3456
#define XB_SPIN_CAP (1u << 20)
#define LAS __attribute__((address_space(3)))
DI unsigned xb_ld(unsigned* p) { return __hip_atomic_load(p, __ATOMIC_RELAXED, __HIP_MEMORY_SCOPE_AGENT); }
DI unsigned xb_add(unsigned* p, unsigned v) { return __hip_atomic_fetch_add(p, v, __ATOMIC_RELAXED, __HIP_MEMORY_SCOPE_AGENT); }
DI unsigned xb_xcc_id() { return (unsigned)__builtin_amdgcn_s_getreg((3 << 11) | 20) & 0xFu; }
#define XB_SPIN(cond, bar) do { unsigned _sp = 0; while (cond) { __builtin_amdgcn_s_sleep(1); \
    if ((++_sp & 255u) == 0u) { if (xb_ld(&(bar)[XB_TMO])) break; if (_sp > XB_SPIN_CAP) { atomicAdd(&(bar)[XB_TMO], 1u); break; } } } } while (0)
struct XcdBarrier { unsigned* bar; unsigned x; volatile LAS unsigned* st; };
DI XcdBarrier xcd_barrier_post(unsigned* bar, volatile LAS unsigned* st) {
  XcdBarrier b; b.bar = bar; b.x = xb_xcc_id(); b.st = st;
  if (threadIdx.x == 0) (void)xb_add(&bar[XB_XCNT(b.x)], 1u);
  return b;
}
DI void xcd_barrier_complete(unsigned* bar, unsigned x, unsigned& nloc, unsigned& nx) {
  const unsigned G = gridDim.x * gridDim.y * gridDim.z;
  unsigned sum, cnt, mine, sp = 0u;
  for (;;) {
    sum = 0u; cnt = 0u; mine = 0u;
#pragma unroll
    for (unsigned j = 0; j < 16; ++j) { const unsigned c = xb_ld(&bar[XB_XCNT(j)]); sum += c; cnt += (c > 0u) ? 1u : 0u; mine = (j == x) ? c : mine; }
    if (sum == G) break;
    __builtin_amdgcn_s_sleep(1);
    if ((++sp & 255u) == 0u) { if (xb_ld(&bar[XB_TMO])) break; if (sp > XB_SPIN_CAP) { atomicAdd(&bar[XB_TMO], 1u); break; } }
  }
  nloc = mine > 0u ? mine : 1u; nx = cnt > 0u ? cnt : 1u;
}
DI void xcd_barrier(const XcdBarrier& b) {
  asm volatile("s_waitcnt vmcnt(0)" ::: "memory");
  __syncthreads();
  if (threadIdx.x == 0) {
    unsigned* bar = b.bar;
    __builtin_amdgcn_s_waitcnt(0);
    unsigned nloc, nx;
    xcd_barrier_complete(bar, b.x, nloc, nx);
    const unsigned old = xb_add(&bar[XB_XSUB(b.x)], 1u);
    const unsigned gen = old / nloc;
    if (old + 1u == (gen + 1u) * nloc) {
      __builtin_amdgcn_fence(__ATOMIC_RELEASE, "agent");
      asm volatile("s_waitcnt vmcnt(0)" ::: "memory");
      const unsigned og = xb_add(&bar[XB_TOP], 1u);
      const unsigned tg = og / nx;
      if (og + 1u == (tg + 1u) * nx) xb_add(&bar[XB_TOPGEN], 1u);
      else XB_SPIN(xb_ld(&bar[XB_TOPGEN]) == tg, bar);
      __builtin_amdgcn_fence(__ATOMIC_ACQUIRE, "agent");
      xb_add(&bar[XB_XGEN(b.x)], 1u);
      asm volatile("s_waitcnt vmcnt(0)" ::: "memory");
    } else {
      XB_SPIN(xb_ld(&bar[XB_XGEN(b.x)]) == gen, bar);
      __builtin_amdgcn_fence(__ATOMIC_ACQUIRE, "agent");
      asm volatile("s_waitcnt vmcnt(0)" ::: "memory");
    }
  }
  __syncthreads();
}

#if MEGA
__global__ void __launch_bounds__(256, 2) mega_kernel(Params p) {
  __shared__ __attribute__((aligned(16))) char smem[65536];
  cg::grid_group grid = cg::this_grid();
  const int bid = blockIdx.x, nblk = gridDim.x;
  (void)xcd_barrier_post((unsigned*)(p.ws + OFF_BAR), (volatile LAS unsigned*)0);
#pragma nounroll
  for (int ph = 0; ph < NPHASE; ph++) {
    int phv = ph;
    asm volatile("" : "+s"(phv));
    run_phase(phv, p, smem, bid, nblk, 0);
    if (p.ws == nullptr) grid.sync();
    { XcdBarrier xb; xb.bar = (unsigned*)(opaque_ptr(p.ws) + OFF_BAR); xb.x = xb_xcc_id(); xb.st = (volatile LAS unsigned*)0; xcd_barrier(xb); }
    if ((DUP_MASK >> ph) & 1u) {
      run_phase(phv, p, smem, bid, nblk, 1);
      { XcdBarrier xb; xb.bar = (unsigned*)(opaque_ptr(p.ws) + OFF_BAR); xb.x = xb_xcc_id(); xb.st = (volatile LAS unsigned*)0; xcd_barrier(xb); }
    }
  }
}
#endif

#if !MEGA
template <int PH>
__global__ void __launch_bounds__(256, 2) phase_kernel_t(Params p) {
  __shared__ __attribute__((aligned(16))) char smem[65536];
  run_phase(PH, p, smem, blockIdx.x, gridDim.x, 0);
}
#endif

extern "C" void kernel_launch(void* const* d_in, const int* in_sizes, int n_in, void* d_out, int out_size, void* d_ws,
                              size_t ws_size, hipStream_t stream) {
  Params p{};
  p.x = (const float*)d_in[0]; p.pos = (const int*)d_in[1]; p.l0_pre = (const float*)d_in[2]; p.w_in0 = (const float*)d_in[3];
  p.w_gk2 = (const float*)d_in[4]; p.b_gk = (const float*)d_in[5]; p.g_onorm = (const float*)d_in[6]; p.w_out0 = (const float*)d_in[7];
  p.l0_post = (const float*)d_in[8]; p.l1_pre = (const float*)d_in[9]; p.w_in1 = (const float*)d_in[10]; p.g_qa = (const float*)d_in[11];
  p.w_qb = (const float*)d_in[12]; p.g_kva = (const float*)d_in[13]; p.w_kvb = (const float*)d_in[14]; p.w_out1 = (const float*)d_in[15];
  p.l1_post = (const float*)d_in[16];
  p.out = (float*)d_out; p.ws = (char*)d_ws;
  for (int i = 0; i < 32; i++) p.invf[i] = (float)pow(10000.0, -(double)i / 32.0);
#if MEGA
  static int grid_blocks = 0;
  if (!grid_blocks) {
    int dev = 0, cus = 0, per_cu = 0;
    hipGetDevice(&dev);
    hipDeviceGetAttribute(&cus, hipDeviceAttributeMultiprocessorCount, dev);
    hipOccupancyMaxActiveBlocksPerMultiprocessor(&per_cu, mega_kernel, 256, 0);
    if (per_cu > 2) per_cu = 2;
    if (per_cu < 1) per_cu = 1;
    grid_blocks = cus * per_cu;
  }
  hipMemsetAsync((char*)d_ws + OFF_BAR, 0, XCD_BAR_WORDS * 4, stream);
  void* args[] = {&p};
  hipError_t e = hipLaunchCooperativeKernel((void*)mega_kernel, dim3(grid_blocks), dim3(256), args, 0, stream);
  if (e != hipSuccess) fprintf(stderr, "cooperative launch failed: %s (grid %d)\n", hipGetErrorString(e), grid_blocks);
#else
#define LPH(N) hipLaunchKernelGGL(phase_kernel_t<N>, dim3(512), dim3(256), 0, stream, p);
  LPH(0) LPH(1) LPH(2) LPH(3) LPH(4) LPH(5) LPH(6) LPH(7) LPH(8) LPH(9) LPH(10) LPH(11) LPH(12)
#undef LPH
#endif
}
```

```cpp
#include <hip/hip_runtime.h>
#include <hip/hip_cooperative_groups.h>
#include <stdint.h>
#include <math.h>
#include <stdio.h>
namespace cg = cooperative_groups;

#ifndef MEGA
#define MEGA 1
#endif

typedef __attribute__((ext_vector_type(8))) short bf16x8;
typedef __attribute__((ext_vector_type(4))) short s16x4;
typedef __attribute__((ext_vector_type(16))) float f32x16;
typedef unsigned short bf16_t;
#define DI __device__ __forceinline__
#define MFMA32(a, b, c) __builtin_amdgcn_mfma_f32_32x32x16_bf16((a), (b), (c), 0, 0, 0)

constexpr int S_ = 8192;
constexpr size_t MiB = (size_t)1 << 20;
constexpr size_t OFF_WIN0T = 0;
constexpr size_t OFF_WOUT0T = 25 * MiB;
constexpr size_t OFF_WIN1T = 33 * MiB;
constexpr size_t OFF_WQBT = 46 * MiB;
constexpr size_t OFF_WKVBT = 49 * MiB;
constexpr size_t OFF_WOUT1T = 53 * MiB;
constexpr size_t OFF_GKLOW = 61 * MiB;
constexpr size_t OFF_DECAY = 61 * MiB + 512 * 1024;
constexpr size_t OFF_CS = 62 * MiB;
constexpr size_t OFF_H = 64 * MiB;
constexpr size_t OFF_QK0 = 96 * MiB;
constexpr size_t OFF_V0T = 128 * MiB;
constexpr size_t OFF_G0 = 160 * MiB;
constexpr size_t OFF_Y = 128 * MiB;
constexpr size_t OFF_QE = 192 * MiB;
constexpr size_t OFF_KLT = 208 * MiB;
constexpr size_t OFF_AM = 224 * MiB;
constexpr size_t OFF_CQ = 0;
constexpr size_t OFF_CKV = 8 * MiB;
constexpr size_t OFF_KR = 16 * MiB;
constexpr size_t OFF_RINVQ = 17 * MiB;
constexpr size_t OFF_RINVKV = 17 * MiB + 64 * 1024;
constexpr size_t OFF_KRRAW = 18 * MiB;
constexpr size_t OFF_CTR = 20 * MiB;
constexpr size_t OFF_BAR = 255 * MiB;
constexpr size_t OFF_SL = 64 * MiB;
constexpr size_t OFF_DC = 80 * MiB;
constexpr size_t OFF_Q = 128 * MiB;
constexpr size_t OFF_KN = 176 * MiB;
constexpr size_t OFF_VT = 208 * MiB;

struct Params {
  const float* x; const int* pos; const float* l0_pre; const float* w_in0; const float* w_gk2; const float* b_gk;
  const float* g_onorm; const float* w_out0; const float* l0_post; const float* l1_pre; const float* w_in1;
  const float* g_qa; const float* w_qb; const float* g_kva; const float* w_kvb; const float* w_out1; const float* l1_post;
  float* out; char* ws;
  float invf[32];
};

DI int tid_opaque() { int t = threadIdx.x; asm volatile("" : "+v"(t)); return t; }
#define TID tid_opaque()
typedef __attribute__((address_space(1))) char gchar_t;
DI char* opaque_ptr(char* q) {
  unsigned long long v = (unsigned long long)q;
  unsigned lo = __builtin_amdgcn_readfirstlane((unsigned)v), hi = __builtin_amdgcn_readfirstlane((unsigned)(v >> 32));
  asm volatile("" : "+s"(lo), "+s"(hi));
  return (char*)(gchar_t*)(((unsigned long long)hi << 32) | lo);
}
typedef __bf16 hbf16x2 __attribute__((ext_vector_type(2)));
typedef float hf32x2 __attribute__((ext_vector_type(2)));
DI unsigned pack2(float a, float b) { hf32x2 f = {a, b}; return __builtin_bit_cast(unsigned, __builtin_convertvector(f, hbf16x2)); }
DI unsigned f2bf(float f) { return (unsigned)__builtin_bit_cast(unsigned short, (__bf16)f); }
DI float bf2f(unsigned h) { return __uint_as_float(h << 16); }
DI float bflo(unsigned u) { return __uint_as_float(u << 16); }
DI float bfhi(unsigned u) { return __uint_as_float(u & 0xffff0000u); }
DI int crow(int i, int h) { return (i & 3) + 8 * (i >> 2) + 4 * h; }
typedef float nt_f4 __attribute__((ext_vector_type(4)));
typedef unsigned nt_u4 __attribute__((ext_vector_type(4)));
typedef unsigned nt_u2 __attribute__((ext_vector_type(2)));
DI float4 ld_nt(const float4* p) { nt_f4 v = __builtin_nontemporal_load((const nt_f4*)p); float4 r; r.x = v.x; r.y = v.y; r.z = v.z; r.w = v.w; return r; }
DI uint4 ld_nt(const uint4* p) { nt_u4 v = __builtin_nontemporal_load((const nt_u4*)p); uint4 r; r.x = v.x; r.y = v.y; r.z = v.z; r.w = v.w; return r; }
DI uint2 ld_nt(const uint2* p) { nt_u2 v = __builtin_nontemporal_load((const nt_u2*)p); uint2 r; r.x = v.x; r.y = v.y; return r; }
DI void st_nt(float4* p, const float4& a) { nt_f4 v = {a.x, a.y, a.z, a.w}; __builtin_nontemporal_store(v, (nt_f4*)p); }
DI float silu(float v) { return v / (1.f + __expf(-v)); }
DI float wave_sum(float v) { for (int o = 32; o > 0; o >>= 1) v += __shfl_xor(v, o); return v; }
DI float block_sum(float v, float* red) {
  v = wave_sum(v);
  __syncthreads();
  if ((TID & 63) == 0) red[TID >> 6] = v;
  __syncthreads();
  return red[0] + red[1] + red[2] + red[3];
}
DI bf16x8 pack8(const f32x16& x, int s) {
  union { unsigned u[4]; bf16x8 v; } p;
  p.u[0] = pack2(x[8 * s + 0], x[8 * s + 1]); p.u[1] = pack2(x[8 * s + 2], x[8 * s + 3]);
  p.u[2] = pack2(x[8 * s + 4], x[8 * s + 5]); p.u[3] = pack2(x[8 * s + 6], x[8 * s + 7]);
  return p.v;
}

DI void transpose_tile4(const float* __restrict__ W, int K, int N, int ntN, const float* __restrict__ gain, bf16_t* __restrict__ WT,
                        int id0, char* smem) {
  const int t = TID;
  float v[4][16];
#pragma unroll
  for (int q = 0; q < 4; q++) {
    const int id = id0 + q, k0 = (id / ntN) * 64, n0 = (id % ntN) * 64;
#pragma unroll
    for (int i = 0; i < 16; i++) {
      const int kk = i * 4 + (t >> 6), n = n0 + (t & 63);
      float x = (n < N) ? __builtin_nontemporal_load(&W[(size_t)(k0 + kk) * N + n]) : 0.f;
      if (gain) x *= gain[k0 + kk];
      v[q][i] = x;
    }
  }
#pragma unroll
  for (int q = 0; q < 4; q++) {
    unsigned short (*tile)[72] = (unsigned short (*)[72])(smem + q * 9216);
#pragma unroll
    for (int i = 0; i < 16; i++) tile[t & 63][i * 4 + (t >> 6)] = (unsigned short)f2bf(v[q][i]);
  }
  __syncthreads();
#pragma unroll
  for (int q = 0; q < 4; q++) {
    unsigned short (*tile)[72] = (unsigned short (*)[72])(smem + q * 9216);
    const int id = id0 + q, k0 = (id / ntN) * 64, n0 = (id % ntN) * 64;
    const int nn = t >> 2, kg = (t & 3) * 16;
    uint4 a = *(const uint4*)&tile[nn][kg];
    uint4 b = *(const uint4*)&tile[nn][kg + 8];
    bf16_t* dst = WT + (size_t)(n0 + nn) * K + k0 + kg;
    *(uint4*)dst = a; *(uint4*)(dst + 8) = b;
  }
  __syncthreads();
}

DI void phase_prep(const Params& p, char* smem, int bid, int nblk) {
  const int t = TID;
  char* ws = opaque_ptr(p.ws);
  for (int task = bid; task < 1920 + 3072; task += nblk) {
    if (task < 1920) {
      const int tile0 = task * 4;
      const float* W; const float* gain = nullptr; bf16_t* WT; int K, N, ntN, id;
      if (tile0 < 3136) { id = tile0; W = p.w_in0; K = 2048; N = 6160; ntN = 98; WT = (bf16_t*)(ws + OFF_WIN0T); }
      else if (tile0 < 4160) { id = tile0 - 3136; W = p.w_out0; K = 2048; N = 2048; ntN = 32; WT = (bf16_t*)(ws + OFF_WOUT0T); }
      else if (tile0 < 5760) { id = tile0 - 4160; W = p.w_in1; K = 2048; N = 3136; ntN = 50; WT = (bf16_t*)(ws + OFF_WIN1T); }
      else if (tile0 < 6144) { id = tile0 - 5760; W = p.w_qb; K = 512; N = 3072; ntN = 48; WT = (bf16_t*)(ws + OFF_WQBT); gain = p.g_qa; }
      else if (tile0 < 6656) { id = tile0 - 6144; W = p.w_kvb; K = 512; N = 4096; ntN = 64; WT = (bf16_t*)(ws + OFF_WKVBT); gain = p.g_kva; }
      else { id = tile0 - 6656; W = p.w_out1; K = 2048; N = 2048; ntN = 32; WT = (bf16_t*)(ws + OFF_WOUT1T); }
      transpose_tile4(W, K, N, ntN, gain, WT, id, smem);
    } else if (task < 1920 + 2048) {
      const int lane = t & 63, row = (task - 1920) * 4 + (t >> 6);
      const float4* xr = (const float4*)(p.x + (size_t)row * 2048) + lane;
      const float4* gr = (const float4*)p.l0_pre + lane;
      float4 xv[8];
#pragma unroll
      for (int j = 0; j < 8; j++) xv[j] = ld_nt(xr + j * 64);
      float ss = 0.f;
#pragma unroll
      for (int j = 0; j < 8; j++) ss += xv[j].x * xv[j].x + xv[j].y * xv[j].y + xv[j].z * xv[j].z + xv[j].w * xv[j].w;
      ss = wave_sum(ss);
      const float rinv = rsqrtf(ss * (1.f / 2048.f) + 1e-6f);
      uint2* hr = (uint2*)(ws + OFF_H + (size_t)row * 4096) + lane;
#pragma unroll
      for (int j = 0; j < 8; j++) {
        const float4 g = gr[j * 64];
        uint2 o; o.x = pack2(xv[j].x * rinv * g.x, xv[j].y * rinv * g.y); o.y = pack2(xv[j].z * rinv * g.z, xv[j].w * rinv * g.w);
        hr[j * 64] = o;
      }
    } else {
      const int idx = (task - 3968) * 256 + t;
      const int token = idx >> 5, i = idx & 31;
      double ang = (double)p.pos[token] * (double)p.invf[i];
      double tt = ang * 0.15915494309189535;
      tt -= floor(tt + 0.5);
      float f = (float)tt;
      float* cs = (float*)(ws + OFF_CS);
      cs[token * 64 + i] = __builtin_amdgcn_cosf(f);
      cs[token * 64 + 32 + i] = __builtin_amdgcn_sinf(f);
    }
  }
}

DI float sq8(const uint4& v) {
  return bflo(v.x) * bflo(v.x) + bfhi(v.x) * bfhi(v.x) + bflo(v.y) * bflo(v.y) + bfhi(v.y) * bfhi(v.y) + bflo(v.z) * bflo(v.z) + bfhi(v.z) * bfhi(v.z) +
         bflo(v.w) * bflo(v.w) + bfhi(v.w) * bfhi(v.w);
}
template <bool SWAP, bool SUMSQ = false>
DI void gemm_main(f32x16 (&acc)[4][2], const bf16_t* A, int lda, const bf16_t* B, int ldb, int K,
                  int m0, int n0, char* smem) {
  const int t = TID, lane = t & 63, w = t >> 6, wm = w >> 1, wn = w & 1, r = lane & 31, h = lane >> 5;
#pragma unroll
  for (int a = 0; a < 4; a++)
#pragma unroll
    for (int b = 0; b < 2; b++)
#pragma unroll
      for (int i = 0; i < 16; i++) acc[a][b][i] = 0.f;
  const int lrow = t >> 2, kc = t & 3;
  const bf16_t* ag = A + (size_t)(m0 + lrow) * lda + kc * 8;
  const bf16_t* bg = B + (size_t)(n0 + lrow) * ldb + kc * 8;
  const int lds_w = lrow * 64 + ((kc ^ ((lrow >> 2) & 3)) << 4);
  uint4 pa0, pa1, pa2, pa3, pb0, pb1;
  bf16x8 fa0, fa1, fa2, fa3, fa4, fa5, fb0, fb1, fb2, fb3, fb4, fb5;
#define G_LOAD(X, ko_)                                                                                   \
  X##a0 = *(const uint4*)(ag + (ko_)); X##a1 = *(const uint4*)(ag + (size_t)64 * lda + (ko_));           \
  X##a2 = *(const uint4*)(ag + (size_t)128 * lda + (ko_)); X##a3 = *(const uint4*)(ag + (size_t)192 * lda + (ko_)); \
  X##b0 = *(const uint4*)(bg + (ko_)); X##b1 = *(const uint4*)(bg + (size_t)64 * ldb + (ko_));
#define L_STORE(X, base_)                                                                                \
  *(uint4*)((base_) + lds_w) = X##a0; *(uint4*)((base_) + lds_w + 4096) = X##a1;                         \
  *(uint4*)((base_) + lds_w + 8192) = X##a2; *(uint4*)((base_) + lds_w + 12288) = X##a3;                 \
  *(uint4*)((base_) + 16384 + lds_w) = X##b0; *(uint4*)((base_) + 16384 + lds_w + 4096) = X##b1;         \
  if (SUMSQ) { q0 += sq8(X##a0); q1 += sq8(X##a1); q2 += sq8(X##a2); q3 += sq8(X##a3); }
#define G_READ(F, base_, c_)                                                                             \
  F##0 = *(const bf16x8*)((base_) + a_off + (c_)); F##1 = *(const bf16x8*)((base_) + a_off + 32 * 64 + (c_));              \
  F##2 = *(const bf16x8*)((base_) + a_off + 64 * 64 + (c_)); F##3 = *(const bf16x8*)((base_) + a_off + 96 * 64 + (c_));    \
  F##4 = *(const bf16x8*)((base_) + b_off + (c_)); F##5 = *(const bf16x8*)((base_) + b_off + 32 * 64 + (c_));
#define G_MMA(a0, a1, a2, a3, b0, b1)                                                                    \
    if (SWAP) {                                                                                          \
      acc[0][0] = MFMA32(b0, a0, acc[0][0]); acc[0][1] = MFMA32(b1, a0, acc[0][1]);                      \
      acc[1][0] = MFMA32(b0, a1, acc[1][0]); acc[1][1] = MFMA32(b1, a1, acc[1][1]);                      \
      acc[2][0] = MFMA32(b0, a2, acc[2][0]); acc[2][1] = MFMA32(b1, a2, acc[2][1]);                      \
      acc[3][0] = MFMA32(b0, a3, acc[3][0]); acc[3][1] = MFMA32(b1, a3, acc[3][1]);                      \
    } else {                                                                                             \
      acc[0][0] = MFMA32(a0, b0, acc[0][0]); acc[0][1] = MFMA32(a0, b1, acc[0][1]);                      \
      acc[1][0] = MFMA32(a1, b0, acc[1][0]); acc[1][1] = MFMA32(a1, b1, acc[1][1]);                      \
      acc[2][0] = MFMA32(a2, b0, acc[2][0]); acc[2][1] = MFMA32(a2, b1, acc[2][1]);                      \
      acc[3][0] = MFMA32(a3, b0, acc[3][0]); acc[3][1] = MFMA32(a3, b1, acc[3][1]);                      \
    }
#define G_MMA6(F) G_MMA(F##0, F##1, F##2, F##3, F##4, F##5)
  float q0 = 0.f, q1 = 0.f, q2 = 0.f, q3 = 0.f;
  const int sw = (r >> 2) & 3;
  const int a_off = (wm * 128 + r) * 64, b_off = 16384 + (wn * 64 + r) * 64;
  const int c0 = (h ^ sw) << 4, c1 = ((2 + h) ^ sw) << 4;
  const int nk = K >> 5;
  G_LOAD(p, 0)
  L_STORE(p, smem)
  G_LOAD(p, 32)
  __syncthreads();
  G_READ(fa, smem, c0)
  G_READ(fb, smem, c1)
  G_MMA6(fa)
  asm volatile("" ::: "memory");
  __builtin_amdgcn_sched_barrier(0);
  L_STORE(p, smem + 24576)
  {
    const int kn = ((2 < nk) ? 2 : (nk - 1)) * 32;
    G_LOAD(p, kn)
  }
  __syncthreads();
  for (int kt = 0; kt < nk - 1; kt++) {
    const char* nb = smem + ((kt + 1) & 1) * 24576;
    G_READ(fa, nb, c0)
    G_MMA6(fb)
    G_READ(fb, nb, c1)
    G_MMA6(fa)
    __builtin_amdgcn_sched_group_barrier(0x100, 6, 0);
    __builtin_amdgcn_sched_group_barrier(0x008, 8, 0);
    __builtin_amdgcn_sched_group_barrier(0x100, 6, 0);
    __builtin_amdgcn_sched_group_barrier(0x008, 8, 0);
    asm volatile("" ::: "memory");
    __builtin_amdgcn_sched_barrier(0);
    if (kt + 2 < nk) {
      L_STORE(p, smem + (kt & 1) * 24576)
    }
    {
      const int kn = ((kt + 3 < nk) ? (kt + 3) : (nk - 1)) * 32;
      G_LOAD(p, kn)
    }
    __syncthreads();
  }
  G_MMA6(fb)
#undef G_LOAD
#undef L_STORE
#undef G_READ
#undef G_MMA
#undef G_MMA6
  if (SUMSQ) {
    q0 += __shfl_xor(q0, 1); q1 += __shfl_xor(q1, 1); q2 += __shfl_xor(q2, 1); q3 += __shfl_xor(q3, 1);
    q0 += __shfl_xor(q0, 2); q1 += __shfl_xor(q1, 2); q2 += __shfl_xor(q2, 2); q3 += __shfl_xor(q3, 2);
    if (kc == 0) {
      float* rf = (float*)(smem + 49152);
      const float ik = 1.f / (float)K;
      rf[lrow] = rsqrtf(q0 * ik + 1e-6f); rf[lrow + 64] = rsqrtf(q1 * ik + 1e-6f);
      rf[lrow + 128] = rsqrtf(q2 * ik + 1e-6f); rf[lrow + 192] = rsqrtf(q3 * ik + 1e-6f);
    }
    __syncthreads();
  }
}

#define EPI_LOOP_BEGIN                                                                                           \
  {                                                                                                              \
    const int lane_ = TID & 63, w_ = TID >> 6, wm_ = w_ >> 1, wn_ = w_ & 1, r_ = lane_ & 31, h_ = lane_ >> 5; \
    _Pragma("unroll") for (int mt = 0; mt < 4; mt++) _Pragma("unroll") for (int nt = 0; nt < 2; nt++)          \
        _Pragma("unroll") for (int i = 0; i < 16; i++) {                                                         \
      const float v = acc[mt][nt][i];
#define EPI_COORD_NS const int row = m0 + wm_ * 128 + mt * 32 + crow(i, h_); const int col = n0 + wn_ * 64 + nt * 32 + r_;
#define EPI_COORD_SW const int row = m0 + wm_ * 128 + mt * 32 + r_; const int col = n0 + wn_ * 64 + nt * 32 + crow(i, h_);
#define EPI_LOOP_END }}

DI void phase_gemm_in0(const Params& p, char* smem, int bid, int nblk) {
  char* ws = opaque_ptr(p.ws);
  const bf16_t* A = (const bf16_t*)(ws + OFF_H);
  const bf16_t* B = (const bf16_t*)(ws + OFF_WIN0T);
  bf16_t* QK = (bf16_t*)(ws + OFF_QK0);
  bf16_t* V0T = (bf16_t*)(ws + OFF_V0T);
  bf16_t* G0 = (bf16_t*)(ws + OFF_G0);
  float* GKL = (float*)(ws + OFF_GKLOW);
  for (int tile = bid; tile < 32 * 48; tile += nblk) {
    const int mi = tile & 31, ni = tile >> 5;
    const int m0 = mi * 256, n0 = ni * 128;
    f32x16 acc[4][2];
    if (ni >= 16) {
      if (ni < 32) {
        gemm_main<true>(acc, A, 2048, B, 2048, 2048, m0, n0, smem);
        EPI_LOOP_BEGIN EPI_COORD_SW
          V0T[(size_t)(col - 2048) * S_ + row] = (bf16_t)f2bf(v);
        EPI_LOOP_END
      } else {
        gemm_main<false>(acc, A, 2048, B, 2048, 2048, m0, n0, smem);
        EPI_LOOP_BEGIN EPI_COORD_NS
          G0[(size_t)row * 2048 + (col - 4096)] = (bf16_t)f2bf(silu(v));
        EPI_LOOP_END
      }
    } else {
      gemm_main<false>(acc, A, 2048, B, 2048, 2048, m0, n0, smem);
      EPI_LOOP_BEGIN EPI_COORD_NS
        QK[(size_t)row * 2048 + col] = (bf16_t)f2bf(v);
      EPI_LOOP_END
    }
  }
  {
    typedef __attribute__((ext_vector_type(4))) float f32x4_t;
    const int t = TID, lane = t & 63, w = t >> 6, l15 = lane & 15, quad = lane >> 4;
    float* red = (float*)smem;
    for (int item = bid; item < 512; item += nblk) {
      const bf16_t* ap = A + (size_t)(item * 16 + l15) * 2048 + 512 * w + 8 * quad;
      const bf16_t* bp = B + (size_t)(6144 + l15) * 2048 + 512 * w + 8 * quad;
      f32x4_t c = {0.f, 0.f, 0.f, 0.f};
#pragma unroll
      for (int s = 0; s < 16; s++) {
        const bf16x8 a = *(const bf16x8*)(ap + 32 * s);
        const bf16x8 b = *(const bf16x8*)(bp + 32 * s);
        c = __builtin_amdgcn_mfma_f32_16x16x32_bf16(a, b, c, 0, 0, 0);
      }
      __syncthreads();
#pragma unroll
      for (int j = 0; j < 4; j++) red[(w * 16 + quad * 4 + j) * 16 + l15] = c[j];
      __syncthreads();
      const float v = red[t] + red[256 + t] + red[512 + t] + red[768 + t];
      GKL[(size_t)item * 256 + t] = v;
    }
  }
}

DI void phase_gla_prep(const Params& p, char* smem, int bid, int nblk) {
  char* ws = opaque_ptr(p.ws);
  const int t = TID, lane = t & 63, w = t >> 6, r = lane & 31, h = lane >> 5;
  const bf16_t* QK = (const bf16_t*)(ws + OFF_QK0);
  const float* GKL = (const float*)(ws + OFF_GKLOW);
  bf16_t* QE = (bf16_t*)(ws + OFF_QE);
  bf16_t* KLT = (bf16_t*)(ws + OFF_KLT);
  bf16_t* AM = (bf16_t*)(ws + OFF_AM);
  float* DEC = (float*)(ws + OFF_DECAY);
  if (bid == 0 && t == 0) { ((int*)(ws + OFF_CTR))[0] = 0; ((int*)(ws + OFF_CTR))[1] = 0; }
  char* lq = smem;
  char* lk = smem + 32768;
  for (int tile = bid; tile < 512; tile += nblk) {
    const int n = tile >> 2, head = tile & 3, t0 = n * 64, d = t, col = head * 256 + d;
    float w2[16];
#pragma unroll
    for (int j = 0; j < 16; j++) w2[j] = p.w_gk2[j * 1024 + col];
    const float bias = p.b_gk[col];
    float b = 0.f;
    const int dperm = (d & ~15) | ((d & 3) | ((d & 4) << 1) | ((d & 8) >> 1));
    for (int c8 = 0; c8 < 8; c8++) {
      float bj[8], qv[8], kv[8];
#pragma unroll
      for (int j = 0; j < 8; j++) {
        const int c = c8 * 8 + j;
        const float4* gl = (const float4*)(GKL + (size_t)(t0 + c) * 16);
        float4 g0 = gl[0], g1 = gl[1], g2 = gl[2], g3 = gl[3];
        float gk = bias + g0.x * w2[0] + g0.y * w2[1] + g0.z * w2[2] + g0.w * w2[3] + g1.x * w2[4] + g1.y * w2[5] + g1.z * w2[6] + g1.w * w2[7]
                 + g2.x * w2[8] + g2.y * w2[9] + g2.z * w2[10] + g2.w * w2[11] + g3.x * w2[12] + g3.y * w2[13] + g3.z * w2[14] + g3.w * w2[15];
        float la = (fminf(gk, 0.f) - __logf(1.f + __expf(-fabsf(gk)))) * (1.f / 16.f);
        b += la;
        bj[j] = b;
        qv[j] = bf2f(QK[(size_t)(t0 + c) * 2048 + col]);
        kv[j] = bf2f(QK[(size_t)(t0 + c) * 2048 + 1024 + col]);
      }
      unsigned klp[4];
#pragma unroll
      for (int j = 0; j < 8; j++) {
        const int c = c8 * 8 + j;
        const float qe = qv[j] * 0.0625f * __expf(bj[j]);
        const float ke = kv[j] * __expf(-bj[j]);
        const unsigned qeb = f2bf(qe), keb = f2bf(ke), klb = keb;
        const int lo = c * 512 + ((((d >> 3) ^ (c & 15))) << 4) + (d & 7) * 2;
        *(unsigned short*)(lq + lo) = (unsigned short)qeb;
        *(unsigned short*)(lk + lo) = (unsigned short)keb;
        QE[(size_t)(t0 + c) * 1024 + head * 256 + dperm] = (bf16_t)qeb;
        if (j & 1) klp[j >> 1] |= klb << 16; else klp[j >> 1] = klb;
      }
      uint4 o; o.x = klp[0]; o.y = klp[1]; o.z = klp[2]; o.w = klp[3];
      *(uint4*)(KLT + (size_t)(head * 256 + d) * S_ + t0 + c8 * 8) = o;
    }
    DEC[(size_t)(n * 4 + head) * 256 + d] = __expf(b);
    __syncthreads();
    {
      const int ct = w >> 1, st = w & 1;
      f32x16 acc;
#pragma unroll
      for (int i = 0; i < 16; i++) acc[i] = 0.f;
      if (!(ct == 0 && st == 1)) {
        const int ra = ct * 32 + r, rb = st * 32 + r;
#pragma unroll
        for (int s = 0; s < 16; s++) {
          bf16x8 a = *(const bf16x8*)(lq + ra * 512 + (((2 * s + h) ^ (ra & 15)) << 4));
          bf16x8 bb = *(const bf16x8*)(lk + rb * 512 + (((2 * s + h) ^ (rb & 15)) << 4));
          acc = MFMA32(a, bb, acc);
        }
      }
      bf16_t* ap = AM + (size_t)(n * 4 + head) * 4096;
#pragma unroll
      for (int i = 0; i < 16; i++) {
        const int c = ct * 32 + crow(i, h), s = st * 32 + r;
        ap[c * 64 + s] = (bf16_t)f2bf(s <= c ? acc[i] : 0.f);
      }
    }
    __syncthreads();
  }
}

constexpr int SCAN_NG = 8, SCAN_GC = 16;
DI void phase_gla_local(const Params& p, char* smem, int bid, int nblk) {
  char* ws = opaque_ptr(p.ws);
  const int t = TID, lane = t & 63, w = t >> 6, r = lane & 31, h = lane >> 5;
  for (int item = bid; item < 64 * (SCAN_NG - 1); item += nblk) {
    const int grp = item >> 6, head = (item >> 4) & 3, dvt = item & 15, dv0 = dvt * 32;
    const int nb = grp * SCAN_GC;
    const bf16_t* v_p = (const bf16_t*)(ws + OFF_V0T) + (size_t)(head * 512 + dv0 + r) * S_ + nb * 64 + 8 * h;
    const bf16_t* kl_p = (const bf16_t*)(ws + OFF_KLT) + (size_t)(head * 256 + 64 * w + r) * S_ + nb * 64 + 8 * h;
    const float* dec_p = (const float*)(ws + OFF_DECAY) + (size_t)nb * 1024 + head * 256 + 64 * w + 4 * h;
    f32x16 St[2];
#pragma unroll
    for (int i = 0; i < 16; i++) { St[0][i] = 0.f; St[1][i] = 0.f; }
    bf16x8 klA[2][4], vfA[4], klB[2][4], vfB[4];
    float4 dcA[2][4], dcB[2][4];
#define LOC_LOAD(KL, VF, DC, n_)                                                                                 \
    {                                                                                                            \
      _Pragma("unroll") for (int s = 0; s < 4; s++) VF[s] = *(const bf16x8*)(v_p + (n_) * 64 + 16 * s);        \
      _Pragma("unroll") for (int dt = 0; dt < 2; dt++) {                                                         \
        _Pragma("unroll") for (int s = 0; s < 4; s++) KL[dt][s] = *(const bf16x8*)(kl_p + (size_t)dt * 32 * S_ + (n_) * 64 + 16 * s); \
        _Pragma("unroll") for (int g4 = 0; g4 < 4; g4++) DC[dt][g4] = *(const float4*)(dec_p + (size_t)(n_) * 1024 + dt * 32 + 8 * g4); \
      }                                                                                                          \
    }
#define LOC_STEP(KL, VF, DC)                                                                                     \
    {                                                                                                            \
      _Pragma("unroll") for (int dt = 0; dt < 2; dt++) {                                                         \
        _Pragma("unroll") for (int s = 0; s < 4; s++) St[dt] = MFMA32(KL[dt][s], VF[s], St[dt]);                 \
        _Pragma("unroll") for (int g4 = 0; g4 < 4; g4++) {                                                       \
          St[dt][4 * g4 + 0] *= DC[dt][g4].x; St[dt][4 * g4 + 1] *= DC[dt][g4].y;                                \
          St[dt][4 * g4 + 2] *= DC[dt][g4].z; St[dt][4 * g4 + 3] *= DC[dt][g4].w;                                \
        }                                                                                                        \
      }                                                                                                          \
    }
    LOC_LOAD(klA, vfA, dcA, 0)
    for (int n = 0; n < SCAN_GC; n += 2) {
      LOC_LOAD(klB, vfB, dcB, n + 1)
      LOC_STEP(klA, vfA, dcA)
      if (n + 2 < SCAN_GC) LOC_LOAD(klA, vfA, dcA, n + 2)
      LOC_STEP(klB, vfB, dcB)
    }
#undef LOC_LOAD
#undef LOC_STEP
    float* sl = (float*)(ws + OFF_SL) + ((size_t)((grp * 4 + head) * 16 + dvt) * 4 + w) * 2048 + lane;
#pragma unroll
    for (int dt = 0; dt < 2; dt++)
#pragma unroll
      for (int i = 0; i < 16; i++) sl[(dt * 16 + i) * 64] = St[dt][i];
    if (dvt == 0) {
      const float* dg = (const float*)(ws + OFF_DECAY) + (size_t)nb * 1024 + head * 256 + t;
      float pr = 1.f;
#pragma unroll 4
      for (int n = 0; n < SCAN_GC; n++) pr *= dg[(size_t)n * 1024];
      ((float*)(ws + OFF_DC))[(grp * 4 + head) * 256 + t] = pr;
    }
  }
}

DI void phase_gla_scan(const Params& p, char* smem, int bid, int nblk) {
  char* ws = opaque_ptr(p.ws);
  const int t = TID, lane = t & 63, w = t >> 6, r = lane & 31, h = lane >> 5;
  float* lo = (float*)smem;
  for (int item = bid; item < 64 * SCAN_NG; item += nblk) {
    const int grp = item >> 6, head = (item >> 4) & 3, dvt = item & 15, dv0 = dvt * 32;
    const int nb = grp * SCAN_GC, ne = nb + SCAN_GC;
    const bf16_t* qe_p = (const bf16_t*)(ws + OFF_QE) + (size_t)r * 1024 + head * 256 + 64 * w + 8 * h;
    const bf16_t* a_p = (const bf16_t*)(ws + OFF_AM) + (size_t)head * 4096 + (size_t)r * 64 + 16 * w + 8 * h;
    const bf16_t* v_p = (const bf16_t*)(ws + OFF_V0T) + (size_t)(head * 512 + dv0 + r) * S_ + 8 * h;
    const bf16_t* kl_p = (const bf16_t*)(ws + OFF_KLT) + (size_t)(head * 256 + 64 * w + r) * S_ + 8 * h;
    bf16_t* o_p = (bf16_t*)(ws + OFF_QK0) + (size_t)(t >> 2) * 2048 + head * 512 + dv0 + (t & 3) * 8;
    f32x16 St[2];
#pragma unroll
    for (int i = 0; i < 16; i++) { St[0][i] = 0.f; St[1][i] = 0.f; }
    for (int j = 0; j < grp; j++) {
      const float* slj = (const float*)(ws + OFF_SL) + ((size_t)((j * 4 + head) * 16 + dvt) * 4 + w) * 2048 + lane;
      const float* dcj = (const float*)(ws + OFF_DC) + (j * 4 + head) * 256 + 64 * w + 4 * h;
#pragma unroll
      for (int dt = 0; dt < 2; dt++)
#pragma unroll
        for (int g4 = 0; g4 < 4; g4++) {
          const float4 dv = *(const float4*)(dcj + 32 * dt + 8 * g4);
          St[dt][4 * g4 + 0] = St[dt][4 * g4 + 0] * dv.x + slj[(dt * 16 + 4 * g4 + 0) * 64];
          St[dt][4 * g4 + 1] = St[dt][4 * g4 + 1] * dv.y + slj[(dt * 16 + 4 * g4 + 1) * 64];
          St[dt][4 * g4 + 2] = St[dt][4 * g4 + 2] * dv.z + slj[(dt * 16 + 4 * g4 + 2) * 64];
          St[dt][4 * g4 + 3] = St[dt][4 * g4 + 3] * dv.w + slj[(dt * 16 + 4 * g4 + 3) * 64];
        }
    }
    qe_p += (size_t)nb * 64 * 1024; a_p += (size_t)nb * 4 * 4096; v_p += nb * 64; kl_p += nb * 64; o_p += (size_t)nb * 64 * 2048;
    bf16x8 qe[2][4], af[2], vf[4], kl[2][4];
    float* ldec = (float*)(smem + 32768);
    const float* dec_g = (const float*)(ws + OFF_DECAY) + (size_t)nb * 1024 + head * 256 + t;
#pragma unroll
    for (int ct = 0; ct < 2; ct++) {
#pragma unroll
      for (int s = 0; s < 4; s++) qe[ct][s] = *(const bf16x8*)(qe_p + (size_t)ct * 32 * 1024 + 16 * s);
      af[ct] = *(const bf16x8*)(a_p + ct * 32 * 64);
    }
#pragma unroll
    for (int s = 0; s < 4; s++) vf[s] = *(const bf16x8*)(v_p + 16 * s);
#pragma unroll
    for (int dt = 0; dt < 2; dt++) {
#pragma unroll
      for (int s = 0; s < 4; s++) kl[dt][s] = *(const bf16x8*)(kl_p + (size_t)dt * 32 * S_ + 16 * s);
    }
    __syncthreads();
    ldec[t] = dec_g[0];
    __syncthreads();
    for (int n = 0; n < SCAN_GC; n++) {
      const bool more = (n + 1 < SCAN_GC);
      float decn = 0.f;
      if (more) decn = dec_g[(size_t)(n + 1) * 1024];
      f32x16 o[2];
#pragma unroll
      for (int i = 0; i < 16; i++) { o[0][i] = 0.f; o[1][i] = 0.f; }
#pragma unroll
      for (int s = 0; s < 4; s++) {
        bf16x8 sb = pack8(St[s >> 1], s & 1);
        o[0] = MFMA32(qe[0][s], sb, o[0]);
        o[1] = MFMA32(qe[1][s], sb, o[1]);
      }
      if (more) {
        const bf16_t* q2 = qe_p + (size_t)(n + 1) * 64 * 1024;
#pragma unroll
        for (int ct = 0; ct < 2; ct++)
#pragma unroll
          for (int s = 0; s < 4; s++) qe[ct][s] = *(const bf16x8*)(q2 + (size_t)ct * 32 * 1024 + 16 * s);
      }
      {
        bf16x8 vw = (w == 0) ? vf[0] : (w == 1) ? vf[1] : (w == 2) ? vf[2] : vf[3];
        o[0] = MFMA32(af[0], vw, o[0]);
        o[1] = MFMA32(af[1], vw, o[1]);
      }
      if (more) {
        const bf16_t* a2 = a_p + (size_t)(n + 1) * 4 * 4096;
        af[0] = *(const bf16x8*)(a2); af[1] = *(const bf16x8*)(a2 + 32 * 64);
      }
#pragma unroll
      for (int dt = 0; dt < 2; dt++) {
#pragma unroll
        for (int s = 0; s < 4; s++) St[dt] = MFMA32(kl[dt][s], vf[s], St[dt]);
#pragma unroll
        for (int g = 0; g < 4; g++) {
          const float4 dv = *(const float4*)(ldec + (n & 1) * 256 + 64 * w + 32 * dt + 8 * g + 4 * h);
          St[dt][4 * g + 0] *= dv.x; St[dt][4 * g + 1] *= dv.y;
          St[dt][4 * g + 2] *= dv.z; St[dt][4 * g + 3] *= dv.w;
        }
      }
      if (more) {
        const int tn = (n + 1) * 64;
#pragma unroll
        for (int s = 0; s < 4; s++) vf[s] = *(const bf16x8*)(v_p + tn + 16 * s);
#pragma unroll
        for (int dt = 0; dt < 2; dt++) {
#pragma unroll
          for (int s = 0; s < 4; s++) kl[dt][s] = *(const bf16x8*)(kl_p + (size_t)dt * 32 * S_ + tn + 16 * s);
        }
      }
      ldec[((n + 1) & 1) * 256 + t] = decn;
#pragma unroll
      for (int ct = 0; ct < 2; ct++)
#pragma unroll
        for (int i = 0; i < 16; i++) lo[(w * 64 + ct * 32 + crow(i, h)) * 32 + r] = o[ct][i];
      __syncthreads();
      {
        const int c = t >> 2, vg = (t & 3) * 8;
        float4 s0 = *(const float4*)(lo + c * 32 + vg), s1 = *(const float4*)(lo + c * 32 + vg + 4);
#pragma unroll
        for (int ww = 1; ww < 4; ww++) {
          float4 x0 = *(const float4*)(lo + (ww * 64 + c) * 32 + vg), x1 = *(const float4*)(lo + (ww * 64 + c) * 32 + vg + 4);
          s0.x += x0.x; s0.y += x0.y; s0.z += x0.z; s0.w += x0.w; s1.x += x1.x; s1.y += x1.y; s1.z += x1.z; s1.w += x1.w;
        }
        uint4 ov; ov.x = pack2(s0.x, s0.y); ov.y = pack2(s0.z, s0.w); ov.z = pack2(s1.x, s1.y); ov.w = pack2(s1.z, s1.w);
        *(uint4*)(o_p + (size_t)n * 64 * 2048) = ov;
      }
      __syncthreads();
    }
  }
}

DI void phase_og(const Params& p, char* smem, int bid, int nblk) {
  char* ws = opaque_ptr(p.ws);
  const int t = TID, lane = t & 63, w = t >> 6;
  const bf16_t* O0 = (const bf16_t*)(ws + OFF_QK0);
  const bf16_t* G0 = (const bf16_t*)(ws + OFF_G0);
  bf16_t* OG = (bf16_t*)(ws + OFF_H);
  const float4* gp = (const float4*)(p.g_onorm + lane * 8);
  const float4 ga = gp[0], gb = gp[1];
  for (int token = bid; token < S_; token += 4 * nblk) {
    uint4 ov[4], gv[4];
#pragma unroll
    for (int u = 0; u < 4; u++) {
      const int tk = token + u * nblk;
      const size_t off = (size_t)(tk < S_ ? tk : token) * 2048 + w * 512 + lane * 8;
      ov[u] = ld_nt((const uint4*)(O0 + off));
      gv[u] = ld_nt((const uint4*)(G0 + off));
    }
#pragma unroll
    for (int u = 0; u < 4; u++) {
      const int tk = token + u * nblk;
      const size_t off = (size_t)tk * 2048 + w * 512 + lane * 8;
      const float f0 = bflo(ov[u].x), f1 = bfhi(ov[u].x), f2 = bflo(ov[u].y), f3 = bfhi(ov[u].y);
      const float f4 = bflo(ov[u].z), f5 = bfhi(ov[u].z), f6 = bflo(ov[u].w), f7 = bfhi(ov[u].w);
      float ss = f0 * f0 + f1 * f1 + f2 * f2 + f3 * f3 + f4 * f4 + f5 * f5 + f6 * f6 + f7 * f7;
      ss = wave_sum(ss);
      const float rinv = rsqrtf(ss * (1.f / 512.f) + 1e-6f);
      uint4 o;
      o.x = pack2(f0 * rinv * ga.x * bflo(gv[u].x), f1 * rinv * ga.y * bfhi(gv[u].x));
      o.y = pack2(f2 * rinv * ga.z * bflo(gv[u].y), f3 * rinv * ga.w * bfhi(gv[u].y));
      o.z = pack2(f4 * rinv * gb.x * bflo(gv[u].z), f5 * rinv * gb.y * bfhi(gv[u].z));
      o.w = pack2(f6 * rinv * gb.z * bflo(gv[u].w), f7 * rinv * gb.w * bfhi(gv[u].w));
      if (tk < S_) *(uint4*)(OG + off) = o;
    }
  }
}

DI void phase_gemm_out(const Params& p, char* smem, int bid, int nblk, size_t off_w) {
  char* ws = opaque_ptr(p.ws);
  const bf16_t* A = (const bf16_t*)(ws + OFF_H);
  const bf16_t* B = (const bf16_t*)(ws + off_w);
  bf16_t* Y = (bf16_t*)(ws + OFF_Y);
  for (int tile = bid; tile < 32 * 16; tile += nblk) {
    const int mi = tile & 31, ni = tile >> 5;
    const int m0 = mi * 256, n0 = ni * 128;
    f32x16 acc[4][2];
    gemm_main<false>(acc, A, 2048, B, 2048, 2048, m0, n0, smem);
    EPI_LOOP_BEGIN EPI_COORD_NS
      Y[(size_t)row * 2048 + col] = (bf16_t)f2bf(v);
    EPI_LOOP_END
  }
}

DI void phase_post0(const Params& p, char* smem, int bid, int nblk) {
  char* ws = opaque_ptr(p.ws);
  const int t = TID, lane = t & 63, w = t >> 6;
  const bf16_t* Y = (const bf16_t*)(ws + OFF_Y);
  const float4* gpo = (const float4*)p.l0_post + lane;
  const float4* gpr = (const float4*)p.l1_pre + lane;
  for (int row = bid * 4 + w; row < S_; row += nblk * 4) {
    const uint2* yr = (const uint2*)(Y + (size_t)row * 2048) + lane;
    const float4* xr = (const float4*)(p.x + (size_t)row * 2048) + lane;
    float4 yv[8], xv[8];
#pragma unroll
    for (int j = 0; j < 8; j++) { const uint2 u = ld_nt(yr + j * 64); yv[j].x = bflo(u.x); yv[j].y = bfhi(u.x); yv[j].z = bflo(u.y); yv[j].w = bfhi(u.y); xv[j] = ld_nt(xr + j * 64); }
    float ss = 0.f;
#pragma unroll
    for (int j = 0; j < 8; j++) ss += yv[j].x * yv[j].x + yv[j].y * yv[j].y + yv[j].z * yv[j].z + yv[j].w * yv[j].w;
    ss = wave_sum(ss);
    const float rinv = rsqrtf(ss * (1.f / 2048.f) + 1e-6f);
    float4* outr = (float4*)(p.out + (size_t)row * 2048) + lane;
    float s2 = 0.f;
#pragma unroll
    for (int j = 0; j < 8; j++) {
      const float4 g = gpo[j * 64];
      xv[j].x += yv[j].x * rinv * g.x; xv[j].y += yv[j].y * rinv * g.y; xv[j].z += yv[j].z * rinv * g.z; xv[j].w += yv[j].w * rinv * g.w;
      outr[j * 64] = xv[j];
      s2 += xv[j].x * xv[j].x + xv[j].y * xv[j].y + xv[j].z * xv[j].z + xv[j].w * xv[j].w;
    }
    s2 = wave_sum(s2);
    const float r2 = rsqrtf(s2 * (1.f / 2048.f) + 1e-6f);
    uint2* hr = (uint2*)(ws + OFF_H + (size_t)row * 4096) + lane;
#pragma unroll
    for (int j = 0; j < 8; j++) {
      const float4 g = gpr[j * 64];
      uint2 o; o.x = pack2(xv[j].x * r2 * g.x, xv[j].y * r2 * g.y); o.y = pack2(xv[j].z * r2 * g.z, xv[j].w * r2 * g.w);
      hr[j * 64] = o;
    }
  }
}

DI void phase_gemm_in1(const Params& p, char* smem, int bid, int nblk) {
  char* ws = opaque_ptr(p.ws);
  const bf16_t* A = (const bf16_t*)(ws + OFF_H);
  const bf16_t* B = (const bf16_t*)(ws + OFF_WIN1T);
  bf16_t* CQ = (bf16_t*)(ws + OFF_CQ);
  bf16_t* CKV = (bf16_t*)(ws + OFF_CKV);
  bf16_t* KR = (bf16_t*)(ws + OFF_KR);
  const float* cs = (const float*)(ws + OFF_CS);
  bf16_t* G1 = (bf16_t*)(ws + OFF_QK0);
  for (int tile = bid; tile < 32 * 25; tile += nblk) {
    const int mi = tile & 31, ni = tile >> 5;
    const int m0 = mi * 256, n0 = ni * 128;
    f32x16 acc[4][2];
    gemm_main<false>(acc, A, 2048, B, 2048, 2048, m0, n0, smem);
    if (ni < 4) {
      EPI_LOOP_BEGIN EPI_COORD_NS
        CQ[(size_t)row * 512 + col] = (bf16_t)f2bf(v);
      EPI_LOOP_END
    } else if (ni < 8) {
      EPI_LOOP_BEGIN EPI_COORD_NS
        CKV[(size_t)row * 512 + (col - 512)] = (bf16_t)f2bf(v);
      EPI_LOOP_END
    } else if (ni == 8 && ((TID >> 6) & 1) == 0) {
      const int lane_ = TID & 63, w_ = TID >> 6, wm_ = w_ >> 1, r_ = lane_ & 31, h_ = lane_ >> 5;
#pragma unroll
      for (int mt = 0; mt < 4; mt++)
#pragma unroll
        for (int i = 0; i < 16; i++) {
          const int row = m0 + wm_ * 128 + mt * 32 + crow(i, h_);
          const float t1 = acc[mt][0][i], t2 = acc[mt][1][i];
          const float c = cs[row * 64 + r_], sn = cs[row * 64 + 32 + r_];
          KR[(size_t)row * 64 + r_] = (bf16_t)f2bf(t1 * c - t2 * sn);
          KR[(size_t)row * 64 + 32 + r_] = (bf16_t)f2bf(t2 * c + t1 * sn);
        }
    } else {
      EPI_LOOP_BEGIN EPI_COORD_NS
        if (col < 3136) G1[(size_t)row * 2048 + (col - 1088)] = (bf16_t)f2bf(silu(v));
      EPI_LOOP_END
    }
  }
}

DI void phase_gemm_qkv(const Params& p, char* smem, int bid, int nblk) {
  char* ws = opaque_ptr(p.ws);
  const bf16_t* CQ = (const bf16_t*)(ws + OFF_CQ);
  const bf16_t* CKV = (const bf16_t*)(ws + OFF_CKV);
  const bf16_t* WQ = (const bf16_t*)(ws + OFF_WQBT);
  const bf16_t* WKV = (const bf16_t*)(ws + OFF_WKVBT);
  const float* cs = (const float*)(ws + OFF_CS);
  bf16_t* Q = (bf16_t*)(ws + OFF_Q);
  bf16_t* KN = (bf16_t*)(ws + OFF_KN);
  bf16_t* VT = (bf16_t*)(ws + OFF_VT);
  const float qscale = 0.07216878364870322f * 1.4426950408889634f;
  const int ntq = 32 * 24, ntkv = 32 * 32;
  for (int tile = bid; tile < ntq + ntkv; tile += nblk) {
    f32x16 acc[4][2];
    if (tile < ntq) {
      const int mi = tile & 31, ni = tile >> 5;
      const int m0 = mi * 256, n0 = ni * 128;
      gemm_main<false, true>(acc, CQ, 512, WQ, 512, 512, m0, n0, smem);
      const float* rf = (const float*)(smem + 49152);
      const int lane_ = TID & 63, w_ = TID >> 6, wm_ = w_ >> 1, wn_ = w_ & 1, r_ = lane_ & 31, h_ = lane_ >> 5;
      const int cb = n0 + wn_ * 64;
      const int head = cb / 192, jb = cb - head * 192;
      if (jb == 128) {
#pragma unroll
        for (int mt = 0; mt < 4; mt++)
#pragma unroll
          for (int i = 0; i < 16; i++) {
            const int row = m0 + wm_ * 128 + mt * 32 + crow(i, h_);
            const float sc = rf[row - m0] * qscale;
            const float t1 = acc[mt][0][i] * sc, t2 = acc[mt][1][i] * sc;
            const float c = cs[row * 64 + r_], s = cs[row * 64 + 32 + r_];
            bf16_t* qp = Q + ((size_t)head * S_ + row) * 192 + 128;
            qp[r_] = (bf16_t)f2bf(t1 * c - t2 * s);
            qp[32 + r_] = (bf16_t)f2bf(t2 * c + t1 * s);
          }
      } else {
#pragma unroll
        for (int mt = 0; mt < 4; mt++)
#pragma unroll
          for (int nt = 0; nt < 2; nt++)
#pragma unroll
            for (int i = 0; i < 16; i++) {
              const int row = m0 + wm_ * 128 + mt * 32 + crow(i, h_);
              const float sc = rf[row - m0] * qscale;
              Q[((size_t)head * S_ + row) * 192 + jb + nt * 32 + r_] = (bf16_t)f2bf(acc[mt][nt][i] * sc);
            }
      }
    } else {
      const int tl = tile - ntq;
      const int mi = tl & 31, ni = tl >> 5;
      const int m0 = mi * 256, n0 = ni * 128;
      const int head = ni >> 1;
      if (ni & 1) {
        gemm_main<true, true>(acc, CKV, 512, WKV, 512, 512, m0, n0, smem);
        const float* rf = (const float*)(smem + 49152);
        EPI_LOOP_BEGIN EPI_COORD_SW
          const int j = col - head * 256 - 128;
          VT[((size_t)head * 128 + j) * S_ + row] = (bf16_t)f2bf(v * rf[row - m0]);
        EPI_LOOP_END
      } else {
        gemm_main<false, true>(acc, CKV, 512, WKV, 512, 512, m0, n0, smem);
        const float* rf = (const float*)(smem + 49152);
        EPI_LOOP_BEGIN EPI_COORD_NS
          const int j = col - head * 256;
          KN[((size_t)head * S_ + row) * 128 + j] = (bf16_t)f2bf(v * rf[row - m0]);
        EPI_LOOP_END
      }
    }
  }
}

DI void phase_attn(const Params& p, char* smem, int bid, int nblk, int rep) {
  char* ws = opaque_ptr(p.ws);
  const int t = TID, lane = t & 63, w = t >> 6, r = lane & 31, h = lane >> 5;
  const bf16_t* Q = (const bf16_t*)(ws + OFF_Q);
  const bf16_t* KN = (const bf16_t*)(ws + OFF_KN);
  const bf16_t* KR = (const bf16_t*)(ws + OFF_KR);
  const bf16_t* VT = (const bf16_t*)(ws + OFF_VT);
  const bf16_t* G1 = (const bf16_t*)(ws + OFF_QK0);
  bf16_t* OG = (bf16_t*)(ws + OFF_H);
  int* ctr = (int*)(ws + OFF_CTR) + rep;
  char* lk = smem;
  char* lv = smem + 25600;
  int* s_item = (int*)(smem + 44032);
  const int k_row = t >> 2, k_c0 = t & 3;
  const int v_row0 = t >> 3, v_kc = t & 7;
  for (;;) {
    __syncthreads();
    if (t == 0) *s_item = atomicAdd(ctr, 1);
    __syncthreads();
    const int item = *s_item;
    if (item >= 1024) break;
    const int qb = 63 - (item >> 4), head = item & 15;
    const int q0w = qb * 128 + w * 32;
    const int ntile = 2 * qb + 2;
    bf16x8 qf[12];
    {
      const bf16_t* qp = Q + ((size_t)head * S_ + q0w + r) * 192 + 8 * h;
#pragma unroll
      for (int s = 0; s < 12; s++) qf[s] = *(const bf16x8*)(qp + 16 * s);
    }
    f32x16 oacc[4];
#pragma unroll
    for (int vt = 0; vt < 4; vt++)
#pragma unroll
      for (int i = 0; i < 16; i++) oacc[vt][i] = 0.f;
    float m_run = -INFINITY, l_run = 0.f;
    uint4 kg0, kg1, kg2, kg3, kg4, kg5, vg0, vg1, vg2, vg3;
    const bf16_t* knp = KN + (size_t)head * S_ * 128;
    const bf16_t* vtp = VT + ((size_t)head * 128 + v_row0) * S_ + v_kc * 8;
#define ATT_LOAD(k0_)                                                                                         \
    {                                                                                                         \
      const bf16_t* kn_ = knp + (size_t)((k0_) + k_row) * 128 + k_c0 * 8;                                     \
      const bf16_t* kr_ = KR + (size_t)((k0_) + k_row) * 64 + k_c0 * 8;                                       \
      const bf16_t* vp_ = vtp + (k0_);                                                                        \
      kg0 = *(const uint4*)(kn_); kg1 = *(const uint4*)(kn_ + 32); kg2 = *(const uint4*)(kn_ + 64); kg3 = *(const uint4*)(kn_ + 96); \
      kg4 = *(const uint4*)(kr_); kg5 = *(const uint4*)(kr_ + 32);                                            \
      vg0 = *(const uint4*)(vp_); vg1 = *(const uint4*)(vp_ + (size_t)32 * S_);                               \
      vg2 = *(const uint4*)(vp_ + (size_t)64 * S_); vg3 = *(const uint4*)(vp_ + (size_t)96 * S_);             \
    }
    ATT_LOAD(0)
    for (int kt = 0; kt < ntile; kt++) {
      const int k0 = kt * 64;
      __syncthreads();
      {
        char* kd = lk + k_row * 400 + k_c0 * 16;
        *(uint4*)(kd) = kg0; *(uint4*)(kd + 64) = kg1; *(uint4*)(kd + 128) = kg2; *(uint4*)(kd + 192) = kg3;
        *(uint4*)(kd + 256) = kg4; *(uint4*)(kd + 320) = kg5;
        char* vd = lv + v_row0 * 144 + (v_kc >> 1) * 32 + (v_kc & 1) * 8;
#define VST(o_, v_) { uint2 u0, u1; u0.x = v_.x; u0.y = v_.y; u1.x = v_.z; u1.y = v_.w; *(uint2*)(vd + (o_)) = u0; *(uint2*)(vd + (o_) + 16) = u1; }
        VST(0, vg0) VST(32 * 144, vg1) VST(64 * 144, vg2) VST(96 * 144, vg3)
#undef VST
      }
      __syncthreads();
      { const int knext = (kt + 1 < ntile) ? k0 + 64 : k0; ATT_LOAD(knext) }
      if (k0 <= q0w + 31) {
        f32x16 sc[2];
#pragma unroll
        for (int i = 0; i < 16; i++) { sc[0][i] = 0.f; sc[1][i] = 0.f; }
        __builtin_amdgcn_s_setprio(1);
#pragma unroll
        for (int s = 0; s < 12; s++) {
          bf16x8 a0 = *(const bf16x8*)(lk + r * 400 + h * 16 + s * 32);
          bf16x8 a1 = *(const bf16x8*)(lk + r * 400 + h * 16 + 32 * 400 + s * 32);
          sc[0] = MFMA32(a0, qf[s], sc[0]);
          sc[1] = MFMA32(a1, qf[s], sc[1]);
        }
        __builtin_amdgcn_s_setprio(0);
        if (k0 + 63 > q0w) {
          const int qg = q0w + r;
#pragma unroll
          for (int mt = 0; mt < 2; mt++)
#pragma unroll
            for (int i = 0; i < 16; i++) {
              const int key = k0 + mt * 32 + crow(i, h);
              if (key > qg) sc[mt][i] = -INFINITY;
            }
        }
        float mx = sc[0][0];
#pragma unroll
        for (int i = 1; i < 16; i++) mx = fmaxf(mx, sc[0][i]);
#pragma unroll
        for (int i = 0; i < 16; i++) mx = fmaxf(mx, sc[1][i]);
        mx = fmaxf(mx, __shfl_xor(mx, 32));
        const float m_new = (mx > m_run + 8.f) ? mx : m_run;
        const bool resc = __any(m_new != m_run);
        const float alpha = __builtin_amdgcn_exp2f(m_run - m_new);
        m_run = m_new;
        float ls = 0.f;
#pragma unroll
        for (int mt = 0; mt < 2; mt++)
#pragma unroll
          for (int i = 0; i < 16; i++) { const float pv = __builtin_amdgcn_exp2f(sc[mt][i] - m_new); sc[mt][i] = pv; ls += pv; }
        l_run = l_run * alpha + ls;
        if (resc) {
#pragma unroll
          for (int vt = 0; vt < 4; vt++)
#pragma unroll
            for (int i = 0; i < 16; i++) oacc[vt][i] *= alpha;
        }
        __builtin_amdgcn_s_setprio(1);
#pragma unroll
        for (int s = 0; s < 4; s++) {
          const bf16x8 pb = pack8(sc[s >> 1], s & 1);
#pragma unroll
          for (int vt = 0; vt < 4; vt++) {
            const bf16x8 a = *(const bf16x8*)(lv + r * 144 + h * 16 + vt * 32 * 144 + s * 32);
            oacc[vt] = MFMA32(a, pb, oacc[vt]);
          }
        }
        __builtin_amdgcn_s_setprio(0);
      }
    }
#undef ATT_LOAD
    const float l_tot = l_run + __shfl_xor(l_run, 32);
    const float inv = 1.f / l_tot;
    const size_t obase = (size_t)(q0w + r) * 2048 + head * 128;
#pragma unroll
    for (int vt = 0; vt < 4; vt++)
#pragma unroll
      for (int g = 0; g < 4; g++) {
        const int v = vt * 32 + 8 * g + 4 * h;
        uint2 gg = *(const uint2*)(G1 + obase + v);
        uint2 o;
        o.x = pack2(oacc[vt][4 * g + 0] * inv * bflo(gg.x), oacc[vt][4 * g + 1] * inv * bfhi(gg.x));
        o.y = pack2(oacc[vt][4 * g + 2] * inv * bflo(gg.y), oacc[vt][4 * g + 3] * inv * bfhi(gg.y));
        *(uint2*)(OG + obase + v) = o;
      }
  }
}

DI void phase_final(const Params& p, char* smem, int bid, int nblk) {
  char* ws = opaque_ptr(p.ws);
  const int t = TID, lane = t & 63, w = t >> 6;
  const bf16_t* Y = (const bf16_t*)(ws + OFF_Y);
  const float4* gpo = (const float4*)p.l1_post + lane;
  for (int row0 = bid * 4 + w; row0 < S_; row0 += nblk * 8) {
    const int row1r = row0 + nblk * 4;
    const bool has1 = row1r < S_;
    const int row1 = has1 ? row1r : row0;
    const uint2* yr0 = (const uint2*)(Y + (size_t)row0 * 2048) + lane;
    const uint2* yr1 = (const uint2*)(Y + (size_t)row1 * 2048) + lane;
    float4* out0 = (float4*)(p.out + (size_t)row0 * 2048) + lane;
    float4* out1 = (float4*)(p.out + (size_t)row1 * 2048) + lane;
    uint2 ya[8], yb[8];
    float4 xa[8], xb[8];
#pragma unroll
    for (int j = 0; j < 8; j++) { ya[j] = ld_nt(yr0 + j * 64); xa[j] = ld_nt((const float4*)out0 + j * 64); yb[j] = ld_nt(yr1 + j * 64); xb[j] = ld_nt((const float4*)out1 + j * 64); }
    float sa = 0.f, sb = 0.f;
#pragma unroll
    for (int j = 0; j < 8; j++) {
      sa += bflo(ya[j].x) * bflo(ya[j].x) + bfhi(ya[j].x) * bfhi(ya[j].x) + bflo(ya[j].y) * bflo(ya[j].y) + bfhi(ya[j].y) * bfhi(ya[j].y);
      sb += bflo(yb[j].x) * bflo(yb[j].x) + bfhi(yb[j].x) * bfhi(yb[j].x) + bflo(yb[j].y) * bflo(yb[j].y) + bfhi(yb[j].y) * bfhi(yb[j].y);
    }
    sa = wave_sum(sa); sb = wave_sum(sb);
    const float ra = rsqrtf(sa * (1.f / 2048.f) + 1e-6f), rb = rsqrtf(sb * (1.f / 2048.f) + 1e-6f);
#pragma unroll
    for (int j = 0; j < 8; j++) {
      const float4 g = gpo[j * 64];
      float4 o = xa[j];
      o.x += bflo(ya[j].x) * ra * g.x; o.y += bfhi(ya[j].x) * ra * g.y; o.z += bflo(ya[j].y) * ra * g.z; o.w += bfhi(ya[j].y) * ra * g.w;
      st_nt(out0 + j * 64, o);
      if (has1) {
        float4 q = xb[j];
        q.x += bflo(yb[j].x) * rb * g.x; q.y += bfhi(yb[j].x) * rb * g.y; q.z += bflo(yb[j].y) * rb * g.z; q.w += bfhi(yb[j].y) * rb * g.w;
        st_nt(out1 + j * 64, q);
      }
    }
  }
}

constexpr int NPHASE = 13;
constexpr unsigned DUP_MASK = 0u;
DI void run_phase(int ph, const Params& p, char* smem, int bid, int nblk, int rep) {
  switch (ph) {
    case 0: phase_prep(p, smem, bid, nblk); break;
    case 1: phase_gemm_in0(p, smem, bid, nblk); break;
    case 2: phase_gla_prep(p, smem, bid, nblk); break;
    case 3: phase_gla_local(p, smem, bid, nblk); break;
    case 4: phase_gla_scan(p, smem, bid, nblk); break;
    case 5: phase_og(p, smem, bid, nblk); break;
    case 6: phase_gemm_out(p, smem, bid, nblk, OFF_WOUT0T); break;
    case 7: phase_post0(p, smem, bid, nblk); break;
    case 8: phase_gemm_in1(p, smem, bid, nblk); break;
    case 9: phase_gemm_qkv(p, smem, bid, nblk); break;
    case 10: phase_attn(p, smem, bid, nblk, rep); break;
    case 11: phase_gemm_out(p, smem, bid, nblk, OFF_WOUT1T); break;
    case 12: phase_final(p, smem, bid, nblk); break;
  }
}

#define XB_TMO      128
#define XB_XCNT(j)  (256  + 64 * (j))
#define XB_XSUB(j)  (1280 + 64 * (j))
#define XB_XGEN(j)  (2304 + 64 * (j))
#define XB_TOP      3328
#define XB_TOPGEN   3392
#define XCD_BAR_WORDS 3456
#define XB_SPIN_CAP (1u << 20)
#define LAS __attribute__((address_space(3)))
DI unsigned xb_ld(unsigned* p) { return __hip_atomic_load(p, __ATOMIC_RELAXED, __HIP_MEMORY_SCOPE_AGENT); }
DI unsigned xb_add(unsigned* p, unsigned v) { return __hip_atomic_fetch_add(p, v, __ATOMIC_RELAXED, __HIP_MEMORY_SCOPE_AGENT); }
DI unsigned xb_xcc_id() { return (unsigned)__builtin_amdgcn_s_getreg((3 << 11) | 20) & 0xFu; }
#define XB_SPIN(cond, bar) do { unsigned _sp = 0; while (cond) { __builtin_amdgcn_s_sleep(1); \
    if ((++_sp & 255u) == 0u) { if (xb_ld(&(bar)[XB_TMO])) break; if (_sp > XB_SPIN_CAP) { atomicAdd(&(bar)[XB_TMO], 1u); break; } } } } while (0)
struct XcdBarrier { unsigned* bar; unsigned x; volatile LAS unsigned* st; };
DI XcdBarrier xcd_barrier_post(unsigned* bar, volatile LAS unsigned* st) {
  XcdBarrier b; b.bar = bar; b.x = xb_xcc_id(); b.st = st;
  if (threadIdx.x == 0) (void)xb_add(&bar[XB_XCNT(b.x)], 1u);
  return b;
}
DI void xcd_barrier_complete(unsigned* bar, unsigned x, unsigned& nloc, unsigned& nx) {
  const unsigned G = gridDim.x * gridDim.y * gridDim.z;
  unsigned sum, cnt, mine, sp = 0u;
  for (;;) {
    sum = 0u; cnt = 0u; mine = 0u;
#pragma unroll
    for (unsigned j = 0; j < 16; ++j) { const unsigned c = xb_ld(&bar[XB_XCNT(j)]); sum += c; cnt += (c > 0u) ? 1u : 0u; mine = (j == x) ? c : mine; }
    if (sum == G) break;
    __builtin_amdgcn_s_sleep(1);
    if ((++sp & 255u) == 0u) { if (xb_ld(&bar[XB_TMO])) break; if (sp > XB_SPIN_CAP) { atomicAdd(&bar[XB_TMO], 1u); break; } }
  }
  nloc = mine > 0u ? mine : 1u; nx = cnt > 0u ? cnt : 1u;
}
DI void xcd_barrier(const XcdBarrier& b) {
  asm volatile("s_waitcnt vmcnt(0)" ::: "memory");
  __syncthreads();
  if (threadIdx.x == 0) {
    unsigned* bar = b.bar;
    __builtin_amdgcn_s_waitcnt(0);
    unsigned nloc, nx;
    xcd_barrier_complete(bar, b.x, nloc, nx);
    const unsigned old = xb_add(&bar[XB_XSUB(b.x)], 1u);
    const unsigned gen = old / nloc;
    if (old + 1u == (gen + 1u) * nloc) {
      __builtin_amdgcn_fence(__ATOMIC_RELEASE, "agent");
      asm volatile("s_waitcnt vmcnt(0)" ::: "memory");
      const unsigned og = xb_add(&bar[XB_TOP], 1u);
      const unsigned tg = og / nx;
      if (og + 1u == (tg + 1u) * nx) xb_add(&bar[XB_TOPGEN], 1u);
      else XB_SPIN(xb_ld(&bar[XB_TOPGEN]) == tg, bar);
      __builtin_amdgcn_fence(__ATOMIC_ACQUIRE, "agent");
      xb_add(&bar[XB_XGEN(b.x)], 1u);
      asm volatile("s_waitcnt vmcnt(0)" ::: "memory");
    } else {
      XB_SPIN(xb_ld(&bar[XB_XGEN(b.x)]) == gen, bar);
      __builtin_amdgcn_fence(__ATOMIC_ACQUIRE, "agent");
      asm volatile("s_waitcnt vmcnt(0)" ::: "memory");
    }
  }
  __syncthreads();
}

#if MEGA
__global__ void __launch_bounds__(256, 2) mega_kernel(Params p) {
  __shared__ __attribute__((aligned(16))) char smem[65536];
  cg::grid_group grid = cg::this_grid();
  const int bid = blockIdx.x, nblk = gridDim.x;
  (void)xcd_barrier_post((unsigned*)(p.ws + OFF_BAR), (volatile LAS unsigned*)0);
#pragma nounroll
  for (int ph = 0; ph < NPHASE; ph++) {
    int phv = ph;
    asm volatile("" : "+s"(phv));
    run_phase(phv, p, smem, bid, nblk, 0);
    if (p.ws == nullptr) grid.sync();
    { XcdBarrier xb; xb.bar = (unsigned*)(opaque_ptr(p.ws) + OFF_BAR); xb.x = xb_xcc_id(); xb.st = (volatile LAS unsigned*)0; xcd_barrier(xb); }
    if ((DUP_MASK >> ph) & 1u) {
      run_phase(phv, p, smem, bid, nblk, 1);
      { XcdBarrier xb; xb.bar = (unsigned*)(opaque_ptr(p.ws) + OFF_BAR); xb.x = xb_xcc_id(); xb.st = (volatile LAS unsigned*)0; xcd_barrier(xb); }
    }
  }
}
#endif

#if !MEGA
template <int PH>
__global__ void __launch_bounds__(256, 2) phase_kernel_t(Params p) {
  __shared__ __attribute__((aligned(16))) char smem[65536];
  run_phase(PH, p, smem, blockIdx.x, gridDim.x, 0);
}
#endif

extern "C" void kernel_launch(void* const* d_in, const int* in_sizes, int n_in, void* d_out, int out_size, void* d_ws,
                              size_t ws_size, hipStream_t stream) {
  Params p{};
  p.x = (const float*)d_in[0]; p.pos = (const int*)d_in[1]; p.l0_pre = (const float*)d_in[2]; p.w_in0 = (const float*)d_in[3];
  p.w_gk2 = (const float*)d_in[4]; p.b_gk = (const float*)d_in[5]; p.g_onorm = (const float*)d_in[6]; p.w_out0 = (const float*)d_in[7];
  p.l0_post = (const float*)d_in[8]; p.l1_pre = (const float*)d_in[9]; p.w_in1 = (const float*)d_in[10]; p.g_qa = (const float*)d_in[11];
  p.w_qb = (const float*)d_in[12]; p.g_kva = (const float*)d_in[13]; p.w_kvb = (const float*)d_in[14]; p.w_out1 = (const float*)d_in[15];
  p.l1_post = (const float*)d_in[16];
  p.out = (float*)d_out; p.ws = (char*)d_ws;
  for (int i = 0; i < 32; i++) p.invf[i] = (float)pow(10000.0, -(double)i / 32.0);
#if MEGA
  static int grid_blocks = 0;
  if (!grid_blocks) {
    int dev = 0, cus = 0, per_cu = 0;
    hipGetDevice(&dev);
    hipDeviceGetAttribute(&cus, hipDeviceAttributeMultiprocessorCount, dev);
    hipOccupancyMaxActiveBlocksPerMultiprocessor(&per_cu, mega_kernel, 256, 0);
    if (per_cu > 2) per_cu = 2;
    if (per_cu < 1) per_cu = 1;
    grid_blocks = cus * per_cu;
  }
  hipMemsetAsync((char*)d_ws + OFF_BAR, 0, XCD_BAR_WORDS * 4, stream);
  void* args[] = {&p};
  hipError_t e = hipLaunchCooperativeKernel((void*)mega_kernel, dim3(grid_blocks), dim3(256), args, 0, stream);
  if (e != hipSuccess) fprintf(stderr, "cooperative launch failed: %s (grid %d)\n", hipGetErrorString(e), grid_blocks);
#else
#define LPH(N) hipLaunchKernelGGL(phase_kernel_t<N>, dim3(512), dim3(256), 0, stream, p);
  LPH(0) LPH(1) LPH(2) LPH(3) LPH(4) LPH(5) LPH(6) LPH(7) LPH(8) LPH(9) LPH(10) LPH(11) LPH(12)
#undef LPH
#endif
}
```

```cpp
#include <hip/hip_runtime.h>
#include <hip/hip_cooperative_groups.h>
#include <stdint.h>
#include <math.h>
#include <stdio.h>
namespace cg = cooperative_groups;

#ifndef MEGA
#define MEGA 1
#endif

typedef __attribute__((ext_vector_type(8))) short bf16x8;
typedef __attribute__((ext_vector_type(4))) short s16x4;
typedef __attribute__((ext_vector_type(16))) float f32x16;
typedef unsigned short bf16_t;
#define DI __device__ __forceinline__
#define MFMA32(a, b, c) __builtin_amdgcn_mfma_f32_32x32x16_bf16((a), (b), (c), 0, 0, 0)

constexpr int S_ = 8192;
constexpr size_t MiB = (size_t)1 << 20;
constexpr size_t OFF_WIN0T = 0;
constexpr size_t OFF_WOUT0T = 25 * MiB;
constexpr size_t OFF_WIN1T = 33 * MiB;
constexpr size_t OFF_WQBT = 46 * MiB;
constexpr size_t OFF_WKVBT = 49 * MiB;
constexpr size_t OFF_WOUT1T = 53 * MiB;
constexpr size_t OFF_GKLOW = 61 * MiB;
constexpr size_t OFF_DECAY = 61 * MiB + 512 * 1024;
constexpr size_t OFF_CS = 62 * MiB;
constexpr size_t OFF_H = 64 * MiB;
constexpr size_t OFF_QK0 = 96 * MiB;
constexpr size_t OFF_V0T = 128 * MiB;
constexpr size_t OFF_G0 = 160 * MiB;
constexpr size_t OFF_Y = 128 * MiB;
constexpr size_t OFF_QE = 192 * MiB;
constexpr size_t OFF_KLT = 208 * MiB;
constexpr size_t OFF_AM = 224 * MiB;
constexpr size_t OFF_CQ = 0;
constexpr size_t OFF_CKV = 8 * MiB;
constexpr size_t OFF_KR = 16 * MiB;
constexpr size_t OFF_RINVQ = 17 * MiB;
constexpr size_t OFF_RINVKV = 17 * MiB + 64 * 1024;
constexpr size_t OFF_KRRAW = 18 * MiB;
constexpr size_t OFF_CTR = 20 * MiB;
constexpr size_t OFF_BAR = 255 * MiB;
constexpr size_t OFF_SL = 64 * MiB;
constexpr size_t OFF_DC = 80 * MiB;
constexpr size_t OFF_Q = 128 * MiB;
constexpr size_t OFF_KN = 176 * MiB;
constexpr size_t OFF_VT = 208 * MiB;

struct Params {
  const float* x; const int* pos; const float* l0_pre; const float* w_in0; const float* w_gk2; const float* b_gk;
  const float* g_onorm; const float* w_out0; const float* l0_post; const float* l1_pre; const float* w_in1;
  const float* g_qa; const float* w_qb; const float* g_kva; const float* w_kvb; const float* w_out1; const float* l1_post;
  float* out; char* ws;
  float invf[32];
};

DI int tid_opaque() { int t = threadIdx.x; asm volatile("" : "+v"(t)); return t; }
#define TID tid_opaque()
typedef __attribute__((address_space(1))) char gchar_t;
DI char* opaque_ptr(char* q) {
  unsigned long long v = (unsigned long long)q;
  unsigned lo = __builtin_amdgcn_readfirstlane((unsigned)v), hi = __builtin_amdgcn_readfirstlane((unsigned)(v >> 32));
  asm volatile("" : "+s"(lo), "+s"(hi));
  return (char*)(gchar_t*)(((unsigned long long)hi << 32) | lo);
}
typedef __bf16 hbf16x2 __attribute__((ext_vector_type(2)));
typedef float hf32x2 __attribute__((ext_vector_type(2)));
DI unsigned pack2(float a, float b) { hf32x2 f = {a, b}; return __builtin_bit_cast(unsigned, __builtin_convertvector(f, hbf16x2)); }
DI unsigned f2bf(float f) { return (unsigned)__builtin_bit_cast(unsigned short, (__bf16)f); }
DI float bf2f(unsigned h) { return __uint_as_float(h << 16); }
DI float bflo(unsigned u) { return __uint_as_float(u << 16); }
DI float bfhi(unsigned u) { return __uint_as_float(u & 0xffff0000u); }
DI int crow(int i, int h) { return (i & 3) + 8 * (i >> 2) + 4 * h; }
typedef float nt_f4 __attribute__((ext_vector_type(4)));
typedef unsigned nt_u4 __attribute__((ext_vector_type(4)));
typedef unsigned nt_u2 __attribute__((ext_vector_type(2)));
DI float4 ld_nt(const float4* p) { nt_f4 v = __builtin_nontemporal_load((const nt_f4*)p); float4 r; r.x = v.x; r.y = v.y; r.z = v.z; r.w = v.w; return r; }
DI uint4 ld_nt(const uint4* p) { nt_u4 v = __builtin_nontemporal_load((const nt_u4*)p); uint4 r; r.x = v.x; r.y = v.y; r.z = v.z; r.w = v.w; return r; }
DI uint2 ld_nt(const uint2* p) { nt_u2 v = __builtin_nontemporal_load((const nt_u2*)p); uint2 r; r.x = v.x; r.y = v.y; return r; }
DI void st_nt(float4* p, const float4& a) { nt_f4 v = {a.x, a.y, a.z, a.w}; __builtin_nontemporal_store(v, (nt_f4*)p); }
DI float silu(float v) { return v / (1.f + __expf(-v)); }
DI float wave_sum(float v) { for (int o = 32; o > 0; o >>= 1) v += __shfl_xor(v, o); return v; }
DI float block_sum(float v, float* red) {
  v = wave_sum(v);
  __syncthreads();
  if ((TID & 63) == 0) red[TID >> 6] = v;
  __syncthreads();
  return red[0] + red[1] + red[2] + red[3];
}
DI bf16x8 pack8(const f32x16& x, int s) {
  union { unsigned u[4]; bf16x8 v; } p;
  p.u[0] = pack2(x[8 * s + 0], x[8 * s + 1]); p.u[1] = pack2(x[8 * s + 2], x[8 * s + 3]);
  p.u[2] = pack2(x[8 * s + 4], x[8 * s + 5]); p.u[3] = pack2(x[8 * s + 6], x[8 * s + 7]);
  return p.v;
}

DI void transpose_tile4(const float* __restrict__ W, int K, int N, int ntN, const float* __restrict__ gain, bf16_t* __restrict__ WT,
                        int id0, char* smem) {
  const int t = TID;
  float v[4][16];
#pragma unroll
  for (int q = 0; q < 4; q++) {
    const int id = id0 + q, k0 = (id / ntN) * 64, n0 = (id % ntN) * 64;
#pragma unroll
    for (int i = 0; i < 16; i++) {
      const int kk = i * 4 + (t >> 6), n = n0 + (t & 63);
      float x = (n < N) ? __builtin_nontemporal_load(&W[(size_t)(k0 + kk) * N + n]) : 0.f;
      if (gain) x *= gain[k0 + kk];
      v[q][i] = x;
    }
  }
#pragma unroll
  for (int q = 0; q < 4; q++) {
    unsigned short (*tile)[72] = (unsigned short (*)[72])(smem + q * 9216);
#pragma unroll
    for (int i = 0; i < 16; i++) tile[t & 63][i * 4 + (t >> 6)] = (unsigned short)f2bf(v[q][i]);
  }
  __syncthreads();
#pragma unroll
  for (int q = 0; q < 4; q++) {
    unsigned short (*tile)[72] = (unsigned short (*)[72])(smem + q * 9216);
    const int id = id0 + q, k0 = (id / ntN) * 64, n0 = (id % ntN) * 64;
    const int nn = t >> 2, kg = (t & 3) * 16;
    uint4 a = *(const uint4*)&tile[nn][kg];
    uint4 b = *(const uint4*)&tile[nn][kg + 8];
    bf16_t* dst = WT + (size_t)(n0 + nn) * K + k0 + kg;
    *(uint4*)dst = a; *(uint4*)(dst + 8) = b;
  }
  __syncthreads();
}

DI void phase_prep(const Params& p, char* smem, int bid, int nblk) {
  const int t = TID;
  char* ws = opaque_ptr(p.ws);
  for (int task = bid; task < 1920 + 3072; task += nblk) {
    if (task < 1920) {
      const int tile0 = task * 4;
      const float* W; const float* gain = nullptr; bf16_t* WT; int K, N, ntN, id;
      if (tile0 < 3136) { id = tile0; W = p.w_in0; K = 2048; N = 6160; ntN = 98; WT = (bf16_t*)(ws + OFF_WIN0T); }
      else if (tile0 < 4160) { id = tile0 - 3136; W = p.w_out0; K = 2048; N = 2048; ntN = 32; WT = (bf16_t*)(ws + OFF_WOUT0T); }
      else if (tile0 < 5760) { id = tile0 - 4160; W = p.w_in1; K = 2048; N = 3136; ntN = 50; WT = (bf16_t*)(ws + OFF_WIN1T); }
      else if (tile0 < 6144) { id = tile0 - 5760; W = p.w_qb; K = 512; N = 3072; ntN = 48; WT = (bf16_t*)(ws + OFF_WQBT); gain = p.g_qa; }
      else if (tile0 < 6656) { id = tile0 - 6144; W = p.w_kvb; K = 512; N = 4096; ntN = 64; WT = (bf16_t*)(ws + OFF_WKVBT); gain = p.g_kva; }
      else { id = tile0 - 6656; W = p.w_out1; K = 2048; N = 2048; ntN = 32; WT = (bf16_t*)(ws + OFF_WOUT1T); }
      transpose_tile4(W, K, N, ntN, gain, WT, id, smem);
    } else if (task < 1920 + 2048) {
      const int lane = t & 63, row = (task - 1920) * 4 + (t >> 6);
      const float4* xr = (const float4*)(p.x + (size_t)row * 2048) + lane;
      const float4* gr = (const float4*)p.l0_pre + lane;
      float4 xv[8];
#pragma unroll
      for (int j = 0; j < 8; j++) xv[j] = ld_nt(xr + j * 64);
      float ss = 0.f;
#pragma unroll
      for (int j = 0; j < 8; j++) ss += xv[j].x * xv[j].x + xv[j].y * xv[j].y + xv[j].z * xv[j].z + xv[j].w * xv[j].w;
      ss = wave_sum(ss);
      const float rinv = rsqrtf(ss * (1.f / 2048.f) + 1e-6f);
      uint2* hr = (uint2*)(ws + OFF_H + (size_t)row * 4096) + lane;
#pragma unroll
      for (int j = 0; j < 8; j++) {
        const float4 g = gr[j * 64];
        uint2 o; o.x = pack2(xv[j].x * rinv * g.x, xv[j].y * rinv * g.y); o.y = pack2(xv[j].z * rinv * g.z, xv[j].w * rinv * g.w);
        hr[j * 64] = o;
      }
    } else {
      const int idx = (task - 3968) * 256 + t;
      const int token = idx >> 5, i = idx & 31;
      double ang = (double)p.pos[token] * (double)p.invf[i];
      double tt = ang * 0.15915494309189535;
      tt -= floor(tt + 0.5);
      float f = (float)tt;
      float* cs = (float*)(ws + OFF_CS);
      cs[token * 64 + i] = __builtin_amdgcn_cosf(f);
      cs[token * 64 + 32 + i] = __builtin_amdgcn_sinf(f);
    }
  }
}

DI float sq8(const uint4& v) {
  return bflo(v.x) * bflo(v.x) + bfhi(v.x) * bfhi(v.x) + bflo(v.y) * bflo(v.y) + bfhi(v.y) * bfhi(v.y) + bflo(v.z) * bflo(v.z) + bfhi(v.z) * bfhi(v.z) +
         bflo(v.w) * bflo(v.w) + bfhi(v.w) * bfhi(v.w);
}
template <bool SWAP, bool SUMSQ = false>
DI void gemm_main(f32x16 (&acc)[4][2], const bf16_t* A, int lda, const bf16_t* B, int ldb, int K,
                  int m0, int n0, char* smem) {
  const int t = TID, lane = t & 63, w = t >> 6, wm = w >> 1, wn = w & 1, r = lane & 31, h = lane >> 5;
#pragma unroll
  for (int a = 0; a < 4; a++)
#pragma unroll
    for (int b = 0; b < 2; b++)
#pragma unroll
      for (int i = 0; i < 16; i++) acc[a][b][i] = 0.f;
  const int lrow = t >> 2, kc = t & 3;
  const bf16_t* ag = A + (size_t)(m0 + lrow) * lda + kc * 8;
  const bf16_t* bg = B + (size_t)(n0 + lrow) * ldb + kc * 8;
  const int lds_w = lrow * 64 + ((kc ^ ((lrow >> 2) & 3)) << 4);
  uint4 pa0, pa1, pa2, pa3, pb0, pb1;
  bf16x8 fa0, fa1, fa2, fa3, fa4, fa5, fb0, fb1, fb2, fb3, fb4, fb5;
#define G_LOAD(X, ko_)                                                                                   \
  X##a0 = *(const uint4*)(ag + (ko_)); X##a1 = *(const uint4*)(ag + (size_t)64 * lda + (ko_));           \
  X##a2 = *(const uint4*)(ag + (size_t)128 * lda + (ko_)); X##a3 = *(const uint4*)(ag + (size_t)192 * lda + (ko_)); \
  X##b0 = *(const uint4*)(bg + (ko_)); X##b1 = *(const uint4*)(bg + (size_t)64 * ldb + (ko_));
#define L_STORE(X, base_)                                                                                \
  *(uint4*)((base_) + lds_w) = X##a0; *(uint4*)((base_) + lds_w + 4096) = X##a1;                         \
  *(uint4*)((base_) + lds_w + 8192) = X##a2; *(uint4*)((base_) + lds_w + 12288) = X##a3;                 \
  *(uint4*)((base_) + 16384 + lds_w) = X##b0; *(uint4*)((base_) + 16384 + lds_w + 4096) = X##b1;         \
  if (SUMSQ) { q0 += sq8(X##a0); q1 += sq8(X##a1); q2 += sq8(X##a2); q3 += sq8(X##a3); }
#define G_READ(F, base_, c_)                                                                             \
  F##0 = *(const bf16x8*)((base_) + a_off + (c_)); F##1 = *(const bf16x8*)((base_) + a_off + 32 * 64 + (c_));              \
  F##2 = *(const bf16x8*)((base_) + a_off + 64 * 64 + (c_)); F##3 = *(const bf16x8*)((base_) + a_off + 96 * 64 + (c_));    \
  F##4 = *(const bf16x8*)((base_) + b_off + (c_)); F##5 = *(const bf16x8*)((base_) + b_off + 32 * 64 + (c_));
#define G_MMA(a0, a1, a2, a3, b0, b1)                                                                    \
    if (SWAP) {                                                                                          \
      acc[0][0] = MFMA32(b0, a0, acc[0][0]); acc[0][1] = MFMA32(b1, a0, acc[0][1]);                      \
      acc[1][0] = MFMA32(b0, a1, acc[1][0]); acc[1][1] = MFMA32(b1, a1, acc[1][1]);                      \
      acc[2][0] = MFMA32(b0, a2, acc[2][0]); acc[2][1] = MFMA32(b1, a2, acc[2][1]);                      \
      acc[3][0] = MFMA32(b0, a3, acc[3][0]); acc[3][1] = MFMA32(b1, a3, acc[3][1]);                      \
    } else {                                                                                             \
      acc[0][0] = MFMA32(a0, b0, acc[0][0]); acc[0][1] = MFMA32(a0, b1, acc[0][1]);                      \
      acc[1][0] = MFMA32(a1, b0, acc[1][0]); acc[1][1] = MFMA32(a1, b1, acc[1][1]);                      \
      acc[2][0] = MFMA32(a2, b0, acc[2][0]); acc[2][1] = MFMA32(a2, b1, acc[2][1]);                      \
      acc[3][0] = MFMA32(a3, b0, acc[3][0]); acc[3][1] = MFMA32(a3, b1, acc[3][1]);                      \
    }
#define G_MMA6(F) G_MMA(F##0, F##1, F##2, F##3, F##4, F##5)
  float q0 = 0.f, q1 = 0.f, q2 = 0.f, q3 = 0.f;
  const int sw = (r >> 2) & 3;
  const int a_off = (wm * 128 + r) * 64, b_off = 16384 + (wn * 64 + r) * 64;
  const int c0 = (h ^ sw) << 4, c1 = ((2 + h) ^ sw) << 4;
  const int nk = K >> 5;
  G_LOAD(p, 0)
  L_STORE(p, smem)
  G_LOAD(p, 32)
  __syncthreads();
  G_READ(fa, smem, c0)
  G_READ(fb, smem, c1)
  G_MMA6(fa)
  asm volatile("" ::: "memory");
  __builtin_amdgcn_sched_barrier(0);
  L_STORE(p, smem + 24576)
  {
    const int kn = ((2 < nk) ? 2 : (nk - 1)) * 32;
    G_LOAD(p, kn)
  }
  __syncthreads();
  for (int kt = 0; kt < nk - 1; kt++) {
    const char* nb = smem + ((kt + 1) & 1) * 24576;
    G_READ(fa, nb, c0)
    G_MMA6(fb)
    G_READ(fb, nb, c1)
    G_MMA6(fa)
    __builtin_amdgcn_sched_group_barrier(0x100, 6, 0);
    __builtin_amdgcn_sched_group_barrier(0x008, 8, 0);
    __builtin_amdgcn_sched_group_barrier(0x100, 6, 0);
    __builtin_amdgcn_sched_group_barrier(0x008, 8, 0);
    asm volatile("" ::: "memory");
    __builtin_amdgcn_sched_barrier(0);
    if (kt + 2 < nk) {
      L_STORE(p, smem + (kt & 1) * 24576)
    }
    {
      const int kn = ((kt + 3 < nk) ? (kt + 3) : (nk - 1)) * 32;
      G_LOAD(p, kn)
    }
    __syncthreads();
  }
  G_MMA6(fb)
#undef G_LOAD
#undef L_STORE
#undef G_READ
#undef G_MMA
#undef G_MMA6
  if (SUMSQ) {
    q0 += __shfl_xor(q0, 1); q1 += __shfl_xor(q1, 1); q2 += __shfl_xor(q2, 1); q3 += __shfl_xor(q3, 1);
    q0 += __shfl_xor(q0, 2); q1 += __shfl_xor(q1, 2); q2 += __shfl_xor(q2, 2); q3 += __shfl_xor(q3, 2);
    if (kc == 0) {
      float* rf = (float*)(smem + 49152);
      const float ik = 1.f / (float)K;
      rf[lrow] = rsqrtf(q0 * ik + 1e-6f); rf[lrow + 64] = rsqrtf(q1 * ik + 1e-6f);
      rf[lrow + 128] = rsqrtf(q2 * ik + 1e-6f); rf[lrow + 192] = rsqrtf(q3 * ik + 1e-6f);
    }
    __syncthreads();
  }
}

template <bool SWAP>
DI void gemm_main_dma(f32x16 (&acc)[4][2], const bf16_t* A, int lda, const bf16_t* B, int ldb, int K,
                      int m0, int n0, char* smem) {
  const int t = TID, lane = t & 63, w = t >> 6, wm = w >> 1, wn = w & 1, r = lane & 31, h = lane >> 5;
#pragma unroll
  for (int a = 0; a < 4; a++)
#pragma unroll
    for (int b = 0; b < 2; b++)
#pragma unroll
      for (int i = 0; i < 16; i++) acc[a][b][i] = 0.f;
  const int drow = lane >> 2, dc = (lane & 3) ^ ((lane >> 4) & 3);
  const bf16_t* ad = A + (size_t)(m0 + 16 * w + drow) * lda + dc * 8;
  const bf16_t* bd = B + (size_t)(n0 + 16 * w + drow) * ldb + dc * 8;
  typedef __attribute__((address_space(3))) unsigned lds_u32;
#define DMA_TILE(base_, ko_)                                                                                      \
  {                                                                                                               \
    lds_u32* l_ = (lds_u32*)((base_) + w * 1024);                                                                 \
    __builtin_amdgcn_global_load_lds((const unsigned*)(ad + (ko_)), l_, 16, 0, 0);                                \
    __builtin_amdgcn_global_load_lds((const unsigned*)(ad + (size_t)64 * lda + (ko_)), l_ + 1024, 16, 0, 0);      \
    __builtin_amdgcn_global_load_lds((const unsigned*)(ad + (size_t)128 * lda + (ko_)), l_ + 2048, 16, 0, 0);     \
    __builtin_amdgcn_global_load_lds((const unsigned*)(ad + (size_t)192 * lda + (ko_)), l_ + 3072, 16, 0, 0);     \
    __builtin_amdgcn_global_load_lds((const unsigned*)(bd + (ko_)), l_ + 4096, 16, 0, 0);                         \
    __builtin_amdgcn_global_load_lds((const unsigned*)(bd + (size_t)64 * ldb + (ko_)), l_ + 5120, 16, 0, 0);      \
  }
  bf16x8 fa0, fa1, fa2, fa3, fa4, fa5, fb0, fb1, fb2, fb3, fb4, fb5;
#define G_READ(F, base_, c_)                                                                             \
  F##0 = *(const bf16x8*)((base_) + a_off + (c_)); F##1 = *(const bf16x8*)((base_) + a_off + 32 * 64 + (c_));              \
  F##2 = *(const bf16x8*)((base_) + a_off + 64 * 64 + (c_)); F##3 = *(const bf16x8*)((base_) + a_off + 96 * 64 + (c_));    \
  F##4 = *(const bf16x8*)((base_) + b_off + (c_)); F##5 = *(const bf16x8*)((base_) + b_off + 32 * 64 + (c_));
#define G_MMA(a0, a1, a2, a3, b0, b1)                                                                    \
    if (SWAP) {                                                                                          \
      acc[0][0] = MFMA32(b0, a0, acc[0][0]); acc[0][1] = MFMA32(b1, a0, acc[0][1]);                      \
      acc[1][0] = MFMA32(b0, a1, acc[1][0]); acc[1][1] = MFMA32(b1, a1, acc[1][1]);                      \
      acc[2][0] = MFMA32(b0, a2, acc[2][0]); acc[2][1] = MFMA32(b1, a2, acc[2][1]);                      \
      acc[3][0] = MFMA32(b0, a3, acc[3][0]); acc[3][1] = MFMA32(b1, a3, acc[3][1]);                      \
    } else {                                                                                             \
      acc[0][0] = MFMA32(a0, b0, acc[0][0]); acc[0][1] = MFMA32(a0, b1, acc[0][1]);                      \
      acc[1][0] = MFMA32(a1, b0, acc[1][0]); acc[1][1] = MFMA32(a1, b1, acc[1][1]);                      \
      acc[2][0] = MFMA32(a2, b0, acc[2][0]); acc[2][1] = MFMA32(a2, b1, acc[2][1]);                      \
      acc[3][0] = MFMA32(a3, b0, acc[3][0]); acc[3][1] = MFMA32(a3, b1, acc[3][1]);                      \
    }
#define G_MMA6(F) G_MMA(F##0, F##1, F##2, F##3, F##4, F##5)
  const int sw = (r >> 2) & 3;
  const int a_off = (wm * 128 + r) * 64, b_off = 16384 + (wn * 64 + r) * 64;
  const int c0 = (h ^ sw) << 4, c1 = ((2 + h) ^ sw) << 4;
  const int nk = K >> 5;
#define RAW_BAR() asm volatile("s_waitcnt lgkmcnt(0)\n\ts_barrier" ::: "memory")
  DMA_TILE(smem, 0)
  DMA_TILE(smem + 24576, 32)
  asm volatile("s_waitcnt vmcnt(6)" ::: "memory");
  RAW_BAR();
  DMA_TILE(smem + 49152, 64)
  G_READ(fa, smem, c0)
  G_READ(fb, smem, c1)
  G_MMA6(fa)
  asm volatile("s_waitcnt vmcnt(6)" ::: "memory");
  RAW_BAR();
  int o_cur = 0, o_nxt = 24576;
  for (int kt = 0; kt < nk - 1; kt++) {
    const bool more = (kt + 3 < nk);
    if (more) DMA_TILE(smem + o_cur, (kt + 3) * 32)
    const char* nb = smem + o_nxt;
    G_READ(fa, nb, c0)
    G_MMA6(fb)
    G_READ(fb, nb, c1)
    G_MMA6(fa)
    if (more) asm volatile("s_waitcnt vmcnt(6)" ::: "memory");
    else asm volatile("s_waitcnt vmcnt(0)" ::: "memory");
    RAW_BAR();
    o_cur = o_nxt; o_nxt = (o_nxt == 49152) ? 0 : o_nxt + 24576;
  }
  G_MMA6(fb)
  __syncthreads();
#undef RAW_BAR
#undef DMA_TILE
#undef G_READ
#undef G_MMA
#undef G_MMA6
}

#define EPI_LOOP_BEGIN                                                                                           \
  {                                                                                                              \
    const int lane_ = TID & 63, w_ = TID >> 6, wm_ = w_ >> 1, wn_ = w_ & 1, r_ = lane_ & 31, h_ = lane_ >> 5; \
    _Pragma("unroll") for (int mt = 0; mt < 4; mt++) _Pragma("unroll") for (int nt = 0; nt < 2; nt++)          \
        _Pragma("unroll") for (int i = 0; i < 16; i++) {                                                         \
      const float v = acc[mt][nt][i];
#define EPI_COORD_NS const int row = m0 + wm_ * 128 + mt * 32 + crow(i, h_); const int col = n0 + wn_ * 64 + nt * 32 + r_;
#define EPI_COORD_SW const int row = m0 + wm_ * 128 + mt * 32 + r_; const int col = n0 + wn_ * 64 + nt * 32 + crow(i, h_);
#define EPI_LOOP_END }}

DI void phase_gemm_in0(const Params& p, char* smem, int bid, int nblk) {
  char* ws = opaque_ptr(p.ws);
  const bf16_t* A = (const bf16_t*)(ws + OFF_H);
  const bf16_t* B = (const bf16_t*)(ws + OFF_WIN0T);
  bf16_t* QK = (bf16_t*)(ws + OFF_QK0);
  bf16_t* V0T = (bf16_t*)(ws + OFF_V0T);
  bf16_t* G0 = (bf16_t*)(ws + OFF_G0);
  float* GKL = (float*)(ws + OFF_GKLOW);
  for (int tile = bid; tile < 32 * 48; tile += nblk) {
    const int mi = tile & 31, ni = tile >> 5;
    const int m0 = mi * 256, n0 = ni * 128;
    f32x16 acc[4][2];
    if (ni >= 16) {
      if (ni < 32) {
        gemm_main_dma<true>(acc, A, 2048, B, 2048, 2048, m0, n0, smem);
        EPI_LOOP_BEGIN EPI_COORD_SW
          V0T[(size_t)(col - 2048) * S_ + row] = (bf16_t)f2bf(v);
        EPI_LOOP_END
      } else {
        gemm_main_dma<false>(acc, A, 2048, B, 2048, 2048, m0, n0, smem);
        EPI_LOOP_BEGIN EPI_COORD_NS
          G0[(size_t)row * 2048 + (col - 4096)] = (bf16_t)f2bf(silu(v));
        EPI_LOOP_END
      }
    } else {
      gemm_main_dma<false>(acc, A, 2048, B, 2048, 2048, m0, n0, smem);
      EPI_LOOP_BEGIN EPI_COORD_NS
        QK[(size_t)row * 2048 + col] = (bf16_t)f2bf(v);
      EPI_LOOP_END
    }
  }
  {
    typedef __attribute__((ext_vector_type(4))) float f32x4_t;
    const int t = TID, lane = t & 63, w = t >> 6, l15 = lane & 15, quad = lane >> 4;
    float* red = (float*)smem;
    for (int item = bid; item < 512; item += nblk) {
      const bf16_t* ap = A + (size_t)(item * 16 + l15) * 2048 + 512 * w + 8 * quad;
      const bf16_t* bp = B + (size_t)(6144 + l15) * 2048 + 512 * w + 8 * quad;
      f32x4_t c = {0.f, 0.f, 0.f, 0.f};
#pragma unroll
      for (int s = 0; s < 16; s++) {
        const bf16x8 a = *(const bf16x8*)(ap + 32 * s);
        const bf16x8 b = *(const bf16x8*)(bp + 32 * s);
        c = __builtin_amdgcn_mfma_f32_16x16x32_bf16(a, b, c, 0, 0, 0);
      }
      __syncthreads();
#pragma unroll
      for (int j = 0; j < 4; j++) red[(w * 16 + quad * 4 + j) * 16 + l15] = c[j];
      __syncthreads();
      const float v = red[t] + red[256 + t] + red[512 + t] + red[768 + t];
      GKL[(size_t)item * 256 + t] = v;
    }
  }
}

DI void phase_gla_prep(const Params& p, char* smem, int bid, int nblk) {
  char* ws = opaque_ptr(p.ws);
  const int t = TID, lane = t & 63, w = t >> 6, r = lane & 31, h = lane >> 5;
  const bf16_t* QK = (const bf16_t*)(ws + OFF_QK0);
  const float* GKL = (const float*)(ws + OFF_GKLOW);
  bf16_t* QE = (bf16_t*)(ws + OFF_QE);
  bf16_t* KLT = (bf16_t*)(ws + OFF_KLT);
  bf16_t* AM = (bf16_t*)(ws + OFF_AM);
  float* DEC = (float*)(ws + OFF_DECAY);
  if (bid == 0 && t == 0) { ((int*)(ws + OFF_CTR))[0] = 0; ((int*)(ws + OFF_CTR))[1] = 0; }
  char* lq = smem;
  char* lk = smem + 32768;
  for (int tile = bid; tile < 512; tile += nblk) {
    const int n = tile >> 2, head = tile & 3, t0 = n * 64, d = t, col = head * 256 + d;
    float w2[16];
#pragma unroll
    for (int j = 0; j < 16; j++) w2[j] = p.w_gk2[j * 1024 + col];
    const float bias = p.b_gk[col];
    float b = 0.f;
    const int dperm = (d & ~15) | ((d & 3) | ((d & 4) << 1) | ((d & 8) >> 1));
    for (int c8 = 0; c8 < 8; c8++) {
      float bj[8], qv[8], kv[8];
#pragma unroll
      for (int j = 0; j < 8; j++) {
        const int c = c8 * 8 + j;
        const float4* gl = (const float4*)(GKL + (size_t)(t0 + c) * 16);
        float4 g0 = gl[0], g1 = gl[1], g2 = gl[2], g3 = gl[3];
        float gk = bias + g0.x * w2[0] + g0.y * w2[1] + g0.z * w2[2] + g0.w * w2[3] + g1.x * w2[4] + g1.y * w2[5] + g1.z * w2[6] + g1.w * w2[7]
                 + g2.x * w2[8] + g2.y * w2[9] + g2.z * w2[10] + g2.w * w2[11] + g3.x * w2[12] + g3.y * w2[13] + g3.z * w2[14] + g3.w * w2[15];
        float la = (fminf(gk, 0.f) - __logf(1.f + __expf(-fabsf(gk)))) * (1.f / 16.f);
        b += la;
        bj[j] = b;
        qv[j] = bf2f(QK[(size_t)(t0 + c) * 2048 + col]);
        kv[j] = bf2f(QK[(size_t)(t0 + c) * 2048 + 1024 + col]);
      }
      unsigned klp[4];
#pragma unroll
      for (int j = 0; j < 8; j++) {
        const int c = c8 * 8 + j;
        const float qe = qv[j] * 0.0625f * __expf(bj[j]);
        const float ke = kv[j] * __expf(-bj[j]);
        const unsigned qeb = f2bf(qe), keb = f2bf(ke), klb = keb;
        const int lo = c * 512 + ((((d >> 3) ^ (c & 15))) << 4) + (d & 7) * 2;
        *(unsigned short*)(lq + lo) = (unsigned short)qeb;
        *(unsigned short*)(lk + lo) = (unsigned short)keb;
        QE[(size_t)(t0 + c) * 1024 + head * 256 + dperm] = (bf16_t)qeb;
        if (j & 1) klp[j >> 1] |= klb << 16; else klp[j >> 1] = klb;
      }
      uint4 o; o.x = klp[0]; o.y = klp[1]; o.z = klp[2]; o.w = klp[3];
      *(uint4*)(KLT + (size_t)(head * 256 + d) * S_ + t0 + c8 * 8) = o;
    }
    DEC[(size_t)(n * 4 + head) * 256 + d] = __expf(b);
    __syncthreads();
    {
      const int ct = w >> 1, st = w & 1;
      f32x16 acc;
#pragma unroll
      for (int i = 0; i < 16; i++) acc[i] = 0.f;
      if (!(ct == 0 && st == 1)) {
        const int ra = ct * 32 + r, rb = st * 32 + r;
#pragma unroll
        for (int s = 0; s < 16; s++) {
          bf16x8 a = *(const bf16x8*)(lq + ra * 512 + (((2 * s + h) ^ (ra & 15)) << 4));
          bf16x8 bb = *(const bf16x8*)(lk + rb * 512 + (((2 * s + h) ^ (rb & 15)) << 4));
          acc = MFMA32(a, bb, acc);
        }
      }
      bf16_t* ap = AM + (size_t)(n * 4 + head) * 4096;
#pragma unroll
      for (int i = 0; i < 16; i++) {
        const int c = ct * 32 + crow(i, h), s = st * 32 + r;
        ap[c * 64 + s] = (bf16_t)f2bf(s <= c ? acc[i] : 0.f);
      }
    }
    __syncthreads();
  }
}

constexpr int SCAN_NG = 8, SCAN_GC = 16;
DI void phase_gla_local(const Params& p, char* smem, int bid, int nblk) {
  char* ws = opaque_ptr(p.ws);
  const int t = TID, lane = t & 63, w = t >> 6, r = lane & 31, h = lane >> 5;
  for (int item = bid; item < 64 * (SCAN_NG - 1); item += nblk) {
    const int grp = item >> 6, head = (item >> 4) & 3, dvt = item & 15, dv0 = dvt * 32;
    const int nb = grp * SCAN_GC;
    const bf16_t* v_p = (const bf16_t*)(ws + OFF_V0T) + (size_t)(head * 512 + dv0 + r) * S_ + nb * 64 + 8 * h;
    const bf16_t* kl_p = (const bf16_t*)(ws + OFF_KLT) + (size_t)(head * 256 + 64 * w + r) * S_ + nb * 64 + 8 * h;
    const float* dec_p = (const float*)(ws + OFF_DECAY) + (size_t)nb * 1024 + head * 256 + 64 * w + 4 * h;
    f32x16 St[2];
#pragma unroll
    for (int i = 0; i < 16; i++) { St[0][i] = 0.f; St[1][i] = 0.f; }
    bf16x8 klA[2][4], vfA[4], klB[2][4], vfB[4];
    float4 dcA[2][4], dcB[2][4];
#define LOC_LOAD(KL, VF, DC, n_)                                                                                 \
    {                                                                                                            \
      _Pragma("unroll") for (int s = 0; s < 4; s++) VF[s] = *(const bf16x8*)(v_p + (n_) * 64 + 16 * s);        \
      _Pragma("unroll") for (int dt = 0; dt < 2; dt++) {                                                         \
        _Pragma("unroll") for (int s = 0; s < 4; s++) KL[dt][s] = *(const bf16x8*)(kl_p + (size_t)dt * 32 * S_ + (n_) * 64 + 16 * s); \
        _Pragma("unroll") for (int g4 = 0; g4 < 4; g4++) DC[dt][g4] = *(const float4*)(dec_p + (size_t)(n_) * 1024 + dt * 32 + 8 * g4); \
      }                                                                                                          \
    }
#define LOC_STEP(KL, VF, DC)                                                                                     \
    {                                                                                                            \
      _Pragma("unroll") for (int dt = 0; dt < 2; dt++) {                                                         \
        _Pragma("unroll") for (int s = 0; s < 4; s++) St[dt] = MFMA32(KL[dt][s], VF[s], St[dt]);                 \
        _Pragma("unroll") for (int g4 = 0; g4 < 4; g4++) {                                                       \
          St[dt][4 * g4 + 0] *= DC[dt][g4].x; St[dt][4 * g4 + 1] *= DC[dt][g4].y;                                \
          St[dt][4 * g4 + 2] *= DC[dt][g4].z; St[dt][4 * g4 + 3] *= DC[dt][g4].w;                                \
        }                                                                                                        \
      }                                                                                                          \
    }
    LOC_LOAD(klA, vfA, dcA, 0)
    for (int n = 0; n < SCAN_GC; n += 2) {
      LOC_LOAD(klB, vfB, dcB, n + 1)
      LOC_STEP(klA, vfA, dcA)
      if (n + 2 < SCAN_GC) LOC_LOAD(klA, vfA, dcA, n + 2)
      LOC_STEP(klB, vfB, dcB)
    }
#undef LOC_LOAD
#undef LOC_STEP
    float* sl = (float*)(ws + OFF_SL) + ((size_t)((grp * 4 + head) * 16 + dvt) * 4 + w) * 2048 + lane;
#pragma unroll
    for (int dt = 0; dt < 2; dt++)
#pragma unroll
      for (int i = 0; i < 16; i++) sl[(dt * 16 + i) * 64] = St[dt][i];
    if (dvt == 0) {
      const float* dg = (const float*)(ws + OFF_DECAY) + (size_t)nb * 1024 + head * 256 + t;
      float pr = 1.f;
#pragma unroll 4
      for (int n = 0; n < SCAN_GC; n++) pr *= dg[(size_t)n * 1024];
      ((float*)(ws + OFF_DC))[(grp * 4 + head) * 256 + t] = pr;
    }
  }
}

DI void phase_gla_scan(const Params& p, char* smem, int bid, int nblk) {
  char* ws = opaque_ptr(p.ws);
  const int t = TID, lane = t & 63, w = t >> 6, r = lane & 31, h = lane >> 5;
  float* lo = (float*)smem;
  for (int item = bid; item < 64 * SCAN_NG; item += nblk) {
    const int grp = item >> 6, head = (item >> 4) & 3, dvt = item & 15, dv0 = dvt * 32;
    const int nb = grp * SCAN_GC, ne = nb + SCAN_GC;
    const bf16_t* qe_p = (const bf16_t*)(ws + OFF_QE) + (size_t)r * 1024 + head * 256 + 64 * w + 8 * h;
    const bf16_t* a_p = (const bf16_t*)(ws + OFF_AM) + (size_t)head * 4096 + (size_t)r * 64 + 16 * w + 8 * h;
    const bf16_t* v_p = (const bf16_t*)(ws + OFF_V0T) + (size_t)(head * 512 + dv0 + r) * S_ + 8 * h;
    const bf16_t* kl_p = (const bf16_t*)(ws + OFF_KLT) + (size_t)(head * 256 + 64 * w + r) * S_ + 8 * h;
    bf16_t* o_p = (bf16_t*)(ws + OFF_QK0) + (size_t)(t >> 2) * 2048 + head * 512 + dv0 + (t & 3) * 8;
    f32x16 St[2];
#pragma unroll
    for (int i = 0; i < 16; i++) { St[0][i] = 0.f; St[1][i] = 0.f; }
    for (int j = 0; j < grp; j++) {
      const float* slj = (const float*)(ws + OFF_SL) + ((size_t)((j * 4 + head) * 16 + dvt) * 4 + w) * 2048 + lane;
      const float* dcj = (const float*)(ws + OFF_DC) + (j * 4 + head) * 256 + 64 * w + 4 * h;
#pragma unroll
      for (int dt = 0; dt < 2; dt++)
#pragma unroll
        for (int g4 = 0; g4 < 4; g4++) {
          const float4 dv = *(const float4*)(dcj + 32 * dt + 8 * g4);
          St[dt][4 * g4 + 0] = St[dt][4 * g4 + 0] * dv.x + slj[(dt * 16 + 4 * g4 + 0) * 64];
          St[dt][4 * g4 + 1] = St[dt][4 * g4 + 1] * dv.y + slj[(dt * 16 + 4 * g4 + 1) * 64];
          St[dt][4 * g4 + 2] = St[dt][4 * g4 + 2] * dv.z + slj[(dt * 16 + 4 * g4 + 2) * 64];
          St[dt][4 * g4 + 3] = St[dt][4 * g4 + 3] * dv.w + slj[(dt * 16 + 4 * g4 + 3) * 64];
        }
    }
    qe_p += (size_t)nb * 64 * 1024; a_p += (size_t)nb * 4 * 4096; v_p += nb * 64; kl_p += nb * 64; o_p += (size_t)nb * 64 * 2048;
    bf16x8 qe[2][4], af[2], vf[4], kl[2][4];
    float* ldec = (float*)(smem + 32768);
    const float* dec_g = (const float*)(ws + OFF_DECAY) + (size_t)nb * 1024 + head * 256 + t;
#pragma unroll
    for (int ct = 0; ct < 2; ct++) {
#pragma unroll
      for (int s = 0; s < 4; s++) qe[ct][s] = *(const bf16x8*)(qe_p + (size_t)ct * 32 * 1024 + 16 * s);
      af[ct] = *(const bf16x8*)(a_p + ct * 32 * 64);
    }
#pragma unroll
    for (int s = 0; s < 4; s++) vf[s] = *(const bf16x8*)(v_p + 16 * s);
#pragma unroll
    for (int dt = 0; dt < 2; dt++) {
#pragma unroll
      for (int s = 0; s < 4; s++) kl[dt][s] = *(const bf16x8*)(kl_p + (size_t)dt * 32 * S_ + 16 * s);
    }
    __syncthreads();
    ldec[t] = dec_g[0];
    __syncthreads();
    for (int n = 0; n < SCAN_GC; n++) {
      const bool more = (n + 1 < SCAN_GC);
      float decn = 0.f;
      if (more) decn = dec_g[(size_t)(n + 1) * 1024];
      f32x16 o[2];
#pragma unroll
      for (int i = 0; i < 16; i++) { o[0][i] = 0.f; o[1][i] = 0.f; }
#pragma unroll
      for (int s = 0; s < 4; s++) {
        bf16x8 sb = pack8(St[s >> 1], s & 1);
        o[0] = MFMA32(qe[0][s], sb, o[0]);
        o[1] = MFMA32(qe[1][s], sb, o[1]);
      }
      if (more) {
        const bf16_t* q2 = qe_p + (size_t)(n + 1) * 64 * 1024;
#pragma unroll
        for (int ct = 0; ct < 2; ct++)
#pragma unroll
          for (int s = 0; s < 4; s++) qe[ct][s] = *(const bf16x8*)(q2 + (size_t)ct * 32 * 1024 + 16 * s);
      }
      {
        bf16x8 vw = (w == 0) ? vf[0] : (w == 1) ? vf[1] : (w == 2) ? vf[2] : vf[3];
        o[0] = MFMA32(af[0], vw, o[0]);
        o[1] = MFMA32(af[1], vw, o[1]);
      }
      if (more) {
        const bf16_t* a2 = a_p + (size_t)(n + 1) * 4 * 4096;
        af[0] = *(const bf16x8*)(a2); af[1] = *(const bf16x8*)(a2 + 32 * 64);
      }
#pragma unroll
      for (int dt = 0; dt < 2; dt++) {
#pragma unroll
        for (int s = 0; s < 4; s++) St[dt] = MFMA32(kl[dt][s], vf[s], St[dt]);
#pragma unroll
        for (int g = 0; g < 4; g++) {
          const float4 dv = *(const float4*)(ldec + (n & 1) * 256 + 64 * w + 32 * dt + 8 * g + 4 * h);
          St[dt][4 * g + 0] *= dv.x; St[dt][4 * g + 1] *= dv.y;
          St[dt][4 * g + 2] *= dv.z; St[dt][4 * g + 3] *= dv.w;
        }
      }
      if (more) {
        const int tn = (n + 1) * 64;
#pragma unroll
        for (int s = 0; s < 4; s++) vf[s] = *(const bf16x8*)(v_p + tn + 16 * s);
#pragma unroll
        for (int dt = 0; dt < 2; dt++) {
#pragma unroll
          for (int s = 0; s < 4; s++) kl[dt][s] = *(const bf16x8*)(kl_p + (size_t)dt * 32 * S_ + tn + 16 * s);
        }
      }
      ldec[((n + 1) & 1) * 256 + t] = decn;
#pragma unroll
      for (int ct = 0; ct < 2; ct++)
#pragma unroll
        for (int i = 0; i < 16; i++) lo[(w * 64 + ct * 32 + crow(i, h)) * 32 + r] = o[ct][i];
      __syncthreads();
      {
        const int c = t >> 2, vg = (t & 3) * 8;
        float4 s0 = *(const float4*)(lo + c * 32 + vg), s1 = *(const float4*)(lo + c * 32 + vg + 4);
#pragma unroll
        for (int ww = 1; ww < 4; ww++) {
          float4 x0 = *(const float4*)(lo + (ww * 64 + c) * 32 + vg), x1 = *(const float4*)(lo + (ww * 64 + c) * 32 + vg + 4);
          s0.x += x0.x; s0.y += x0.y; s0.z += x0.z; s0.w += x0.w; s1.x += x1.x; s1.y += x1.y; s1.z += x1.z; s1.w += x1.w;
        }
        uint4 ov; ov.x = pack2(s0.x, s0.y); ov.y = pack2(s0.z, s0.w); ov.z = pack2(s1.x, s1.y); ov.w = pack2(s1.z, s1.w);
        *(uint4*)(o_p + (size_t)n * 64 * 2048) = ov;
      }
      __syncthreads();
    }
  }
}

DI void phase_og(const Params& p, char* smem, int bid, int nblk) {
  char* ws = opaque_ptr(p.ws);
  const int t = TID, lane = t & 63, w = t >> 6;
  const bf16_t* O0 = (const bf16_t*)(ws + OFF_QK0);
  const bf16_t* G0 = (const bf16_t*)(ws + OFF_G0);
  bf16_t* OG = (bf16_t*)(ws + OFF_H);
  const float4* gp = (const float4*)(p.g_onorm + lane * 8);
  const float4 ga = gp[0], gb = gp[1];
  for (int token = bid; token < S_; token += 4 * nblk) {
    uint4 ov[4], gv[4];
#pragma unroll
    for (int u = 0; u < 4; u++) {
      const int tk = token + u * nblk;
      const size_t off = (size_t)(tk < S_ ? tk : token) * 2048 + w * 512 + lane * 8;
      ov[u] = ld_nt((const uint4*)(O0 + off));
      gv[u] = ld_nt((const uint4*)(G0 + off));
    }
#pragma unroll
    for (int u = 0; u < 4; u++) {
      const int tk = token + u * nblk;
      const size_t off = (size_t)tk * 2048 + w * 512 + lane * 8;
      const float f0 = bflo(ov[u].x), f1 = bfhi(ov[u].x), f2 = bflo(ov[u].y), f3 = bfhi(ov[u].y);
      const float f4 = bflo(ov[u].z), f5 = bfhi(ov[u].z), f6 = bflo(ov[u].w), f7 = bfhi(ov[u].w);
      float ss = f0 * f0 + f1 * f1 + f2 * f2 + f3 * f3 + f4 * f4 + f5 * f5 + f6 * f6 + f7 * f7;
      ss = wave_sum(ss);
      const float rinv = rsqrtf(ss * (1.f / 512.f) + 1e-6f);
      uint4 o;
      o.x = pack2(f0 * rinv * ga.x * bflo(gv[u].x), f1 * rinv * ga.y * bfhi(gv[u].x));
      o.y = pack2(f2 * rinv * ga.z * bflo(gv[u].y), f3 * rinv * ga.w * bfhi(gv[u].y));
      o.z = pack2(f4 * rinv * gb.x * bflo(gv[u].z), f5 * rinv * gb.y * bfhi(gv[u].z));
      o.w = pack2(f6 * rinv * gb.z * bflo(gv[u].w), f7 * rinv * gb.w * bfhi(gv[u].w));
      if (tk < S_) *(uint4*)(OG + off) = o;
    }
  }
}

DI void phase_gemm_out(const Params& p, char* smem, int bid, int nblk, size_t off_w) {
  char* ws = opaque_ptr(p.ws);
  const bf16_t* A = (const bf16_t*)(ws + OFF_H);
  const bf16_t* B = (const bf16_t*)(ws + off_w);
  bf16_t* Y = (bf16_t*)(ws + OFF_Y);
  for (int tile = bid; tile < 32 * 16; tile += nblk) {
    const int mi = tile & 31, ni = tile >> 5;
    const int m0 = mi * 256, n0 = ni * 128;
    f32x16 acc[4][2];
    gemm_main_dma<false>(acc, A, 2048, B, 2048, 2048, m0, n0, smem);
    EPI_LOOP_BEGIN EPI_COORD_NS
      Y[(size_t)row * 2048 + col] = (bf16_t)f2bf(v);
    EPI_LOOP_END
  }
}

DI void phase_post0(const Params& p, char* smem, int bid, int nblk) {
  char* ws = opaque_ptr(p.ws);
  const int t = TID, lane = t & 63, w = t >> 6;
  const bf16_t* Y = (const bf16_t*)(ws + OFF_Y);
  const float4* gpo = (const float4*)p.l0_post + lane;
  const float4* gpr = (const float4*)p.l1_pre + lane;
  for (int row = bid * 4 + w; row < S_; row += nblk * 4) {
    const uint2* yr = (const uint2*)(Y + (size_t)row * 2048) + lane;
    const float4* xr = (const float4*)(p.x + (size_t)row * 2048) + lane;
    float4 yv[8], xv[8];
#pragma unroll
    for (int j = 0; j < 8; j++) { const uint2 u = ld_nt(yr + j * 64); yv[j].x = bflo(u.x); yv[j].y = bfhi(u.x); yv[j].z = bflo(u.y); yv[j].w = bfhi(u.y); xv[j] = ld_nt(xr + j * 64); }
    float ss = 0.f;
#pragma unroll
    for (int j = 0; j < 8; j++) ss += yv[j].x * yv[j].x + yv[j].y * yv[j].y + yv[j].z * yv[j].z + yv[j].w * yv[j].w;
    ss = wave_sum(ss);
    const float rinv = rsqrtf(ss * (1.f / 2048.f) + 1e-6f);
    float4* outr = (float4*)(p.out + (size_t)row * 2048) + lane;
    float s2 = 0.f;
#pragma unroll
    for (int j = 0; j < 8; j++) {
      const float4 g = gpo[j * 64];
      xv[j].x += yv[j].x * rinv * g.x; xv[j].y += yv[j].y * rinv * g.y; xv[j].z += yv[j].z * rinv * g.z; xv[j].w += yv[j].w * rinv * g.w;
      outr[j * 64] = xv[j];
      s2 += xv[j].x * xv[j].x + xv[j].y * xv[j].y + xv[j].z * xv[j].z + xv[j].w * xv[j].w;
    }
    s2 = wave_sum(s2);
    const float r2 = rsqrtf(s2 * (1.f / 2048.f) + 1e-6f);
    uint2* hr = (uint2*)(ws + OFF_H + (size_t)row * 4096) + lane;
#pragma unroll
    for (int j = 0; j < 8; j++) {
      const float4 g = gpr[j * 64];
      uint2 o; o.x = pack2(xv[j].x * r2 * g.x, xv[j].y * r2 * g.y); o.y = pack2(xv[j].z * r2 * g.z, xv[j].w * r2 * g.w);
      hr[j * 64] = o;
    }
  }
}

DI void phase_gemm_in1(const Params& p, char* smem, int bid, int nblk) {
  char* ws = opaque_ptr(p.ws);
  const bf16_t* A = (const bf16_t*)(ws + OFF_H);
  const bf16_t* B = (const bf16_t*)(ws + OFF_WIN1T);
  bf16_t* CQ = (bf16_t*)(ws + OFF_CQ);
  bf16_t* CKV = (bf16_t*)(ws + OFF_CKV);
  bf16_t* KR = (bf16_t*)(ws + OFF_KR);
  const float* cs = (const float*)(ws + OFF_CS);
  bf16_t* G1 = (bf16_t*)(ws + OFF_QK0);
  for (int tile = bid; tile < 32 * 25; tile += nblk) {
    const int mi = tile & 31, ni = tile >> 5;
    const int m0 = mi * 256, n0 = ni * 128;
    f32x16 acc[4][2];
    gemm_main_dma<false>(acc, A, 2048, B, 2048, 2048, m0, n0, smem);
    if (ni < 4) {
      EPI_LOOP_BEGIN EPI_COORD_NS
        CQ[(size_t)row * 512 + col] = (bf16_t)f2bf(v);
      EPI_LOOP_END
    } else if (ni < 8) {
      EPI_LOOP_BEGIN EPI_COORD_NS
        CKV[(size_t)row * 512 + (col - 512)] = (bf16_t)f2bf(v);
      EPI_LOOP_END
    } else if (ni == 8 && ((TID >> 6) & 1) == 0) {
      const int lane_ = TID & 63, w_ = TID >> 6, wm_ = w_ >> 1, r_ = lane_ & 31, h_ = lane_ >> 5;
#pragma unroll
      for (int mt = 0; mt < 4; mt++)
#pragma unroll
        for (int i = 0; i < 16; i++) {
          const int row = m0 + wm_ * 128 + mt * 32 + crow(i, h_);
          const float t1 = acc[mt][0][i], t2 = acc[mt][1][i];
          const float c = cs[row * 64 + r_], sn = cs[row * 64 + 32 + r_];
          KR[(size_t)row * 64 + r_] = (bf16_t)f2bf(t1 * c - t2 * sn);
          KR[(size_t)row * 64 + 32 + r_] = (bf16_t)f2bf(t2 * c + t1 * sn);
        }
    } else {
      EPI_LOOP_BEGIN EPI_COORD_NS
        if (col < 3136) G1[(size_t)row * 2048 + (col - 1088)] = (bf16_t)f2bf(silu(v));
      EPI_LOOP_END
    }
  }
}

DI void phase_gemm_qkv(const Params& p, char* smem, int bid, int nblk) {
  char* ws = opaque_ptr(p.ws);
  const bf16_t* CQ = (const bf16_t*)(ws + OFF_CQ);
  const bf16_t* CKV = (const bf16_t*)(ws + OFF_CKV);
  const bf16_t* WQ = (const bf16_t*)(ws + OFF_WQBT);
  const bf16_t* WKV = (const bf16_t*)(ws + OFF_WKVBT);
  const float* cs = (const float*)(ws + OFF_CS);
  bf16_t* Q = (bf16_t*)(ws + OFF_Q);
  bf16_t* KN = (bf16_t*)(ws + OFF_KN);
  bf16_t* VT = (bf16_t*)(ws + OFF_VT);
  const float qscale = 0.07216878364870322f * 1.4426950408889634f;
  const int ntq = 32 * 24, ntkv = 32 * 32;
  for (int tile = bid; tile < ntq + ntkv; tile += nblk) {
    f32x16 acc[4][2];
    if (tile < ntq) {
      const int mi = tile & 31, ni = tile >> 5;
      const int m0 = mi * 256, n0 = ni * 128;
      gemm_main<false, true>(acc, CQ, 512, WQ, 512, 512, m0, n0, smem);
      const float* rf = (const float*)(smem + 49152);
      const int lane_ = TID & 63, w_ = TID >> 6, wm_ = w_ >> 1, wn_ = w_ & 1, r_ = lane_ & 31, h_ = lane_ >> 5;
      const int cb = n0 + wn_ * 64;
      const int head = cb / 192, jb = cb - head * 192;
      if (jb == 128) {
#pragma unroll
        for (int mt = 0; mt < 4; mt++)
#pragma unroll
          for (int i = 0; i < 16; i++) {
            const int row = m0 + wm_ * 128 + mt * 32 + crow(i, h_);
            const float sc = rf[row - m0] * qscale;
            const float t1 = acc[mt][0][i] * sc, t2 = acc[mt][1][i] * sc;
            const float c = cs[row * 64 + r_], s = cs[row * 64 + 32 + r_];
            bf16_t* qp = Q + ((size_t)head * S_ + row) * 192 + 128;
            qp[r_] = (bf16_t)f2bf(t1 * c - t2 * s);
            qp[32 + r_] = (bf16_t)f2bf(t2 * c + t1 * s);
          }
      } else {
#pragma unroll
        for (int mt = 0; mt < 4; mt++)
#pragma unroll
          for (int nt = 0; nt < 2; nt++)
#pragma unroll
            for (int i = 0; i < 16; i++) {
              const int row = m0 + wm_ * 128 + mt * 32 + crow(i, h_);
              const float sc = rf[row - m0] * qscale;
              Q[((size_t)head * S_ + row) * 192 + jb + nt * 32 + r_] = (bf16_t)f2bf(acc[mt][nt][i] * sc);
            }
      }
    } else {
      const int tl = tile - ntq;
      const int mi = tl & 31, ni = tl >> 5;
      const int m0 = mi * 256, n0 = ni * 128;
      const int head = ni >> 1;
      if (ni & 1) {
        gemm_main<true, true>(acc, CKV, 512, WKV, 512, 512, m0, n0, smem);
        const float* rf = (const float*)(smem + 49152);
        EPI_LOOP_BEGIN EPI_COORD_SW
          const int j = col - head * 256 - 128;
          VT[((size_t)head * 128 + j) * S_ + row] = (bf16_t)f2bf(v * rf[row - m0]);
        EPI_LOOP_END
      } else {
        gemm_main<false, true>(acc, CKV, 512, WKV, 512, 512, m0, n0, smem);
        const float* rf = (const float*)(smem + 49152);
        EPI_LOOP_BEGIN EPI_COORD_NS
          const int j = col - head * 256;
          KN[((size_t)head * S_ + row) * 128 + j] = (bf16_t)f2bf(v * rf[row - m0]);
        EPI_LOOP_END
      }
    }
  }
}

DI void phase_attn(const Params& p, char* smem, int bid, int nblk, int rep) {
  char* ws = opaque_ptr(p.ws);
  const int t = TID, lane = t & 63, w = t >> 6, r = lane & 31, h = lane >> 5;
  const bf16_t* Q = (const bf16_t*)(ws + OFF_Q);
  const bf16_t* KN = (const bf16_t*)(ws + OFF_KN);
  const bf16_t* KR = (const bf16_t*)(ws + OFF_KR);
  const bf16_t* VT = (const bf16_t*)(ws + OFF_VT);
  const bf16_t* G1 = (const bf16_t*)(ws + OFF_QK0);
  bf16_t* OG = (bf16_t*)(ws + OFF_H);
  int* ctr = (int*)(ws + OFF_CTR) + rep;
  char* lk = smem;
  char* lv = smem + 25600;
  int* s_item = (int*)(smem + 44032);
  const int k_row = t >> 2, k_c0 = t & 3;
  const int v_row0 = t >> 3, v_kc = t & 7;
  for (;;) {
    __syncthreads();
    if (t == 0) *s_item = atomicAdd(ctr, 1);
    __syncthreads();
    const int item = *s_item;
    if (item >= 1024) break;
    const int qb = 63 - (item >> 4), head = item & 15;
    const int q0w = qb * 128 + w * 32;
    const int ntile = 2 * qb + 2;
    bf16x8 qf[12];
    {
      const bf16_t* qp = Q + ((size_t)head * S_ + q0w + r) * 192 + 8 * h;
#pragma unroll
      for (int s = 0; s < 12; s++) qf[s] = *(const bf16x8*)(qp + 16 * s);
    }
    f32x16 oacc[4];
#pragma unroll
    for (int vt = 0; vt < 4; vt++)
#pragma unroll
      for (int i = 0; i < 16; i++) oacc[vt][i] = 0.f;
    float m_run = -INFINITY, l_run = 0.f;
    uint4 kg0, kg1, kg2, kg3, kg4, kg5, vg0, vg1, vg2, vg3;
    const bf16_t* knp = KN + (size_t)head * S_ * 128;
    const bf16_t* vtp = VT + ((size_t)head * 128 + v_row0) * S_ + v_kc * 8;
#define ATT_LOAD(k0_)                                                                                         \
    {                                                                                                         \
      const bf16_t* kn_ = knp + (size_t)((k0_) + k_row) * 128 + k_c0 * 8;                                     \
      const bf16_t* kr_ = KR + (size_t)((k0_) + k_row) * 64 + k_c0 * 8;                                       \
      const bf16_t* vp_ = vtp + (k0_);                                                                        \
      kg0 = *(const uint4*)(kn_); kg1 = *(const uint4*)(kn_ + 32); kg2 = *(const uint4*)(kn_ + 64); kg3 = *(const uint4*)(kn_ + 96); \
      kg4 = *(const uint4*)(kr_); kg5 = *(const uint4*)(kr_ + 32);                                            \
      vg0 = *(const uint4*)(vp_); vg1 = *(const uint4*)(vp_ + (size_t)32 * S_);                               \
      vg2 = *(const uint4*)(vp_ + (size_t)64 * S_); vg3 = *(const uint4*)(vp_ + (size_t)96 * S_);             \
    }
    ATT_LOAD(0)
    for (int kt = 0; kt < ntile; kt++) {
      const int k0 = kt * 64;
      __syncthreads();
      {
        char* kd = lk + k_row * 400 + k_c0 * 16;
        *(uint4*)(kd) = kg0; *(uint4*)(kd + 64) = kg1; *(uint4*)(kd + 128) = kg2; *(uint4*)(kd + 192) = kg3;
        *(uint4*)(kd + 256) = kg4; *(uint4*)(kd + 320) = kg5;
        char* vd = lv + v_row0 * 144 + (v_kc >> 1) * 32 + (v_kc & 1) * 8;
#define VST(o_, v_) { uint2 u0, u1; u0.x = v_.x; u0.y = v_.y; u1.x = v_.z; u1.y = v_.w; *(uint2*)(vd + (o_)) = u0; *(uint2*)(vd + (o_) + 16) = u1; }
        VST(0, vg0) VST(32 * 144, vg1) VST(64 * 144, vg2) VST(96 * 144, vg3)
#undef VST
      }
      __syncthreads();
      { const int knext = (kt + 1 < ntile) ? k0 + 64 : k0; ATT_LOAD(knext) }
      if (k0 <= q0w + 31) {
        f32x16 sc[2];
#pragma unroll
        for (int i = 0; i < 16; i++) { sc[0][i] = 0.f; sc[1][i] = 0.f; }
        __builtin_amdgcn_s_setprio(1);
#pragma unroll
        for (int s = 0; s < 12; s++) {
          bf16x8 a0 = *(const bf16x8*)(lk + r * 400 + h * 16 + s * 32);
          bf16x8 a1 = *(const bf16x8*)(lk + r * 400 + h * 16 + 32 * 400 + s * 32);
          sc[0] = MFMA32(a0, qf[s], sc[0]);
          sc[1] = MFMA32(a1, qf[s], sc[1]);
        }
        __builtin_amdgcn_s_setprio(0);
        if (k0 + 63 > q0w) {
          const int qg = q0w + r;
#pragma unroll
          for (int mt = 0; mt < 2; mt++)
#pragma unroll
            for (int i = 0; i < 16; i++) {
              const int key = k0 + mt * 32 + crow(i, h);
              if (key > qg) sc[mt][i] = -INFINITY;
            }
        }
        float mx = sc[0][0];
#pragma unroll
        for (int i = 1; i < 16; i++) mx = fmaxf(mx, sc[0][i]);
#pragma unroll
        for (int i = 0; i < 16; i++) mx = fmaxf(mx, sc[1][i]);
        mx = fmaxf(mx, __shfl_xor(mx, 32));
        const float m_new = (mx > m_run + 8.f) ? mx : m_run;
        const bool resc = __any(m_new != m_run);
        const float alpha = __builtin_amdgcn_exp2f(m_run - m_new);
        m_run = m_new;
        float ls = 0.f;
#pragma unroll
        for (int mt = 0; mt < 2; mt++)
#pragma unroll
          for (int i = 0; i < 16; i++) { const float pv = __builtin_amdgcn_exp2f(sc[mt][i] - m_new); sc[mt][i] = pv; ls += pv; }
        l_run = l_run * alpha + ls;
        if (resc) {
#pragma unroll
          for (int vt = 0; vt < 4; vt++)
#pragma unroll
            for (int i = 0; i < 16; i++) oacc[vt][i] *= alpha;
        }
        __builtin_amdgcn_s_setprio(1);
#pragma unroll
        for (int s = 0; s < 4; s++) {
          const bf16x8 pb = pack8(sc[s >> 1], s & 1);
#pragma unroll
          for (int vt = 0; vt < 4; vt++) {
            const bf16x8 a = *(const bf16x8*)(lv + r * 144 + h * 16 + vt * 32 * 144 + s * 32);
            oacc[vt] = MFMA32(a, pb, oacc[vt]);
          }
        }
        __builtin_amdgcn_s_setprio(0);
      }
    }
#undef ATT_LOAD
    const float l_tot = l_run + __shfl_xor(l_run, 32);
    const float inv = 1.f / l_tot;
    const size_t obase = (size_t)(q0w + r) * 2048 + head * 128;
#pragma unroll
    for (int vt = 0; vt < 4; vt++)
#pragma unroll
      for (int g = 0; g < 4; g++) {
        const int v = vt * 32 + 8 * g + 4 * h;
        uint2 gg = *(const uint2*)(G1 + obase + v);
        uint2 o;
        o.x = pack2(oacc[vt][4 * g + 0] * inv * bflo(gg.x), oacc[vt][4 * g + 1] * inv * bfhi(gg.x));
        o.y = pack2(oacc[vt][4 * g + 2] * inv * bflo(gg.y), oacc[vt][4 * g + 3] * inv * bfhi(gg.y));
        *(uint2*)(OG + obase + v) = o;
      }
  }
}

DI void phase_final(const Params& p, char* smem, int bid, int nblk) {
  char* ws = opaque_ptr(p.ws);
  const int t = TID, lane = t & 63, w = t >> 6;
  const bf16_t* Y = (const bf16_t*)(ws + OFF_Y);
  const float4* gpo = (const float4*)p.l1_post + lane;
  for (int row0 = bid * 4 + w; row0 < S_; row0 += nblk * 8) {
    const int row1r = row0 + nblk * 4;
    const bool has1 = row1r < S_;
    const int row1 = has1 ? row1r : row0;
    const uint2* yr0 = (const uint2*)(Y + (size_t)row0 * 2048) + lane;
    const uint2* yr1 = (const uint2*)(Y + (size_t)row1 * 2048) + lane;
    float4* out0 = (float4*)(p.out + (size_t)row0 * 2048) + lane;
    float4* out1 = (float4*)(p.out + (size_t)row1 * 2048) + lane;
    uint2 ya[8], yb[8];
    float4 xa[8], xb[8];
#pragma unroll
    for (int j = 0; j < 8; j++) { ya[j] = ld_nt(yr0 + j * 64); xa[j] = ld_nt((const float4*)out0 + j * 64); yb[j] = ld_nt(yr1 + j * 64); xb[j] = ld_nt((const float4*)out1 + j * 64); }
    float sa = 0.f, sb = 0.f;
#pragma unroll
    for (int j = 0; j < 8; j++) {
      sa += bflo(ya[j].x) * bflo(ya[j].x) + bfhi(ya[j].x) * bfhi(ya[j].x) + bflo(ya[j].y) * bflo(ya[j].y) + bfhi(ya[j].y) * bfhi(ya[j].y);
      sb += bflo(yb[j].x) * bflo(yb[j].x) + bfhi(yb[j].x) * bfhi(yb[j].x) + bflo(yb[j].y) * bflo(yb[j].y) + bfhi(yb[j].y) * bfhi(yb[j].y);
    }
    sa = wave_sum(sa); sb = wave_sum(sb);
    const float ra = rsqrtf(sa * (1.f / 2048.f) + 1e-6f), rb = rsqrtf(sb * (1.f / 2048.f) + 1e-6f);
#pragma unroll
    for (int j = 0; j < 8; j++) {
      const float4 g = gpo[j * 64];
      float4 o = xa[j];
      o.x += bflo(ya[j].x) * ra * g.x; o.y += bfhi(ya[j].x) * ra * g.y; o.z += bflo(ya[j].y) * ra * g.z; o.w += bfhi(ya[j].y) * ra * g.w;
      st_nt(out0 + j * 64, o);
      if (has1) {
        float4 q = xb[j];
        q.x += bflo(yb[j].x) * rb * g.x; q.y += bfhi(yb[j].x) * rb * g.y; q.z += bflo(yb[j].y) * rb * g.z; q.w += bfhi(yb[j].y) * rb * g.w;
        st_nt(out1 + j * 64, q);
      }
    }
  }
}

constexpr int NPHASE = 13;
constexpr unsigned DUP_MASK = 0u;
DI void run_phase(int ph, const Params& p, char* smem, int bid, int nblk, int rep) {
  switch (ph) {
    case 0: phase_prep(p, smem, bid, nblk); break;
    case 1: phase_gemm_in0(p, smem, bid, nblk); break;
    case 2: phase_gla_prep(p, smem, bid, nblk); break;
    case 3: phase_gla_local(p, smem, bid, nblk); break;
    case 4: phase_gla_scan(p, smem, bid, nblk); break;
    case 5: phase_og(p, smem, bid, nblk); break;
    case 6: phase_gemm_out(p, smem, bid, nblk, OFF_WOUT0T); break;
    case 7: phase_post0(p, smem, bid, nblk); break;
    case 8: phase_gemm_in1(p, smem, bid, nblk); break;
    case 9: phase_gemm_qkv(p, smem, bid, nblk); break;
    case 10: phase_attn(p, smem, bid, nblk, rep); break;
    case 11: phase_gemm_out(p, smem, bid, nblk, OFF_WOUT1T); break;
    case 12: phase_final(p, smem, bid, nblk); break;
  }
}

#define XB_TMO      128
#define XB_XCNT(j)  (256  + 64 * (j))
#define XB_XSUB(j)  (1280 + 64 * (j))
#define XB_XGEN(j)  (2304 + 64 * (j))
#define XB_TOP      3328
#define XB_TOPGEN   3392
#define XCD_BAR_WORDS 3456
#define XB_SPIN_CAP (1u << 20)
#define LAS __attribute__((address_space(3)))
DI unsigned xb_ld(unsigned* p) { return __hip_atomic_load(p, __ATOMIC_RELAXED, __HIP_MEMORY_SCOPE_AGENT); }
DI unsigned xb_add(unsigned* p, unsigned v) { return __hip_atomic_fetch_add(p, v, __ATOMIC_RELAXED, __HIP_MEMORY_SCOPE_AGENT); }
DI unsigned xb_xcc_id() { return (unsigned)__builtin_amdgcn_s_getreg((3 << 11) | 20) & 0xFu; }
#define XB_SPIN(cond, bar) do { unsigned _sp = 0; while (cond) { __builtin_amdgcn_s_sleep(1); \
    if ((++_sp & 255u) == 0u) { if (xb_ld(&(bar)[XB_TMO])) break; if (_sp > XB_SPIN_CAP) { atomicAdd(&(bar)[XB_TMO], 1u); break; } } } } while (0)
struct XcdBarrier { unsigned* bar; unsigned x; volatile LAS unsigned* st; };
DI XcdBarrier xcd_barrier_post(unsigned* bar, volatile LAS unsigned* st) {
  XcdBarrier b; b.bar = bar; b.x = xb_xcc_id(); b.st = st;
  if (threadIdx.x == 0) (void)xb_add(&bar[XB_XCNT(b.x)], 1u);
  return b;
}
DI void xcd_barrier_complete(unsigned* bar, unsigned x, unsigned& nloc, unsigned& nx) {
  const unsigned G = gridDim.x * gridDim.y * gridDim.z;
  unsigned sum, cnt, mine, sp = 0u;
  for (;;) {
    sum = 0u; cnt = 0u; mine = 0u;
#pragma unroll
    for (unsigned j = 0; j < 16; ++j) { const unsigned c = xb_ld(&bar[XB_XCNT(j)]); sum += c; cnt += (c > 0u) ? 1u : 0u; mine = (j == x) ? c : mine; }
    if (sum == G) break;
    __builtin_amdgcn_s_sleep(1);
    if ((++sp & 255u) == 0u) { if (xb_ld(&bar[XB_TMO])) break; if (sp > XB_SPIN_CAP) { atomicAdd(&bar[XB_TMO], 1u); break; } }
  }
  nloc = mine > 0u ? mine : 1u; nx = cnt > 0u ? cnt : 1u;
}
DI void xcd_barrier(const XcdBarrier& b) {
  asm volatile("s_waitcnt vmcnt(0)" ::: "memory");
  __syncthreads();
  if (threadIdx.x == 0) {
    unsigned* bar = b.bar;
    __builtin_amdgcn_s_waitcnt(0);
    unsigned nloc, nx;
    xcd_barrier_complete(bar, b.x, nloc, nx);
    const unsigned old = xb_add(&bar[XB_XSUB(b.x)], 1u);
    const unsigned gen = old / nloc;
    if (old + 1u == (gen + 1u) * nloc) {
      __builtin_amdgcn_fence(__ATOMIC_RELEASE, "agent");
      asm volatile("s_waitcnt vmcnt(0)" ::: "memory");
      const unsigned og = xb_add(&bar[XB_TOP], 1u);
      const unsigned tg = og / nx;
      if (og + 1u == (tg + 1u) * nx) xb_add(&bar[XB_TOPGEN], 1u);
      else XB_SPIN(xb_ld(&bar[XB_TOPGEN]) == tg, bar);
      __builtin_amdgcn_fence(__ATOMIC_ACQUIRE, "agent");
      xb_add(&bar[XB_XGEN(b.x)], 1u);
      asm volatile("s_waitcnt vmcnt(0)" ::: "memory");
    } else {
      XB_SPIN(xb_ld(&bar[XB_XGEN(b.x)]) == gen, bar);
      __builtin_amdgcn_fence(__ATOMIC_ACQUIRE, "agent");
      asm volatile("s_waitcnt vmcnt(0)" ::: "memory");
    }
  }
  __syncthreads();
}

#if MEGA
__global__ void __launch_bounds__(256, 2) mega_kernel(Params p) {
  __shared__ __attribute__((aligned(16))) char smem[73728];
  cg::grid_group grid = cg::this_grid();
  const int bid = blockIdx.x, nblk = gridDim.x;
  (void)xcd_barrier_post((unsigned*)(p.ws + OFF_BAR), (volatile LAS unsigned*)0);
#pragma nounroll
  for (int ph = 0; ph < NPHASE; ph++) {
    int phv = ph;
    asm volatile("" : "+s"(phv));
    run_phase(phv, p, smem, bid, nblk, 0);
    if (p.ws == nullptr) grid.sync();
    { XcdBarrier xb; xb.bar = (unsigned*)(opaque_ptr(p.ws) + OFF_BAR); xb.x = xb_xcc_id(); xb.st = (volatile LAS unsigned*)0; xcd_barrier(xb); }
    if ((DUP_MASK >> ph) & 1u) {
      run_phase(phv, p, smem, bid, nblk, 1);
      { XcdBarrier xb; xb.bar = (unsigned*)(opaque_ptr(p.ws) + OFF_BAR); xb.x = xb_xcc_id(); xb.st = (volatile LAS unsigned*)0; xcd_barrier(xb); }
    }
  }
}
#endif

#if !MEGA
template <int PH>
__global__ void __launch_bounds__(256, 2) phase_kernel_t(Params p) {
  __shared__ __attribute__((aligned(16))) char smem[73728];
  run_phase(PH, p, smem, blockIdx.x, gridDim.x, 0);
}
#endif

extern "C" void kernel_launch(void* const* d_in, const int* in_sizes, int n_in, void* d_out, int out_size, void* d_ws,
                              size_t ws_size, hipStream_t stream) {
  Params p{};
  p.x = (const float*)d_in[0]; p.pos = (const int*)d_in[1]; p.l0_pre = (const float*)d_in[2]; p.w_in0 = (const float*)d_in[3];
  p.w_gk2 = (const float*)d_in[4]; p.b_gk = (const float*)d_in[5]; p.g_onorm = (const float*)d_in[6]; p.w_out0 = (const float*)d_in[7];
  p.l0_post = (const float*)d_in[8]; p.l1_pre = (const float*)d_in[9]; p.w_in1 = (const float*)d_in[10]; p.g_qa = (const float*)d_in[11];
  p.w_qb = (const float*)d_in[12]; p.g_kva = (const float*)d_in[13]; p.w_kvb = (const float*)d_in[14]; p.w_out1 = (const float*)d_in[15];
  p.l1_post = (const float*)d_in[16];
  p.out = (float*)d_out; p.ws = (char*)d_ws;
  for (int i = 0; i < 32; i++) p.invf[i] = (float)pow(10000.0, -(double)i / 32.0);
#if MEGA
  static int grid_blocks = 0;
  if (!grid_blocks) {
    int dev = 0, cus = 0, per_cu = 0;
    hipGetDevice(&dev);
    hipDeviceGetAttribute(&cus, hipDeviceAttributeMultiprocessorCount, dev);
    hipOccupancyMaxActiveBlocksPerMultiprocessor(&per_cu, mega_kernel, 256, 0);
    if (per_cu > 2) per_cu = 2;
    if (per_cu < 1) per_cu = 1;
    grid_blocks = cus * per_cu;
  }
  hipMemsetAsync((char*)d_ws + OFF_BAR, 0, XCD_BAR_WORDS * 4, stream);
  void* args[] = {&p};
  hipError_t e = hipLaunchCooperativeKernel((void*)mega_kernel, dim3(grid_blocks), dim3(256), args, 0, stream);
  if (e != hipSuccess) fprintf(stderr, "cooperative launch failed: %s (grid %d)\n", hipGetErrorString(e), grid_blocks);
#else
#define LPH(N) hipLaunchKernelGGL(phase_kernel_t<N>, dim3(512), dim3(256), 0, stream, p);
  LPH(0) LPH(1) LPH(2) LPH(3) LPH(4) LPH(5) LPH(6) LPH(7) LPH(8) LPH(9) LPH(10) LPH(11) LPH(12)
#undef LPH
#endif
}
```

```cpp
#include <hip/hip_runtime.h>
#include <hip/hip_cooperative_groups.h>
#include <stdint.h>
#include <math.h>
#include <stdio.h>
namespace cg = cooperative_groups;

#ifndef MEGA
#define MEGA 1
#endif

typedef __attribute__((ext_vector_type(8))) short bf16x8;
typedef __attribute__((ext_vector_type(4))) short s16x4;
typedef __attribute__((ext_vector_type(16))) float f32x16;
typedef unsigned short bf16_t;
#define DI __device__ __forceinline__
#define MFMA32(a, b, c) __builtin_amdgcn_mfma_f32_32x32x16_bf16((a), (b), (c), 0, 0, 0)

constexpr int S_ = 8192;
constexpr size_t MiB = (size_t)1 << 20;
constexpr size_t OFF_WIN0T = 0;
constexpr size_t OFF_WOUT0T = 25 * MiB;
constexpr size_t OFF_WIN1T = 33 * MiB;
constexpr size_t OFF_WQBT = 46 * MiB;
constexpr size_t OFF_WKVBT = 49 * MiB;
constexpr size_t OFF_WOUT1T = 53 * MiB;
constexpr size_t OFF_GKLOW = 61 * MiB;
constexpr size_t OFF_DECAY = 61 * MiB + 512 * 1024;
constexpr size_t OFF_CS = 62 * MiB;
constexpr size_t OFF_H = 64 * MiB;
constexpr size_t OFF_QK0 = 96 * MiB;
constexpr size_t OFF_V0T = 128 * MiB;
constexpr size_t OFF_G0 = 160 * MiB;
constexpr size_t OFF_Y = 128 * MiB;
constexpr size_t OFF_QE = 192 * MiB;
constexpr size_t OFF_KLT = 208 * MiB;
constexpr size_t OFF_AM = 224 * MiB;
constexpr size_t OFF_CQ = 0;
constexpr size_t OFF_CKV = 8 * MiB;
constexpr size_t OFF_KR = 16 * MiB;
constexpr size_t OFF_RINVQ = 17 * MiB;
constexpr size_t OFF_RINVKV = 17 * MiB + 64 * 1024;
constexpr size_t OFF_KRRAW = 18 * MiB;
constexpr size_t OFF_CTR = 20 * MiB;
constexpr size_t OFF_BAR = 255 * MiB;
constexpr size_t OFF_SL = 64 * MiB;
constexpr size_t OFF_DC = 80 * MiB;
constexpr size_t OFF_Q = 128 * MiB;
constexpr size_t OFF_KN = 176 * MiB;
constexpr size_t OFF_VT = 208 * MiB;

struct Params {
  const float* x; const int* pos; const float* l0_pre; const float* w_in0; const float* w_gk2; const float* b_gk;
  const float* g_onorm; const float* w_out0; const float* l0_post; const float* l1_pre; const float* w_in1;
  const float* g_qa; const float* w_qb; const float* g_kva; const float* w_kvb; const float* w_out1; const float* l1_post;
  float* out; char* ws;
  float invf[32];
};

DI int tid_opaque() { int t = threadIdx.x; asm volatile("" : "+v"(t)); return t; }
#define TID tid_opaque()
typedef __attribute__((address_space(1))) char gchar_t;
DI char* opaque_ptr(char* q) {
  unsigned long long v = (unsigned long long)q;
  unsigned lo = __builtin_amdgcn_readfirstlane((unsigned)v), hi = __builtin_amdgcn_readfirstlane((unsigned)(v >> 32));
  asm volatile("" : "+s"(lo), "+s"(hi));
  return (char*)(gchar_t*)(((unsigned long long)hi << 32) | lo);
}
typedef __bf16 hbf16x2 __attribute__((ext_vector_type(2)));
typedef float hf32x2 __attribute__((ext_vector_type(2)));
DI unsigned pack2(float a, float b) { hf32x2 f = {a, b}; return __builtin_bit_cast(unsigned, __builtin_convertvector(f, hbf16x2)); }
DI unsigned f2bf(float f) { return (unsigned)__builtin_bit_cast(unsigned short, (__bf16)f); }
DI float bf2f(unsigned h) { return __uint_as_float(h << 16); }
DI float bflo(unsigned u) { return __uint_as_float(u << 16); }
DI float bfhi(unsigned u) { return __uint_as_float(u & 0xffff0000u); }
DI int crow(int i, int h) { return (i & 3) + 8 * (i >> 2) + 4 * h; }
typedef float nt_f4 __attribute__((ext_vector_type(4)));
typedef unsigned nt_u4 __attribute__((ext_vector_type(4)));
typedef unsigned nt_u2 __attribute__((ext_vector_type(2)));
DI float4 ld_nt(const float4* p) { nt_f4 v = __builtin_nontemporal_load((const nt_f4*)p); float4 r; r.x = v.x; r.y = v.y; r.z = v.z; r.w = v.w; return r; }
DI uint4 ld_nt(const uint4* p) { nt_u4 v = __builtin_nontemporal_load((const nt_u4*)p); uint4 r; r.x = v.x; r.y = v.y; r.z = v.z; r.w = v.w; return r; }
DI uint2 ld_nt(const uint2* p) { nt_u2 v = __builtin_nontemporal_load((const nt_u2*)p); uint2 r; r.x = v.x; r.y = v.y; return r; }
DI void st_nt(float4* p, const float4& a) { nt_f4 v = {a.x, a.y, a.z, a.w}; __builtin_nontemporal_store(v, (nt_f4*)p); }
DI float silu(float v) { return v / (1.f + __expf(-v)); }
DI float wave_sum(float v) { for (int o = 32; o > 0; o >>= 1) v += __shfl_xor(v, o); return v; }
DI float block_sum(float v, float* red) {
  v = wave_sum(v);
  __syncthreads();
  if ((TID & 63) == 0) red[TID >> 6] = v;
  __syncthreads();
  return red[0] + red[1] + red[2] + red[3];
}
DI bf16x8 pack8(const f32x16& x, int s) {
  union { unsigned u[4]; bf16x8 v; } p;
  p.u[0] = pack2(x[8 * s + 0], x[8 * s + 1]); p.u[1] = pack2(x[8 * s + 2], x[8 * s + 3]);
  p.u[2] = pack2(x[8 * s + 4], x[8 * s + 5]); p.u[3] = pack2(x[8 * s + 6], x[8 * s + 7]);
  return p.v;
}

DI void transpose_tile4(const float* __restrict__ W, int K, int N, int ntN, const float* __restrict__ gain, bf16_t* __restrict__ WT,
                        int id0, char* smem) {
  const int t = TID;
  float v[4][16];
#pragma unroll
  for (int q = 0; q < 4; q++) {
    const int id = id0 + q, k0 = (id / ntN) * 64, n0 = (id % ntN) * 64;
#pragma unroll
    for (int i = 0; i < 16; i++) {
      const int kk = i * 4 + (t >> 6), n = n0 + (t & 63);
      float x = (n < N) ? __builtin_nontemporal_load(&W[(size_t)(k0 + kk) * N + n]) : 0.f;
      if (gain) x *= gain[k0 + kk];
      v[q][i] = x;
    }
  }
#pragma unroll
  for (int q = 0; q < 4; q++) {
    unsigned short (*tile)[72] = (unsigned short (*)[72])(smem + q * 9216);
#pragma unroll
    for (int i = 0; i < 16; i++) tile[t & 63][i * 4 + (t >> 6)] = (unsigned short)f2bf(v[q][i]);
  }
  __syncthreads();
#pragma unroll
  for (int q = 0; q < 4; q++) {
    unsigned short (*tile)[72] = (unsigned short (*)[72])(smem + q * 9216);
    const int id = id0 + q, k0 = (id / ntN) * 64, n0 = (id % ntN) * 64;
    const int nn = t >> 2, kg = (t & 3) * 16;
    uint4 a = *(const uint4*)&tile[nn][kg];
    uint4 b = *(const uint4*)&tile[nn][kg + 8];
    bf16_t* dst = WT + (size_t)(n0 + nn) * K + k0 + kg;
    *(uint4*)dst = a; *(uint4*)(dst + 8) = b;
  }
  __syncthreads();
}

DI void phase_prep(const Params& p, char* smem, int bid, int nblk) {
  const int t = TID;
  char* ws = opaque_ptr(p.ws);
  for (int task = bid; task < 1920 + 3072; task += nblk) {
    if (task < 1920) {
      const int tile0 = task * 4;
      const float* W; const float* gain = nullptr; bf16_t* WT; int K, N, ntN, id;
      if (tile0 < 3136) { id = tile0; W = p.w_in0; K = 2048; N = 6160; ntN = 98; WT = (bf16_t*)(ws + OFF_WIN0T); }
      else if (tile0 < 4160) { id = tile0 - 3136; W = p.w_out0; K = 2048; N = 2048; ntN = 32; WT = (bf16_t*)(ws + OFF_WOUT0T); }
      else if (tile0 < 5760) { id = tile0 - 4160; W = p.w_in1; K = 2048; N = 3136; ntN = 50; WT = (bf16_t*)(ws + OFF_WIN1T); }
      else if (tile0 < 6144) { id = tile0 - 5760; W = p.w_qb; K = 512; N = 3072; ntN = 48; WT = (bf16_t*)(ws + OFF_WQBT); gain = p.g_qa; }
      else if (tile0 < 6656) { id = tile0 - 6144; W = p.w_kvb; K = 512; N = 4096; ntN = 64; WT = (bf16_t*)(ws + OFF_WKVBT); gain = p.g_kva; }
      else { id = tile0 - 6656; W = p.w_out1; K = 2048; N = 2048; ntN = 32; WT = (bf16_t*)(ws + OFF_WOUT1T); }
      transpose_tile4(W, K, N, ntN, gain, WT, id, smem);
    } else if (task < 1920 + 2048) {
      const int lane = t & 63, row = (task - 1920) * 4 + (t >> 6);
      const float4* xr = (const float4*)(p.x + (size_t)row * 2048) + lane;
      const float4* gr = (const float4*)p.l0_pre + lane;
      float4 xv[8];
#pragma unroll
      for (int j = 0; j < 8; j++) xv[j] = ld_nt(xr + j * 64);
      float ss = 0.f;
#pragma unroll
      for (int j = 0; j < 8; j++) ss += xv[j].x * xv[j].x + xv[j].y * xv[j].y + xv[j].z * xv[j].z + xv[j].w * xv[j].w;
      ss = wave_sum(ss);
      const float rinv = rsqrtf(ss * (1.f / 2048.f) + 1e-6f);
      uint2* hr = (uint2*)(ws + OFF_H + (size_t)row * 4096) + lane;
#pragma unroll
      for (int j = 0; j < 8; j++) {
        const float4 g = gr[j * 64];
        uint2 o; o.x = pack2(xv[j].x * rinv * g.x, xv[j].y * rinv * g.y); o.y = pack2(xv[j].z * rinv * g.z, xv[j].w * rinv * g.w);
        hr[j * 64] = o;
      }
    } else {
      const int idx = (task - 3968) * 256 + t;
      const int token = idx >> 5, i = idx & 31;
      double ang = (double)p.pos[token] * (double)p.invf[i];
      double tt = ang * 0.15915494309189535;
      tt -= floor(tt + 0.5);
      float f = (float)tt;
      float* cs = (float*)(ws + OFF_CS);
      cs[token * 64 + i] = __builtin_amdgcn_cosf(f);
      cs[token * 64 + 32 + i] = __builtin_amdgcn_sinf(f);
    }
  }
}

DI float sq8(const uint4& v) {
  return bflo(v.x) * bflo(v.x) + bfhi(v.x) * bfhi(v.x) + bflo(v.y) * bflo(v.y) + bfhi(v.y) * bfhi(v.y) + bflo(v.z) * bflo(v.z) + bfhi(v.z) * bfhi(v.z) +
         bflo(v.w) * bflo(v.w) + bfhi(v.w) * bfhi(v.w);
}
template <bool SWAP, bool SUMSQ = false>
DI void gemm_main(f32x16 (&acc)[4][2], const bf16_t* A, int lda, const bf16_t* B, int ldb, int K,
                  int m0, int n0, char* smem) {
  const int t = TID, lane = t & 63, w = t >> 6, wm = w >> 1, wn = w & 1, r = lane & 31, h = lane >> 5;
#pragma unroll
  for (int a = 0; a < 4; a++)
#pragma unroll
    for (int b = 0; b < 2; b++)
#pragma unroll
      for (int i = 0; i < 16; i++) acc[a][b][i] = 0.f;
  const int lrow = t >> 2, kc = t & 3;
  const bf16_t* ag = A + (size_t)(m0 + lrow) * lda + kc * 8;
  const bf16_t* bg = B + (size_t)(n0 + lrow) * ldb + kc * 8;
  const int lds_w = lrow * 64 + ((kc ^ ((lrow >> 2) & 3)) << 4);
  uint4 pa0, pa1, pa2, pa3, pb0, pb1;
  bf16x8 fa0, fa1, fa2, fa3, fa4, fa5, fb0, fb1, fb2, fb3, fb4, fb5;
#define G_LOAD(X, ko_)                                                                                   \
  X##a0 = *(const uint4*)(ag + (ko_)); X##a1 = *(const uint4*)(ag + (size_t)64 * lda + (ko_));           \
  X##a2 = *(const uint4*)(ag + (size_t)128 * lda + (ko_)); X##a3 = *(const uint4*)(ag + (size_t)192 * lda + (ko_)); \
  X##b0 = *(const uint4*)(bg + (ko_)); X##b1 = *(const uint4*)(bg + (size_t)64 * ldb + (ko_));
#define L_STORE(X, base_)                                                                                \
  *(uint4*)((base_) + lds_w) = X##a0; *(uint4*)((base_) + lds_w + 4096) = X##a1;                         \
  *(uint4*)((base_) + lds_w + 8192) = X##a2; *(uint4*)((base_) + lds_w + 12288) = X##a3;                 \
  *(uint4*)((base_) + 16384 + lds_w) = X##b0; *(uint4*)((base_) + 16384 + lds_w + 4096) = X##b1;         \
  if (SUMSQ) { q0 += sq8(X##a0); q1 += sq8(X##a1); q2 += sq8(X##a2); q3 += sq8(X##a3); }
#define G_READ(F, base_, c_)                                                                             \
  F##0 = *(const bf16x8*)((base_) + a_off + (c_)); F##1 = *(const bf16x8*)((base_) + a_off + 32 * 64 + (c_));              \
  F##2 = *(const bf16x8*)((base_) + a_off + 64 * 64 + (c_)); F##3 = *(const bf16x8*)((base_) + a_off + 96 * 64 + (c_));    \
  F##4 = *(const bf16x8*)((base_) + b_off + (c_)); F##5 = *(const bf16x8*)((base_) + b_off + 32 * 64 + (c_));
#define G_MMA(a0, a1, a2, a3, b0, b1)                                                                    \
    if (SWAP) {                                                                                          \
      acc[0][0] = MFMA32(b0, a0, acc[0][0]); acc[0][1] = MFMA32(b1, a0, acc[0][1]);                      \
      acc[1][0] = MFMA32(b0, a1, acc[1][0]); acc[1][1] = MFMA32(b1, a1, acc[1][1]);                      \
      acc[2][0] = MFMA32(b0, a2, acc[2][0]); acc[2][1] = MFMA32(b1, a2, acc[2][1]);                      \
      acc[3][0] = MFMA32(b0, a3, acc[3][0]); acc[3][1] = MFMA32(b1, a3, acc[3][1]);                      \
    } else {                                                                                             \
      acc[0][0] = MFMA32(a0, b0, acc[0][0]); acc[0][1] = MFMA32(a0, b1, acc[0][1]);                      \
      acc[1][0] = MFMA32(a1, b0, acc[1][0]); acc[1][1] = MFMA32(a1, b1, acc[1][1]);                      \
      acc[2][0] = MFMA32(a2, b0, acc[2][0]); acc[2][1] = MFMA32(a2, b1, acc[2][1]);                      \
      acc[3][0] = MFMA32(a3, b0, acc[3][0]); acc[3][1] = MFMA32(a3, b1, acc[3][1]);                      \
    }
#define G_MMA6(F) G_MMA(F##0, F##1, F##2, F##3, F##4, F##5)
  float q0 = 0.f, q1 = 0.f, q2 = 0.f, q3 = 0.f;
  const int sw = (r >> 2) & 3;
  const int a_off = (wm * 128 + r) * 64, b_off = 16384 + (wn * 64 + r) * 64;
  const int c0 = (h ^ sw) << 4, c1 = ((2 + h) ^ sw) << 4;
  const int nk = K >> 5;
  G_LOAD(p, 0)
  L_STORE(p, smem)
  G_LOAD(p, 32)
  __syncthreads();
  G_READ(fa, smem, c0)
  G_READ(fb, smem, c1)
  G_MMA6(fa)
  asm volatile("" ::: "memory");
  __builtin_amdgcn_sched_barrier(0);
  L_STORE(p, smem + 24576)
  {
    const int kn = ((2 < nk) ? 2 : (nk - 1)) * 32;
    G_LOAD(p, kn)
  }
  __syncthreads();
  for (int kt = 0; kt < nk - 1; kt++) {
    const char* nb = smem + ((kt + 1) & 1) * 24576;
    G_READ(fa, nb, c0)
    G_MMA6(fb)
    G_READ(fb, nb, c1)
    G_MMA6(fa)
    __builtin_amdgcn_sched_group_barrier(0x100, 6, 0);
    __builtin_amdgcn_sched_group_barrier(0x008, 8, 0);
    __builtin_amdgcn_sched_group_barrier(0x100, 6, 0);
    __builtin_amdgcn_sched_group_barrier(0x008, 8, 0);
    asm volatile("" ::: "memory");
    __builtin_amdgcn_sched_barrier(0);
    if (kt + 2 < nk) {
      L_STORE(p, smem + (kt & 1) * 24576)
    }
    {
      const int kn = ((kt + 3 < nk) ? (kt + 3) : (nk - 1)) * 32;
      G_LOAD(p, kn)
    }
    __syncthreads();
  }
  G_MMA6(fb)
#undef G_LOAD
#undef L_STORE
#undef G_READ
#undef G_MMA
#undef G_MMA6
  if (SUMSQ) {
    q0 += __shfl_xor(q0, 1); q1 += __shfl_xor(q1, 1); q2 += __shfl_xor(q2, 1); q3 += __shfl_xor(q3, 1);
    q0 += __shfl_xor(q0, 2); q1 += __shfl_xor(q1, 2); q2 += __shfl_xor(q2, 2); q3 += __shfl_xor(q3, 2);
    if (kc == 0) {
      float* rf = (float*)(smem + 49152);
      const float ik = 1.f / (float)K;
      rf[lrow] = rsqrtf(q0 * ik + 1e-6f); rf[lrow + 64] = rsqrtf(q1 * ik + 1e-6f);
      rf[lrow + 128] = rsqrtf(q2 * ik + 1e-6f); rf[lrow + 192] = rsqrtf(q3 * ik + 1e-6f);
    }
    __syncthreads();
  }
}

#define EPI_LOOP_BEGIN                                                                                           \
  {                                                                                                              \
    const int lane_ = TID & 63, w_ = TID >> 6, wm_ = w_ >> 1, wn_ = w_ & 1, r_ = lane_ & 31, h_ = lane_ >> 5; \
    _Pragma("unroll") for (int mt = 0; mt < 4; mt++) _Pragma("unroll") for (int nt = 0; nt < 2; nt++)          \
        _Pragma("unroll") for (int i = 0; i < 16; i++) {                                                         \
      const float v = acc[mt][nt][i];
#define EPI_COORD_NS const int row = m0 + wm_ * 128 + mt * 32 + crow(i, h_); const int col = n0 + wn_ * 64 + nt * 32 + r_;
#define EPI_COORD_SW const int row = m0 + wm_ * 128 + mt * 32 + r_; const int col = n0 + wn_ * 64 + nt * 32 + crow(i, h_);
#define EPI_LOOP_END }}

DI void phase_gemm_in0(const Params& p, char* smem, int bid, int nblk) {
  char* ws = opaque_ptr(p.ws);
  const bf16_t* A = (const bf16_t*)(ws + OFF_H);
  const bf16_t* B = (const bf16_t*)(ws + OFF_WIN0T);
  bf16_t* QK = (bf16_t*)(ws + OFF_QK0);
  bf16_t* V0T = (bf16_t*)(ws + OFF_V0T);
  bf16_t* G0 = (bf16_t*)(ws + OFF_G0);
  float* GKL = (float*)(ws + OFF_GKLOW);
  for (int tile = bid; tile < 32 * 48; tile += nblk) {
    const int mi = tile & 31, ni = tile >> 5;
    const int m0 = mi * 256, n0 = ni * 128;
    f32x16 acc[4][2];
    if (ni >= 16) {
      if (ni < 32) {
        gemm_main<true>(acc, A, 2048, B, 2048, 2048, m0, n0, smem);
        EPI_LOOP_BEGIN EPI_COORD_SW
          V0T[(size_t)(col - 2048) * S_ + row] = (bf16_t)f2bf(v);
        EPI_LOOP_END
      } else {
        gemm_main<false>(acc, A, 2048, B, 2048, 2048, m0, n0, smem);
        EPI_LOOP_BEGIN EPI_COORD_NS
          G0[(size_t)row * 2048 + (col - 4096)] = (bf16_t)f2bf(silu(v));
        EPI_LOOP_END
      }
    } else {
      gemm_main<false>(acc, A, 2048, B, 2048, 2048, m0, n0, smem);
      EPI_LOOP_BEGIN EPI_COORD_NS
        QK[(size_t)row * 2048 + col] = (bf16_t)f2bf(v);
      EPI_LOOP_END
    }
  }
  {
    typedef __attribute__((ext_vector_type(4))) float f32x4_t;
    const int t = TID, lane = t & 63, w = t >> 6, l15 = lane & 15, quad = lane >> 4;
    float* red = (float*)smem;
    for (int item = bid; item < 512; item += nblk) {
      const bf16_t* ap = A + (size_t)(item * 16 + l15) * 2048 + 512 * w + 8 * quad;
      const bf16_t* bp = B + (size_t)(6144 + l15) * 2048 + 512 * w + 8 * quad;
      f32x4_t c = {0.f, 0.f, 0.f, 0.f};
#pragma unroll
      for (int s = 0; s < 16; s++) {
        const bf16x8 a = *(const bf16x8*)(ap + 32 * s);
        const bf16x8 b = *(const bf16x8*)(bp + 32 * s);
        c = __builtin_amdgcn_mfma_f32_16x16x32_bf16(a, b, c, 0, 0, 0);
      }
      __syncthreads();
#pragma unroll
      for (int j = 0; j < 4; j++) red[(w * 16 + quad * 4 + j) * 16 + l15] = c[j];
      __syncthreads();
      const float v = red[t] + red[256 + t] + red[512 + t] + red[768 + t];
      GKL[(size_t)item * 256 + t] = v;
    }
  }
}

DI void phase_gla_prep(const Params& p, char* smem, int bid, int nblk) {
  char* ws = opaque_ptr(p.ws);
  const int t = TID, lane = t & 63, w = t >> 6, r = lane & 31, h = lane >> 5;
  const bf16_t* QK = (const bf16_t*)(ws + OFF_QK0);
  const float* GKL = (const float*)(ws + OFF_GKLOW);
  bf16_t* QE = (bf16_t*)(ws + OFF_QE);
  bf16_t* KLT = (bf16_t*)(ws + OFF_KLT);
  bf16_t* AM = (bf16_t*)(ws + OFF_AM);
  float* DEC = (float*)(ws + OFF_DECAY);
  if (bid == 0 && t == 0) { ((int*)(ws + OFF_CTR))[0] = 0; ((int*)(ws + OFF_CTR))[1] = 0; }
  char* lq = smem;
  char* lk = smem + 32768;
  for (int tile = bid; tile < 512; tile += nblk) {
    const int n = tile >> 2, head = tile & 3, t0 = n * 64, d = t, col = head * 256 + d;
    __syncthreads();
    ((float4*)(smem + 65536))[t] = ((const float4*)(GKL + (size_t)t0 * 16))[t];
    __syncthreads();
    float w2[16];
#pragma unroll
    for (int j = 0; j < 16; j++) w2[j] = p.w_gk2[j * 1024 + col];
    const float bias = p.b_gk[col];
    float b = 0.f;
    const int dperm = (d & ~15) | ((d & 3) | ((d & 4) << 1) | ((d & 8) >> 1));
    for (int c8 = 0; c8 < 8; c8++) {
      float bj[8], qv[8], kv[8];
#pragma unroll
      for (int j = 0; j < 8; j++) {
        const int c = c8 * 8 + j;
        const float4* gl = (const float4*)(smem + 65536) + c * 4;
        float4 g0 = gl[0], g1 = gl[1], g2 = gl[2], g3 = gl[3];
        float gk = bias + g0.x * w2[0] + g0.y * w2[1] + g0.z * w2[2] + g0.w * w2[3] + g1.x * w2[4] + g1.y * w2[5] + g1.z * w2[6] + g1.w * w2[7]
                 + g2.x * w2[8] + g2.y * w2[9] + g2.z * w2[10] + g2.w * w2[11] + g3.x * w2[12] + g3.y * w2[13] + g3.z * w2[14] + g3.w * w2[15];
        float la = (fminf(gk, 0.f) - __logf(1.f + __expf(-fabsf(gk)))) * (1.f / 16.f);
        b += la;
        bj[j] = b;
        qv[j] = bf2f(QK[(size_t)(t0 + c) * 2048 + col]);
        kv[j] = bf2f(QK[(size_t)(t0 + c) * 2048 + 1024 + col]);
      }
      unsigned klp[4];
#pragma unroll
      for (int j = 0; j < 8; j++) {
        const int c = c8 * 8 + j;
        const float qe = qv[j] * 0.0625f * __expf(bj[j]);
        const float ke = kv[j] * __expf(-bj[j]);
        const unsigned qeb = f2bf(qe), keb = f2bf(ke), klb = keb;
        const int lo = c * 512 + ((((d >> 3) ^ (c & 15))) << 4) + (d & 7) * 2;
        *(unsigned short*)(lq + lo) = (unsigned short)qeb;
        *(unsigned short*)(lk + lo) = (unsigned short)keb;
        QE[(size_t)(t0 + c) * 1024 + head * 256 + dperm] = (bf16_t)qeb;
        if (j & 1) klp[j >> 1] |= klb << 16; else klp[j >> 1] = klb;
      }
      uint4 o; o.x = klp[0]; o.y = klp[1]; o.z = klp[2]; o.w = klp[3];
      *(uint4*)(KLT + (size_t)(head * 256 + d) * S_ + t0 + c8 * 8) = o;
    }
    DEC[(size_t)(n * 4 + head) * 256 + d] = __expf(b);
    __syncthreads();
    {
      const int ct = w >> 1, st = w & 1;
      f32x16 acc;
#pragma unroll
      for (int i = 0; i < 16; i++) acc[i] = 0.f;
      if (!(ct == 0 && st == 1)) {
        const int ra = ct * 32 + r, rb = st * 32 + r;
#pragma unroll
        for (int s = 0; s < 16; s++) {
          bf16x8 a = *(const bf16x8*)(lq + ra * 512 + (((2 * s + h) ^ (ra & 15)) << 4));
          bf16x8 bb = *(const bf16x8*)(lk + rb * 512 + (((2 * s + h) ^ (rb & 15)) << 4));
          acc = MFMA32(a, bb, acc);
        }
      }
      bf16_t* ap = AM + (size_t)(n * 4 + head) * 4096;
#pragma unroll
      for (int i = 0; i < 16; i++) {
        const int c = ct * 32 + crow(i, h), s = st * 32 + r;
        ap[c * 64 + s] = (bf16_t)f2bf(s <= c ? acc[i] : 0.f);
      }
    }
    __syncthreads();
  }
}

constexpr int SCAN_NG = 8, SCAN_GC = 16;
DI void phase_gla_local(const Params& p, char* smem, int bid, int nblk) {
  char* ws = opaque_ptr(p.ws);
  const int t = TID, lane = t & 63, w = t >> 6, r = lane & 31, h = lane >> 5;
  for (int item = bid; item < 64 * (SCAN_NG - 1); item += nblk) {
    const int grp = item >> 6, head = (item >> 4) & 3, dvt = item & 15, dv0 = dvt * 32;
    const int nb = grp * SCAN_GC;
    const bf16_t* v_p = (const bf16_t*)(ws + OFF_V0T) + (size_t)(head * 512 + dv0 + r) * S_ + nb * 64 + 8 * h;
    const bf16_t* kl_p = (const bf16_t*)(ws + OFF_KLT) + (size_t)(head * 256 + 64 * w + r) * S_ + nb * 64 + 8 * h;
    const float* dec_p = (const float*)(ws + OFF_DECAY) + (size_t)nb * 1024 + head * 256 + 64 * w + 4 * h;
    f32x16 St[2];
#pragma unroll
    for (int i = 0; i < 16; i++) { St[0][i] = 0.f; St[1][i] = 0.f; }
    bf16x8 klA[2][4], vfA[4], klB[2][4], vfB[4];
    float4 dcA[2][4], dcB[2][4];
#define LOC_LOAD(KL, VF, DC, n_)                                                                                 \
    {                                                                                                            \
      _Pragma("unroll") for (int s = 0; s < 4; s++) VF[s] = *(const bf16x8*)(v_p + (n_) * 64 + 16 * s);        \
      _Pragma("unroll") for (int dt = 0; dt < 2; dt++) {                                                         \
        _Pragma("unroll") for (int s = 0; s < 4; s++) KL[dt][s] = *(const bf16x8*)(kl_p + (size_t)dt * 32 * S_ + (n_) * 64 + 16 * s); \
        _Pragma("unroll") for (int g4 = 0; g4 < 4; g4++) DC[dt][g4] = *(const float4*)(dec_p + (size_t)(n_) * 1024 + dt * 32 + 8 * g4); \
      }                                                                                                          \
    }
#define LOC_STEP(KL, VF, DC)                                                                                     \
    {                                                                                                            \
      _Pragma("unroll") for (int dt = 0; dt < 2; dt++) {                                                         \
        _Pragma("unroll") for (int s = 0; s < 4; s++) St[dt] = MFMA32(KL[dt][s], VF[s], St[dt]);                 \
        _Pragma("unroll") for (int g4 = 0; g4 < 4; g4++) {                                                       \
          St[dt][4 * g4 + 0] *= DC[dt][g4].x; St[dt][4 * g4 + 1] *= DC[dt][g4].y;                                \
          St[dt][4 * g4 + 2] *= DC[dt][g4].z; St[dt][4 * g4 + 3] *= DC[dt][g4].w;                                \
        }                                                                                                        \
      }                                                                                                          \
    }
    LOC_LOAD(klA, vfA, dcA, 0)
    for (int n = 0; n < SCAN_GC; n += 2) {
      LOC_LOAD(klB, vfB, dcB, n + 1)
      LOC_STEP(klA, vfA, dcA)
      if (n + 2 < SCAN_GC) LOC_LOAD(klA, vfA, dcA, n + 2)
      LOC_STEP(klB, vfB, dcB)
    }
#undef LOC_LOAD
#undef LOC_STEP
    float* sl = (float*)(ws + OFF_SL) + ((size_t)((grp * 4 + head) * 16 + dvt) * 4 + w) * 2048 + lane;
#pragma unroll
    for (int dt = 0; dt < 2; dt++)
#pragma unroll
      for (int i = 0; i < 16; i++) sl[(dt * 16 + i) * 64] = St[dt][i];
    if (dvt == 0) {
      const float* dg = (const float*)(ws + OFF_DECAY) + (size_t)nb * 1024 + head * 256 + t;
      float pr = 1.f;
#pragma unroll 4
      for (int n = 0; n < SCAN_GC; n++) pr *= dg[(size_t)n * 1024];
      ((float*)(ws + OFF_DC))[(grp * 4 + head) * 256 + t] = pr;
    }
  }
}

DI void phase_gla_scan(const Params& p, char* smem, int bid, int nblk) {
  char* ws = opaque_ptr(p.ws);
  const int t = TID, lane = t & 63, w = t >> 6, r = lane & 31, h = lane >> 5;
  float* lo = (float*)smem;
  for (int item = bid; item < 64 * SCAN_NG; item += nblk) {
    const int grp = item >> 6, head = (item >> 4) & 3, dvt = item & 15, dv0 = dvt * 32;
    const int nb = grp * SCAN_GC, ne = nb + SCAN_GC;
    const bf16_t* qe_p = (const bf16_t*)(ws + OFF_QE) + (size_t)r * 1024 + head * 256 + 64 * w + 8 * h;
    const bf16_t* a_p = (const bf16_t*)(ws + OFF_AM) + (size_t)head * 4096 + (size_t)r * 64 + 16 * w + 8 * h;
    const bf16_t* v_p = (const bf16_t*)(ws + OFF_V0T) + (size_t)(head * 512 + dv0 + r) * S_ + 8 * h;
    const bf16_t* kl_p = (const bf16_t*)(ws + OFF_KLT) + (size_t)(head * 256 + 64 * w + r) * S_ + 8 * h;
    bf16_t* o_p = (bf16_t*)(ws + OFF_QK0) + (size_t)(t >> 2) * 2048 + head * 512 + dv0 + (t & 3) * 8;
    f32x16 St[2];
#pragma unroll
    for (int i = 0; i < 16; i++) { St[0][i] = 0.f; St[1][i] = 0.f; }
    for (int j = 0; j < grp; j++) {
      const float* slj = (const float*)(ws + OFF_SL) + ((size_t)((j * 4 + head) * 16 + dvt) * 4 + w) * 2048 + lane;
      const float* dcj = (const float*)(ws + OFF_DC) + (j * 4 + head) * 256 + 64 * w + 4 * h;
#pragma unroll
      for (int dt = 0; dt < 2; dt++)
#pragma unroll
        for (int g4 = 0; g4 < 4; g4++) {
          const float4 dv = *(const float4*)(dcj + 32 * dt + 8 * g4);
          St[dt][4 * g4 + 0] = St[dt][4 * g4 + 0] * dv.x + slj[(dt * 16 + 4 * g4 + 0) * 64];
          St[dt][4 * g4 + 1] = St[dt][4 * g4 + 1] * dv.y + slj[(dt * 16 + 4 * g4 + 1) * 64];
          St[dt][4 * g4 + 2] = St[dt][4 * g4 + 2] * dv.z + slj[(dt * 16 + 4 * g4 + 2) * 64];
          St[dt][4 * g4 + 3] = St[dt][4 * g4 + 3] * dv.w + slj[(dt * 16 + 4 * g4 + 3) * 64];
        }
    }
    qe_p += (size_t)nb * 64 * 1024; a_p += (size_t)nb * 4 * 4096; v_p += nb * 64; kl_p += nb * 64; o_p += (size_t)nb * 64 * 2048;
    bf16x8 qe[2][4], af[2], vf[4], kl[2][4];
    float* ldec = (float*)(smem + 32768);
    const float* dec_g = (const float*)(ws + OFF_DECAY) + (size_t)nb * 1024 + head * 256 + t;
#pragma unroll
    for (int ct = 0; ct < 2; ct++) {
#pragma unroll
      for (int s = 0; s < 4; s++) qe[ct][s] = *(const bf16x8*)(qe_p + (size_t)ct * 32 * 1024 + 16 * s);
      af[ct] = *(const bf16x8*)(a_p + ct * 32 * 64);
    }
#pragma unroll
    for (int s = 0; s < 4; s++) vf[s] = *(const bf16x8*)(v_p + 16 * s);
#pragma unroll
    for (int dt = 0; dt < 2; dt++) {
#pragma unroll
      for (int s = 0; s < 4; s++) kl[dt][s] = *(const bf16x8*)(kl_p + (size_t)dt * 32 * S_ + 16 * s);
    }
    __syncthreads();
    ldec[t] = dec_g[0];
    __syncthreads();
    for (int n = 0; n < SCAN_GC; n++) {
      const bool more = (n + 1 < SCAN_GC);
      float decn = 0.f;
      if (more) decn = dec_g[(size_t)(n + 1) * 1024];
      f32x16 o[2];
#pragma unroll
      for (int i = 0; i < 16; i++) { o[0][i] = 0.f; o[1][i] = 0.f; }
#pragma unroll
      for (int s = 0; s < 4; s++) {
        bf16x8 sb = pack8(St[s >> 1], s & 1);
        o[0] = MFMA32(qe[0][s], sb, o[0]);
        o[1] = MFMA32(qe[1][s], sb, o[1]);
      }
      if (more) {
        const bf16_t* q2 = qe_p + (size_t)(n + 1) * 64 * 1024;
#pragma unroll
        for (int ct = 0; ct < 2; ct++)
#pragma unroll
          for (int s = 0; s < 4; s++) qe[ct][s] = *(const bf16x8*)(q2 + (size_t)ct * 32 * 1024 + 16 * s);
      }
      {
        bf16x8 vw = (w == 0) ? vf[0] : (w == 1) ? vf[1] : (w == 2) ? vf[2] : vf[3];
        o[0] = MFMA32(af[0], vw, o[0]);
        o[1] = MFMA32(af[1], vw, o[1]);
      }
      if (more) {
        const bf16_t* a2 = a_p + (size_t)(n + 1) * 4 * 4096;
        af[0] = *(const bf16x8*)(a2); af[1] = *(const bf16x8*)(a2 + 32 * 64);
      }
#pragma unroll
      for (int dt = 0; dt < 2; dt++) {
#pragma unroll
        for (int s = 0; s < 4; s++) St[dt] = MFMA32(kl[dt][s], vf[s], St[dt]);
#pragma unroll
        for (int g = 0; g < 4; g++) {
          const float4 dv = *(const float4*)(ldec + (n & 1) * 256 + 64 * w + 32 * dt + 8 * g + 4 * h);
          St[dt][4 * g + 0] *= dv.x; St[dt][4 * g + 1] *= dv.y;
          St[dt][4 * g + 2] *= dv.z; St[dt][4 * g + 3] *= dv.w;
        }
      }
      if (more) {
        const int tn = (n + 1) * 64;
#pragma unroll
        for (int s = 0; s < 4; s++) vf[s] = *(const bf16x8*)(v_p + tn + 16 * s);
#pragma unroll
        for (int dt = 0; dt < 2; dt++) {
#pragma unroll
          for (int s = 0; s < 4; s++) kl[dt][s] = *(const bf16x8*)(kl_p + (size_t)dt * 32 * S_ + tn + 16 * s);
        }
      }
      ldec[((n + 1) & 1) * 256 + t] = decn;
#pragma unroll
      for (int ct = 0; ct < 2; ct++)
#pragma unroll
        for (int i = 0; i < 16; i++) lo[(w * 64 + ct * 32 + crow(i, h)) * 32 + r] = o[ct][i];
      __syncthreads();
      {
        const int c = t >> 2, vg = (t & 3) * 8;
        float4 s0 = *(const float4*)(lo + c * 32 + vg), s1 = *(const float4*)(lo + c * 32 + vg + 4);
#pragma unroll
        for (int ww = 1; ww < 4; ww++) {
          float4 x0 = *(const float4*)(lo + (ww * 64 + c) * 32 + vg), x1 = *(const float4*)(lo + (ww * 64 + c) * 32 + vg + 4);
          s0.x += x0.x; s0.y += x0.y; s0.z += x0.z; s0.w += x0.w; s1.x += x1.x; s1.y += x1.y; s1.z += x1.z; s1.w += x1.w;
        }
        uint4 ov; ov.x = pack2(s0.x, s0.y); ov.y = pack2(s0.z, s0.w); ov.z = pack2(s1.x, s1.y); ov.w = pack2(s1.z, s1.w);
        *(uint4*)(o_p + (size_t)n * 64 * 2048) = ov;
      }
      __syncthreads();
    }
  }
}

DI void phase_og(const Params& p, char* smem, int bid, int nblk) {
  char* ws = opaque_ptr(p.ws);
  const int t = TID, lane = t & 63, w = t >> 6;
  const bf16_t* O0 = (const bf16_t*)(ws + OFF_QK0);
  const bf16_t* G0 = (const bf16_t*)(ws + OFF_G0);
  bf16_t* OG = (bf16_t*)(ws + OFF_H);
  const float4* gp = (const float4*)(p.g_onorm + lane * 8);
  const float4 ga = gp[0], gb = gp[1];
  for (int token = bid; token < S_; token += 4 * nblk) {
    uint4 ov[4], gv[4];
#pragma unroll
    for (int u = 0; u < 4; u++) {
      const int tk = token + u * nblk;
      const size_t off = (size_t)(tk < S_ ? tk : token) * 2048 + w * 512 + lane * 8;
      ov[u] = ld_nt((const uint4*)(O0 + off));
      gv[u] = ld_nt((const uint4*)(G0 + off));
    }
#pragma unroll
    for (int u = 0; u < 4; u++) {
      const int tk = token + u * nblk;
      const size_t off = (size_t)tk * 2048 + w * 512 + lane * 8;
      const float f0 = bflo(ov[u].x), f1 = bfhi(ov[u].x), f2 = bflo(ov[u].y), f3 = bfhi(ov[u].y);
      const float f4 = bflo(ov[u].z), f5 = bfhi(ov[u].z), f6 = bflo(ov[u].w), f7 = bfhi(ov[u].w);
      float ss = f0 * f0 + f1 * f1 + f2 * f2 + f3 * f3 + f4 * f4 + f5 * f5 + f6 * f6 + f7 * f7;
      ss = wave_sum(ss);
      const float rinv = rsqrtf(ss * (1.f / 512.f) + 1e-6f);
      uint4 o;
      o.x = pack2(f0 * rinv * ga.x * bflo(gv[u].x), f1 * rinv * ga.y * bfhi(gv[u].x));
      o.y = pack2(f2 * rinv * ga.z * bflo(gv[u].y), f3 * rinv * ga.w * bfhi(gv[u].y));
      o.z = pack2(f4 * rinv * gb.x * bflo(gv[u].z), f5 * rinv * gb.y * bfhi(gv[u].z));
      o.w = pack2(f6 * rinv * gb.z * bflo(gv[u].w), f7 * rinv * gb.w * bfhi(gv[u].w));
      if (tk < S_) *(uint4*)(OG + off) = o;
    }
  }
}

DI void phase_gemm_out(const Params& p, char* smem, int bid, int nblk, size_t off_w) {
  char* ws = opaque_ptr(p.ws);
  const bf16_t* A = (const bf16_t*)(ws + OFF_H);
  const bf16_t* B = (const bf16_t*)(ws + off_w);
  bf16_t* Y = (bf16_t*)(ws + OFF_Y);
  for (int tile = bid; tile < 32 * 16; tile += nblk) {
    const int mi = tile & 31, ni = tile >> 5;
    const int m0 = mi * 256, n0 = ni * 128;
    f32x16 acc[4][2];
    gemm_main<false>(acc, A, 2048, B, 2048, 2048, m0, n0, smem);
    EPI_LOOP_BEGIN EPI_COORD_NS
      Y[(size_t)row * 2048 + col] = (bf16_t)f2bf(v);
    EPI_LOOP_END
  }
}

DI void phase_post0(const Params& p, char* smem, int bid, int nblk) {
  char* ws = opaque_ptr(p.ws);
  const int t = TID, lane = t & 63, w = t >> 6;
  const bf16_t* Y = (const bf16_t*)(ws + OFF_Y);
  const float4* gpo = (const float4*)p.l0_post + lane;
  const float4* gpr = (const float4*)p.l1_pre + lane;
  for (int row = bid * 4 + w; row < S_; row += nblk * 4) {
    const uint2* yr = (const uint2*)(Y + (size_t)row * 2048) + lane;
    const float4* xr = (const float4*)(p.x + (size_t)row * 2048) + lane;
    float4 yv[8], xv[8];
#pragma unroll
    for (int j = 0; j < 8; j++) { const uint2 u = ld_nt(yr + j * 64); yv[j].x = bflo(u.x); yv[j].y = bfhi(u.x); yv[j].z = bflo(u.y); yv[j].w = bfhi(u.y); xv[j] = ld_nt(xr + j * 64); }
    float ss = 0.f;
#pragma unroll
    for (int j = 0; j < 8; j++) ss += yv[j].x * yv[j].x + yv[j].y * yv[j].y + yv[j].z * yv[j].z + yv[j].w * yv[j].w;
    ss = wave_sum(ss);
    const float rinv = rsqrtf(ss * (1.f / 2048.f) + 1e-6f);
    float4* outr = (float4*)(p.out + (size_t)row * 2048) + lane;
    float s2 = 0.f;
#pragma unroll
    for (int j = 0; j < 8; j++) {
      const float4 g = gpo[j * 64];
      xv[j].x += yv[j].x * rinv * g.x; xv[j].y += yv[j].y * rinv * g.y; xv[j].z += yv[j].z * rinv * g.z; xv[j].w += yv[j].w * rinv * g.w;
      outr[j * 64] = xv[j];
      s2 += xv[j].x * xv[j].x + xv[j].y * xv[j].y + xv[j].z * xv[j].z + xv[j].w * xv[j].w;
    }
    s2 = wave_sum(s2);
    const float r2 = rsqrtf(s2 * (1.f / 2048.f) + 1e-6f);
    uint2* hr = (uint2*)(ws + OFF_H + (size_t)row * 4096) + lane;
#pragma unroll
    for (int j = 0; j < 8; j++) {
      const float4 g = gpr[j * 64];
      uint2 o; o.x = pack2(xv[j].x * r2 * g.x, xv[j].y * r2 * g.y); o.y = pack2(xv[j].z * r2 * g.z, xv[j].w * r2 * g.w);
      hr[j * 64] = o;
    }
  }
}

DI void phase_gemm_in1(const Params& p, char* smem, int bid, int nblk) {
  char* ws = opaque_ptr(p.ws);
  const bf16_t* A = (const bf16_t*)(ws + OFF_H);
  const bf16_t* B = (const bf16_t*)(ws + OFF_WIN1T);
  bf16_t* CQ = (bf16_t*)(ws + OFF_CQ);
  bf16_t* CKV = (bf16_t*)(ws + OFF_CKV);
  bf16_t* KR = (bf16_t*)(ws + OFF_KR);
  const float* cs = (const float*)(ws + OFF_CS);
  bf16_t* G1 = (bf16_t*)(ws + OFF_QK0);
  for (int tile = bid; tile < 32 * 25; tile += nblk) {
    const int mi = tile & 31, ni = tile >> 5;
    const int m0 = mi * 256, n0 = ni * 128;
    f32x16 acc[4][2];
    gemm_main<false>(acc, A, 2048, B, 2048, 2048, m0, n0, smem);
    if (ni < 4) {
      EPI_LOOP_BEGIN EPI_COORD_NS
        CQ[(size_t)row * 512 + col] = (bf16_t)f2bf(v);
      EPI_LOOP_END
    } else if (ni < 8) {
      EPI_LOOP_BEGIN EPI_COORD_NS
        CKV[(size_t)row * 512 + (col - 512)] = (bf16_t)f2bf(v);
      EPI_LOOP_END
    } else if (ni == 8 && ((TID >> 6) & 1) == 0) {
      const int lane_ = TID & 63, w_ = TID >> 6, wm_ = w_ >> 1, r_ = lane_ & 31, h_ = lane_ >> 5;
#pragma unroll
      for (int mt = 0; mt < 4; mt++)
#pragma unroll
        for (int i = 0; i < 16; i++) {
          const int row = m0 + wm_ * 128 + mt * 32 + crow(i, h_);
          const float t1 = acc[mt][0][i], t2 = acc[mt][1][i];
          const float c = cs[row * 64 + r_], sn = cs[row * 64 + 32 + r_];
          KR[(size_t)row * 64 + r_] = (bf16_t)f2bf(t1 * c - t2 * sn);
          KR[(size_t)row * 64 + 32 + r_] = (bf16_t)f2bf(t2 * c + t1 * sn);
        }
    } else {
      EPI_LOOP_BEGIN EPI_COORD_NS
        if (col < 3136) G1[(size_t)row * 2048 + (col - 1088)] = (bf16_t)f2bf(silu(v));
      EPI_LOOP_END
    }
  }
}

DI void phase_gemm_qkv(const Params& p, char* smem, int bid, int nblk) {
  char* ws = opaque_ptr(p.ws);
  const bf16_t* CQ = (const bf16_t*)(ws + OFF_CQ);
  const bf16_t* CKV = (const bf16_t*)(ws + OFF_CKV);
  const bf16_t* WQ = (const bf16_t*)(ws + OFF_WQBT);
  const bf16_t* WKV = (const bf16_t*)(ws + OFF_WKVBT);
  const float* cs = (const float*)(ws + OFF_CS);
  bf16_t* Q = (bf16_t*)(ws + OFF_Q);
  bf16_t* KN = (bf16_t*)(ws + OFF_KN);
  bf16_t* VT = (bf16_t*)(ws + OFF_VT);
  const float qscale = 0.07216878364870322f * 1.4426950408889634f;
  const int ntq = 32 * 24, ntkv = 32 * 32;
  for (int tile = bid; tile < ntq + ntkv; tile += nblk) {
    f32x16 acc[4][2];
    if (tile < ntq) {
      const int mi = tile & 31, ni = tile >> 5;
      const int m0 = mi * 256, n0 = ni * 128;
      gemm_main<false, true>(acc, CQ, 512, WQ, 512, 512, m0, n0, smem);
      const float* rf = (const float*)(smem + 49152);
      const int lane_ = TID & 63, w_ = TID >> 6, wm_ = w_ >> 1, wn_ = w_ & 1, r_ = lane_ & 31, h_ = lane_ >> 5;
      const int cb = n0 + wn_ * 64;
      const int head = cb / 192, jb = cb - head * 192;
      if (jb == 128) {
#pragma unroll
        for (int mt = 0; mt < 4; mt++)
#pragma unroll
          for (int i = 0; i < 16; i++) {
            const int row = m0 + wm_ * 128 + mt * 32 + crow(i, h_);
            const float sc = rf[row - m0] * qscale;
            const float t1 = acc[mt][0][i] * sc, t2 = acc[mt][1][i] * sc;
            const float c = cs[row * 64 + r_], s = cs[row * 64 + 32 + r_];
            bf16_t* qp = Q + ((size_t)head * S_ + row) * 192 + 128;
            qp[r_] = (bf16_t)f2bf(t1 * c - t2 * s);
            qp[32 + r_] = (bf16_t)f2bf(t2 * c + t1 * s);
          }
      } else {
#pragma unroll
        for (int mt = 0; mt < 4; mt++)
#pragma unroll
          for (int nt = 0; nt < 2; nt++)
#pragma unroll
            for (int i = 0; i < 16; i++) {
              const int row = m0 + wm_ * 128 + mt * 32 + crow(i, h_);
              const float sc = rf[row - m0] * qscale;
              Q[((size_t)head * S_ + row) * 192 + jb + nt * 32 + r_] = (bf16_t)f2bf(acc[mt][nt][i] * sc);
            }
      }
    } else {
      const int tl = tile - ntq;
      const int mi = tl & 31, ni = tl >> 5;
      const int m0 = mi * 256, n0 = ni * 128;
      const int head = ni >> 1;
      if (ni & 1) {
        gemm_main<true, true>(acc, CKV, 512, WKV, 512, 512, m0, n0, smem);
        const float* rf = (const float*)(smem + 49152);
        EPI_LOOP_BEGIN EPI_COORD_SW
          const int j = col - head * 256 - 128;
          VT[((size_t)head * 128 + j) * S_ + row] = (bf16_t)f2bf(v * rf[row - m0]);
        EPI_LOOP_END
      } else {
        gemm_main<false, true>(acc, CKV, 512, WKV, 512, 512, m0, n0, smem);
        const float* rf = (const float*)(smem + 49152);
        EPI_LOOP_BEGIN EPI_COORD_NS
          const int j = col - head * 256;
          KN[((size_t)head * S_ + row) * 128 + j] = (bf16_t)f2bf(v * rf[row - m0]);
        EPI_LOOP_END
      }
    }
  }
}

DI void phase_attn(const Params& p, char* smem, int bid, int nblk, int rep) {
  char* ws = opaque_ptr(p.ws);
  const int t = TID, lane = t & 63, w = t >> 6, r = lane & 31, h = lane >> 5;
  const bf16_t* Q = (const bf16_t*)(ws + OFF_Q);
  const bf16_t* KN = (const bf16_t*)(ws + OFF_KN);
  const bf16_t* KR = (const bf16_t*)(ws + OFF_KR);
  const bf16_t* VT = (const bf16_t*)(ws + OFF_VT);
  const bf16_t* G1 = (const bf16_t*)(ws + OFF_QK0);
  bf16_t* OG = (bf16_t*)(ws + OFF_H);
  int* ctr = (int*)(ws + OFF_CTR) + rep;
  char* lk = smem;
  char* lv = smem + 25600;
  int* s_item = (int*)(smem + 44032);
  const int k_row = t >> 2, k_c0 = t & 3;
  const int v_row0 = t >> 3, v_kc = t & 7;
  for (;;) {
    __syncthreads();
    if (t == 0) *s_item = atomicAdd(ctr, 1);
    __syncthreads();
    const int item = *s_item;
    if (item >= 1024) break;
    const int qb = 63 - (item >> 4), head = item & 15;
    const int q0w = qb * 128 + w * 32;
    const int ntile = 2 * qb + 2;
    bf16x8 qf[12];
    {
      const bf16_t* qp = Q + ((size_t)head * S_ + q0w + r) * 192 + 8 * h;
#pragma unroll
      for (int s = 0; s < 12; s++) qf[s] = *(const bf16x8*)(qp + 16 * s);
    }
    f32x16 oacc[4];
#pragma unroll
    for (int vt = 0; vt < 4; vt++)
#pragma unroll
      for (int i = 0; i < 16; i++) oacc[vt][i] = 0.f;
    float m_run = -INFINITY, l_run = 0.f;
    uint4 kg0, kg1, kg2, kg3, kg4, kg5, vg0, vg1, vg2, vg3;
    const bf16_t* knp = KN + (size_t)head * S_ * 128;
    const bf16_t* vtp = VT + ((size_t)head * 128 + v_row0) * S_ + v_kc * 8;
#define ATT_LOAD(k0_)                                                                                         \
    {                                                                                                         \
      const bf16_t* kn_ = knp + (size_t)((k0_) + k_row) * 128 + k_c0 * 8;                                     \
      const bf16_t* kr_ = KR + (size_t)((k0_) + k_row) * 64 + k_c0 * 8;                                       \
      const bf16_t* vp_ = vtp + (k0_);                                                                        \
      kg0 = *(const uint4*)(kn_); kg1 = *(const uint4*)(kn_ + 32); kg2 = *(const uint4*)(kn_ + 64); kg3 = *(const uint4*)(kn_ + 96); \
      kg4 = *(const uint4*)(kr_); kg5 = *(const uint4*)(kr_ + 32);                                            \
      vg0 = *(const uint4*)(vp_); vg1 = *(const uint4*)(vp_ + (size_t)32 * S_);                               \
      vg2 = *(const uint4*)(vp_ + (size_t)64 * S_); vg3 = *(const uint4*)(vp_ + (size_t)96 * S_);             \
    }
    ATT_LOAD(0)
    for (int kt = 0; kt < ntile; kt++) {
      const int k0 = kt * 64;
      __syncthreads();
      {
        char* kd = lk + k_row * 400 + k_c0 * 16;
        *(uint4*)(kd) = kg0; *(uint4*)(kd + 64) = kg1; *(uint4*)(kd + 128) = kg2; *(uint4*)(kd + 192) = kg3;
        *(uint4*)(kd + 256) = kg4; *(uint4*)(kd + 320) = kg5;
        char* vd = lv + v_row0 * 144 + (v_kc >> 1) * 32 + (v_kc & 1) * 8;
#define VST(o_, v_) { uint2 u0, u1; u0.x = v_.x; u0.y = v_.y; u1.x = v_.z; u1.y = v_.w; *(uint2*)(vd + (o_)) = u0; *(uint2*)(vd + (o_) + 16) = u1; }
        VST(0, vg0) VST(32 * 144, vg1) VST(64 * 144, vg2) VST(96 * 144, vg3)
#undef VST
      }
      __syncthreads();
      { const int knext = (kt + 1 < ntile) ? k0 + 64 : k0; ATT_LOAD(knext) }
      if (k0 <= q0w + 31) {
        f32x16 sc[2];
#pragma unroll
        for (int i = 0; i < 16; i++) { sc[0][i] = 0.f; sc[1][i] = 0.f; }
        __builtin_amdgcn_s_setprio(1);
#pragma unroll
        for (int s = 0; s < 12; s++) {
          bf16x8 a0 = *(const bf16x8*)(lk + r * 400 + h * 16 + s * 32);
          bf16x8 a1 = *(const bf16x8*)(lk + r * 400 + h * 16 + 32 * 400 + s * 32);
          sc[0] = MFMA32(a0, qf[s], sc[0]);
          sc[1] = MFMA32(a1, qf[s], sc[1]);
        }
        __builtin_amdgcn_s_setprio(0);
        if (k0 + 63 > q0w) {
          const int qg = q0w + r;
#pragma unroll
          for (int mt = 0; mt < 2; mt++)
#pragma unroll
            for (int i = 0; i < 16; i++) {
              const int key = k0 + mt * 32 + crow(i, h);
              if (key > qg) sc[mt][i] = -INFINITY;
            }
        }
        float mx = sc[0][0];
#pragma unroll
        for (int i = 1; i < 16; i++) mx = fmaxf(mx, sc[0][i]);
#pragma unroll
        for (int i = 0; i < 16; i++) mx = fmaxf(mx, sc[1][i]);
        mx = fmaxf(mx, __shfl_xor(mx, 32));
        const float m_new = (mx > m_run + 8.f) ? mx : m_run;
        const bool resc = __any(m_new != m_run);
        const float alpha = __builtin_amdgcn_exp2f(m_run - m_new);
        m_run = m_new;
        float ls = 0.f;
#pragma unroll
        for (int mt = 0; mt < 2; mt++)
#pragma unroll
          for (int i = 0; i < 16; i++) { const float pv = __builtin_amdgcn_exp2f(sc[mt][i] - m_new); sc[mt][i] = pv; ls += pv; }
        l_run = l_run * alpha + ls;
        if (resc) {
#pragma unroll
          for (int vt = 0; vt < 4; vt++)
#pragma unroll
            for (int i = 0; i < 16; i++) oacc[vt][i] *= alpha;
        }
        __builtin_amdgcn_s_setprio(1);
#pragma unroll
        for (int s = 0; s < 4; s++) {
          const bf16x8 pb = pack8(sc[s >> 1], s & 1);
#pragma unroll
          for (int vt = 0; vt < 4; vt++) {
            const bf16x8 a = *(const bf16x8*)(lv + r * 144 + h * 16 + vt * 32 * 144 + s * 32);
            oacc[vt] = MFMA32(a, pb, oacc[vt]);
          }
        }
        __builtin_amdgcn_s_setprio(0);
      }
    }
#undef ATT_LOAD
    const float l_tot = l_run + __shfl_xor(l_run, 32);
    const float inv = 1.f / l_tot;
    const size_t obase = (size_t)(q0w + r) * 2048 + head * 128;
#pragma unroll
    for (int vt = 0; vt < 4; vt++)
#pragma unroll
      for (int g = 0; g < 4; g++) {
        const int v = vt * 32 + 8 * g + 4 * h;
        uint2 gg = *(const uint2*)(G1 + obase + v);
        uint2 o;
        o.x = pack2(oacc[vt][4 * g + 0] * inv * bflo(gg.x), oacc[vt][4 * g + 1] * inv * bfhi(gg.x));
        o.y = pack2(oacc[vt][4 * g + 2] * inv * bflo(gg.y), oacc[vt][4 * g + 3] * inv * bfhi(gg.y));
        *(uint2*)(OG + obase + v) = o;
      }
  }
}

DI void phase_final(const Params& p, char* smem, int bid, int nblk) {
  char* ws = opaque_ptr(p.ws);
  const int t = TID, lane = t & 63, w = t >> 6;
  const bf16_t* Y = (const bf16_t*)(ws + OFF_Y);
  const float4* gpo = (const float4*)p.l1_post + lane;
  for (int row0 = bid * 4 + w; row0 < S_; row0 += nblk * 8) {
    const int row1r = row0 + nblk * 4;
    const bool has1 = row1r < S_;
    const int row1 = has1 ? row1r : row0;
    const uint2* yr0 = (const uint2*)(Y + (size_t)row0 * 2048) + lane;
    const uint2* yr1 = (const uint2*)(Y + (size_t)row1 * 2048) + lane;
    float4* out0 = (float4*)(p.out + (size_t)row0 * 2048) + lane;
    float4* out1 = (float4*)(p.out + (size_t)row1 * 2048) + lane;
    uint2 ya[8], yb[8];
    float4 xa[8], xb[8];
#pragma unroll
    for (int j = 0; j < 8; j++) { ya[j] = ld_nt(yr0 + j * 64); xa[j] = ld_nt((const float4*)out0 + j * 64); yb[j] = ld_nt(yr1 + j * 64); xb[j] = ld_nt((const float4*)out1 + j * 64); }
    float sa = 0.f, sb = 0.f;
#pragma unroll
    for (int j = 0; j < 8; j++) {
      sa += bflo(ya[j].x) * bflo(ya[j].x) + bfhi(ya[j].x) * bfhi(ya[j].x) + bflo(ya[j].y) * bflo(ya[j].y) + bfhi(ya[j].y) * bfhi(ya[j].y);
      sb += bflo(yb[j].x) * bflo(yb[j].x) + bfhi(yb[j].x) * bfhi(yb[j].x) + bflo(yb[j].y) * bflo(yb[j].y) + bfhi(yb[j].y) * bfhi(yb[j].y);
    }
    sa = wave_sum(sa); sb = wave_sum(sb);
    const float ra = rsqrtf(sa * (1.f / 2048.f) + 1e-6f), rb = rsqrtf(sb * (1.f / 2048.f) + 1e-6f);
#pragma unroll
    for (int j = 0; j < 8; j++) {
      const float4 g = gpo[j * 64];
      float4 o = xa[j];
      o.x += bflo(ya[j].x) * ra * g.x; o.y += bfhi(ya[j].x) * ra * g.y; o.z += bflo(ya[j].y) * ra * g.z; o.w += bfhi(ya[j].y) * ra * g.w;
      st_nt(out0 + j * 64, o);
      if (has1) {
        float4 q = xb[j];
        q.x += bflo(yb[j].x) * rb * g.x; q.y += bfhi(yb[j].x) * rb * g.y; q.z += bflo(yb[j].y) * rb * g.z; q.w += bfhi(yb[j].y) * rb * g.w;
        st_nt(out1 + j * 64, q);
      }
    }
  }
}

constexpr int NPHASE = 13;
constexpr unsigned DUP_MASK = 0u;
DI void run_phase(int ph, const Params& p, char* smem, int bid, int nblk, int rep) {
  switch (ph) {
    case 0: phase_prep(p, smem, bid, nblk); break;
    case 1: phase_gemm_in0(p, smem, bid, nblk); break;
    case 2: phase_gla_prep(p, smem, bid, nblk); break;
    case 3: phase_gla_local(p, smem, bid, nblk); break;
    case 4: phase_gla_scan(p, smem, bid, nblk); break;
    case 5: phase_og(p, smem, bid, nblk); break;
    case 6: phase_gemm_out(p, smem, bid, nblk, OFF_WOUT0T); break;
    case 7: phase_post0(p, smem, bid, nblk); break;
    case 8: phase_gemm_in1(p, smem, bid, nblk); break;
    case 9: phase_gemm_qkv(p, smem, bid, nblk); break;
    case 10: phase_attn(p, smem, bid, nblk, rep); break;
    case 11: phase_gemm_out(p, smem, bid, nblk, OFF_WOUT1T); break;
    case 12: phase_final(p, smem, bid, nblk); break;
  }
}

#define XB_TMO      128
#define XB_XCNT(j)  (256  + 64 * (j))
#define XB_XSUB(j)  (1280 + 64 * (j))
#define XB_XGEN(j)  (2304 + 64 * (j))
#define XB_TOP      3328
#define XB_TOPGEN   3392
#define XCD_BAR_WORDS 3456
#define XB_SPIN_CAP (1u << 20)
#define LAS __attribute__((address_space(3)))
DI unsigned xb_ld(unsigned* p) { return __hip_atomic_load(p, __ATOMIC_RELAXED, __HIP_MEMORY_SCOPE_AGENT); }
DI unsigned xb_add(unsigned* p, unsigned v) { return __hip_atomic_fetch_add(p, v, __ATOMIC_RELAXED, __HIP_MEMORY_SCOPE_AGENT); }
DI unsigned xb_xcc_id() { return (unsigned)__builtin_amdgcn_s_getreg((3 << 11) | 20) & 0xFu; }
#define XB_SPIN(cond, bar) do { unsigned _sp = 0; while (cond) { __builtin_amdgcn_s_sleep(1); \
    if ((++_sp & 255u) == 0u) { if (xb_ld(&(bar)[XB_TMO])) break; if (_sp > XB_SPIN_CAP) { atomicAdd(&(bar)[XB_TMO], 1u); break; } } } } while (0)
struct XcdBarrier { unsigned* bar; unsigned x; volatile LAS unsigned* st; };
DI XcdBarrier xcd_barrier_post(unsigned* bar, volatile LAS unsigned* st) {
  XcdBarrier b; b.bar = bar; b.x = xb_xcc_id(); b.st = st;
  if (threadIdx.x == 0) (void)xb_add(&bar[XB_XCNT(b.x)], 1u);
  return b;
}
DI void xcd_barrier_complete(unsigned* bar, unsigned x, unsigned& nloc, unsigned& nx) {
  const unsigned G = gridDim.x * gridDim.y * gridDim.z;
  unsigned sum, cnt, mine, sp = 0u;
  for (;;) {
    sum = 0u; cnt = 0u; mine = 0u;
#pragma unroll
    for (unsigned j = 0; j < 16; ++j) { const unsigned c = xb_ld(&bar[XB_XCNT(j)]); sum += c; cnt += (c > 0u) ? 1u : 0u; mine = (j == x) ? c : mine; }
    if (sum == G) break;
    __builtin_amdgcn_s_sleep(1);
    if ((++sp & 255u) == 0u) { if (xb_ld(&bar[XB_TMO])) break; if (sp > XB_SPIN_CAP) { atomicAdd(&bar[XB_TMO], 1u); break; } }
  }
  nloc = mine > 0u ? mine : 1u; nx = cnt > 0u ? cnt : 1u;
}
DI void xcd_barrier(const XcdBarrier& b) {
  asm volatile("s_waitcnt vmcnt(0)" ::: "memory");
  __syncthreads();
  if (threadIdx.x == 0) {
    unsigned* bar = b.bar;
    __builtin_amdgcn_s_waitcnt(0);
    unsigned nloc, nx;
    xcd_barrier_complete(bar, b.x, nloc, nx);
    const unsigned old = xb_add(&bar[XB_XSUB(b.x)], 1u);
    const unsigned gen = old / nloc;
    if (old + 1u == (gen + 1u) * nloc) {
      __builtin_amdgcn_fence(__ATOMIC_RELEASE, "agent");
      asm volatile("s_waitcnt vmcnt(0)" ::: "memory");
      const unsigned og = xb_add(&bar[XB_TOP], 1u);
      const unsigned tg = og / nx;
      if (og + 1u == (tg + 1u) * nx) xb_add(&bar[XB_TOPGEN], 1u);
      else XB_SPIN(xb_ld(&bar[XB_TOPGEN]) == tg, bar);
      __builtin_amdgcn_fence(__ATOMIC_ACQUIRE, "agent");
      xb_add(&bar[XB_XGEN(b.x)], 1u);
      asm volatile("s_waitcnt vmcnt(0)" ::: "memory");
    } else {
      XB_SPIN(xb_ld(&bar[XB_XGEN(b.x)]) == gen, bar);
      __builtin_amdgcn_fence(__ATOMIC_ACQUIRE, "agent");
      asm volatile("s_waitcnt vmcnt(0)" ::: "memory");
    }
  }
  __syncthreads();
}

#if MEGA
__global__ void __launch_bounds__(256, 2) mega_kernel(Params p) {
  __shared__ __attribute__((aligned(16))) char smem[69632];
  cg::grid_group grid = cg::this_grid();
  const int bid = blockIdx.x, nblk = gridDim.x;
  (void)xcd_barrier_post((unsigned*)(p.ws + OFF_BAR), (volatile LAS unsigned*)0);
#pragma nounroll
  for (int ph = 0; ph < NPHASE; ph++) {
    int phv = ph;
    asm volatile("" : "+s"(phv));
    run_phase(phv, p, smem, bid, nblk, 0);
    if (p.ws == nullptr) grid.sync();
    { XcdBarrier xb; xb.bar = (unsigned*)(opaque_ptr(p.ws) + OFF_BAR); xb.x = xb_xcc_id(); xb.st = (volatile LAS unsigned*)0; xcd_barrier(xb); }
    if ((DUP_MASK >> ph) & 1u) {
      run_phase(phv, p, smem, bid, nblk, 1);
      { XcdBarrier xb; xb.bar = (unsigned*)(opaque_ptr(p.ws) + OFF_BAR); xb.x = xb_xcc_id(); xb.st = (volatile LAS unsigned*)0; xcd_barrier(xb); }
    }
  }
}
#endif

#if !MEGA
template <int PH>
__global__ void __launch_bounds__(256, 2) phase_kernel_t(Params p) {
  __shared__ __attribute__((aligned(16))) char smem[69632];
  run_phase(PH, p, smem, blockIdx.x, gridDim.x, 0);
}
#endif

extern "C" void kernel_launch(void* const* d_in, const int* in_sizes, int n_in, void* d_out, int out_size, void* d_ws,
                              size_t ws_size, hipStream_t stream) {
  Params p{};
  p.x = (const float*)d_in[0]; p.pos = (const int*)d_in[1]; p.l0_pre = (const float*)d_in[2]; p.w_in0 = (const float*)d_in[3];
  p.w_gk2 = (const float*)d_in[4]; p.b_gk = (const float*)d_in[5]; p.g_onorm = (const float*)d_in[6]; p.w_out0 = (const float*)d_in[7];
  p.l0_post = (const float*)d_in[8]; p.l1_pre = (const float*)d_in[9]; p.w_in1 = (const float*)d_in[10]; p.g_qa = (const float*)d_in[11];
  p.w_qb = (const float*)d_in[12]; p.g_kva = (const float*)d_in[13]; p.w_kvb = (const float*)d_in[14]; p.w_out1 = (const float*)d_in[15];
  p.l1_post = (const float*)d_in[16];
  p.out = (float*)d_out; p.ws = (char*)d_ws;
  for (int i = 0; i < 32; i++) p.invf[i] = (float)pow(10000.0, -(double)i / 32.0);
#if MEGA
  static int grid_blocks = 0;
  if (!grid_blocks) {
    int dev = 0, cus = 0, per_cu = 0;
    hipGetDevice(&dev);
    hipDeviceGetAttribute(&cus, hipDeviceAttributeMultiprocessorCount, dev);
    hipOccupancyMaxActiveBlocksPerMultiprocessor(&per_cu, mega_kernel, 256, 0);
    if (per_cu > 2) per_cu = 2;
    if (per_cu < 1) per_cu = 1;
    grid_blocks = cus * per_cu;
  }
  hipMemsetAsync((char*)d_ws + OFF_BAR, 0, XCD_BAR_WORDS * 4, stream);
  void* args[] = {&p};
  hipError_t e = hipLaunchCooperativeKernel((void*)mega_kernel, dim3(grid_blocks), dim3(256), args, 0, stream);
  if (e != hipSuccess) fprintf(stderr, "cooperative launch failed: %s (grid %d)\n", hipGetErrorString(e), grid_blocks);
#else
#define LPH(N) hipLaunchKernelGGL(phase_kernel_t<N>, dim3(512), dim3(256), 0, stream, p);
  LPH(0) LPH(1) LPH(2) LPH(3) LPH(4) LPH(5) LPH(6) LPH(7) LPH(8) LPH(9) LPH(10) LPH(11) LPH(12)
#undef LPH
#endif
}
```

```cpp
#include <hip/hip_runtime.h>
#include <hip/hip_cooperative_groups.h>
#include <stdint.h>
#include <math.h>
#include <stdio.h>
namespace cg = cooperative_groups;

#ifndef MEGA
#define MEGA 1
#endif

typedef __attribute__((ext_vector_type(8))) short bf16x8;
typedef __attribute__((ext_vector_type(4))) short s16x4;
typedef __attribute__((ext_vector_type(16))) float f32x16;
typedef unsigned short bf16_t;
#define DI __device__ __forceinline__
#define MFMA32(a, b, c) __builtin_amdgcn_mfma_f32_32x32x16_bf16((a), (b), (c), 0, 0, 0)

constexpr int S_ = 8192;
constexpr size_t MiB = (size_t)1 << 20;
constexpr size_t OFF_WIN0T = 0;
constexpr size_t OFF_WOUT0T = 25 * MiB;
constexpr size_t OFF_WIN1T = 33 * MiB;
constexpr size_t OFF_WQBT = 46 * MiB;
constexpr size_t OFF_WKVBT = 49 * MiB;
constexpr size_t OFF_WOUT1T = 53 * MiB;
constexpr size_t OFF_GKLOW = 61 * MiB;
constexpr size_t OFF_DECAY = 61 * MiB + 512 * 1024;
constexpr size_t OFF_CS = 62 * MiB;
constexpr size_t OFF_H = 64 * MiB;
constexpr size_t OFF_QK0 = 96 * MiB;
constexpr size_t OFF_V0T = 128 * MiB;
constexpr size_t OFF_G0 = 160 * MiB;
constexpr size_t OFF_Y = 128 * MiB;
constexpr size_t OFF_QE = 192 * MiB;
constexpr size_t OFF_KLT = 208 * MiB;
constexpr size_t OFF_AM = 224 * MiB;
constexpr size_t OFF_CQ = 0;
constexpr size_t OFF_CKV = 8 * MiB;
constexpr size_t OFF_KR = 16 * MiB;
constexpr size_t OFF_RINVQ = 17 * MiB;
constexpr size_t OFF_RINVKV = 17 * MiB + 64 * 1024;
constexpr size_t OFF_KRRAW = 18 * MiB;
constexpr size_t OFF_CTR = 20 * MiB;
constexpr size_t OFF_BAR = 255 * MiB;
constexpr size_t OFF_SL = 64 * MiB;
constexpr size_t OFF_DC = 80 * MiB;
constexpr size_t OFF_Q = 128 * MiB;
constexpr size_t OFF_KN = 176 * MiB;
constexpr size_t OFF_VT = 208 * MiB;

struct Params {
  const float* x; const int* pos; const float* l0_pre; const float* w_in0; const float* w_gk2; const float* b_gk;
  const float* g_onorm; const float* w_out0; const float* l0_post; const float* l1_pre; const float* w_in1;
  const float* g_qa; const float* w_qb; const float* g_kva; const float* w_kvb; const float* w_out1; const float* l1_post;
  float* out; char* ws;
  float invf[32];
};

DI int tid_opaque() { int t = threadIdx.x; asm volatile("" : "+v"(t)); return t; }
#define TID tid_opaque()
typedef __attribute__((address_space(1))) char gchar_t;
DI char* opaque_ptr(char* q) {
  unsigned long long v = (unsigned long long)q;
  unsigned lo = __builtin_amdgcn_readfirstlane((unsigned)v), hi = __builtin_amdgcn_readfirstlane((unsigned)(v >> 32));
  asm volatile("" : "+s"(lo), "+s"(hi));
  return (char*)(gchar_t*)(((unsigned long long)hi << 32) | lo);
}
typedef __bf16 hbf16x2 __attribute__((ext_vector_type(2)));
typedef float hf32x2 __attribute__((ext_vector_type(2)));
DI unsigned pack2(float a, float b) { hf32x2 f = {a, b}; return __builtin_bit_cast(unsigned, __builtin_convertvector(f, hbf16x2)); }
DI unsigned f2bf(float f) { return (unsigned)__builtin_bit_cast(unsigned short, (__bf16)f); }
DI float bf2f(unsigned h) { return __uint_as_float(h << 16); }
DI float bflo(unsigned u) { return __uint_as_float(u << 16); }
DI float bfhi(unsigned u) { return __uint_as_float(u & 0xffff0000u); }
DI int crow(int i, int h) { return (i & 3) + 8 * (i >> 2) + 4 * h; }
typedef float nt_f4 __attribute__((ext_vector_type(4)));
typedef unsigned nt_u4 __attribute__((ext_vector_type(4)));
typedef unsigned nt_u2 __attribute__((ext_vector_type(2)));
DI float4 ld_nt(const float4* p) { nt_f4 v = __builtin_nontemporal_load((const nt_f4*)p); float4 r; r.x = v.x; r.y = v.y; r.z = v.z; r.w = v.w; return r; }
DI uint4 ld_nt(const uint4* p) { nt_u4 v = __builtin_nontemporal_load((const nt_u4*)p); uint4 r; r.x = v.x; r.y = v.y; r.z = v.z; r.w = v.w; return r; }
DI uint2 ld_nt(const uint2* p) { nt_u2 v = __builtin_nontemporal_load((const nt_u2*)p); uint2 r; r.x = v.x; r.y = v.y; return r; }
DI void st_nt(float4* p, const float4& a) { nt_f4 v = {a.x, a.y, a.z, a.w}; __builtin_nontemporal_store(v, (nt_f4*)p); }
DI float silu(float v) { return v / (1.f + __expf(-v)); }
DI float wave_sum(float v) { for (int o = 32; o > 0; o >>= 1) v += __shfl_xor(v, o); return v; }
DI float block_sum(float v, float* red) {
  v = wave_sum(v);
  __syncthreads();
  if ((TID & 63) == 0) red[TID >> 6] = v;
  __syncthreads();
  return red[0] + red[1] + red[2] + red[3];
}
DI bf16x8 pack8(const f32x16& x, int s) {
  union { unsigned u[4]; bf16x8 v; } p;
  p.u[0] = pack2(x[8 * s + 0], x[8 * s + 1]); p.u[1] = pack2(x[8 * s + 2], x[8 * s + 3]);
  p.u[2] = pack2(x[8 * s + 4], x[8 * s + 5]); p.u[3] = pack2(x[8 * s + 6], x[8 * s + 7]);
  return p.v;
}

DI void transpose_tile4(const float* __restrict__ W, int K, int N, int ntN, const float* __restrict__ gain, bf16_t* __restrict__ WT,
                        int id0, char* smem) {
  const int t = TID;
  float v[4][16];
#pragma unroll
  for (int q = 0; q < 4; q++) {
    const int id = id0 + q, k0 = (id / ntN) * 64, n0 = (id % ntN) * 64;
#pragma unroll
    for (int i = 0; i < 16; i++) {
      const int kk = i * 4 + (t >> 6), n = n0 + (t & 63);
      float x = (n < N) ? __builtin_nontemporal_load(&W[(size_t)(k0 + kk) * N + n]) : 0.f;
      if (gain) x *= gain[k0 + kk];
      v[q][i] = x;
    }
  }
#pragma unroll
  for (int q = 0; q < 4; q++) {
    unsigned short (*tile)[72] = (unsigned short (*)[72])(smem + q * 9216);
#pragma unroll
    for (int i = 0; i < 16; i++) tile[t & 63][i * 4 + (t >> 6)] = (unsigned short)f2bf(v[q][i]);
  }
  __syncthreads();
#pragma unroll
  for (int q = 0; q < 4; q++) {
    unsigned short (*tile)[72] = (unsigned short (*)[72])(smem + q * 9216);
    const int id = id0 + q, k0 = (id / ntN) * 64, n0 = (id % ntN) * 64;
    const int nn = t >> 2, kg = (t & 3) * 16;
    uint4 a = *(const uint4*)&tile[nn][kg];
    uint4 b = *(const uint4*)&tile[nn][kg + 8];
    bf16_t* dst = WT + (size_t)(n0 + nn) * K + k0 + kg;
    *(uint4*)dst = a; *(uint4*)(dst + 8) = b;
  }
  __syncthreads();
}

DI void phase_prep(const Params& p, char* smem, int bid, int nblk) {
  const int t = TID;
  char* ws = opaque_ptr(p.ws);
  for (int task = bid; task < 1920 + 3072; task += nblk) {
    if (task < 1920) {
      const int tile0 = task * 4;
      const float* W; const float* gain = nullptr; bf16_t* WT; int K, N, ntN, id;
      if (tile0 < 3136) { id = tile0; W = p.w_in0; K = 2048; N = 6160; ntN = 98; WT = (bf16_t*)(ws + OFF_WIN0T); }
      else if (tile0 < 4160) { id = tile0 - 3136; W = p.w_out0; K = 2048; N = 2048; ntN = 32; WT = (bf16_t*)(ws + OFF_WOUT0T); }
      else if (tile0 < 5760) { id = tile0 - 4160; W = p.w_in1; K = 2048; N = 3136; ntN = 50; WT = (bf16_t*)(ws + OFF_WIN1T); }
      else if (tile0 < 6144) { id = tile0 - 5760; W = p.w_qb; K = 512; N = 3072; ntN = 48; WT = (bf16_t*)(ws + OFF_WQBT); gain = p.g_qa; }
      else if (tile0 < 6656) { id = tile0 - 6144; W = p.w_kvb; K = 512; N = 4096; ntN = 64; WT = (bf16_t*)(ws + OFF_WKVBT); gain = p.g_kva; }
      else { id = tile0 - 6656; W = p.w_out1; K = 2048; N = 2048; ntN = 32; WT = (bf16_t*)(ws + OFF_WOUT1T); }
      transpose_tile4(W, K, N, ntN, gain, WT, id, smem);
    } else if (task < 1920 + 2048) {
      const int lane = t & 63, row = (task - 1920) * 4 + (t >> 6);
      const float4* xr = (const float4*)(p.x + (size_t)row * 2048) + lane;
      const float4* gr = (const float4*)p.l0_pre + lane;
      float4 xv[8];
#pragma unroll
      for (int j = 0; j < 8; j++) xv[j] = ld_nt(xr + j * 64);
      float ss = 0.f;
#pragma unroll
      for (int j = 0; j < 8; j++) ss += xv[j].x * xv[j].x + xv[j].y * xv[j].y + xv[j].z * xv[j].z + xv[j].w * xv[j].w;
      ss = wave_sum(ss);
      const float rinv = rsqrtf(ss * (1.f / 2048.f) + 1e-6f);
      uint2* hr = (uint2*)(ws + OFF_H + (size_t)row * 4096) + lane;
#pragma unroll
      for (int j = 0; j < 8; j++) {
        const float4 g = gr[j * 64];
        uint2 o; o.x = pack2(xv[j].x * rinv * g.x, xv[j].y * rinv * g.y); o.y = pack2(xv[j].z * rinv * g.z, xv[j].w * rinv * g.w);
        hr[j * 64] = o;
      }
    } else {
      const int idx = (task - 3968) * 256 + t;
      const int token = idx >> 5, i = idx & 31;
      double ang = (double)p.pos[token] * (double)p.invf[i];
      double tt = ang * 0.15915494309189535;
      tt -= floor(tt + 0.5);
      float f = (float)tt;
      float* cs = (float*)(ws + OFF_CS);
      cs[token * 64 + i] = __builtin_amdgcn_cosf(f);
      cs[token * 64 + 32 + i] = __builtin_amdgcn_sinf(f);
    }
  }
}

DI float sq8(const uint4& v) {
  return bflo(v.x) * bflo(v.x) + bfhi(v.x) * bfhi(v.x) + bflo(v.y) * bflo(v.y) + bfhi(v.y) * bfhi(v.y) + bflo(v.z) * bflo(v.z) + bfhi(v.z) * bfhi(v.z) +
         bflo(v.w) * bflo(v.w) + bfhi(v.w) * bfhi(v.w);
}
template <bool SWAP, bool SUMSQ = false>
DI void gemm_main(f32x16 (&acc)[4][2], const bf16_t* A, int lda, const bf16_t* B, int ldb, int K,
                  int m0, int n0, char* smem) {
  const int t = TID, lane = t & 63, w = t >> 6, wm = w >> 1, wn = w & 1, r = lane & 31, h = lane >> 5;
#pragma unroll
  for (int a = 0; a < 4; a++)
#pragma unroll
    for (int b = 0; b < 2; b++)
#pragma unroll
      for (int i = 0; i < 16; i++) acc[a][b][i] = 0.f;
  const int lrow = t >> 2, kc = t & 3;
  const bf16_t* ag = A + (size_t)(m0 + lrow) * lda + kc * 8;
  const bf16_t* bg = B + (size_t)(n0 + lrow) * ldb + kc * 8;
  const int lds_w = lrow * 64 + ((kc ^ ((lrow >> 2) & 3)) << 4);
  uint4 pa0, pa1, pa2, pa3, pb0, pb1;
  bf16x8 fa0, fa1, fa2, fa3, fa4, fa5, fb0, fb1, fb2, fb3, fb4, fb5;
#define G_LOAD(X, ko_)                                                                                   \
  X##a0 = *(const uint4*)(ag + (ko_)); X##a1 = *(const uint4*)(ag + (size_t)64 * lda + (ko_));           \
  X##a2 = *(const uint4*)(ag + (size_t)128 * lda + (ko_)); X##a3 = *(const uint4*)(ag + (size_t)192 * lda + (ko_)); \
  X##b0 = *(const uint4*)(bg + (ko_)); X##b1 = *(const uint4*)(bg + (size_t)64 * ldb + (ko_));
#define L_STORE(X, base_)                                                                                \
  *(uint4*)((base_) + lds_w) = X##a0; *(uint4*)((base_) + lds_w + 4096) = X##a1;                         \
  *(uint4*)((base_) + lds_w + 8192) = X##a2; *(uint4*)((base_) + lds_w + 12288) = X##a3;                 \
  *(uint4*)((base_) + 16384 + lds_w) = X##b0; *(uint4*)((base_) + 16384 + lds_w + 4096) = X##b1;         \
  if (SUMSQ) { q0 += sq8(X##a0); q1 += sq8(X##a1); q2 += sq8(X##a2); q3 += sq8(X##a3); }
#define G_READ(F, base_, c_)                                                                             \
  F##0 = *(const bf16x8*)((base_) + a_off + (c_)); F##1 = *(const bf16x8*)((base_) + a_off + 32 * 64 + (c_));              \
  F##2 = *(const bf16x8*)((base_) + a_off + 64 * 64 + (c_)); F##3 = *(const bf16x8*)((base_) + a_off + 96 * 64 + (c_));    \
  F##4 = *(const bf16x8*)((base_) + b_off + (c_)); F##5 = *(const bf16x8*)((base_) + b_off + 32 * 64 + (c_));
#define G_MMA(a0, a1, a2, a3, b0, b1)                                                                    \
    if (SWAP) {                                                                                          \
      acc[0][0] = MFMA32(b0, a0, acc[0][0]); acc[0][1] = MFMA32(b1, a0, acc[0][1]);                      \
      acc[1][0] = MFMA32(b0, a1, acc[1][0]); acc[1][1] = MFMA32(b1, a1, acc[1][1]);                      \
      acc[2][0] = MFMA32(b0, a2, acc[2][0]); acc[2][1] = MFMA32(b1, a2, acc[2][1]);                      \
      acc[3][0] = MFMA32(b0, a3, acc[3][0]); acc[3][1] = MFMA32(b1, a3, acc[3][1]);                      \
    } else {                                                                                             \
      acc[0][0] = MFMA32(a0, b0, acc[0][0]); acc[0][1] = MFMA32(a0, b1, acc[0][1]);                      \
      acc[1][0] = MFMA32(a1, b0, acc[1][0]); acc[1][1] = MFMA32(a1, b1, acc[1][1]);                      \
      acc[2][0] = MFMA32(a2, b0, acc[2][0]); acc[2][1] = MFMA32(a2, b1, acc[2][1]);                      \
      acc[3][0] = MFMA32(a3, b0, acc[3][0]); acc[3][1] = MFMA32(a3, b1, acc[3][1]);                      \
    }
#define G_MMA6(F) G_MMA(F##0, F##1, F##2, F##3, F##4, F##5)
  float q0 = 0.f, q1 = 0.f, q2 = 0.f, q3 = 0.f;
  const int sw = (r >> 2) & 3;
  const int a_off = (wm * 128 + r) * 64, b_off = 16384 + (wn * 64 + r) * 64;
  const int c0 = (h ^ sw) << 4, c1 = ((2 + h) ^ sw) << 4;
  const int nk = K >> 5;
  G_LOAD(p, 0)
  L_STORE(p, smem)
  G_LOAD(p, 32)
  __syncthreads();
  G_READ(fa, smem, c0)
  G_READ(fb, smem, c1)
  G_MMA6(fa)
  asm volatile("" ::: "memory");
  __builtin_amdgcn_sched_barrier(0);
  L_STORE(p, smem + 24576)
  {
    const int kn = ((2 < nk) ? 2 : (nk - 1)) * 32;
    G_LOAD(p, kn)
  }
  __syncthreads();
  for (int kt = 0; kt < nk - 1; kt++) {
    const char* nb = smem + ((kt + 1) & 1) * 24576;
    G_READ(fa, nb, c0)
    G_MMA6(fb)
    G_READ(fb, nb, c1)
    G_MMA6(fa)
    __builtin_amdgcn_sched_group_barrier(0x100, 6, 0);
    __builtin_amdgcn_sched_group_barrier(0x008, 8, 0);
    __builtin_amdgcn_sched_group_barrier(0x100, 6, 0);
    __builtin_amdgcn_sched_group_barrier(0x008, 8, 0);
    asm volatile("" ::: "memory");
    __builtin_amdgcn_sched_barrier(0);
    if (kt + 2 < nk) {
      L_STORE(p, smem + (kt & 1) * 24576)
    }
    {
      const int kn = ((kt + 3 < nk) ? (kt + 3) : (nk - 1)) * 32;
      G_LOAD(p, kn)
    }
    __syncthreads();
  }
  G_MMA6(fb)
#undef G_LOAD
#undef L_STORE
#undef G_READ
#undef G_MMA
#undef G_MMA6
  if (SUMSQ) {
    q0 += __shfl_xor(q0, 1); q1 += __shfl_xor(q1, 1); q2 += __shfl_xor(q2, 1); q3 += __shfl_xor(q3, 1);
    q0 += __shfl_xor(q0, 2); q1 += __shfl_xor(q1, 2); q2 += __shfl_xor(q2, 2); q3 += __shfl_xor(q3, 2);
    if (kc == 0) {
      float* rf = (float*)(smem + 49152);
      const float ik = 1.f / (float)K;
      rf[lrow] = rsqrtf(q0 * ik + 1e-6f); rf[lrow + 64] = rsqrtf(q1 * ik + 1e-6f);
      rf[lrow + 128] = rsqrtf(q2 * ik + 1e-6f); rf[lrow + 192] = rsqrtf(q3 * ik + 1e-6f);
    }
    __syncthreads();
  }
}

#define EPI_LOOP_BEGIN                                                                                           \
  {                                                                                                              \
    const int lane_ = TID & 63, w_ = TID >> 6, wm_ = w_ >> 1, wn_ = w_ & 1, r_ = lane_ & 31, h_ = lane_ >> 5; \
    _Pragma("unroll") for (int mt = 0; mt < 4; mt++) _Pragma("unroll") for (int nt = 0; nt < 2; nt++)          \
        _Pragma("unroll") for (int i = 0; i < 16; i++) {                                                         \
      const float v = acc[mt][nt][i];
#define EPI_COORD_NS const int row = m0 + wm_ * 128 + mt * 32 + crow(i, h_); const int col = n0 + wn_ * 64 + nt * 32 + r_;
#define EPI_COORD_SW const int row = m0 + wm_ * 128 + mt * 32 + r_; const int col = n0 + wn_ * 64 + nt * 32 + crow(i, h_);
#define EPI_LOOP_END }}

DI void phase_gemm_in0(const Params& p, char* smem, int bid, int nblk) {
  char* ws = opaque_ptr(p.ws);
  const bf16_t* A = (const bf16_t*)(ws + OFF_H);
  const bf16_t* B = (const bf16_t*)(ws + OFF_WIN0T);
  bf16_t* QK = (bf16_t*)(ws + OFF_QK0);
  bf16_t* V0T = (bf16_t*)(ws + OFF_V0T);
  bf16_t* G0 = (bf16_t*)(ws + OFF_G0);
  float* GKL = (float*)(ws + OFF_GKLOW);
  for (int tile = bid; tile < 32 * 48; tile += nblk) {
    const int mi = tile & 31, ni = tile >> 5;
    const int m0 = mi * 256, n0 = ni * 128;
    f32x16 acc[4][2];
    if (ni >= 16) {
      if (ni < 32) {
        gemm_main<true>(acc, A, 2048, B, 2048, 2048, m0, n0, smem);
        EPI_LOOP_BEGIN EPI_COORD_SW
          V0T[(size_t)(col - 2048) * S_ + row] = (bf16_t)f2bf(v);
        EPI_LOOP_END
      } else {
        gemm_main<false>(acc, A, 2048, B, 2048, 2048, m0, n0, smem);
        EPI_LOOP_BEGIN EPI_COORD_NS
          G0[(size_t)row * 2048 + (col - 4096)] = (bf16_t)f2bf(silu(v));
        EPI_LOOP_END
      }
    } else {
      gemm_main<false>(acc, A, 2048, B, 2048, 2048, m0, n0, smem);
      EPI_LOOP_BEGIN EPI_COORD_NS
        QK[(size_t)row * 2048 + col] = (bf16_t)f2bf(v);
      EPI_LOOP_END
    }
  }
  {
    typedef __attribute__((ext_vector_type(4))) float f32x4_t;
    const int t = TID, lane = t & 63, w = t >> 6, l15 = lane & 15, quad = lane >> 4;
    float* red = (float*)smem;
    for (int item = bid; item < 512; item += nblk) {
      const bf16_t* ap = A + (size_t)(item * 16 + l15) * 2048 + 512 * w + 8 * quad;
      const bf16_t* bp = B + (size_t)(6144 + l15) * 2048 + 512 * w + 8 * quad;
      f32x4_t c = {0.f, 0.f, 0.f, 0.f};
#pragma unroll
      for (int s = 0; s < 16; s++) {
        const bf16x8 a = *(const bf16x8*)(ap + 32 * s);
        const bf16x8 b = *(const bf16x8*)(bp + 32 * s);
        c = __builtin_amdgcn_mfma_f32_16x16x32_bf16(a, b, c, 0, 0, 0);
      }
      __syncthreads();
#pragma unroll
      for (int j = 0; j < 4; j++) red[(w * 16 + quad * 4 + j) * 16 + l15] = c[j];
      __syncthreads();
      const float v = red[t] + red[256 + t] + red[512 + t] + red[768 + t];
      GKL[(size_t)item * 256 + t] = v;
    }
  }
}

DI void phase_gla_prep(const Params& p, char* smem, int bid, int nblk) {
  char* ws = opaque_ptr(p.ws);
  const int t = TID, lane = t & 63, w = t >> 6, r = lane & 31, h = lane >> 5;
  const bf16_t* QK = (const bf16_t*)(ws + OFF_QK0);
  const float* GKL = (const float*)(ws + OFF_GKLOW);
  bf16_t* QE = (bf16_t*)(ws + OFF_QE);
  bf16_t* KLT = (bf16_t*)(ws + OFF_KLT);
  bf16_t* AM = (bf16_t*)(ws + OFF_AM);
  float* DEC = (float*)(ws + OFF_DECAY);
  if (bid == 0 && t == 0) { ((int*)(ws + OFF_CTR))[0] = 0; ((int*)(ws + OFF_CTR))[1] = 0; }
  char* lq = smem;
  char* lk = smem + 32768;
  for (int tile = bid; tile < 512; tile += nblk) {
    const int n = tile >> 2, head = tile & 3, t0 = n * 64, d = t, col = head * 256 + d;
    __syncthreads();
    ((float4*)(smem + 65536))[t] = ((const float4*)(GKL + (size_t)t0 * 16))[t];
    __syncthreads();
    float w2[16];
#pragma unroll
    for (int j = 0; j < 16; j++) w2[j] = p.w_gk2[j * 1024 + col];
    const float bias = p.b_gk[col];
    float b = 0.f;
    const int dperm = (d & ~15) | ((d & 3) | ((d & 4) << 1) | ((d & 8) >> 1));
    for (int c16 = 0; c16 < 4; c16++) {
      float bj[16], qv[16], kv[16];
#pragma unroll
      for (int j = 0; j < 16; j++) {
        const int c = c16 * 16 + j;
        const float4* gl = (const float4*)(smem + 65536) + c * 4;
        float4 g0 = gl[0], g1 = gl[1], g2 = gl[2], g3 = gl[3];
        float gk = bias + g0.x * w2[0] + g0.y * w2[1] + g0.z * w2[2] + g0.w * w2[3] + g1.x * w2[4] + g1.y * w2[5] + g1.z * w2[6] + g1.w * w2[7]
                 + g2.x * w2[8] + g2.y * w2[9] + g2.z * w2[10] + g2.w * w2[11] + g3.x * w2[12] + g3.y * w2[13] + g3.z * w2[14] + g3.w * w2[15];
        float la = (fminf(gk, 0.f) - __logf(1.f + __expf(-fabsf(gk)))) * (1.f / 16.f);
        b += la;
        bj[j] = b;
        qv[j] = bf2f(QK[(size_t)(t0 + c) * 2048 + col]);
        kv[j] = bf2f(QK[(size_t)(t0 + c) * 2048 + 1024 + col]);
      }
      unsigned klp[8];
#pragma unroll
      for (int j = 0; j < 16; j++) {
        const int c = c16 * 16 + j;
        const float qe = qv[j] * 0.0625f * __expf(bj[j]);
        const float ke = kv[j] * __expf(-bj[j]);
        const unsigned qeb = f2bf(qe), keb = f2bf(ke), klb = keb;
        const int lo = c * 512 + ((((d >> 3) ^ (c & 15))) << 4) + (d & 7) * 2;
        *(unsigned short*)(lq + lo) = (unsigned short)qeb;
        *(unsigned short*)(lk + lo) = (unsigned short)keb;
        QE[(size_t)(t0 + c) * 1024 + head * 256 + dperm] = (bf16_t)qeb;
        if (j & 1) klp[j >> 1] |= klb << 16; else klp[j >> 1] = klb;
      }
      uint4 o0, o1; o0.x = klp[0]; o0.y = klp[1]; o0.z = klp[2]; o0.w = klp[3]; o1.x = klp[4]; o1.y = klp[5]; o1.z = klp[6]; o1.w = klp[7];
      bf16_t* kdst = KLT + (size_t)(head * 256 + d) * S_ + t0 + c16 * 16;
      *(uint4*)kdst = o0; *(uint4*)(kdst + 8) = o1;
    }
    DEC[(size_t)(n * 4 + head) * 256 + d] = __expf(b);
    __syncthreads();
    {
      const int ct = w >> 1, st = w & 1;
      f32x16 acc;
#pragma unroll
      for (int i = 0; i < 16; i++) acc[i] = 0.f;
      if (!(ct == 0 && st == 1)) {
        const int ra = ct * 32 + r, rb = st * 32 + r;
#pragma unroll
        for (int s = 0; s < 16; s++) {
          bf16x8 a = *(const bf16x8*)(lq + ra * 512 + (((2 * s + h) ^ (ra & 15)) << 4));
          bf16x8 bb = *(const bf16x8*)(lk + rb * 512 + (((2 * s + h) ^ (rb & 15)) << 4));
          acc = MFMA32(a, bb, acc);
        }
      }
      bf16_t* ap = AM + (size_t)(n * 4 + head) * 4096;
#pragma unroll
      for (int i = 0; i < 16; i++) {
        const int c = ct * 32 + crow(i, h), s = st * 32 + r;
        ap[c * 64 + s] = (bf16_t)f2bf(s <= c ? acc[i] : 0.f);
      }
    }
    __syncthreads();
  }
}

constexpr int SCAN_NG = 8, SCAN_GC = 16;
DI void phase_gla_local(const Params& p, char* smem, int bid, int nblk) {
  char* ws = opaque_ptr(p.ws);
  const int t = TID, lane = t & 63, w = t >> 6, r = lane & 31, h = lane >> 5;
  for (int item = bid; item < 64 * (SCAN_NG - 1); item += nblk) {
    const int grp = item >> 6, head = (item >> 4) & 3, dvt = item & 15, dv0 = dvt * 32;
    const int nb = grp * SCAN_GC;
    const bf16_t* v_p = (const bf16_t*)(ws + OFF_V0T) + (size_t)(head * 512 + dv0 + r) * S_ + nb * 64 + 8 * h;
    const bf16_t* kl_p = (const bf16_t*)(ws + OFF_KLT) + (size_t)(head * 256 + 64 * w + r) * S_ + nb * 64 + 8 * h;
    const float* dec_p = (const float*)(ws + OFF_DECAY) + (size_t)nb * 1024 + head * 256 + 64 * w + 4 * h;
    f32x16 St[2];
#pragma unroll
    for (int i = 0; i < 16; i++) { St[0][i] = 0.f; St[1][i] = 0.f; }
    bf16x8 klA[2][4], vfA[4], klB[2][4], vfB[4];
    float4 dcA[2][4], dcB[2][4];
#define LOC_LOAD(KL, VF, DC, n_)                                                                                 \
    {                                                                                                            \
      _Pragma("unroll") for (int s = 0; s < 4; s++) VF[s] = *(const bf16x8*)(v_p + (n_) * 64 + 16 * s);        \
      _Pragma("unroll") for (int dt = 0; dt < 2; dt++) {                                                         \
        _Pragma("unroll") for (int s = 0; s < 4; s++) KL[dt][s] = *(const bf16x8*)(kl_p + (size_t)dt * 32 * S_ + (n_) * 64 + 16 * s); \
        _Pragma("unroll") for (int g4 = 0; g4 < 4; g4++) DC[dt][g4] = *(const float4*)(dec_p + (size_t)(n_) * 1024 + dt * 32 + 8 * g4); \
      }                                                                                                          \
    }
#define LOC_STEP(KL, VF, DC)                                                                                     \
    {                                                                                                            \
      _Pragma("unroll") for (int dt = 0; dt < 2; dt++) {                                                         \
        _Pragma("unroll") for (int s = 0; s < 4; s++) St[dt] = MFMA32(KL[dt][s], VF[s], St[dt]);                 \
        _Pragma("unroll") for (int g4 = 0; g4 < 4; g4++) {                                                       \
          St[dt][4 * g4 + 0] *= DC[dt][g4].x; St[dt][4 * g4 + 1] *= DC[dt][g4].y;                                \
          St[dt][4 * g4 + 2] *= DC[dt][g4].z; St[dt][4 * g4 + 3] *= DC[dt][g4].w;                                \
        }                                                                                                        \
      }                                                                                                          \
    }
    LOC_LOAD(klA, vfA, dcA, 0)
    for (int n = 0; n < SCAN_GC; n += 2) {
      LOC_LOAD(klB, vfB, dcB, n + 1)
      LOC_STEP(klA, vfA, dcA)
      if (n + 2 < SCAN_GC) LOC_LOAD(klA, vfA, dcA, n + 2)
      LOC_STEP(klB, vfB, dcB)
    }
#undef LOC_LOAD
#undef LOC_STEP
    float* sl = (float*)(ws + OFF_SL) + ((size_t)((grp * 4 + head) * 16 + dvt) * 4 + w) * 2048 + lane;
#pragma unroll
    for (int dt = 0; dt < 2; dt++)
#pragma unroll
      for (int i = 0; i < 16; i++) sl[(dt * 16 + i) * 64] = St[dt][i];
    if (dvt == 0) {
      const float* dg = (const float*)(ws + OFF_DECAY) + (size_t)nb * 1024 + head * 256 + t;
      float pr = 1.f;
#pragma unroll 4
      for (int n = 0; n < SCAN_GC; n++) pr *= dg[(size_t)n * 1024];
      ((float*)(ws + OFF_DC))[(grp * 4 + head) * 256 + t] = pr;
    }
  }
}

DI void phase_gla_scan(const Params& p, char* smem, int bid, int nblk) {
  char* ws = opaque_ptr(p.ws);
  const int t = TID, lane = t & 63, w = t >> 6, r = lane & 31, h = lane >> 5;
  float* lo = (float*)smem;
  for (int item = bid; item < 64 * SCAN_NG; item += nblk) {
    const int grp = item >> 6, head = (item >> 4) & 3, dvt = item & 15, dv0 = dvt * 32;
    const int nb = grp * SCAN_GC, ne = nb + SCAN_GC;
    const bf16_t* qe_p = (const bf16_t*)(ws + OFF_QE) + (size_t)r * 1024 + head * 256 + 64 * w + 8 * h;
    const bf16_t* a_p = (const bf16_t*)(ws + OFF_AM) + (size_t)head * 4096 + (size_t)r * 64 + 16 * w + 8 * h;
    const bf16_t* v_p = (const bf16_t*)(ws + OFF_V0T) + (size_t)(head * 512 + dv0 + r) * S_ + 8 * h;
    const bf16_t* kl_p = (const bf16_t*)(ws + OFF_KLT) + (size_t)(head * 256 + 64 * w + r) * S_ + 8 * h;
    bf16_t* o_p = (bf16_t*)(ws + OFF_QK0) + (size_t)(t >> 2) * 2048 + head * 512 + dv0 + (t & 3) * 8;
    f32x16 St[2];
#pragma unroll
    for (int i = 0; i < 16; i++) { St[0][i] = 0.f; St[1][i] = 0.f; }
    for (int j = 0; j < grp; j++) {
      const float* slj = (const float*)(ws + OFF_SL) + ((size_t)((j * 4 + head) * 16 + dvt) * 4 + w) * 2048 + lane;
      const float* dcj = (const float*)(ws + OFF_DC) + (j * 4 + head) * 256 + 64 * w + 4 * h;
#pragma unroll
      for (int dt = 0; dt < 2; dt++)
#pragma unroll
        for (int g4 = 0; g4 < 4; g4++) {
          const float4 dv = *(const float4*)(dcj + 32 * dt + 8 * g4);
          St[dt][4 * g4 + 0] = St[dt][4 * g4 + 0] * dv.x + slj[(dt * 16 + 4 * g4 + 0) * 64];
          St[dt][4 * g4 + 1] = St[dt][4 * g4 + 1] * dv.y + slj[(dt * 16 + 4 * g4 + 1) * 64];
          St[dt][4 * g4 + 2] = St[dt][4 * g4 + 2] * dv.z + slj[(dt * 16 + 4 * g4 + 2) * 64];
          St[dt][4 * g4 + 3] = St[dt][4 * g4 + 3] * dv.w + slj[(dt * 16 + 4 * g4 + 3) * 64];
        }
    }
    qe_p += (size_t)nb * 64 * 1024; a_p += (size_t)nb * 4 * 4096; v_p += nb * 64; kl_p += nb * 64; o_p += (size_t)nb * 64 * 2048;
    bf16x8 qe[2][4], af[2], vf[4], kl[2][4];
    float* ldec = (float*)(smem + 32768);
    const float* dec_g = (const float*)(ws + OFF_DECAY) + (size_t)nb * 1024 + head * 256 + t;
#pragma unroll
    for (int ct = 0; ct < 2; ct++) {
#pragma unroll
      for (int s = 0; s < 4; s++) qe[ct][s] = *(const bf16x8*)(qe_p + (size_t)ct * 32 * 1024 + 16 * s);
      af[ct] = *(const bf16x8*)(a_p + ct * 32 * 64);
    }
#pragma unroll
    for (int s = 0; s < 4; s++) vf[s] = *(const bf16x8*)(v_p + 16 * s);
#pragma unroll
    for (int dt = 0; dt < 2; dt++) {
#pragma unroll
      for (int s = 0; s < 4; s++) kl[dt][s] = *(const bf16x8*)(kl_p + (size_t)dt * 32 * S_ + 16 * s);
    }
    __syncthreads();
    ldec[t] = dec_g[0];
    __syncthreads();
    for (int n = 0; n < SCAN_GC; n++) {
      const bool more = (n + 1 < SCAN_GC);
      float decn = 0.f;
      if (more) decn = dec_g[(size_t)(n + 1) * 1024];
      f32x16 o[2];
#pragma unroll
      for (int i = 0; i < 16; i++) { o[0][i] = 0.f; o[1][i] = 0.f; }
#pragma unroll
      for (int s = 0; s < 4; s++) {
        bf16x8 sb = pack8(St[s >> 1], s & 1);
        o[0] = MFMA32(qe[0][s], sb, o[0]);
        o[1] = MFMA32(qe[1][s], sb, o[1]);
      }
      if (more) {
        const bf16_t* q2 = qe_p + (size_t)(n + 1) * 64 * 1024;
#pragma unroll
        for (int ct = 0; ct < 2; ct++)
#pragma unroll
          for (int s = 0; s < 4; s++) qe[ct][s] = *(const bf16x8*)(q2 + (size_t)ct * 32 * 1024 + 16 * s);
      }
      {
        bf16x8 vw = (w == 0) ? vf[0] : (w == 1) ? vf[1] : (w == 2) ? vf[2] : vf[3];
        o[0] = MFMA32(af[0], vw, o[0]);
        o[1] = MFMA32(af[1], vw, o[1]);
      }
      if (more) {
        const bf16_t* a2 = a_p + (size_t)(n + 1) * 4 * 4096;
        af[0] = *(const bf16x8*)(a2); af[1] = *(const bf16x8*)(a2 + 32 * 64);
      }
#pragma unroll
      for (int dt = 0; dt < 2; dt++) {
#pragma unroll
        for (int s = 0; s < 4; s++) St[dt] = MFMA32(kl[dt][s], vf[s], St[dt]);
#pragma unroll
        for (int g = 0; g < 4; g++) {
          const float4 dv = *(const float4*)(ldec + (n & 1) * 256 + 64 * w + 32 * dt + 8 * g + 4 * h);
          St[dt][4 * g + 0] *= dv.x; St[dt][4 * g + 1] *= dv.y;
          St[dt][4 * g + 2] *= dv.z; St[dt][4 * g + 3] *= dv.w;
        }
      }
      if (more) {
        const int tn = (n + 1) * 64;
#pragma unroll
        for (int s = 0; s < 4; s++) vf[s] = *(const bf16x8*)(v_p + tn + 16 * s);
#pragma unroll
        for (int dt = 0; dt < 2; dt++) {
#pragma unroll
          for (int s = 0; s < 4; s++) kl[dt][s] = *(const bf16x8*)(kl_p + (size_t)dt * 32 * S_ + tn + 16 * s);
        }
      }
      ldec[((n + 1) & 1) * 256 + t] = decn;
#pragma unroll
      for (int ct = 0; ct < 2; ct++)
#pragma unroll
        for (int i = 0; i < 16; i++) lo[(w * 64 + ct * 32 + crow(i, h)) * 32 + r] = o[ct][i];
      __syncthreads();
      {
        const int c = t >> 2, vg = (t & 3) * 8;
        float4 s0 = *(const float4*)(lo + c * 32 + vg), s1 = *(const float4*)(lo + c * 32 + vg + 4);
#pragma unroll
        for (int ww = 1; ww < 4; ww++) {
          float4 x0 = *(const float4*)(lo + (ww * 64 + c) * 32 + vg), x1 = *(const float4*)(lo + (ww * 64 + c) * 32 + vg + 4);
          s0.x += x0.x; s0.y += x0.y; s0.z += x0.z; s0.w += x0.w; s1.x += x1.x; s1.y += x1.y; s1.z += x1.z; s1.w += x1.w;
        }
        uint4 ov; ov.x = pack2(s0.x, s0.y); ov.y = pack2(s0.z, s0.w); ov.z = pack2(s1.x, s1.y); ov.w = pack2(s1.z, s1.w);
        *(uint4*)(o_p + (size_t)n * 64 * 2048) = ov;
      }
      __syncthreads();
    }
  }
}

DI void phase_og(const Params& p, char* smem, int bid, int nblk) {
  char* ws = opaque_ptr(p.ws);
  const int t = TID, lane = t & 63, w = t >> 6;
  const bf16_t* O0 = (const bf16_t*)(ws + OFF_QK0);
  const bf16_t* G0 = (const bf16_t*)(ws + OFF_G0);
  bf16_t* OG = (bf16_t*)(ws + OFF_H);
  const float4* gp = (const float4*)(p.g_onorm + lane * 8);
  const float4 ga = gp[0], gb = gp[1];
  for (int token = bid; token < S_; token += 4 * nblk) {
    uint4 ov[4], gv[4];
#pragma unroll
    for (int u = 0; u < 4; u++) {
      const int tk = token + u * nblk;
      const size_t off = (size_t)(tk < S_ ? tk : token) * 2048 + w * 512 + lane * 8;
      ov[u] = ld_nt((const uint4*)(O0 + off));
      gv[u] = ld_nt((const uint4*)(G0 + off));
    }
#pragma unroll
    for (int u = 0; u < 4; u++) {
      const int tk = token + u * nblk;
      const size_t off = (size_t)tk * 2048 + w * 512 + lane * 8;
      const float f0 = bflo(ov[u].x), f1 = bfhi(ov[u].x), f2 = bflo(ov[u].y), f3 = bfhi(ov[u].y);
      const float f4 = bflo(ov[u].z), f5 = bfhi(ov[u].z), f6 = bflo(ov[u].w), f7 = bfhi(ov[u].w);
      float ss = f0 * f0 + f1 * f1 + f2 * f2 + f3 * f3 + f4 * f4 + f5 * f5 + f6 * f6 + f7 * f7;
      ss = wave_sum(ss);
      const float rinv = rsqrtf(ss * (1.f / 512.f) + 1e-6f);
      uint4 o;
      o.x = pack2(f0 * rinv * ga.x * bflo(gv[u].x), f1 * rinv * ga.y * bfhi(gv[u].x));
      o.y = pack2(f2 * rinv * ga.z * bflo(gv[u].y), f3 * rinv * ga.w * bfhi(gv[u].y));
      o.z = pack2(f4 * rinv * gb.x * bflo(gv[u].z), f5 * rinv * gb.y * bfhi(gv[u].z));
      o.w = pack2(f6 * rinv * gb.z * bflo(gv[u].w), f7 * rinv * gb.w * bfhi(gv[u].w));
      if (tk < S_) *(uint4*)(OG + off) = o;
    }
  }
}

DI void phase_gemm_out(const Params& p, char* smem, int bid, int nblk, size_t off_w) {
  char* ws = opaque_ptr(p.ws);
  const bf16_t* A = (const bf16_t*)(ws + OFF_H);
  const bf16_t* B = (const bf16_t*)(ws + off_w);
  bf16_t* Y = (bf16_t*)(ws + OFF_Y);
  for (int tile = bid; tile < 32 * 16; tile += nblk) {
    const int mi = tile & 31, ni = tile >> 5;
    const int m0 = mi * 256, n0 = ni * 128;
    f32x16 acc[4][2];
    gemm_main<false>(acc, A, 2048, B, 2048, 2048, m0, n0, smem);
    EPI_LOOP_BEGIN EPI_COORD_NS
      Y[(size_t)row * 2048 + col] = (bf16_t)f2bf(v);
    EPI_LOOP_END
  }
}

DI void phase_post0(const Params& p, char* smem, int bid, int nblk) {
  char* ws = opaque_ptr(p.ws);
  const int t = TID, lane = t & 63, w = t >> 6;
  const bf16_t* Y = (const bf16_t*)(ws + OFF_Y);
  const float4* gpo = (const float4*)p.l0_post + lane;
  const float4* gpr = (const float4*)p.l1_pre + lane;
  for (int row = bid * 4 + w; row < S_; row += nblk * 4) {
    const uint2* yr = (const uint2*)(Y + (size_t)row * 2048) + lane;
    const float4* xr = (const float4*)(p.x + (size_t)row * 2048) + lane;
    float4 yv[8], xv[8];
#pragma unroll
    for (int j = 0; j < 8; j++) { const uint2 u = ld_nt(yr + j * 64); yv[j].x = bflo(u.x); yv[j].y = bfhi(u.x); yv[j].z = bflo(u.y); yv[j].w = bfhi(u.y); xv[j] = ld_nt(xr + j * 64); }
    float ss = 0.f;
#pragma unroll
    for (int j = 0; j < 8; j++) ss += yv[j].x * yv[j].x + yv[j].y * yv[j].y + yv[j].z * yv[j].z + yv[j].w * yv[j].w;
    ss = wave_sum(ss);
    const float rinv = rsqrtf(ss * (1.f / 2048.f) + 1e-6f);
    float4* outr = (float4*)(p.out + (size_t)row * 2048) + lane;
    float s2 = 0.f;
#pragma unroll
    for (int j = 0; j < 8; j++) {
      const float4 g = gpo[j * 64];
      xv[j].x += yv[j].x * rinv * g.x; xv[j].y += yv[j].y * rinv * g.y; xv[j].z += yv[j].z * rinv * g.z; xv[j].w += yv[j].w * rinv * g.w;
      outr[j * 64] = xv[j];
      s2 += xv[j].x * xv[j].x + xv[j].y * xv[j].y + xv[j].z * xv[j].z + xv[j].w * xv[j].w;
    }
    s2 = wave_sum(s2);
    const float r2 = rsqrtf(s2 * (1.f / 2048.f) + 1e-6f);
    uint2* hr = (uint2*)(ws + OFF_H + (size_t)row * 4096) + lane;
#pragma unroll
    for (int j = 0; j < 8; j++) {
      const float4 g = gpr[j * 64];
      uint2 o; o.x = pack2(xv[j].x * r2 * g.x, xv[j].y * r2 * g.y); o.y = pack2(xv[j].z * r2 * g.z, xv[j].w * r2 * g.w);
      hr[j * 64] = o;
    }
  }
}

DI void phase_gemm_in1(const Params& p, char* smem, int bid, int nblk) {
  char* ws = opaque_ptr(p.ws);
  const bf16_t* A = (const bf16_t*)(ws + OFF_H);
  const bf16_t* B = (const bf16_t*)(ws + OFF_WIN1T);
  bf16_t* CQ = (bf16_t*)(ws + OFF_CQ);
  bf16_t* CKV = (bf16_t*)(ws + OFF_CKV);
  bf16_t* KR = (bf16_t*)(ws + OFF_KR);
  const float* cs = (const float*)(ws + OFF_CS);
  bf16_t* G1 = (bf16_t*)(ws + OFF_QK0);
  for (int tile = bid; tile < 32 * 25; tile += nblk) {
    const int mi = tile & 31, ni = tile >> 5;
    const int m0 = mi * 256, n0 = ni * 128;
    f32x16 acc[4][2];
    gemm_main<false>(acc, A, 2048, B, 2048, 2048, m0, n0, smem);
    if (ni < 4) {
      EPI_LOOP_BEGIN EPI_COORD_NS
        CQ[(size_t)row * 512 + col] = (bf16_t)f2bf(v);
      EPI_LOOP_END
    } else if (ni < 8) {
      EPI_LOOP_BEGIN EPI_COORD_NS
        CKV[(size_t)row * 512 + (col - 512)] = (bf16_t)f2bf(v);
      EPI_LOOP_END
    } else if (ni == 8 && ((TID >> 6) & 1) == 0) {
      const int lane_ = TID & 63, w_ = TID >> 6, wm_ = w_ >> 1, r_ = lane_ & 31, h_ = lane_ >> 5;
#pragma unroll
      for (int mt = 0; mt < 4; mt++)
#pragma unroll
        for (int i = 0; i < 16; i++) {
          const int row = m0 + wm_ * 128 + mt * 32 + crow(i, h_);
          const float t1 = acc[mt][0][i], t2 = acc[mt][1][i];
          const float c = cs[row * 64 + r_], sn = cs[row * 64 + 32 + r_];
          KR[(size_t)row * 64 + r_] = (bf16_t)f2bf(t1 * c - t2 * sn);
          KR[(size_t)row * 64 + 32 + r_] = (bf16_t)f2bf(t2 * c + t1 * sn);
        }
    } else {
      EPI_LOOP_BEGIN EPI_COORD_NS
        if (col < 3136) G1[(size_t)row * 2048 + (col - 1088)] = (bf16_t)f2bf(silu(v));
      EPI_LOOP_END
    }
  }
}

DI void phase_gemm_qkv(const Params& p, char* smem, int bid, int nblk) {
  char* ws = opaque_ptr(p.ws);
  const bf16_t* CQ = (const bf16_t*)(ws + OFF_CQ);
  const bf16_t* CKV = (const bf16_t*)(ws + OFF_CKV);
  const bf16_t* WQ = (const bf16_t*)(ws + OFF_WQBT);
  const bf16_t* WKV = (const bf16_t*)(ws + OFF_WKVBT);
  const float* cs = (const float*)(ws + OFF_CS);
  bf16_t* Q = (bf16_t*)(ws + OFF_Q);
  bf16_t* KN = (bf16_t*)(ws + OFF_KN);
  bf16_t* VT = (bf16_t*)(ws + OFF_VT);
  const float qscale = 0.07216878364870322f * 1.4426950408889634f;
  const int ntq = 32 * 24, ntkv = 32 * 32;
  for (int tile = bid; tile < ntq + ntkv; tile += nblk) {
    f32x16 acc[4][2];
    if (tile < ntq) {
      const int mi = tile & 31, ni = tile >> 5;
      const int m0 = mi * 256, n0 = ni * 128;
      gemm_main<false, true>(acc, CQ, 512, WQ, 512, 512, m0, n0, smem);
      const float* rf = (const float*)(smem + 49152);
      const int lane_ = TID & 63, w_ = TID >> 6, wm_ = w_ >> 1, wn_ = w_ & 1, r_ = lane_ & 31, h_ = lane_ >> 5;
      const int cb = n0 + wn_ * 64;
      const int head = cb / 192, jb = cb - head * 192;
      if (jb == 128) {
#pragma unroll
        for (int mt = 0; mt < 4; mt++)
#pragma unroll
          for (int i = 0; i < 16; i++) {
            const int row = m0 + wm_ * 128 + mt * 32 + crow(i, h_);
            const float sc = rf[row - m0] * qscale;
            const float t1 = acc[mt][0][i] * sc, t2 = acc[mt][1][i] * sc;
            const float c = cs[row * 64 + r_], s = cs[row * 64 + 32 + r_];
            bf16_t* qp = Q + ((size_t)head * S_ + row) * 192 + 128;
            qp[r_] = (bf16_t)f2bf(t1 * c - t2 * s);
            qp[32 + r_] = (bf16_t)f2bf(t2 * c + t1 * s);
          }
      } else {
#pragma unroll
        for (int mt = 0; mt < 4; mt++)
#pragma unroll
          for (int nt = 0; nt < 2; nt++)
#pragma unroll
            for (int i = 0; i < 16; i++) {
              const int row = m0 + wm_ * 128 + mt * 32 + crow(i, h_);
              const float sc = rf[row - m0] * qscale;
              Q[((size_t)head * S_ + row) * 192 + jb + nt * 32 + r_] = (bf16_t)f2bf(acc[mt][nt][i] * sc);
            }
      }
    } else {
      const int tl = tile - ntq;
      const int mi = tl & 31, ni = tl >> 5;
      const int m0 = mi * 256, n0 = ni * 128;
      const int head = ni >> 1;
      if (ni & 1) {
        gemm_main<true, true>(acc, CKV, 512, WKV, 512, 512, m0, n0, smem);
        const float* rf = (const float*)(smem + 49152);
        EPI_LOOP_BEGIN EPI_COORD_SW
          const int j = col - head * 256 - 128;
          VT[((size_t)head * 128 + j) * S_ + row] = (bf16_t)f2bf(v * rf[row - m0]);
        EPI_LOOP_END
      } else {
        gemm_main<false, true>(acc, CKV, 512, WKV, 512, 512, m0, n0, smem);
        const float* rf = (const float*)(smem + 49152);
        EPI_LOOP_BEGIN EPI_COORD_NS
          const int j = col - head * 256;
          KN[((size_t)head * S_ + row) * 128 + j] = (bf16_t)f2bf(v * rf[row - m0]);
        EPI_LOOP_END
      }
    }
  }
}

DI void phase_attn(const Params& p, char* smem, int bid, int nblk, int rep) {
  char* ws = opaque_ptr(p.ws);
  const int t = TID, lane = t & 63, w = t >> 6, r = lane & 31, h = lane >> 5;
  const bf16_t* Q = (const bf16_t*)(ws + OFF_Q);
  const bf16_t* KN = (const bf16_t*)(ws + OFF_KN);
  const bf16_t* KR = (const bf16_t*)(ws + OFF_KR);
  const bf16_t* VT = (const bf16_t*)(ws + OFF_VT);
  const bf16_t* G1 = (const bf16_t*)(ws + OFF_QK0);
  bf16_t* OG = (bf16_t*)(ws + OFF_H);
  int* ctr = (int*)(ws + OFF_CTR) + rep;
  char* lk = smem;
  char* lv = smem + 25600;
  int* s_item = (int*)(smem + 44032);
  const int k_row = t >> 2, k_c0 = t & 3;
  const int v_row0 = t >> 3, v_kc = t & 7;
  for (;;) {
    __syncthreads();
    if (t == 0) *s_item = atomicAdd(ctr, 1);
    __syncthreads();
    const int item = *s_item;
    if (item >= 1024) break;
    const int qb = 63 - (item >> 4), head = item & 15;
    const int q0w = qb * 128 + w * 32;
    const int ntile = 2 * qb + 2;
    bf16x8 qf[12];
    {
      const bf16_t* qp = Q + ((size_t)head * S_ + q0w + r) * 192 + 8 * h;
#pragma unroll
      for (int s = 0; s < 12; s++) qf[s] = *(const bf16x8*)(qp + 16 * s);
    }
    f32x16 oacc[4];
#pragma unroll
    for (int vt = 0; vt < 4; vt++)
#pragma unroll
      for (int i = 0; i < 16; i++) oacc[vt][i] = 0.f;
    float m_run = -INFINITY, l_run = 0.f;
    uint4 kg0, kg1, kg2, kg3, kg4, kg5, vg0, vg1, vg2, vg3;
    const bf16_t* knp = KN + (size_t)head * S_ * 128;
    const bf16_t* vtp = VT + ((size_t)head * 128 + v_row0) * S_ + v_kc * 8;
#define ATT_LOAD(k0_)                                                                                         \
    {                                                                                                         \
      const bf16_t* kn_ = knp + (size_t)((k0_) + k_row) * 128 + k_c0 * 8;                                     \
      const bf16_t* kr_ = KR + (size_t)((k0_) + k_row) * 64 + k_c0 * 8;                                       \
      const bf16_t* vp_ = vtp + (k0_);                                                                        \
      kg0 = *(const uint4*)(kn_); kg1 = *(const uint4*)(kn_ + 32); kg2 = *(const uint4*)(kn_ + 64); kg3 = *(const uint4*)(kn_ + 96); \
      kg4 = *(const uint4*)(kr_); kg5 = *(const uint4*)(kr_ + 32);                                            \
      vg0 = *(const uint4*)(vp_); vg1 = *(const uint4*)(vp_ + (size_t)32 * S_);                               \
      vg2 = *(const uint4*)(vp_ + (size_t)64 * S_); vg3 = *(const uint4*)(vp_ + (size_t)96 * S_);             \
    }
    ATT_LOAD(0)
    for (int kt = 0; kt < ntile; kt++) {
      const int k0 = kt * 64;
      __syncthreads();
      {
        char* kd = lk + k_row * 400 + k_c0 * 16;
        *(uint4*)(kd) = kg0; *(uint4*)(kd + 64) = kg1; *(uint4*)(kd + 128) = kg2; *(uint4*)(kd + 192) = kg3;
        *(uint4*)(kd + 256) = kg4; *(uint4*)(kd + 320) = kg5;
        char* vd = lv + v_row0 * 144 + (v_kc >> 1) * 32 + (v_kc & 1) * 8;
#define VST(o_, v_) { uint2 u0, u1; u0.x = v_.x; u0.y = v_.y; u1.x = v_.z; u1.y = v_.w; *(uint2*)(vd + (o_)) = u0; *(uint2*)(vd + (o_) + 16) = u1; }
        VST(0, vg0) VST(32 * 144, vg1) VST(64 * 144, vg2) VST(96 * 144, vg3)
#undef VST
      }
      __syncthreads();
      { const int knext = (kt + 1 < ntile) ? k0 + 64 : k0; ATT_LOAD(knext) }
      if (k0 <= q0w + 31) {
        f32x16 sc[2];
#pragma unroll
        for (int i = 0; i < 16; i++) { sc[0][i] = 0.f; sc[1][i] = 0.f; }
        __builtin_amdgcn_s_setprio(1);
#pragma unroll
        for (int s = 0; s < 12; s++) {
          bf16x8 a0 = *(const bf16x8*)(lk + r * 400 + h * 16 + s * 32);
          bf16x8 a1 = *(const bf16x8*)(lk + r * 400 + h * 16 + 32 * 400 + s * 32);
          sc[0] = MFMA32(a0, qf[s], sc[0]);
          sc[1] = MFMA32(a1, qf[s], sc[1]);
        }
        __builtin_amdgcn_s_setprio(0);
        if (k0 + 63 > q0w) {
          const int qg = q0w + r;
#pragma unroll
          for (int mt = 0; mt < 2; mt++)
#pragma unroll
            for (int i = 0; i < 16; i++) {
              const int key = k0 + mt * 32 + crow(i, h);
              if (key > qg) sc[mt][i] = -INFINITY;
            }
        }
        float mx = sc[0][0];
#pragma unroll
        for (int i = 1; i < 16; i++) mx = fmaxf(mx, sc[0][i]);
#pragma unroll
        for (int i = 0; i < 16; i++) mx = fmaxf(mx, sc[1][i]);
        mx = fmaxf(mx, __shfl_xor(mx, 32));
        const float m_new = (mx > m_run + 8.f) ? mx : m_run;
        const bool resc = __any(m_new != m_run);
        const float alpha = __builtin_amdgcn_exp2f(m_run - m_new);
        m_run = m_new;
        float ls = 0.f;
#pragma unroll
        for (int mt = 0; mt < 2; mt++)
#pragma unroll
          for (int i = 0; i < 16; i++) { const float pv = __builtin_amdgcn_exp2f(sc[mt][i] - m_new); sc[mt][i] = pv; ls += pv; }
        l_run = l_run * alpha + ls;
        if (resc) {
#pragma unroll
          for (int vt = 0; vt < 4; vt++)
#pragma unroll
            for (int i = 0; i < 16; i++) oacc[vt][i] *= alpha;
        }
        __builtin_amdgcn_s_setprio(1);
#pragma unroll
        for (int s = 0; s < 4; s++) {
          const bf16x8 pb = pack8(sc[s >> 1], s & 1);
#pragma unroll
          for (int vt = 0; vt < 4; vt++) {
            const bf16x8 a = *(const bf16x8*)(lv + r * 144 + h * 16 + vt * 32 * 144 + s * 32);
            oacc[vt] = MFMA32(a, pb, oacc[vt]);
          }
        }
        __builtin_amdgcn_s_setprio(0);
      }
    }
#undef ATT_LOAD
    const float l_tot = l_run + __shfl_xor(l_run, 32);
    const float inv = 1.f / l_tot;
    const size_t obase = (size_t)(q0w + r) * 2048 + head * 128;
#pragma unroll
    for (int vt = 0; vt < 4; vt++)
#pragma unroll
      for (int g = 0; g < 4; g++) {
        const int v = vt * 32 + 8 * g + 4 * h;
        uint2 gg = *(const uint2*)(G1 + obase + v);
        uint2 o;
        o.x = pack2(oacc[vt][4 * g + 0] * inv * bflo(gg.x), oacc[vt][4 * g + 1] * inv * bfhi(gg.x));
        o.y = pack2(oacc[vt][4 * g + 2] * inv * bflo(gg.y), oacc[vt][4 * g + 3] * inv * bfhi(gg.y));
        *(uint2*)(OG + obase + v) = o;
      }
  }
}

DI void phase_final(const Params& p, char* smem, int bid, int nblk) {
  char* ws = opaque_ptr(p.ws);
  const int t = TID, lane = t & 63, w = t >> 6;
  const bf16_t* Y = (const bf16_t*)(ws + OFF_Y);
  const float4* gpo = (const float4*)p.l1_post + lane;
  for (int row0 = bid * 4 + w; row0 < S_; row0 += nblk * 8) {
    const int row1r = row0 + nblk * 4;
    const bool has1 = row1r < S_;
    const int row1 = has1 ? row1r : row0;
    const uint2* yr0 = (const uint2*)(Y + (size_t)row0 * 2048) + lane;
    const uint2* yr1 = (const uint2*)(Y + (size_t)row1 * 2048) + lane;
    float4* out0 = (float4*)(p.out + (size_t)row0 * 2048) + lane;
    float4* out1 = (float4*)(p.out + (size_t)row1 * 2048) + lane;
    uint2 ya[8], yb[8];
    float4 xa[8], xb[8];
#pragma unroll
    for (int j = 0; j < 8; j++) { ya[j] = ld_nt(yr0 + j * 64); xa[j] = ld_nt((const float4*)out0 + j * 64); yb[j] = ld_nt(yr1 + j * 64); xb[j] = ld_nt((const float4*)out1 + j * 64); }
    float sa = 0.f, sb = 0.f;
#pragma unroll
    for (int j = 0; j < 8; j++) {
      sa += bflo(ya[j].x) * bflo(ya[j].x) + bfhi(ya[j].x) * bfhi(ya[j].x) + bflo(ya[j].y) * bflo(ya[j].y) + bfhi(ya[j].y) * bfhi(ya[j].y);
      sb += bflo(yb[j].x) * bflo(yb[j].x) + bfhi(yb[j].x) * bfhi(yb[j].x) + bflo(yb[j].y) * bflo(yb[j].y) + bfhi(yb[j].y) * bfhi(yb[j].y);
    }
    sa = wave_sum(sa); sb = wave_sum(sb);
    const float ra = rsqrtf(sa * (1.f / 2048.f) + 1e-6f), rb = rsqrtf(sb * (1.f / 2048.f) + 1e-6f);
#pragma unroll
    for (int j = 0; j < 8; j++) {
      const float4 g = gpo[j * 64];
      float4 o = xa[j];
      o.x += bflo(ya[j].x) * ra * g.x; o.y += bfhi(ya[j].x) * ra * g.y; o.z += bflo(ya[j].y) * ra * g.z; o.w += bfhi(ya[j].y) * ra * g.w;
      st_nt(out0 + j * 64, o);
      if (has1) {
        float4 q = xb[j];
        q.x += bflo(yb[j].x) * rb * g.x; q.y += bfhi(yb[j].x) * rb * g.y; q.z += bflo(yb[j].y) * rb * g.z; q.w += bfhi(yb[j].y) * rb * g.w;
        st_nt(out1 + j * 64, q);
      }
    }
  }
}

constexpr int NPHASE = 13;
constexpr unsigned DUP_MASK = 0u;
DI void run_phase(int ph, const Params& p, char* smem, int bid, int nblk, int rep) {
  switch (ph) {
    case 0: phase_prep(p, smem, bid, nblk); break;
    case 1: phase_gemm_in0(p, smem, bid, nblk); break;
    case 2: phase_gla_prep(p, smem, bid, nblk); break;
    case 3: phase_gla_local(p, smem, bid, nblk); break;
    case 4: phase_gla_scan(p, smem, bid, nblk); break;
    case 5: phase_og(p, smem, bid, nblk); break;
    case 6: phase_gemm_out(p, smem, bid, nblk, OFF_WOUT0T); break;
    case 7: phase_post0(p, smem, bid, nblk); break;
    case 8: phase_gemm_in1(p, smem, bid, nblk); break;
    case 9: phase_gemm_qkv(p, smem, bid, nblk); break;
    case 10: phase_attn(p, smem, bid, nblk, rep); break;
    case 11: phase_gemm_out(p, smem, bid, nblk, OFF_WOUT1T); break;
    case 12: phase_final(p, smem, bid, nblk); break;
  }
}

#define XB_TMO      128
#define XB_XCNT(j)  (256  + 64 * (j))
#define XB_XSUB(j)  (1280 + 64 * (j))
#define XB_XGEN(j)  (2304 + 64 * (j))
#define XB_TOP      3328
#define XB_TOPGEN   3392
#define XCD_BAR_WORDS 3456
#define XB_SPIN_CAP (1u << 20)
#define LAS __attribute__((address_space(3)))
DI unsigned xb_ld(unsigned* p) { return __hip_atomic_load(p, __ATOMIC_RELAXED, __HIP_MEMORY_SCOPE_AGENT); }
DI unsigned xb_add(unsigned* p, unsigned v) { return __hip_atomic_fetch_add(p, v, __ATOMIC_RELAXED, __HIP_MEMORY_SCOPE_AGENT); }
DI unsigned xb_xcc_id() { return (unsigned)__builtin_amdgcn_s_getreg((3 << 11) | 20) & 0xFu; }
#define XB_SPIN(cond, bar) do { unsigned _sp = 0; while (cond) { __builtin_amdgcn_s_sleep(1); \
    if ((++_sp & 255u) == 0u) { if (xb_ld(&(bar)[XB_TMO])) break; if (_sp > XB_SPIN_CAP) { atomicAdd(&(bar)[XB_TMO], 1u); break; } } } } while (0)
struct XcdBarrier { unsigned* bar; unsigned x; volatile LAS unsigned* st; };
DI XcdBarrier xcd_barrier_post(unsigned* bar, volatile LAS unsigned* st) {
  XcdBarrier b; b.bar = bar; b.x = xb_xcc_id(); b.st = st;
  if (threadIdx.x == 0) (void)xb_add(&bar[XB_XCNT(b.x)], 1u);
  return b;
}
DI void xcd_barrier_complete(unsigned* bar, unsigned x, unsigned& nloc, unsigned& nx) {
  const unsigned G = gridDim.x * gridDim.y * gridDim.z;
  unsigned sum, cnt, mine, sp = 0u;
  for (;;) {
    sum = 0u; cnt = 0u; mine = 0u;
#pragma unroll
    for (unsigned j = 0; j < 16; ++j) { const unsigned c = xb_ld(&bar[XB_XCNT(j)]); sum += c; cnt += (c > 0u) ? 1u : 0u; mine = (j == x) ? c : mine; }
    if (sum == G) break;
    __builtin_amdgcn_s_sleep(1);
    if ((++sp & 255u) == 0u) { if (xb_ld(&bar[XB_TMO])) break; if (sp > XB_SPIN_CAP) { atomicAdd(&bar[XB_TMO], 1u); break; } }
  }
  nloc = mine > 0u ? mine : 1u; nx = cnt > 0u ? cnt : 1u;
}
DI void xcd_barrier(const XcdBarrier& b) {
  asm volatile("s_waitcnt vmcnt(0)" ::: "memory");
  __syncthreads();
  if (threadIdx.x == 0) {
    unsigned* bar = b.bar;
    __builtin_amdgcn_s_waitcnt(0);
    unsigned nloc, nx;
    xcd_barrier_complete(bar, b.x, nloc, nx);
    const unsigned old = xb_add(&bar[XB_XSUB(b.x)], 1u);
    const unsigned gen = old / nloc;
    if (old + 1u == (gen + 1u) * nloc) {
      __builtin_amdgcn_fence(__ATOMIC_RELEASE, "agent");
      asm volatile("s_waitcnt vmcnt(0)" ::: "memory");
      const unsigned og = xb_add(&bar[XB_TOP], 1u);
      const unsigned tg = og / nx;
      if (og + 1u == (tg + 1u) * nx) xb_add(&bar[XB_TOPGEN], 1u);
      else XB_SPIN(xb_ld(&bar[XB_TOPGEN]) == tg, bar);
      __builtin_amdgcn_fence(__ATOMIC_ACQUIRE, "agent");
      xb_add(&bar[XB_XGEN(b.x)], 1u);
      asm volatile("s_waitcnt vmcnt(0)" ::: "memory");
    } else {
      XB_SPIN(xb_ld(&bar[XB_XGEN(b.x)]) == gen, bar);
      __builtin_amdgcn_fence(__ATOMIC_ACQUIRE, "agent");
      asm volatile("s_waitcnt vmcnt(0)" ::: "memory");
    }
  }
  __syncthreads();
}

#if MEGA
__global__ void __launch_bounds__(256, 2) mega_kernel(Params p) {
  __shared__ __attribute__((aligned(16))) char smem[69632];
  cg::grid_group grid = cg::this_grid();
  const int bid = blockIdx.x, nblk = gridDim.x;
  (void)xcd_barrier_post((unsigned*)(p.ws + OFF_BAR), (volatile LAS unsigned*)0);
#pragma nounroll
  for (int ph = 0; ph < NPHASE; ph++) {
    int phv = ph;
    asm volatile("" : "+s"(phv));
    run_phase(phv, p, smem, bid, nblk, 0);
    if (p.ws == nullptr) grid.sync();
    { XcdBarrier xb; xb.bar = (unsigned*)(opaque_ptr(p.ws) + OFF_BAR); xb.x = xb_xcc_id(); xb.st = (volatile LAS unsigned*)0; xcd_barrier(xb); }
    if ((DUP_MASK >> ph) & 1u) {
      run_phase(phv, p, smem, bid, nblk, 1);
      { XcdBarrier xb; xb.bar = (unsigned*)(opaque_ptr(p.ws) + OFF_BAR); xb.x = xb_xcc_id(); xb.st = (volatile LAS unsigned*)0; xcd_barrier(xb); }
    }
  }
}
#endif

#if !MEGA
template <int PH>
__global__ void __launch_bounds__(256, 2) phase_kernel_t(Params p) {
  __shared__ __attribute__((aligned(16))) char smem[69632];
  run_phase(PH, p, smem, blockIdx.x, gridDim.x, 0);
}
#endif

extern "C" void kernel_launch(void* const* d_in, const int* in_sizes, int n_in, void* d_out, int out_size, void* d_ws,
                              size_t ws_size, hipStream_t stream) {
  Params p{};
  p.x = (const float*)d_in[0]; p.pos = (const int*)d_in[1]; p.l0_pre = (const float*)d_in[2]; p.w_in0 = (const float*)d_in[3];
  p.w_gk2 = (const float*)d_in[4]; p.b_gk = (const float*)d_in[5]; p.g_onorm = (const float*)d_in[6]; p.w_out0 = (const float*)d_in[7];
  p.l0_post = (const float*)d_in[8]; p.l1_pre = (const float*)d_in[9]; p.w_in1 = (const float*)d_in[10]; p.g_qa = (const float*)d_in[11];
  p.w_qb = (const float*)d_in[12]; p.g_kva = (const float*)d_in[13]; p.w_kvb = (const float*)d_in[14]; p.w_out1 = (const float*)d_in[15];
  p.l1_post = (const float*)d_in[16];
  p.out = (float*)d_out; p.ws = (char*)d_ws;
  for (int i = 0; i < 32; i++) p.invf[i] = (float)pow(10000.0, -(double)i / 32.0);
#if MEGA
  static int grid_blocks = 0;
  if (!grid_blocks) {
    int dev = 0, cus = 0, per_cu = 0;
    hipGetDevice(&dev);
    hipDeviceGetAttribute(&cus, hipDeviceAttributeMultiprocessorCount, dev);
    hipOccupancyMaxActiveBlocksPerMultiprocessor(&per_cu, mega_kernel, 256, 0);
    if (per_cu > 2) per_cu = 2;
    if (per_cu < 1) per_cu = 1;
    grid_blocks = cus * per_cu;
  }
  hipMemsetAsync((char*)d_ws + OFF_BAR, 0, XCD_BAR_WORDS * 4, stream);
  void* args[] = {&p};
  hipError_t e = hipLaunchCooperativeKernel((void*)mega_kernel, dim3(grid_blocks), dim3(256), args, 0, stream);
  if (e != hipSuccess) fprintf(stderr, "cooperative launch failed: %s (grid %d)\n", hipGetErrorString(e), grid_blocks);
#else
#define LPH(N) hipLaunchKernelGGL(phase_kernel_t<N>, dim3(512), dim3(256), 0, stream, p);
  LPH(0) LPH(1) LPH(2) LPH(3) LPH(4) LPH(5) LPH(6) LPH(7) LPH(8) LPH(9) LPH(10) LPH(11) LPH(12)
#undef LPH
#endif
}
```

```cpp
#include <hip/hip_runtime.h>
#include <hip/hip_cooperative_groups.h>
#include <stdint.h>
#include <math.h>
#include <stdio.h>
namespace cg = cooperative_groups;

#ifndef MEGA
#define MEGA 1
#endif

typedef __attribute__((ext_vector_type(8))) short bf16x8;
typedef __attribute__((ext_vector_type(4))) short s16x4;
typedef __attribute__((ext_vector_type(16))) float f32x16;
typedef unsigned short bf16_t;
#define DI __device__ __forceinline__
#define MFMA32(a, b, c) __builtin_amdgcn_mfma_f32_32x32x16_bf16((a), (b), (c), 0, 0, 0)

constexpr int S_ = 8192;
constexpr size_t MiB = (size_t)1 << 20;
constexpr size_t OFF_WIN0T = 0;
constexpr size_t OFF_WOUT0T = 25 * MiB;
constexpr size_t OFF_WIN1T = 33 * MiB;
constexpr size_t OFF_WQBT = 46 * MiB;
constexpr size_t OFF_WKVBT = 49 * MiB;
constexpr size_t OFF_WOUT1T = 53 * MiB;
constexpr size_t OFF_GKLOW = 61 * MiB;
constexpr size_t OFF_DECAY = 61 * MiB + 512 * 1024;
constexpr size_t OFF_CS = 62 * MiB;
constexpr size_t OFF_H = 64 * MiB;
constexpr size_t OFF_QK0 = 96 * MiB;
constexpr size_t OFF_V0T = 128 * MiB;
constexpr size_t OFF_G0 = 160 * MiB;
constexpr size_t OFF_Y = 128 * MiB;
constexpr size_t OFF_QE = 192 * MiB;
constexpr size_t OFF_KLT = 208 * MiB;
constexpr size_t OFF_AM = 224 * MiB;
constexpr size_t OFF_CQ = 0;
constexpr size_t OFF_CKV = 8 * MiB;
constexpr size_t OFF_KR = 16 * MiB;
constexpr size_t OFF_RINVQ = 17 * MiB;
constexpr size_t OFF_RINVKV = 17 * MiB + 64 * 1024;
constexpr size_t OFF_KRRAW = 18 * MiB;
constexpr size_t OFF_CTR = 20 * MiB;
constexpr size_t OFF_BAR = 255 * MiB;
constexpr size_t OFF_SL = 64 * MiB;
constexpr size_t OFF_DC = 80 * MiB;
constexpr size_t OFF_Q = 128 * MiB;
constexpr size_t OFF_KN = 176 * MiB;
constexpr size_t OFF_VT = 208 * MiB;

struct Params {
  const float* x; const int* pos; const float* l0_pre; const float* w_in0; const float* w_gk2; const float* b_gk;
  const float* g_onorm; const float* w_out0; const float* l0_post; const float* l1_pre; const float* w_in1;
  const float* g_qa; const float* w_qb; const float* g_kva; const float* w_kvb; const float* w_out1; const float* l1_post;
  float* out; char* ws;
  float invf[32];
};

DI int tid_opaque() { int t = threadIdx.x; asm volatile("" : "+v"(t)); return t; }
#define TID tid_opaque()
typedef __attribute__((address_space(1))) char gchar_t;
DI char* opaque_ptr(char* q) {
  unsigned long long v = (unsigned long long)q;
  unsigned lo = __builtin_amdgcn_readfirstlane((unsigned)v), hi = __builtin_amdgcn_readfirstlane((unsigned)(v >> 32));
  asm volatile("" : "+s"(lo), "+s"(hi));
  return (char*)(gchar_t*)(((unsigned long long)hi << 32) | lo);
}
typedef __bf16 hbf16x2 __attribute__((ext_vector_type(2)));
typedef float hf32x2 __attribute__((ext_vector_type(2)));
DI unsigned pack2(float a, float b) { hf32x2 f = {a, b}; return __builtin_bit_cast(unsigned, __builtin_convertvector(f, hbf16x2)); }
DI unsigned f2bf(float f) { return (unsigned)__builtin_bit_cast(unsigned short, (__bf16)f); }
DI float bf2f(unsigned h) { return __uint_as_float(h << 16); }
DI float bflo(unsigned u) { return __uint_as_float(u << 16); }
DI float bfhi(unsigned u) { return __uint_as_float(u & 0xffff0000u); }
DI int crow(int i, int h) { return (i & 3) + 8 * (i >> 2) + 4 * h; }
typedef float nt_f4 __attribute__((ext_vector_type(4)));
typedef unsigned nt_u4 __attribute__((ext_vector_type(4)));
typedef unsigned nt_u2 __attribute__((ext_vector_type(2)));
DI float4 ld_nt(const float4* p) { nt_f4 v = __builtin_nontemporal_load((const nt_f4*)p); float4 r; r.x = v.x; r.y = v.y; r.z = v.z; r.w = v.w; return r; }
DI uint4 ld_nt(const uint4* p) { nt_u4 v = __builtin_nontemporal_load((const nt_u4*)p); uint4 r; r.x = v.x; r.y = v.y; r.z = v.z; r.w = v.w; return r; }
DI uint2 ld_nt(const uint2* p) { nt_u2 v = __builtin_nontemporal_load((const nt_u2*)p); uint2 r; r.x = v.x; r.y = v.y; return r; }
DI void st_nt(float4* p, const float4& a) { nt_f4 v = {a.x, a.y, a.z, a.w}; __builtin_nontemporal_store(v, (nt_f4*)p); }
DI float silu(float v) { return v / (1.f + __expf(-v)); }
DI float wave_sum(float v) { for (int o = 32; o > 0; o >>= 1) v += __shfl_xor(v, o); return v; }
DI float block_sum(float v, float* red) {
  v = wave_sum(v);
  __syncthreads();
  if ((TID & 63) == 0) red[TID >> 6] = v;
  __syncthreads();
  return red[0] + red[1] + red[2] + red[3];
}
DI bf16x8 pack8(const f32x16& x, int s) {
  union { unsigned u[4]; bf16x8 v; } p;
  p.u[0] = pack2(x[8 * s + 0], x[8 * s + 1]); p.u[1] = pack2(x[8 * s + 2], x[8 * s + 3]);
  p.u[2] = pack2(x[8 * s + 4], x[8 * s + 5]); p.u[3] = pack2(x[8 * s + 6], x[8 * s + 7]);
  return p.v;
}

DI void transpose_tile4(const float* __restrict__ W, int K, int N, int ntN, const float* __restrict__ gain, bf16_t* __restrict__ WT,
                        int id0, char* smem) {
  const int t = TID;
  float v[4][16];
#pragma unroll
  for (int q = 0; q < 4; q++) {
    const int id = id0 + q, k0 = (id / ntN) * 64, n0 = (id % ntN) * 64;
#pragma unroll
    for (int i = 0; i < 16; i++) {
      const int kk = i * 4 + (t >> 6), n = n0 + (t & 63);
      float x = (n < N) ? __builtin_nontemporal_load(&W[(size_t)(k0 + kk) * N + n]) : 0.f;
      if (gain) x *= gain[k0 + kk];
      v[q][i] = x;
    }
  }
#pragma unroll
  for (int q = 0; q < 4; q++) {
    unsigned short (*tile)[72] = (unsigned short (*)[72])(smem + q * 9216);
#pragma unroll
    for (int i = 0; i < 16; i++) tile[t & 63][i * 4 + (t >> 6)] = (unsigned short)f2bf(v[q][i]);
  }
  __syncthreads();
#pragma unroll
  for (int q = 0; q < 4; q++) {
    unsigned short (*tile)[72] = (unsigned short (*)[72])(smem + q * 9216);
    const int id = id0 + q, k0 = (id / ntN) * 64, n0 = (id % ntN) * 64;
    const int nn = t >> 2, kg = (t & 3) * 16;
    uint4 a = *(const uint4*)&tile[nn][kg];
    uint4 b = *(const uint4*)&tile[nn][kg + 8];
    bf16_t* dst = WT + (size_t)(n0 + nn) * K + k0 + kg;
    *(uint4*)dst = a; *(uint4*)(dst + 8) = b;
  }
  __syncthreads();
}

DI void phase_prep(const Params& p, char* smem, int bid, int nblk) {
  const int t = TID;
  char* ws = opaque_ptr(p.ws);
  for (int task = bid; task < 1920 + 3072; task += nblk) {
    if (task < 1920) {
      const int tile0 = task * 4;
      const float* W; const float* gain = nullptr; bf16_t* WT; int K, N, ntN, id;
      if (tile0 < 3136) { id = tile0; W = p.w_in0; K = 2048; N = 6160; ntN = 98; WT = (bf16_t*)(ws + OFF_WIN0T); }
      else if (tile0 < 4160) { id = tile0 - 3136; W = p.w_out0; K = 2048; N = 2048; ntN = 32; WT = (bf16_t*)(ws + OFF_WOUT0T); }
      else if (tile0 < 5760) { id = tile0 - 4160; W = p.w_in1; K = 2048; N = 3136; ntN = 50; WT = (bf16_t*)(ws + OFF_WIN1T); }
      else if (tile0 < 6144) { id = tile0 - 5760; W = p.w_qb; K = 512; N = 3072; ntN = 48; WT = (bf16_t*)(ws + OFF_WQBT); gain = p.g_qa; }
      else if (tile0 < 6656) { id = tile0 - 6144; W = p.w_kvb; K = 512; N = 4096; ntN = 64; WT = (bf16_t*)(ws + OFF_WKVBT); gain = p.g_kva; }
      else { id = tile0 - 6656; W = p.w_out1; K = 2048; N = 2048; ntN = 32; WT = (bf16_t*)(ws + OFF_WOUT1T); }
      transpose_tile4(W, K, N, ntN, gain, WT, id, smem);
    } else if (task < 1920 + 2048) {
      const int lane = t & 63, row = (task - 1920) * 4 + (t >> 6);
      const float4* xr = (const float4*)(p.x + (size_t)row * 2048) + lane;
      const float4* gr = (const float4*)p.l0_pre + lane;
      float4 xv[8];
#pragma unroll
      for (int j = 0; j < 8; j++) xv[j] = ld_nt(xr + j * 64);
      float ss = 0.f;
#pragma unroll
      for (int j = 0; j < 8; j++) ss += xv[j].x * xv[j].x + xv[j].y * xv[j].y + xv[j].z * xv[j].z + xv[j].w * xv[j].w;
      ss = wave_sum(ss);
      const float rinv = rsqrtf(ss * (1.f / 2048.f) + 1e-6f);
      uint2* hr = (uint2*)(ws + OFF_H + (size_t)row * 4096) + lane;
#pragma unroll
      for (int j = 0; j < 8; j++) {
        const float4 g = gr[j * 64];
        uint2 o; o.x = pack2(xv[j].x * rinv * g.x, xv[j].y * rinv * g.y); o.y = pack2(xv[j].z * rinv * g.z, xv[j].w * rinv * g.w);
        hr[j * 64] = o;
      }
    } else {
      const int idx = (task - 3968) * 256 + t;
      const int token = idx >> 5, i = idx & 31;
      double ang = (double)p.pos[token] * (double)p.invf[i];
      double tt = ang * 0.15915494309189535;
      tt -= floor(tt + 0.5);
      float f = (float)tt;
      float* cs = (float*)(ws + OFF_CS);
      cs[token * 64 + i] = __builtin_amdgcn_cosf(f);
      cs[token * 64 + 32 + i] = __builtin_amdgcn_sinf(f);
    }
  }
}

DI float sq8(const uint4& v) {
  return bflo(v.x) * bflo(v.x) + bfhi(v.x) * bfhi(v.x) + bflo(v.y) * bflo(v.y) + bfhi(v.y) * bfhi(v.y) + bflo(v.z) * bflo(v.z) + bfhi(v.z) * bfhi(v.z) +
         bflo(v.w) * bflo(v.w) + bfhi(v.w) * bfhi(v.w);
}
template <bool SWAP, bool SUMSQ = false>
DI void gemm_main(f32x16 (&acc)[4][2], const bf16_t* A, int lda, const bf16_t* B, int ldb, int K,
                  int m0, int n0, char* smem) {
  const int t = TID, lane = t & 63, w = t >> 6, wm = w >> 1, wn = w & 1, r = lane & 31, h = lane >> 5;
#pragma unroll
  for (int a = 0; a < 4; a++)
#pragma unroll
    for (int b = 0; b < 2; b++)
#pragma unroll
      for (int i = 0; i < 16; i++) acc[a][b][i] = 0.f;
  const int lrow = t >> 2, kc = t & 3;
  const bf16_t* ag = A + (size_t)(m0 + lrow) * lda + kc * 8;
  const bf16_t* bg = B + (size_t)(n0 + lrow) * ldb + kc * 8;
  const int lds_w = lrow * 64 + ((kc ^ ((lrow >> 2) & 3)) << 4);
  uint4 pa0, pa1, pa2, pa3, pb0, pb1;
  bf16x8 fa0, fa1, fa2, fa3, fa4, fa5, fb0, fb1, fb2, fb3, fb4, fb5;
#define G_LOAD(X, ko_)                                                                                   \
  X##a0 = *(const uint4*)(ag + (ko_)); X##a1 = *(const uint4*)(ag + (size_t)64 * lda + (ko_));           \
  X##a2 = *(const uint4*)(ag + (size_t)128 * lda + (ko_)); X##a3 = *(const uint4*)(ag + (size_t)192 * lda + (ko_)); \
  X##b0 = *(const uint4*)(bg + (ko_)); X##b1 = *(const uint4*)(bg + (size_t)64 * ldb + (ko_));
#define L_STORE(X, base_)                                                                                \
  *(uint4*)((base_) + lds_w) = X##a0; *(uint4*)((base_) + lds_w + 4096) = X##a1;                         \
  *(uint4*)((base_) + lds_w + 8192) = X##a2; *(uint4*)((base_) + lds_w + 12288) = X##a3;                 \
  *(uint4*)((base_) + 16384 + lds_w) = X##b0; *(uint4*)((base_) + 16384 + lds_w + 4096) = X##b1;         \
  if (SUMSQ) { q0 += sq8(X##a0); q1 += sq8(X##a1); q2 += sq8(X##a2); q3 += sq8(X##a3); }
#define G_READ(F, base_, c_)                                                                             \
  F##0 = *(const bf16x8*)((base_) + a_off + (c_)); F##1 = *(const bf16x8*)((base_) + a_off + 32 * 64 + (c_));              \
  F##2 = *(const bf16x8*)((base_) + a_off + 64 * 64 + (c_)); F##3 = *(const bf16x8*)((base_) + a_off + 96 * 64 + (c_));    \
  F##4 = *(const bf16x8*)((base_) + b_off + (c_)); F##5 = *(const bf16x8*)((base_) + b_off + 32 * 64 + (c_));
#define G_MMA(a0, a1, a2, a3, b0, b1)                                                                    \
    if (SWAP) {                                                                                          \
      acc[0][0] = MFMA32(b0, a0, acc[0][0]); acc[0][1] = MFMA32(b1, a0, acc[0][1]);                      \
      acc[1][0] = MFMA32(b0, a1, acc[1][0]); acc[1][1] = MFMA32(b1, a1, acc[1][1]);                      \
      acc[2][0] = MFMA32(b0, a2, acc[2][0]); acc[2][1] = MFMA32(b1, a2, acc[2][1]);                      \
      acc[3][0] = MFMA32(b0, a3, acc[3][0]); acc[3][1] = MFMA32(b1, a3, acc[3][1]);                      \
    } else {                                                                                             \
      acc[0][0] = MFMA32(a0, b0, acc[0][0]); acc[0][1] = MFMA32(a0, b1, acc[0][1]);                      \
      acc[1][0] = MFMA32(a1, b0, acc[1][0]); acc[1][1] = MFMA32(a1, b1, acc[1][1]);                      \
      acc[2][0] = MFMA32(a2, b0, acc[2][0]); acc[2][1] = MFMA32(a2, b1, acc[2][1]);                      \
      acc[3][0] = MFMA32(a3, b0, acc[3][0]); acc[3][1] = MFMA32(a3, b1, acc[3][1]);                      \
    }
#define G_MMA6(F) G_MMA(F##0, F##1, F##2, F##3, F##4, F##5)
  float q0 = 0.f, q1 = 0.f, q2 = 0.f, q3 = 0.f;
  const int sw = (r >> 2) & 3;
  const int a_off = (wm * 128 + r) * 64, b_off = 16384 + (wn * 64 + r) * 64;
  const int c0 = (h ^ sw) << 4, c1 = ((2 + h) ^ sw) << 4;
  const int nk = K >> 5;
  G_LOAD(p, 0)
  L_STORE(p, smem)
  G_LOAD(p, 32)
  __syncthreads();
  G_READ(fa, smem, c0)
  G_READ(fb, smem, c1)
  G_MMA6(fa)
  asm volatile("" ::: "memory");
  __builtin_amdgcn_sched_barrier(0);
  L_STORE(p, smem + 24576)
  {
    const int kn = ((2 < nk) ? 2 : (nk - 1)) * 32;
    G_LOAD(p, kn)
  }
  __syncthreads();
  for (int kt = 0; kt < nk - 1; kt++) {
    const char* nb = smem + ((kt + 1) & 1) * 24576;
    G_READ(fa, nb, c0)
    G_MMA6(fb)
    G_READ(fb, nb, c1)
    G_MMA6(fa)
    __builtin_amdgcn_sched_group_barrier(0x100, 6, 0);
    __builtin_amdgcn_sched_group_barrier(0x008, 8, 0);
    __builtin_amdgcn_sched_group_barrier(0x100, 6, 0);
    __builtin_amdgcn_sched_group_barrier(0x008, 8, 0);
    asm volatile("" ::: "memory");
    __builtin_amdgcn_sched_barrier(0);
    if (kt + 2 < nk) {
      L_STORE(p, smem + (kt & 1) * 24576)
    }
    {
      const int kn = ((kt + 3 < nk) ? (kt + 3) : (nk - 1)) * 32;
      G_LOAD(p, kn)
    }
    __syncthreads();
  }
  G_MMA6(fb)
#undef G_LOAD
#undef L_STORE
#undef G_READ
#undef G_MMA
#undef G_MMA6
  if (SUMSQ) {
    q0 += __shfl_xor(q0, 1); q1 += __shfl_xor(q1, 1); q2 += __shfl_xor(q2, 1); q3 += __shfl_xor(q3, 1);
    q0 += __shfl_xor(q0, 2); q1 += __shfl_xor(q1, 2); q2 += __shfl_xor(q2, 2); q3 += __shfl_xor(q3, 2);
    if (kc == 0) {
      float* rf = (float*)(smem + 49152);
      const float ik = 1.f / (float)K;
      rf[lrow] = rsqrtf(q0 * ik + 1e-6f); rf[lrow + 64] = rsqrtf(q1 * ik + 1e-6f);
      rf[lrow + 128] = rsqrtf(q2 * ik + 1e-6f); rf[lrow + 192] = rsqrtf(q3 * ik + 1e-6f);
    }
    __syncthreads();
  }
}

#define EPI_LOOP_BEGIN                                                                                           \
  {                                                                                                              \
    const int lane_ = TID & 63, w_ = TID >> 6, wm_ = w_ >> 1, wn_ = w_ & 1, r_ = lane_ & 31, h_ = lane_ >> 5; \
    _Pragma("unroll") for (int mt = 0; mt < 4; mt++) _Pragma("unroll") for (int nt = 0; nt < 2; nt++)          \
        _Pragma("unroll") for (int i = 0; i < 16; i++) {                                                         \
      const float v = acc[mt][nt][i];
#define EPI_COORD_NS const int row = m0 + wm_ * 128 + mt * 32 + crow(i, h_); const int col = n0 + wn_ * 64 + nt * 32 + r_;
#define EPI_COORD_SW const int row = m0 + wm_ * 128 + mt * 32 + r_; const int col = n0 + wn_ * 64 + nt * 32 + crow(i, h_);
#define EPI_LOOP_END }}

DI void phase_gemm_in0(const Params& p, char* smem, int bid, int nblk) {
  char* ws = opaque_ptr(p.ws);
  const bf16_t* A = (const bf16_t*)(ws + OFF_H);
  const bf16_t* B = (const bf16_t*)(ws + OFF_WIN0T);
  bf16_t* QK = (bf16_t*)(ws + OFF_QK0);
  bf16_t* V0T = (bf16_t*)(ws + OFF_V0T);
  bf16_t* G0 = (bf16_t*)(ws + OFF_G0);
  float* GKL = (float*)(ws + OFF_GKLOW);
  for (int tile = bid; tile < 32 * 48; tile += nblk) {
    const int mi = tile & 31, ni = tile >> 5;
    const int m0 = mi * 256, n0 = ni * 128;
    f32x16 acc[4][2];
    if (ni >= 16) {
      if (ni < 32) {
        gemm_main<true>(acc, A, 2048, B, 2048, 2048, m0, n0, smem);
        EPI_LOOP_BEGIN EPI_COORD_SW
          V0T[(size_t)(col - 2048) * S_ + row] = (bf16_t)f2bf(v);
        EPI_LOOP_END
      } else {
        gemm_main<false>(acc, A, 2048, B, 2048, 2048, m0, n0, smem);
        EPI_LOOP_BEGIN EPI_COORD_NS
          G0[(size_t)row * 2048 + (col - 4096)] = (bf16_t)f2bf(silu(v));
        EPI_LOOP_END
      }
    } else {
      gemm_main<false>(acc, A, 2048, B, 2048, 2048, m0, n0, smem);
      EPI_LOOP_BEGIN EPI_COORD_NS
        QK[(size_t)row * 2048 + col] = (bf16_t)f2bf(v);
      EPI_LOOP_END
    }
  }
  {
    typedef __attribute__((ext_vector_type(4))) float f32x4_t;
    const int t = TID, lane = t & 63, w = t >> 6, l15 = lane & 15, quad = lane >> 4;
    float* red = (float*)smem;
    for (int item = bid; item < 512; item += nblk) {
      const bf16_t* ap = A + (size_t)(item * 16 + l15) * 2048 + 512 * w + 8 * quad;
      const bf16_t* bp = B + (size_t)(6144 + l15) * 2048 + 512 * w + 8 * quad;
      f32x4_t c = {0.f, 0.f, 0.f, 0.f};
#pragma unroll
      for (int s = 0; s < 16; s++) {
        const bf16x8 a = *(const bf16x8*)(ap + 32 * s);
        const bf16x8 b = *(const bf16x8*)(bp + 32 * s);
        c = __builtin_amdgcn_mfma_f32_16x16x32_bf16(a, b, c, 0, 0, 0);
      }
      __syncthreads();
#pragma unroll
      for (int j = 0; j < 4; j++) red[(w * 16 + quad * 4 + j) * 16 + l15] = c[j];
      __syncthreads();
      const float v = red[t] + red[256 + t] + red[512 + t] + red[768 + t];
      GKL[(size_t)item * 256 + t] = v;
    }
  }
}

DI void phase_gla_prep(const Params& p, char* smem, int bid, int nblk) {
  char* ws = opaque_ptr(p.ws);
  const int t = TID, lane = t & 63, w = t >> 6, r = lane & 31, h = lane >> 5;
  const bf16_t* QK = (const bf16_t*)(ws + OFF_QK0);
  const float* GKL = (const float*)(ws + OFF_GKLOW);
  bf16_t* QE = (bf16_t*)(ws + OFF_QE);
  bf16_t* KLT = (bf16_t*)(ws + OFF_KLT);
  bf16_t* AM = (bf16_t*)(ws + OFF_AM);
  float* DEC = (float*)(ws + OFF_DECAY);
  if (bid == 0 && t == 0) { ((int*)(ws + OFF_CTR))[0] = 0; ((int*)(ws + OFF_CTR))[1] = 0; }
  char* lq = smem;
  char* lk = smem + 32768;
  for (int tile = bid; tile < 512; tile += nblk) {
    const int n = tile >> 2, head = tile & 3, t0 = n * 64, d = t, col = head * 256 + d;
    __syncthreads();
    ((float4*)(smem + 65536))[t] = ((const float4*)(GKL + (size_t)t0 * 16))[t];
    __syncthreads();
    float w2[16];
#pragma unroll
    for (int j = 0; j < 16; j++) w2[j] = p.w_gk2[j * 1024 + col];
    const float bias = p.b_gk[col];
    float b = 0.f;
    const int dperm = (d & ~15) | ((d & 3) | ((d & 4) << 1) | ((d & 8) >> 1));
    for (int c16 = 0; c16 < 4; c16++) {
      float bj[16], qv[16], kv[16];
#pragma unroll
      for (int j = 0; j < 16; j++) {
        const int c = c16 * 16 + j;
        const float4* gl = (const float4*)(smem + 65536) + c * 4;
        float4 g0 = gl[0], g1 = gl[1], g2 = gl[2], g3 = gl[3];
        float gk = bias + g0.x * w2[0] + g0.y * w2[1] + g0.z * w2[2] + g0.w * w2[3] + g1.x * w2[4] + g1.y * w2[5] + g1.z * w2[6] + g1.w * w2[7]
                 + g2.x * w2[8] + g2.y * w2[9] + g2.z * w2[10] + g2.w * w2[11] + g3.x * w2[12] + g3.y * w2[13] + g3.z * w2[14] + g3.w * w2[15];
        float la = (fminf(gk, 0.f) - __logf(1.f + __expf(-fabsf(gk)))) * (1.f / 16.f);
        b += la;
        bj[j] = b;
        qv[j] = bf2f(QK[(size_t)(t0 + c) * 2048 + col]);
        kv[j] = bf2f(QK[(size_t)(t0 + c) * 2048 + 1024 + col]);
      }
      unsigned klp[8];
#pragma unroll
      for (int j = 0; j < 16; j++) {
        const int c = c16 * 16 + j;
        const float qe = qv[j] * 0.0625f * __expf(bj[j]);
        const float ke = kv[j] * __expf(-bj[j]);
        const unsigned qeb = f2bf(qe), keb = f2bf(ke), klb = keb;
        const int lo = c * 512 + ((((d >> 3) ^ (c & 15))) << 4) + (d & 7) * 2;
        *(unsigned short*)(lq + lo) = (unsigned short)qeb;
        *(unsigned short*)(lk + lo) = (unsigned short)keb;
        QE[(size_t)(t0 + c) * 1024 + head * 256 + dperm] = (bf16_t)qeb;
        if (j & 1) klp[j >> 1] |= klb << 16; else klp[j >> 1] = klb;
      }
      uint4 o0, o1; o0.x = klp[0]; o0.y = klp[1]; o0.z = klp[2]; o0.w = klp[3]; o1.x = klp[4]; o1.y = klp[5]; o1.z = klp[6]; o1.w = klp[7];
      bf16_t* kdst = KLT + (size_t)(head * 256 + d) * S_ + t0 + c16 * 16;
      *(uint4*)kdst = o0; *(uint4*)(kdst + 8) = o1;
    }
    DEC[(size_t)(n * 4 + head) * 256 + d] = __expf(b);
    __syncthreads();
    {
      const int ct = w >> 1, st = w & 1;
      f32x16 acc;
#pragma unroll
      for (int i = 0; i < 16; i++) acc[i] = 0.f;
      if (!(ct == 0 && st == 1)) {
        const int ra = ct * 32 + r, rb = st * 32 + r;
#pragma unroll
        for (int s = 0; s < 16; s++) {
          bf16x8 a = *(const bf16x8*)(lq + ra * 512 + (((2 * s + h) ^ (ra & 15)) << 4));
          bf16x8 bb = *(const bf16x8*)(lk + rb * 512 + (((2 * s + h) ^ (rb & 15)) << 4));
          acc = MFMA32(a, bb, acc);
        }
      }
      bf16_t* ap = AM + (size_t)(n * 4 + head) * 4096;
#pragma unroll
      for (int i = 0; i < 16; i++) {
        const int c = ct * 32 + crow(i, h), s = st * 32 + r;
        ap[c * 64 + s] = (bf16_t)f2bf(s <= c ? acc[i] : 0.f);
      }
    }
    __syncthreads();
  }
}

constexpr int SCAN_NG = 8, SCAN_GC = 16;
DI void phase_gla_local(const Params& p, char* smem, int bid, int nblk) {
  char* ws = opaque_ptr(p.ws);
  const int t = TID, lane = t & 63, w = t >> 6, r = lane & 31, h = lane >> 5;
  for (int item = bid; item < 64 * (SCAN_NG - 1); item += nblk) {
    const int grp = item >> 6, head = (item >> 4) & 3, dvt = item & 15, dv0 = dvt * 32;
    const int nb = grp * SCAN_GC;
    const bf16_t* v_p = (const bf16_t*)(ws + OFF_V0T) + (size_t)(head * 512 + dv0 + r) * S_ + nb * 64 + 8 * h;
    const bf16_t* kl_p = (const bf16_t*)(ws + OFF_KLT) + (size_t)(head * 256 + 64 * w + r) * S_ + nb * 64 + 8 * h;
    const float* dec_p = (const float*)(ws + OFF_DECAY) + (size_t)nb * 1024 + head * 256 + 64 * w + 4 * h;
    f32x16 St[2];
#pragma unroll
    for (int i = 0; i < 16; i++) { St[0][i] = 0.f; St[1][i] = 0.f; }
    bf16x8 klA[2][4], vfA[4], klB[2][4], vfB[4];
    float4 dcA[2][4], dcB[2][4];
#define LOC_LOAD(KL, VF, DC, n_)                                                                                 \
    {                                                                                                            \
      _Pragma("unroll") for (int s = 0; s < 4; s++) VF[s] = *(const bf16x8*)(v_p + (n_) * 64 + 16 * s);        \
      _Pragma("unroll") for (int dt = 0; dt < 2; dt++) {                                                         \
        _Pragma("unroll") for (int s = 0; s < 4; s++) KL[dt][s] = *(const bf16x8*)(kl_p + (size_t)dt * 32 * S_ + (n_) * 64 + 16 * s); \
        _Pragma("unroll") for (int g4 = 0; g4 < 4; g4++) DC[dt][g4] = *(const float4*)(dec_p + (size_t)(n_) * 1024 + dt * 32 + 8 * g4); \
      }                                                                                                          \
    }
#define LOC_STEP(KL, VF, DC)                                                                                     \
    {                                                                                                            \
      _Pragma("unroll") for (int dt = 0; dt < 2; dt++) {                                                         \
        _Pragma("unroll") for (int s = 0; s < 4; s++) St[dt] = MFMA32(KL[dt][s], VF[s], St[dt]);                 \
        _Pragma("unroll") for (int g4 = 0; g4 < 4; g4++) {                                                       \
          St[dt][4 * g4 + 0] *= DC[dt][g4].x; St[dt][4 * g4 + 1] *= DC[dt][g4].y;                                \
          St[dt][4 * g4 + 2] *= DC[dt][g4].z; St[dt][4 * g4 + 3] *= DC[dt][g4].w;                                \
        }                                                                                                        \
      }                                                                                                          \
    }
    LOC_LOAD(klA, vfA, dcA, 0)
    for (int n = 0; n < SCAN_GC; n += 2) {
      LOC_LOAD(klB, vfB, dcB, n + 1)
      LOC_STEP(klA, vfA, dcA)
      if (n + 2 < SCAN_GC) LOC_LOAD(klA, vfA, dcA, n + 2)
      LOC_STEP(klB, vfB, dcB)
    }
#undef LOC_LOAD
#undef LOC_STEP
    float* sl = (float*)(ws + OFF_SL) + ((size_t)((grp * 4 + head) * 16 + dvt) * 4 + w) * 2048 + lane;
#pragma unroll
    for (int dt = 0; dt < 2; dt++)
#pragma unroll
      for (int i = 0; i < 16; i++) sl[(dt * 16 + i) * 64] = St[dt][i];
    if (dvt == 0) {
      const float* dg = (const float*)(ws + OFF_DECAY) + (size_t)nb * 1024 + head * 256 + t;
      float pr = 1.f;
#pragma unroll 4
      for (int n = 0; n < SCAN_GC; n++) pr *= dg[(size_t)n * 1024];
      ((float*)(ws + OFF_DC))[(grp * 4 + head) * 256 + t] = pr;
    }
  }
}

DI void phase_gla_scan(const Params& p, char* smem, int bid, int nblk) {
  char* ws = opaque_ptr(p.ws);
  const int t = TID, lane = t & 63, w = t >> 6, r = lane & 31, h = lane >> 5;
  float* lo = (float*)smem;
  for (int item = bid; item < 64 * SCAN_NG; item += nblk) {
    const int grp = item >> 6, head = (item >> 4) & 3, dvt = item & 15, dv0 = dvt * 32;
    const int nb = grp * SCAN_GC, ne = nb + SCAN_GC;
    const bf16_t* qe_p = (const bf16_t*)(ws + OFF_QE) + (size_t)r * 1024 + head * 256 + 64 * w + 8 * h;
    const bf16_t* a_p = (const bf16_t*)(ws + OFF_AM) + (size_t)head * 4096 + (size_t)r * 64 + 16 * w + 8 * h;
    const bf16_t* v_p = (const bf16_t*)(ws + OFF_V0T) + (size_t)(head * 512 + dv0 + r) * S_ + 8 * h;
    const bf16_t* kl_p = (const bf16_t*)(ws + OFF_KLT) + (size_t)(head * 256 + 64 * w + r) * S_ + 8 * h;
    bf16_t* o_p = (bf16_t*)(ws + OFF_QK0) + (size_t)(t >> 2) * 2048 + head * 512 + dv0 + (t & 3) * 8;
    f32x16 St[2];
#pragma unroll
    for (int i = 0; i < 16; i++) { St[0][i] = 0.f; St[1][i] = 0.f; }
    for (int j = 0; j < grp; j++) {
      const float* slj = (const float*)(ws + OFF_SL) + ((size_t)((j * 4 + head) * 16 + dvt) * 4 + w) * 2048 + lane;
      const float* dcj = (const float*)(ws + OFF_DC) + (j * 4 + head) * 256 + 64 * w + 4 * h;
#pragma unroll
      for (int dt = 0; dt < 2; dt++)
#pragma unroll
        for (int g4 = 0; g4 < 4; g4++) {
          const float4 dv = *(const float4*)(dcj + 32 * dt + 8 * g4);
          St[dt][4 * g4 + 0] = St[dt][4 * g4 + 0] * dv.x + slj[(dt * 16 + 4 * g4 + 0) * 64];
          St[dt][4 * g4 + 1] = St[dt][4 * g4 + 1] * dv.y + slj[(dt * 16 + 4 * g4 + 1) * 64];
          St[dt][4 * g4 + 2] = St[dt][4 * g4 + 2] * dv.z + slj[(dt * 16 + 4 * g4 + 2) * 64];
          St[dt][4 * g4 + 3] = St[dt][4 * g4 + 3] * dv.w + slj[(dt * 16 + 4 * g4 + 3) * 64];
        }
    }
    qe_p += (size_t)nb * 64 * 1024; a_p += (size_t)nb * 4 * 4096; v_p += nb * 64; kl_p += nb * 64; o_p += (size_t)nb * 64 * 2048;
    bf16x8 qe[2][4], af[2], vf[4], kl[2][4];
    float* ldec = (float*)(smem + 32768);
    const float* dec_g = (const float*)(ws + OFF_DECAY) + (size_t)nb * 1024 + head * 256 + t;
#pragma unroll
    for (int ct = 0; ct < 2; ct++) {
#pragma unroll
      for (int s = 0; s < 4; s++) qe[ct][s] = *(const bf16x8*)(qe_p + (size_t)ct * 32 * 1024 + 16 * s);
      af[ct] = *(const bf16x8*)(a_p + ct * 32 * 64);
    }
#pragma unroll
    for (int s = 0; s < 4; s++) vf[s] = *(const bf16x8*)(v_p + 16 * s);
#pragma unroll
    for (int dt = 0; dt < 2; dt++) {
#pragma unroll
      for (int s = 0; s < 4; s++) kl[dt][s] = *(const bf16x8*)(kl_p + (size_t)dt * 32 * S_ + 16 * s);
    }
    __syncthreads();
    ldec[t] = dec_g[0];
    __syncthreads();
    for (int n = 0; n < SCAN_GC; n++) {
      const bool more = (n + 1 < SCAN_GC);
      float decn = 0.f;
      if (more) decn = dec_g[(size_t)(n + 1) * 1024];
      f32x16 o[2];
#pragma unroll
      for (int i = 0; i < 16; i++) { o[0][i] = 0.f; o[1][i] = 0.f; }
#pragma unroll
      for (int s = 0; s < 4; s++) {
        bf16x8 sb = pack8(St[s >> 1], s & 1);
        o[0] = MFMA32(qe[0][s], sb, o[0]);
        o[1] = MFMA32(qe[1][s], sb, o[1]);
      }
      if (more) {
        const bf16_t* q2 = qe_p + (size_t)(n + 1) * 64 * 1024;
#pragma unroll
        for (int ct = 0; ct < 2; ct++)
#pragma unroll
          for (int s = 0; s < 4; s++) qe[ct][s] = *(const bf16x8*)(q2 + (size_t)ct * 32 * 1024 + 16 * s);
      }
      {
        bf16x8 vw = (w == 0) ? vf[0] : (w == 1) ? vf[1] : (w == 2) ? vf[2] : vf[3];
        o[0] = MFMA32(af[0], vw, o[0]);
        o[1] = MFMA32(af[1], vw, o[1]);
      }
      if (more) {
        const bf16_t* a2 = a_p + (size_t)(n + 1) * 4 * 4096;
        af[0] = *(const bf16x8*)(a2); af[1] = *(const bf16x8*)(a2 + 32 * 64);
      }
#pragma unroll
      for (int dt = 0; dt < 2; dt++) {
#pragma unroll
        for (int s = 0; s < 4; s++) St[dt] = MFMA32(kl[dt][s], vf[s], St[dt]);
#pragma unroll
        for (int g = 0; g < 4; g++) {
          const float4 dv = *(const float4*)(ldec + (n & 1) * 256 + 64 * w + 32 * dt + 8 * g + 4 * h);
          St[dt][4 * g + 0] *= dv.x; St[dt][4 * g + 1] *= dv.y;
          St[dt][4 * g + 2] *= dv.z; St[dt][4 * g + 3] *= dv.w;
        }
      }
      if (more) {
        const int tn = (n + 1) * 64;
#pragma unroll
        for (int s = 0; s < 4; s++) vf[s] = *(const bf16x8*)(v_p + tn + 16 * s);
#pragma unroll
        for (int dt = 0; dt < 2; dt++) {
#pragma unroll
          for (int s = 0; s < 4; s++) kl[dt][s] = *(const bf16x8*)(kl_p + (size_t)dt * 32 * S_ + tn + 16 * s);
        }
      }
      ldec[((n + 1) & 1) * 256 + t] = decn;
#pragma unroll
      for (int ct = 0; ct < 2; ct++)
#pragma unroll
        for (int i = 0; i < 16; i++) lo[(w * 64 + ct * 32 + crow(i, h)) * 32 + r] = o[ct][i];
      __syncthreads();
      {
        const int c = t >> 2, vg = (t & 3) * 8;
        float4 s0 = *(const float4*)(lo + c * 32 + vg), s1 = *(const float4*)(lo + c * 32 + vg + 4);
#pragma unroll
        for (int ww = 1; ww < 4; ww++) {
          float4 x0 = *(const float4*)(lo + (ww * 64 + c) * 32 + vg), x1 = *(const float4*)(lo + (ww * 64 + c) * 32 + vg + 4);
          s0.x += x0.x; s0.y += x0.y; s0.z += x0.z; s0.w += x0.w; s1.x += x1.x; s1.y += x1.y; s1.z += x1.z; s1.w += x1.w;
        }
        uint4 ov; ov.x = pack2(s0.x, s0.y); ov.y = pack2(s0.z, s0.w); ov.z = pack2(s1.x, s1.y); ov.w = pack2(s1.z, s1.w);
        *(uint4*)(o_p + (size_t)n * 64 * 2048) = ov;
      }
      __syncthreads();
    }
  }
}

DI void phase_og(const Params& p, char* smem, int bid, int nblk) {
  char* ws = opaque_ptr(p.ws);
  const int t = TID, lane = t & 63, w = t >> 6;
  const bf16_t* O0 = (const bf16_t*)(ws + OFF_QK0);
  const bf16_t* G0 = (const bf16_t*)(ws + OFF_G0);
  bf16_t* OG = (bf16_t*)(ws + OFF_H);
  const float4* gp = (const float4*)(p.g_onorm + lane * 8);
  const float4 ga = gp[0], gb = gp[1];
  for (int token = bid; token < S_; token += 4 * nblk) {
    uint4 ov[4], gv[4];
#pragma unroll
    for (int u = 0; u < 4; u++) {
      const int tk = token + u * nblk;
      const size_t off = (size_t)(tk < S_ ? tk : token) * 2048 + w * 512 + lane * 8;
      ov[u] = ld_nt((const uint4*)(O0 + off));
      gv[u] = ld_nt((const uint4*)(G0 + off));
    }
#pragma unroll
    for (int u = 0; u < 4; u++) {
      const int tk = token + u * nblk;
      const size_t off = (size_t)tk * 2048 + w * 512 + lane * 8;
      const float f0 = bflo(ov[u].x), f1 = bfhi(ov[u].x), f2 = bflo(ov[u].y), f3 = bfhi(ov[u].y);
      const float f4 = bflo(ov[u].z), f5 = bfhi(ov[u].z), f6 = bflo(ov[u].w), f7 = bfhi(ov[u].w);
      float ss = f0 * f0 + f1 * f1 + f2 * f2 + f3 * f3 + f4 * f4 + f5 * f5 + f6 * f6 + f7 * f7;
      ss = wave_sum(ss);
      const float rinv = rsqrtf(ss * (1.f / 512.f) + 1e-6f);
      uint4 o;
      o.x = pack2(f0 * rinv * ga.x * bflo(gv[u].x), f1 * rinv * ga.y * bfhi(gv[u].x));
      o.y = pack2(f2 * rinv * ga.z * bflo(gv[u].y), f3 * rinv * ga.w * bfhi(gv[u].y));
      o.z = pack2(f4 * rinv * gb.x * bflo(gv[u].z), f5 * rinv * gb.y * bfhi(gv[u].z));
      o.w = pack2(f6 * rinv * gb.z * bflo(gv[u].w), f7 * rinv * gb.w * bfhi(gv[u].w));
      if (tk < S_) *(uint4*)(OG + off) = o;
    }
  }
}

DI void phase_gemm_out(const Params& p, char* smem, int bid, int nblk, size_t off_w) {
  char* ws = opaque_ptr(p.ws);
  const bf16_t* A = (const bf16_t*)(ws + OFF_H);
  const bf16_t* B = (const bf16_t*)(ws + off_w);
  bf16_t* Y = (bf16_t*)(ws + OFF_Y);
  for (int tile = bid; tile < 32 * 16; tile += nblk) {
    const int mi = tile & 31, ni = tile >> 5;
    const int m0 = mi * 256, n0 = ni * 128;
    f32x16 acc[4][2];
    gemm_main<false>(acc, A, 2048, B, 2048, 2048, m0, n0, smem);
    EPI_LOOP_BEGIN EPI_COORD_NS
      Y[(size_t)row * 2048 + col] = (bf16_t)f2bf(v);
    EPI_LOOP_END
  }
}

DI void phase_post0(const Params& p, char* smem, int bid, int nblk) {
  char* ws = opaque_ptr(p.ws);
  const int t = TID, lane = t & 63, w = t >> 6;
  const bf16_t* Y = (const bf16_t*)(ws + OFF_Y);
  const float4* gpo = (const float4*)p.l0_post + lane;
  const float4* gpr = (const float4*)p.l1_pre + lane;
  for (int row0 = bid * 4 + w; row0 < S_; row0 += nblk * 8) {
    const int row1r = row0 + nblk * 4;
    const bool has1 = row1r < S_;
    const int row1 = has1 ? row1r : row0;
    const uint2* yr0 = (const uint2*)(Y + (size_t)row0 * 2048) + lane;
    const uint2* yr1 = (const uint2*)(Y + (size_t)row1 * 2048) + lane;
    const float4* xr0 = (const float4*)(p.x + (size_t)row0 * 2048) + lane;
    const float4* xr1 = (const float4*)(p.x + (size_t)row1 * 2048) + lane;
    uint2 ya[8], yb[8];
    float4 xa[8], xb[8];
#pragma unroll
    for (int j = 0; j < 8; j++) { ya[j] = ld_nt(yr0 + j * 64); xa[j] = ld_nt(xr0 + j * 64); yb[j] = ld_nt(yr1 + j * 64); xb[j] = ld_nt(xr1 + j * 64); }
    float sa = 0.f, sb = 0.f;
#pragma unroll
    for (int j = 0; j < 8; j++) {
      sa += bflo(ya[j].x) * bflo(ya[j].x) + bfhi(ya[j].x) * bfhi(ya[j].x) + bflo(ya[j].y) * bflo(ya[j].y) + bfhi(ya[j].y) * bfhi(ya[j].y);
      sb += bflo(yb[j].x) * bflo(yb[j].x) + bfhi(yb[j].x) * bfhi(yb[j].x) + bflo(yb[j].y) * bflo(yb[j].y) + bfhi(yb[j].y) * bfhi(yb[j].y);
    }
    sa = wave_sum(sa); sb = wave_sum(sb);
    const float ra = rsqrtf(sa * (1.f / 2048.f) + 1e-6f), rb = rsqrtf(sb * (1.f / 2048.f) + 1e-6f);
    float4* out0 = (float4*)(p.out + (size_t)row0 * 2048) + lane;
    float4* out1 = (float4*)(p.out + (size_t)row1 * 2048) + lane;
    float s2a = 0.f, s2b = 0.f;
#pragma unroll
    for (int j = 0; j < 8; j++) {
      const float4 g = gpo[j * 64];
      xa[j].x += bflo(ya[j].x) * ra * g.x; xa[j].y += bfhi(ya[j].x) * ra * g.y; xa[j].z += bflo(ya[j].y) * ra * g.z; xa[j].w += bfhi(ya[j].y) * ra * g.w;
      xb[j].x += bflo(yb[j].x) * rb * g.x; xb[j].y += bfhi(yb[j].x) * rb * g.y; xb[j].z += bflo(yb[j].y) * rb * g.z; xb[j].w += bfhi(yb[j].y) * rb * g.w;
      out0[j * 64] = xa[j];
      if (has1) out1[j * 64] = xb[j];
      s2a += xa[j].x * xa[j].x + xa[j].y * xa[j].y + xa[j].z * xa[j].z + xa[j].w * xa[j].w;
      s2b += xb[j].x * xb[j].x + xb[j].y * xb[j].y + xb[j].z * xb[j].z + xb[j].w * xb[j].w;
    }
    s2a = wave_sum(s2a); s2b = wave_sum(s2b);
    const float r2a = rsqrtf(s2a * (1.f / 2048.f) + 1e-6f), r2b = rsqrtf(s2b * (1.f / 2048.f) + 1e-6f);
    uint2* h0 = (uint2*)(ws + OFF_H + (size_t)row0 * 4096) + lane;
    uint2* h1 = (uint2*)(ws + OFF_H + (size_t)row1 * 4096) + lane;
#pragma unroll
    for (int j = 0; j < 8; j++) {
      const float4 g = gpr[j * 64];
      uint2 o; o.x = pack2(xa[j].x * r2a * g.x, xa[j].y * r2a * g.y); o.y = pack2(xa[j].z * r2a * g.z, xa[j].w * r2a * g.w);
      h0[j * 64] = o;
      if (has1) { uint2 q; q.x = pack2(xb[j].x * r2b * g.x, xb[j].y * r2b * g.y); q.y = pack2(xb[j].z * r2b * g.z, xb[j].w * r2b * g.w); h1[j * 64] = q; }
    }
  }
}

DI void phase_gemm_in1(const Params& p, char* smem, int bid, int nblk) {
  char* ws = opaque_ptr(p.ws);
  const bf16_t* A = (const bf16_t*)(ws + OFF_H);
  const bf16_t* B = (const bf16_t*)(ws + OFF_WIN1T);
  bf16_t* CQ = (bf16_t*)(ws + OFF_CQ);
  bf16_t* CKV = (bf16_t*)(ws + OFF_CKV);
  bf16_t* KR = (bf16_t*)(ws + OFF_KR);
  const float* cs = (const float*)(ws + OFF_CS);
  bf16_t* G1 = (bf16_t*)(ws + OFF_QK0);
  for (int tile = bid; tile < 32 * 25; tile += nblk) {
    const int mi = tile & 31, ni = tile >> 5;
    const int m0 = mi * 256, n0 = ni * 128;
    f32x16 acc[4][2];
    gemm_main<false>(acc, A, 2048, B, 2048, 2048, m0, n0, smem);
    if (ni < 4) {
      EPI_LOOP_BEGIN EPI_COORD_NS
        CQ[(size_t)row * 512 + col] = (bf16_t)f2bf(v);
      EPI_LOOP_END
    } else if (ni < 8) {
      EPI_LOOP_BEGIN EPI_COORD_NS
        CKV[(size_t)row * 512 + (col - 512)] = (bf16_t)f2bf(v);
      EPI_LOOP_END
    } else if (ni == 8 && ((TID >> 6) & 1) == 0) {
      const int lane_ = TID & 63, w_ = TID >> 6, wm_ = w_ >> 1, r_ = lane_ & 31, h_ = lane_ >> 5;
#pragma unroll
      for (int mt = 0; mt < 4; mt++)
#pragma unroll
        for (int i = 0; i < 16; i++) {
          const int row = m0 + wm_ * 128 + mt * 32 + crow(i, h_);
          const float t1 = acc[mt][0][i], t2 = acc[mt][1][i];
          const float c = cs[row * 64 + r_], sn = cs[row * 64 + 32 + r_];
          KR[(size_t)row * 64 + r_] = (bf16_t)f2bf(t1 * c - t2 * sn);
          KR[(size_t)row * 64 + 32 + r_] = (bf16_t)f2bf(t2 * c + t1 * sn);
        }
    } else {
      EPI_LOOP_BEGIN EPI_COORD_NS
        if (col < 3136) G1[(size_t)row * 2048 + (col - 1088)] = (bf16_t)f2bf(silu(v));
      EPI_LOOP_END
    }
  }
}

DI void phase_gemm_qkv(const Params& p, char* smem, int bid, int nblk) {
  char* ws = opaque_ptr(p.ws);
  const bf16_t* CQ = (const bf16_t*)(ws + OFF_CQ);
  const bf16_t* CKV = (const bf16_t*)(ws + OFF_CKV);
  const bf16_t* WQ = (const bf16_t*)(ws + OFF_WQBT);
  const bf16_t* WKV = (const bf16_t*)(ws + OFF_WKVBT);
  const float* cs = (const float*)(ws + OFF_CS);
  bf16_t* Q = (bf16_t*)(ws + OFF_Q);
  bf16_t* KN = (bf16_t*)(ws + OFF_KN);
  bf16_t* VT = (bf16_t*)(ws + OFF_VT);
  const float qscale = 0.07216878364870322f * 1.4426950408889634f;
  const int ntq = 32 * 24, ntkv = 32 * 32;
  for (int tile = bid; tile < ntq + ntkv; tile += nblk) {
    f32x16 acc[4][2];
    if (tile < ntq) {
      const int mi = tile & 31, ni = tile >> 5;
      const int m0 = mi * 256, n0 = ni * 128;
      gemm_main<false, true>(acc, CQ, 512, WQ, 512, 512, m0, n0, smem);
      const float* rf = (const float*)(smem + 49152);
      const int lane_ = TID & 63, w_ = TID >> 6, wm_ = w_ >> 1, wn_ = w_ & 1, r_ = lane_ & 31, h_ = lane_ >> 5;
      const int cb = n0 + wn_ * 64;
      const int head = cb / 192, jb = cb - head * 192;
      if (jb == 128) {
#pragma unroll
        for (int mt = 0; mt < 4; mt++)
#pragma unroll
          for (int i = 0; i < 16; i++) {
            const int row = m0 + wm_ * 128 + mt * 32 + crow(i, h_);
            const float sc = rf[row - m0] * qscale;
            const float t1 = acc[mt][0][i] * sc, t2 = acc[mt][1][i] * sc;
            const float c = cs[row * 64 + r_], s = cs[row * 64 + 32 + r_];
            bf16_t* qp = Q + ((size_t)head * S_ + row) * 192 + 128;
            qp[r_] = (bf16_t)f2bf(t1 * c - t2 * s);
            qp[32 + r_] = (bf16_t)f2bf(t2 * c + t1 * s);
          }
      } else {
#pragma unroll
        for (int mt = 0; mt < 4; mt++)
#pragma unroll
          for (int nt = 0; nt < 2; nt++)
#pragma unroll
            for (int i = 0; i < 16; i++) {
              const int row = m0 + wm_ * 128 + mt * 32 + crow(i, h_);
              const float sc = rf[row - m0] * qscale;
              Q[((size_t)head * S_ + row) * 192 + jb + nt * 32 + r_] = (bf16_t)f2bf(acc[mt][nt][i] * sc);
            }
      }
    } else {
      const int tl = tile - ntq;
      const int mi = tl & 31, ni = tl >> 5;
      const int m0 = mi * 256, n0 = ni * 128;
      const int head = ni >> 1;
      if (ni & 1) {
        gemm_main<true, true>(acc, CKV, 512, WKV, 512, 512, m0, n0, smem);
        const float* rf = (const float*)(smem + 49152);
        EPI_LOOP_BEGIN EPI_COORD_SW
          const int j = col - head * 256 - 128;
          VT[((size_t)head * 128 + j) * S_ + row] = (bf16_t)f2bf(v * rf[row - m0]);
        EPI_LOOP_END
      } else {
        gemm_main<false, true>(acc, CKV, 512, WKV, 512, 512, m0, n0, smem);
        const float* rf = (const float*)(smem + 49152);
        EPI_LOOP_BEGIN EPI_COORD_NS
          const int j = col - head * 256;
          KN[((size_t)head * S_ + row) * 128 + j] = (bf16_t)f2bf(v * rf[row - m0]);
        EPI_LOOP_END
      }
    }
  }
}

DI void phase_attn(const Params& p, char* smem, int bid, int nblk, int rep) {
  char* ws = opaque_ptr(p.ws);
  const int t = TID, lane = t & 63, w = t >> 6, r = lane & 31, h = lane >> 5;
  const bf16_t* Q = (const bf16_t*)(ws + OFF_Q);
  const bf16_t* KN = (const bf16_t*)(ws + OFF_KN);
  const bf16_t* KR = (const bf16_t*)(ws + OFF_KR);
  const bf16_t* VT = (const bf16_t*)(ws + OFF_VT);
  const bf16_t* G1 = (const bf16_t*)(ws + OFF_QK0);
  bf16_t* OG = (bf16_t*)(ws + OFF_H);
  int* ctr = (int*)(ws + OFF_CTR) + rep;
  char* lk = smem;
  char* lv = smem + 25600;
  int* s_item = (int*)(smem + 44032);
  const int k_row = t >> 2, k_c0 = t & 3;
  const int v_row0 = t >> 3, v_kc = t & 7;
  for (;;) {
    __syncthreads();
    if (t == 0) *s_item = atomicAdd(ctr, 1);
    __syncthreads();
    const int item = *s_item;
    if (item >= 1024) break;
    const int qb = 63 - (item >> 4), head = item & 15;
    const int q0w = qb * 128 + w * 32;
    const int ntile = 2 * qb + 2;
    bf16x8 qf[12];
    {
      const bf16_t* qp = Q + ((size_t)head * S_ + q0w + r) * 192 + 8 * h;
#pragma unroll
      for (int s = 0; s < 12; s++) qf[s] = *(const bf16x8*)(qp + 16 * s);
    }
    f32x16 oacc[4];
#pragma unroll
    for (int vt = 0; vt < 4; vt++)
#pragma unroll
      for (int i = 0; i < 16; i++) oacc[vt][i] = 0.f;
    float m_run = -INFINITY, l_run = 0.f;
    uint4 kg0, kg1, kg2, kg3, kg4, kg5, vg0, vg1, vg2, vg3;
    const bf16_t* knp = KN + (size_t)head * S_ * 128;
    const bf16_t* vtp = VT + ((size_t)head * 128 + v_row0) * S_ + v_kc * 8;
#define ATT_LOAD(k0_)                                                                                         \
    {                                                                                                         \
      const bf16_t* kn_ = knp + (size_t)((k0_) + k_row) * 128 + k_c0 * 8;                                     \
      const bf16_t* kr_ = KR + (size_t)((k0_) + k_row) * 64 + k_c0 * 8;                                       \
      const bf16_t* vp_ = vtp + (k0_);                                                                        \
      kg0 = *(const uint4*)(kn_); kg1 = *(const uint4*)(kn_ + 32); kg2 = *(const uint4*)(kn_ + 64); kg3 = *(const uint4*)(kn_ + 96); \
      kg4 = *(const uint4*)(kr_); kg5 = *(const uint4*)(kr_ + 32);                                            \
      vg0 = *(const uint4*)(vp_); vg1 = *(const uint4*)(vp_ + (size_t)32 * S_);                               \
      vg2 = *(const uint4*)(vp_ + (size_t)64 * S_); vg3 = *(const uint4*)(vp_ + (size_t)96 * S_);             \
    }
    ATT_LOAD(0)
    for (int kt = 0; kt < ntile; kt++) {
      const int k0 = kt * 64;
      __syncthreads();
      {
        char* kd = lk + k_row * 400 + k_c0 * 16;
        *(uint4*)(kd) = kg0; *(uint4*)(kd + 64) = kg1; *(uint4*)(kd + 128) = kg2; *(uint4*)(kd + 192) = kg3;
        *(uint4*)(kd + 256) = kg4; *(uint4*)(kd + 320) = kg5;
        char* vd = lv + v_row0 * 144 + (v_kc >> 1) * 32 + (v_kc & 1) * 8;
#define VST(o_, v_) { uint2 u0, u1; u0.x = v_.x; u0.y = v_.y; u1.x = v_.z; u1.y = v_.w; *(uint2*)(vd + (o_)) = u0; *(uint2*)(vd + (o_) + 16) = u1; }
        VST(0, vg0) VST(32 * 144, vg1) VST(64 * 144, vg2) VST(96 * 144, vg3)
#undef VST
      }
      __syncthreads();
      { const int knext = (kt + 1 < ntile) ? k0 + 64 : k0; ATT_LOAD(knext) }
      if (k0 <= q0w + 31) {
        f32x16 sc[2];
#pragma unroll
        for (int i = 0; i < 16; i++) { sc[0][i] = 0.f; sc[1][i] = 0.f; }
        __builtin_amdgcn_s_setprio(1);
#pragma unroll
        for (int s = 0; s < 12; s++) {
          bf16x8 a0 = *(const bf16x8*)(lk + r * 400 + h * 16 + s * 32);
          bf16x8 a1 = *(const bf16x8*)(lk + r * 400 + h * 16 + 32 * 400 + s * 32);
          sc[0] = MFMA32(a0, qf[s], sc[0]);
          sc[1] = MFMA32(a1, qf[s], sc[1]);
        }
        __builtin_amdgcn_s_setprio(0);
        if (k0 + 63 > q0w) {
          const int qg = q0w + r;
#pragma unroll
          for (int mt = 0; mt < 2; mt++)
#pragma unroll
            for (int i = 0; i < 16; i++) {
              const int key = k0 + mt * 32 + crow(i, h);
              if (key > qg) sc[mt][i] = -INFINITY;
            }
        }
        float mx = sc[0][0];
#pragma unroll
        for (int i = 1; i < 16; i++) mx = fmaxf(mx, sc[0][i]);
#pragma unroll
        for (int i = 0; i < 16; i++) mx = fmaxf(mx, sc[1][i]);
        mx = fmaxf(mx, __shfl_xor(mx, 32));
        const float m_new = (mx > m_run + 8.f) ? mx : m_run;
        const bool resc = __any(m_new != m_run);
        const float alpha = __builtin_amdgcn_exp2f(m_run - m_new);
        m_run = m_new;
        float ls = 0.f;
#pragma unroll
        for (int mt = 0; mt < 2; mt++)
#pragma unroll
          for (int i = 0; i < 16; i++) { const float pv = __builtin_amdgcn_exp2f(sc[mt][i] - m_new); sc[mt][i] = pv; ls += pv; }
        l_run = l_run * alpha + ls;
        if (resc) {
#pragma unroll
          for (int vt = 0; vt < 4; vt++)
#pragma unroll
            for (int i = 0; i < 16; i++) oacc[vt][i] *= alpha;
        }
        __builtin_amdgcn_s_setprio(1);
#pragma unroll
        for (int s = 0; s < 4; s++) {
          const bf16x8 pb = pack8(sc[s >> 1], s & 1);
#pragma unroll
          for (int vt = 0; vt < 4; vt++) {
            const bf16x8 a = *(const bf16x8*)(lv + r * 144 + h * 16 + vt * 32 * 144 + s * 32);
            oacc[vt] = MFMA32(a, pb, oacc[vt]);
          }
        }
        __builtin_amdgcn_s_setprio(0);
      }
    }
#undef ATT_LOAD
    const float l_tot = l_run + __shfl_xor(l_run, 32);
    const float inv = 1.f / l_tot;
    const size_t obase = (size_t)(q0w + r) * 2048 + head * 128;
#pragma unroll
    for (int vt = 0; vt < 4; vt++)
#pragma unroll
      for (int g = 0; g < 4; g++) {
        const int v = vt * 32 + 8 * g + 4 * h;
        uint2 gg = *(const uint2*)(G1 + obase + v);
        uint2 o;
        o.x = pack2(oacc[vt][4 * g + 0] * inv * bflo(gg.x), oacc[vt][4 * g + 1] * inv * bfhi(gg.x));
        o.y = pack2(oacc[vt][4 * g + 2] * inv * bflo(gg.y), oacc[vt][4 * g + 3] * inv * bfhi(gg.y));
        *(uint2*)(OG + obase + v) = o;
      }
  }
}

DI void phase_final(const Params& p, char* smem, int bid, int nblk) {
  char* ws = opaque_ptr(p.ws);
  const int t = TID, lane = t & 63, w = t >> 6;
  const bf16_t* Y = (const bf16_t*)(ws + OFF_Y);
  const float4* gpo = (const float4*)p.l1_post + lane;
  for (int row0 = bid * 4 + w; row0 < S_; row0 += nblk * 8) {
    const int row1r = row0 + nblk * 4;
    const bool has1 = row1r < S_;
    const int row1 = has1 ? row1r : row0;
    const uint2* yr0 = (const uint2*)(Y + (size_t)row0 * 2048) + lane;
    const uint2* yr1 = (const uint2*)(Y + (size_t)row1 * 2048) + lane;
    float4* out0 = (float4*)(p.out + (size_t)row0 * 2048) + lane;
    float4* out1 = (float4*)(p.out + (size_t)row1 * 2048) + lane;
    uint2 ya[8], yb[8];
    float4 xa[8], xb[8];
#pragma unroll
    for (int j = 0; j < 8; j++) { ya[j] = ld_nt(yr0 + j * 64); xa[j] = ld_nt((const float4*)out0 + j * 64); yb[j] = ld_nt(yr1 + j * 64); xb[j] = ld_nt((const float4*)out1 + j * 64); }
    float sa = 0.f, sb = 0.f;
#pragma unroll
    for (int j = 0; j < 8; j++) {
      sa += bflo(ya[j].x) * bflo(ya[j].x) + bfhi(ya[j].x) * bfhi(ya[j].x) + bflo(ya[j].y) * bflo(ya[j].y) + bfhi(ya[j].y) * bfhi(ya[j].y);
      sb += bflo(yb[j].x) * bflo(yb[j].x) + bfhi(yb[j].x) * bfhi(yb[j].x) + bflo(yb[j].y) * bflo(yb[j].y) + bfhi(yb[j].y) * bfhi(yb[j].y);
    }
    sa = wave_sum(sa); sb = wave_sum(sb);
    const float ra = rsqrtf(sa * (1.f / 2048.f) + 1e-6f), rb = rsqrtf(sb * (1.f / 2048.f) + 1e-6f);
#pragma unroll
    for (int j = 0; j < 8; j++) {
      const float4 g = gpo[j * 64];
      float4 o = xa[j];
      o.x += bflo(ya[j].x) * ra * g.x; o.y += bfhi(ya[j].x) * ra * g.y; o.z += bflo(ya[j].y) * ra * g.z; o.w += bfhi(ya[j].y) * ra * g.w;
      st_nt(out0 + j * 64, o);
      if (has1) {
        float4 q = xb[j];
        q.x += bflo(yb[j].x) * rb * g.x; q.y += bfhi(yb[j].x) * rb * g.y; q.z += bflo(yb[j].y) * rb * g.z; q.w += bfhi(yb[j].y) * rb * g.w;
        st_nt(out1 + j * 64, q);
      }
    }
  }
}

constexpr int NPHASE = 13;
constexpr unsigned DUP_MASK = 0u;
DI void run_phase(int ph, const Params& p, char* smem, int bid, int nblk, int rep) {
  switch (ph) {
    case 0: phase_prep(p, smem, bid, nblk); break;
    case 1: phase_gemm_in0(p, smem, bid, nblk); break;
    case 2: phase_gla_prep(p, smem, bid, nblk); break;
    case 3: phase_gla_local(p, smem, bid, nblk); break;
    case 4: phase_gla_scan(p, smem, bid, nblk); break;
    case 5: phase_og(p, smem, bid, nblk); break;
    case 6: phase_gemm_out(p, smem, bid, nblk, OFF_WOUT0T); break;
    case 7: phase_post0(p, smem, bid, nblk); break;
    case 8: phase_gemm_in1(p, smem, bid, nblk); break;
    case 9: phase_gemm_qkv(p, smem, bid, nblk); break;
    case 10: phase_attn(p, smem, bid, nblk, rep); break;
    case 11: phase_gemm_out(p, smem, bid, nblk, OFF_WOUT1T); break;
    case 12: phase_final(p, smem, bid, nblk); break;
  }
}

#define XB_TMO      128
#define XB_XCNT(j)  (256  + 64 * (j))
#define XB_XSUB(j)  (1280 + 64 * (j))
#define XB_XGEN(j)  (2304 + 64 * (j))
#define XB_TOP      3328
#define XB_TOPGEN   3392
#define XCD_BAR_WORDS 3456
#define XB_SPIN_CAP (1u << 20)
#define LAS __attribute__((address_space(3)))
DI unsigned xb_ld(unsigned* p) { return __hip_atomic_load(p, __ATOMIC_RELAXED, __HIP_MEMORY_SCOPE_AGENT); }
DI unsigned xb_add(unsigned* p, unsigned v) { return __hip_atomic_fetch_add(p, v, __ATOMIC_RELAXED, __HIP_MEMORY_SCOPE_AGENT); }
DI unsigned xb_xcc_id() { return (unsigned)__builtin_amdgcn_s_getreg((3 << 11) | 20) & 0xFu; }
#define XB_SPIN(cond, bar) do { unsigned _sp = 0; while (cond) { __builtin_amdgcn_s_sleep(1); \
    if ((++_sp & 255u) == 0u) { if (xb_ld(&(bar)[XB_TMO])) break; if (_sp > XB_SPIN_CAP) { atomicAdd(&(bar)[XB_TMO], 1u); break; } } } } while (0)
struct XcdBarrier { unsigned* bar; unsigned x; volatile LAS unsigned* st; };
DI XcdBarrier xcd_barrier_post(unsigned* bar, volatile LAS unsigned* st) {
  XcdBarrier b; b.bar = bar; b.x = xb_xcc_id(); b.st = st;
  if (threadIdx.x == 0) (void)xb_add(&bar[XB_XCNT(b.x)], 1u);
  return b;
}
DI void xcd_barrier_complete(unsigned* bar, unsigned x, unsigned& nloc, unsigned& nx) {
  const unsigned G = gridDim.x * gridDim.y * gridDim.z;
  unsigned sum, cnt, mine, sp = 0u;
  for (;;) {
    sum = 0u; cnt = 0u; mine = 0u;
#pragma unroll
    for (unsigned j = 0; j < 16; ++j) { const unsigned c = xb_ld(&bar[XB_XCNT(j)]); sum += c; cnt += (c > 0u) ? 1u : 0u; mine = (j == x) ? c : mine; }
    if (sum == G) break;
    __builtin_amdgcn_s_sleep(1);
    if ((++sp & 255u) == 0u) { if (xb_ld(&bar[XB_TMO])) break; if (sp > XB_SPIN_CAP) { atomicAdd(&bar[XB_TMO], 1u); break; } }
  }
  nloc = mine > 0u ? mine : 1u; nx = cnt > 0u ? cnt : 1u;
}
DI void xcd_barrier(const XcdBarrier& b) {
  asm volatile("s_waitcnt vmcnt(0)" ::: "memory");
  __syncthreads();
  if (threadIdx.x == 0) {
    unsigned* bar = b.bar;
    __builtin_amdgcn_s_waitcnt(0);
    unsigned nloc, nx;
    xcd_barrier_complete(bar, b.x, nloc, nx);
    const unsigned old = xb_add(&bar[XB_XSUB(b.x)], 1u);
    const unsigned gen = old / nloc;
    if (old + 1u == (gen + 1u) * nloc) {
      __builtin_amdgcn_fence(__ATOMIC_RELEASE, "agent");
      asm volatile("s_waitcnt vmcnt(0)" ::: "memory");
      const unsigned og = xb_add(&bar[XB_TOP], 1u);
      const unsigned tg = og / nx;
      if (og + 1u == (tg + 1u) * nx) xb_add(&bar[XB_TOPGEN], 1u);
      else XB_SPIN(xb_ld(&bar[XB_TOPGEN]) == tg, bar);
      __builtin_amdgcn_fence(__ATOMIC_ACQUIRE, "agent");
      xb_add(&bar[XB_XGEN(b.x)], 1u);
      asm volatile("s_waitcnt vmcnt(0)" ::: "memory");
    } else {
      XB_SPIN(xb_ld(&bar[XB_XGEN(b.x)]) == gen, bar);
      __builtin_amdgcn_fence(__ATOMIC_ACQUIRE, "agent");
      asm volatile("s_waitcnt vmcnt(0)" ::: "memory");
    }
  }
  __syncthreads();
}

#if MEGA
__global__ void __launch_bounds__(256, 2) mega_kernel(Params p) {
  __shared__ __attribute__((aligned(16))) char smem[69632];
  cg::grid_group grid = cg::this_grid();
  const int bid = blockIdx.x, nblk = gridDim.x;
  (void)xcd_barrier_post((unsigned*)(p.ws + OFF_BAR), (volatile LAS unsigned*)0);
#pragma nounroll
  for (int ph = 0; ph < NPHASE; ph++) {
    int phv = ph;
    asm volatile("" : "+s"(phv));
    run_phase(phv, p, smem, bid, nblk, 0);
    if (p.ws == nullptr) grid.sync();
    { XcdBarrier xb; xb.bar = (unsigned*)(opaque_ptr(p.ws) + OFF_BAR); xb.x = xb_xcc_id(); xb.st = (volatile LAS unsigned*)0; xcd_barrier(xb); }
    if ((DUP_MASK >> ph) & 1u) {
      run_phase(phv, p, smem, bid, nblk, 1);
      { XcdBarrier xb; xb.bar = (unsigned*)(opaque_ptr(p.ws) + OFF_BAR); xb.x = xb_xcc_id(); xb.st = (volatile LAS unsigned*)0; xcd_barrier(xb); }
    }
  }
}
#endif

#if !MEGA
template <int PH>
__global__ void __launch_bounds__(256, 2) phase_kernel_t(Params p) {
  __shared__ __attribute__((aligned(16))) char smem[69632];
  run_phase(PH, p, smem, blockIdx.x, gridDim.x, 0);
}
#endif

extern "C" void kernel_launch(void* const* d_in, const int* in_sizes, int n_in, void* d_out, int out_size, void* d_ws,
                              size_t ws_size, hipStream_t stream) {
  Params p{};
  p.x = (const float*)d_in[0]; p.pos = (const int*)d_in[1]; p.l0_pre = (const float*)d_in[2]; p.w_in0 = (const float*)d_in[3];
  p.w_gk2 = (const float*)d_in[4]; p.b_gk = (const float*)d_in[5]; p.g_onorm = (const float*)d_in[6]; p.w_out0 = (const float*)d_in[7];
  p.l0_post = (const float*)d_in[8]; p.l1_pre = (const float*)d_in[9]; p.w_in1 = (const float*)d_in[10]; p.g_qa = (const float*)d_in[11];
  p.w_qb = (const float*)d_in[12]; p.g_kva = (const float*)d_in[13]; p.w_kvb = (const float*)d_in[14]; p.w_out1 = (const float*)d_in[15];
  p.l1_post = (const float*)d_in[16];
  p.out = (float*)d_out; p.ws = (char*)d_ws;
  for (int i = 0; i < 32; i++) p.invf[i] = (float)pow(10000.0, -(double)i / 32.0);
#if MEGA
  static int grid_blocks = 0;
  if (!grid_blocks) {
    int dev = 0, cus = 0, per_cu = 0;
    hipGetDevice(&dev);
    hipDeviceGetAttribute(&cus, hipDeviceAttributeMultiprocessorCount, dev);
    hipOccupancyMaxActiveBlocksPerMultiprocessor(&per_cu, mega_kernel, 256, 0);
    if (per_cu > 2) per_cu = 2;
    if (per_cu < 1) per_cu = 1;
    grid_blocks = cus * per_cu;
  }
  hipMemsetAsync((char*)d_ws + OFF_BAR, 0, XCD_BAR_WORDS * 4, stream);
  void* args[] = {&p};
  hipError_t e = hipLaunchCooperativeKernel((void*)mega_kernel, dim3(grid_blocks), dim3(256), args, 0, stream);
  if (e != hipSuccess) fprintf(stderr, "cooperative launch failed: %s (grid %d)\n", hipGetErrorString(e), grid_blocks);
#else
#define LPH(N) hipLaunchKernelGGL(phase_kernel_t<N>, dim3(512), dim3(256), 0, stream, p);
  LPH(0) LPH(1) LPH(2) LPH(3) LPH(4) LPH(5) LPH(6) LPH(7) LPH(8) LPH(9) LPH(10) LPH(11) LPH(12)
#undef LPH
#endif
}
```

```cpp
#include <hip/hip_runtime.h>
#include <hip/hip_cooperative_groups.h>
#include <stdint.h>
#include <math.h>
#include <stdio.h>
namespace cg = cooperative_groups;

#ifndef MEGA
#define MEGA 1
#endif

typedef __attribute__((ext_vector_type(8))) short bf16x8;
typedef __attribute__((ext_vector_type(4))) short s16x4;
typedef __attribute__((ext_vector_type(16))) float f32x16;
typedef unsigned short bf16_t;
#define DI __device__ __forceinline__
#define MFMA32(a, b, c) __builtin_amdgcn_mfma_f32_32x32x16_bf16((a), (b), (c), 0, 0, 0)

constexpr int S_ = 8192;
constexpr size_t MiB = (size_t)1 << 20;
constexpr size_t OFF_WIN0T = 0;
constexpr size_t OFF_WOUT0T = 25 * MiB;
constexpr size_t OFF_WIN1T = 33 * MiB;
constexpr size_t OFF_WQBT = 46 * MiB;
constexpr size_t OFF_WKVBT = 49 * MiB;
constexpr size_t OFF_WOUT1T = 53 * MiB;
constexpr size_t OFF_GKLOW = 61 * MiB;
constexpr size_t OFF_DECAY = 61 * MiB + 512 * 1024;
constexpr size_t OFF_CS = 62 * MiB;
constexpr size_t OFF_H = 64 * MiB;
constexpr size_t OFF_QK0 = 96 * MiB;
constexpr size_t OFF_V0T = 128 * MiB;
constexpr size_t OFF_G0 = 160 * MiB;
constexpr size_t OFF_Y = 128 * MiB;
constexpr size_t OFF_QE = 192 * MiB;
constexpr size_t OFF_KLT = 208 * MiB;
constexpr size_t OFF_AM = 224 * MiB;
constexpr size_t OFF_CQ = 0;
constexpr size_t OFF_CKV = 8 * MiB;
constexpr size_t OFF_KR = 16 * MiB;
constexpr size_t OFF_RINVQ = 17 * MiB;
constexpr size_t OFF_RINVKV = 17 * MiB + 64 * 1024;
constexpr size_t OFF_KRRAW = 18 * MiB;
constexpr size_t OFF_CTR = 20 * MiB;
constexpr size_t OFF_BAR = 255 * MiB;
constexpr size_t OFF_SL = 64 * MiB;
constexpr size_t OFF_DC = 80 * MiB;
constexpr size_t OFF_Q = 128 * MiB;
constexpr size_t OFF_KN = 176 * MiB;
constexpr size_t OFF_VT = 208 * MiB;

struct Params {
  const float* x; const int* pos; const float* l0_pre; const float* w_in0; const float* w_gk2; const float* b_gk;
  const float* g_onorm; const float* w_out0; const float* l0_post; const float* l1_pre; const float* w_in1;
  const float* g_qa; const float* w_qb; const float* g_kva; const float* w_kvb; const float* w_out1; const float* l1_post;
  float* out; char* ws;
  float invf[32];
};

DI int tid_opaque() { int t = threadIdx.x; asm volatile("" : "+v"(t)); return t; }
#define TID tid_opaque()
typedef __attribute__((address_space(1))) char gchar_t;
DI char* opaque_ptr(char* q) {
  unsigned long long v = (unsigned long long)q;
  unsigned lo = __builtin_amdgcn_readfirstlane((unsigned)v), hi = __builtin_amdgcn_readfirstlane((unsigned)(v >> 32));
  asm volatile("" : "+s"(lo), "+s"(hi));
  return (char*)(gchar_t*)(((unsigned long long)hi << 32) | lo);
}
typedef __bf16 hbf16x2 __attribute__((ext_vector_type(2)));
typedef float hf32x2 __attribute__((ext_vector_type(2)));
DI unsigned pack2(float a, float b) { hf32x2 f = {a, b}; return __builtin_bit_cast(unsigned, __builtin_convertvector(f, hbf16x2)); }
DI unsigned f2bf(float f) { return (unsigned)__builtin_bit_cast(unsigned short, (__bf16)f); }
DI float bf2f(unsigned h) { return __uint_as_float(h << 16); }
DI float bflo(unsigned u) { return __uint_as_float(u << 16); }
DI float bfhi(unsigned u) { return __uint_as_float(u & 0xffff0000u); }
DI int crow(int i, int h) { return (i & 3) + 8 * (i >> 2) + 4 * h; }
typedef float nt_f4 __attribute__((ext_vector_type(4)));
typedef unsigned nt_u4 __attribute__((ext_vector_type(4)));
typedef unsigned nt_u2 __attribute__((ext_vector_type(2)));
DI float4 ld_nt(const float4* p) { nt_f4 v = __builtin_nontemporal_load((const nt_f4*)p); float4 r; r.x = v.x; r.y = v.y; r.z = v.z; r.w = v.w; return r; }
DI uint4 ld_nt(const uint4* p) { nt_u4 v = __builtin_nontemporal_load((const nt_u4*)p); uint4 r; r.x = v.x; r.y = v.y; r.z = v.z; r.w = v.w; return r; }
DI uint2 ld_nt(const uint2* p) { nt_u2 v = __builtin_nontemporal_load((const nt_u2*)p); uint2 r; r.x = v.x; r.y = v.y; return r; }
DI void st_nt(float4* p, const float4& a) { nt_f4 v = {a.x, a.y, a.z, a.w}; __builtin_nontemporal_store(v, (nt_f4*)p); }
DI float silu(float v) { return v / (1.f + __expf(-v)); }
DI float wave_sum(float v) { for (int o = 32; o > 0; o >>= 1) v += __shfl_xor(v, o); return v; }
DI float block_sum(float v, float* red) {
  v = wave_sum(v);
  __syncthreads();
  if ((TID & 63) == 0) red[TID >> 6] = v;
  __syncthreads();
  return red[0] + red[1] + red[2] + red[3];
}
DI bf16x8 pack8(const f32x16& x, int s) {
  union { unsigned u[4]; bf16x8 v; } p;
  p.u[0] = pack2(x[8 * s + 0], x[8 * s + 1]); p.u[1] = pack2(x[8 * s + 2], x[8 * s + 3]);
  p.u[2] = pack2(x[8 * s + 4], x[8 * s + 5]); p.u[3] = pack2(x[8 * s + 6], x[8 * s + 7]);
  return p.v;
}

DI void transpose_tile4(const float* __restrict__ W, int K, int N, int ntN, const float* __restrict__ gain, bf16_t* __restrict__ WT,
                        int id0, char* smem) {
  const int t = TID;
  float v[4][16];
#pragma unroll
  for (int q = 0; q < 4; q++) {
    const int id = id0 + q, k0 = (id / ntN) * 64, n0 = (id % ntN) * 64;
#pragma unroll
    for (int i = 0; i < 16; i++) {
      const int kk = i * 4 + (t >> 6), n = n0 + (t & 63);
      float x = (n < N) ? __builtin_nontemporal_load(&W[(size_t)(k0 + kk) * N + n]) : 0.f;
      if (gain) x *= gain[k0 + kk];
      v[q][i] = x;
    }
  }
#pragma unroll
  for (int q = 0; q < 4; q++) {
    unsigned short (*tile)[72] = (unsigned short (*)[72])(smem + q * 9216);
#pragma unroll
    for (int i = 0; i < 16; i++) tile[t & 63][i * 4 + (t >> 6)] = (unsigned short)f2bf(v[q][i]);
  }
  __syncthreads();
#pragma unroll
  for (int q = 0; q < 4; q++) {
    unsigned short (*tile)[72] = (unsigned short (*)[72])(smem + q * 9216);
    const int id = id0 + q, k0 = (id / ntN) * 64, n0 = (id % ntN) * 64;
    const int nn = t >> 2, kg = (t & 3) * 16;
    uint4 a = *(const uint4*)&tile[nn][kg];
    uint4 b = *(const uint4*)&tile[nn][kg + 8];
    bf16_t* dst = WT + (size_t)(n0 + nn) * K + k0 + kg;
    *(uint4*)dst = a; *(uint4*)(dst + 8) = b;
  }
  __syncthreads();
}

DI void phase_prep(const Params& p, char* smem, int bid, int nblk) {
  const int t = TID;
  char* ws = opaque_ptr(p.ws);
  for (int task = bid; task < 1920 + 3072; task += nblk) {
    if (task < 1920) {
      const int tile0 = task * 4;
      const float* W; const float* gain = nullptr; bf16_t* WT; int K, N, ntN, id;
      if (tile0 < 3136) { id = tile0; W = p.w_in0; K = 2048; N = 6160; ntN = 98; WT = (bf16_t*)(ws + OFF_WIN0T); }
      else if (tile0 < 4160) { id = tile0 - 3136; W = p.w_out0; K = 2048; N = 2048; ntN = 32; WT = (bf16_t*)(ws + OFF_WOUT0T); }
      else if (tile0 < 5760) { id = tile0 - 4160; W = p.w_in1; K = 2048; N = 3136; ntN = 50; WT = (bf16_t*)(ws + OFF_WIN1T); }
      else if (tile0 < 6144) { id = tile0 - 5760; W = p.w_qb; K = 512; N = 3072; ntN = 48; WT = (bf16_t*)(ws + OFF_WQBT); gain = p.g_qa; }
      else if (tile0 < 6656) { id = tile0 - 6144; W = p.w_kvb; K = 512; N = 4096; ntN = 64; WT = (bf16_t*)(ws + OFF_WKVBT); gain = p.g_kva; }
      else { id = tile0 - 6656; W = p.w_out1; K = 2048; N = 2048; ntN = 32; WT = (bf16_t*)(ws + OFF_WOUT1T); }
      transpose_tile4(W, K, N, ntN, gain, WT, id, smem);
    } else if (task < 1920 + 2048) {
      if (task < 1920 + 1024) {
        const int lane = t & 63, row0 = (task - 1920) * 4 + (t >> 6), row1 = row0 + 4096;
        const float4* xr0 = (const float4*)(p.x + (size_t)row0 * 2048) + lane;
        const float4* xr1 = (const float4*)(p.x + (size_t)row1 * 2048) + lane;
        const float4* gr = (const float4*)p.l0_pre + lane;
        float4 xa[8], xb[8];
#pragma unroll
        for (int j = 0; j < 8; j++) { xa[j] = ld_nt(xr0 + j * 64); xb[j] = ld_nt(xr1 + j * 64); }
        float sa = 0.f, sb = 0.f;
#pragma unroll
        for (int j = 0; j < 8; j++) {
          sa += xa[j].x * xa[j].x + xa[j].y * xa[j].y + xa[j].z * xa[j].z + xa[j].w * xa[j].w;
          sb += xb[j].x * xb[j].x + xb[j].y * xb[j].y + xb[j].z * xb[j].z + xb[j].w * xb[j].w;
        }
        sa = wave_sum(sa); sb = wave_sum(sb);
        const float ra = rsqrtf(sa * (1.f / 2048.f) + 1e-6f), rb = rsqrtf(sb * (1.f / 2048.f) + 1e-6f);
        uint2* h0 = (uint2*)(ws + OFF_H + (size_t)row0 * 4096) + lane;
        uint2* h1 = (uint2*)(ws + OFF_H + (size_t)row1 * 4096) + lane;
#pragma unroll
        for (int j = 0; j < 8; j++) {
          const float4 g = gr[j * 64];
          uint2 o; o.x = pack2(xa[j].x * ra * g.x, xa[j].y * ra * g.y); o.y = pack2(xa[j].z * ra * g.z, xa[j].w * ra * g.w);
          h0[j * 64] = o;
          uint2 q; q.x = pack2(xb[j].x * rb * g.x, xb[j].y * rb * g.y); q.y = pack2(xb[j].z * rb * g.z, xb[j].w * rb * g.w);
          h1[j * 64] = q;
        }
      }
    } else {
      const int idx = (task - 3968) * 256 + t;
      const int token = idx >> 5, i = idx & 31;
      double ang = (double)p.pos[token] * (double)p.invf[i];
      double tt = ang * 0.15915494309189535;
      tt -= floor(tt + 0.5);
      float f = (float)tt;
      float* cs = (float*)(ws + OFF_CS);
      cs[token * 64 + i] = __builtin_amdgcn_cosf(f);
      cs[token * 64 + 32 + i] = __builtin_amdgcn_sinf(f);
    }
  }
}

DI float sq8(const uint4& v) {
  return bflo(v.x) * bflo(v.x) + bfhi(v.x) * bfhi(v.x) + bflo(v.y) * bflo(v.y) + bfhi(v.y) * bfhi(v.y) + bflo(v.z) * bflo(v.z) + bfhi(v.z) * bfhi(v.z) +
         bflo(v.w) * bflo(v.w) + bfhi(v.w) * bfhi(v.w);
}
template <bool SWAP, bool SUMSQ = false>
DI void gemm_main(f32x16 (&acc)[4][2], const bf16_t* A, int lda, const bf16_t* B, int ldb, int K,
                  int m0, int n0, char* smem) {
  const int t = TID, lane = t & 63, w = t >> 6, wm = w >> 1, wn = w & 1, r = lane & 31, h = lane >> 5;
#pragma unroll
  for (int a = 0; a < 4; a++)
#pragma unroll
    for (int b = 0; b < 2; b++)
#pragma unroll
      for (int i = 0; i < 16; i++) acc[a][b][i] = 0.f;
  const int lrow = t >> 2, kc = t & 3;
  const bf16_t* ag = A + (size_t)(m0 + lrow) * lda + kc * 8;
  const bf16_t* bg = B + (size_t)(n0 + lrow) * ldb + kc * 8;
  const int lds_w = lrow * 64 + ((kc ^ ((lrow >> 2) & 3)) << 4);
  uint4 pa0, pa1, pa2, pa3, pb0, pb1;
  bf16x8 fa0, fa1, fa2, fa3, fa4, fa5, fb0, fb1, fb2, fb3, fb4, fb5;
#define G_LOAD(X, ko_)                                                                                   \
  X##a0 = *(const uint4*)(ag + (ko_)); X##a1 = *(const uint4*)(ag + (size_t)64 * lda + (ko_));           \
  X##a2 = *(const uint4*)(ag + (size_t)128 * lda + (ko_)); X##a3 = *(const uint4*)(ag + (size_t)192 * lda + (ko_)); \
  X##b0 = *(const uint4*)(bg + (ko_)); X##b1 = *(const uint4*)(bg + (size_t)64 * ldb + (ko_));
#define L_STORE(X, base_)                                                                                \
  *(uint4*)((base_) + lds_w) = X##a0; *(uint4*)((base_) + lds_w + 4096) = X##a1;                         \
  *(uint4*)((base_) + lds_w + 8192) = X##a2; *(uint4*)((base_) + lds_w + 12288) = X##a3;                 \
  *(uint4*)((base_) + 16384 + lds_w) = X##b0; *(uint4*)((base_) + 16384 + lds_w + 4096) = X##b1;         \
  if (SUMSQ) { q0 += sq8(X##a0); q1 += sq8(X##a1); q2 += sq8(X##a2); q3 += sq8(X##a3); }
#define G_READ(F, base_, c_)                                                                             \
  F##0 = *(const bf16x8*)((base_) + a_off + (c_)); F##1 = *(const bf16x8*)((base_) + a_off + 32 * 64 + (c_));              \
  F##2 = *(const bf16x8*)((base_) + a_off + 64 * 64 + (c_)); F##3 = *(const bf16x8*)((base_) + a_off + 96 * 64 + (c_));    \
  F##4 = *(const bf16x8*)((base_) + b_off + (c_)); F##5 = *(const bf16x8*)((base_) + b_off + 32 * 64 + (c_));
#define G_MMA(a0, a1, a2, a3, b0, b1)                                                                    \
    if (SWAP) {                                                                                          \
      acc[0][0] = MFMA32(b0, a0, acc[0][0]); acc[0][1] = MFMA32(b1, a0, acc[0][1]);                      \
      acc[1][0] = MFMA32(b0, a1, acc[1][0]); acc[1][1] = MFMA32(b1, a1, acc[1][1]);                      \
      acc[2][0] = MFMA32(b0, a2, acc[2][0]); acc[2][1] = MFMA32(b1, a2, acc[2][1]);                      \
      acc[3][0] = MFMA32(b0, a3, acc[3][0]); acc[3][1] = MFMA32(b1, a3, acc[3][1]);                      \
    } else {                                                                                             \
      acc[0][0] = MFMA32(a0, b0, acc[0][0]); acc[0][1] = MFMA32(a0, b1, acc[0][1]);                      \
      acc[1][0] = MFMA32(a1, b0, acc[1][0]); acc[1][1] = MFMA32(a1, b1, acc[1][1]);                      \
      acc[2][0] = MFMA32(a2, b0, acc[2][0]); acc[2][1] = MFMA32(a2, b1, acc[2][1]);                      \
      acc[3][0] = MFMA32(a3, b0, acc[3][0]); acc[3][1] = MFMA32(a3, b1, acc[3][1]);                      \
    }
#define G_MMA6(F) G_MMA(F##0, F##1, F##2, F##3, F##4, F##5)
  float q0 = 0.f, q1 = 0.f, q2 = 0.f, q3 = 0.f;
  const int sw = (r >> 2) & 3;
  const int a_off = (wm * 128 + r) * 64, b_off = 16384 + (wn * 64 + r) * 64;
  const int c0 = (h ^ sw) << 4, c1 = ((2 + h) ^ sw) << 4;
  const int nk = K >> 5;
  G_LOAD(p, 0)
  L_STORE(p, smem)
  G_LOAD(p, 32)
  __syncthreads();
  G_READ(fa, smem, c0)
  G_READ(fb, smem, c1)
  G_MMA6(fa)
  asm volatile("" ::: "memory");
  __builtin_amdgcn_sched_barrier(0);
  L_STORE(p, smem + 24576)
  {
    const int kn = ((2 < nk) ? 2 : (nk - 1)) * 32;
    G_LOAD(p, kn)
  }
  __syncthreads();
  for (int kt = 0; kt < nk - 1; kt++) {
    const char* nb = smem + ((kt + 1) & 1) * 24576;
    G_READ(fa, nb, c0)
    G_MMA6(fb)
    G_READ(fb, nb, c1)
    G_MMA6(fa)
    __builtin_amdgcn_sched_group_barrier(0x100, 6, 0);
    __builtin_amdgcn_sched_group_barrier(0x008, 8, 0);
    __builtin_amdgcn_sched_group_barrier(0x100, 6, 0);
    __builtin_amdgcn_sched_group_barrier(0x008, 8, 0);
    asm volatile("" ::: "memory");
    __builtin_amdgcn_sched_barrier(0);
    if (kt + 2 < nk) {
      L_STORE(p, smem + (kt & 1) * 24576)
    }
    {
      const int kn = ((kt + 3 < nk) ? (kt + 3) : (nk - 1)) * 32;
      G_LOAD(p, kn)
    }
    __syncthreads();
  }
  G_MMA6(fb)
#undef G_LOAD
#undef L_STORE
#undef G_READ
#undef G_MMA
#undef G_MMA6
  if (SUMSQ) {
    q0 += __shfl_xor(q0, 1); q1 += __shfl_xor(q1, 1); q2 += __shfl_xor(q2, 1); q3 += __shfl_xor(q3, 1);
    q0 += __shfl_xor(q0, 2); q1 += __shfl_xor(q1, 2); q2 += __shfl_xor(q2, 2); q3 += __shfl_xor(q3, 2);
    if (kc == 0) {
      float* rf = (float*)(smem + 49152);
      const float ik = 1.f / (float)K;
      rf[lrow] = rsqrtf(q0 * ik + 1e-6f); rf[lrow + 64] = rsqrtf(q1 * ik + 1e-6f);
      rf[lrow + 128] = rsqrtf(q2 * ik + 1e-6f); rf[lrow + 192] = rsqrtf(q3 * ik + 1e-6f);
    }
    __syncthreads();
  }
}

#define EPI_LOOP_BEGIN                                                                                           \
  {                                                                                                              \
    const int lane_ = TID & 63, w_ = TID >> 6, wm_ = w_ >> 1, wn_ = w_ & 1, r_ = lane_ & 31, h_ = lane_ >> 5; \
    _Pragma("unroll") for (int mt = 0; mt < 4; mt++) _Pragma("unroll") for (int nt = 0; nt < 2; nt++)          \
        _Pragma("unroll") for (int i = 0; i < 16; i++) {                                                         \
      const float v = acc[mt][nt][i];
#define EPI_COORD_NS const int row = m0 + wm_ * 128 + mt * 32 + crow(i, h_); const int col = n0 + wn_ * 64 + nt * 32 + r_;
#define EPI_COORD_SW const int row = m0 + wm_ * 128 + mt * 32 + r_; const int col = n0 + wn_ * 64 + nt * 32 + crow(i, h_);
#define EPI_LOOP_END }}

DI void phase_gemm_in0(const Params& p, char* smem, int bid, int nblk) {
  char* ws = opaque_ptr(p.ws);
  const bf16_t* A = (const bf16_t*)(ws + OFF_H);
  const bf16_t* B = (const bf16_t*)(ws + OFF_WIN0T);
  bf16_t* QK = (bf16_t*)(ws + OFF_QK0);
  bf16_t* V0T = (bf16_t*)(ws + OFF_V0T);
  bf16_t* G0 = (bf16_t*)(ws + OFF_G0);
  float* GKL = (float*)(ws + OFF_GKLOW);
  for (int tile = bid; tile < 32 * 48; tile += nblk) {
    const int mi = tile & 31, ni = tile >> 5;
    const int m0 = mi * 256, n0 = ni * 128;
    f32x16 acc[4][2];
    if (ni >= 16) {
      if (ni < 32) {
        gemm_main<true>(acc, A, 2048, B, 2048, 2048, m0, n0, smem);
        EPI_LOOP_BEGIN EPI_COORD_SW
          V0T[(size_t)(col - 2048) * S_ + row] = (bf16_t)f2bf(v);
        EPI_LOOP_END
      } else {
        gemm_main<false>(acc, A, 2048, B, 2048, 2048, m0, n0, smem);
        EPI_LOOP_BEGIN EPI_COORD_NS
          G0[(size_t)row * 2048 + (col - 4096)] = (bf16_t)f2bf(silu(v));
        EPI_LOOP_END
      }
    } else {
      gemm_main<false>(acc, A, 2048, B, 2048, 2048, m0, n0, smem);
      EPI_LOOP_BEGIN EPI_COORD_NS
        QK[(size_t)row * 2048 + col] = (bf16_t)f2bf(v);
      EPI_LOOP_END
    }
  }
  {
    typedef __attribute__((ext_vector_type(4))) float f32x4_t;
    const int t = TID, lane = t & 63, w = t >> 6, l15 = lane & 15, quad = lane >> 4;
    float* red = (float*)smem;
    for (int item = bid; item < 512; item += nblk) {
      const bf16_t* ap = A + (size_t)(item * 16 + l15) * 2048 + 512 * w + 8 * quad;
      const bf16_t* bp = B + (size_t)(6144 + l15) * 2048 + 512 * w + 8 * quad;
      f32x4_t c = {0.f, 0.f, 0.f, 0.f};
#pragma unroll
      for (int s = 0; s < 16; s++) {
        const bf16x8 a = *(const bf16x8*)(ap + 32 * s);
        const bf16x8 b = *(const bf16x8*)(bp + 32 * s);
        c = __builtin_amdgcn_mfma_f32_16x16x32_bf16(a, b, c, 0, 0, 0);
      }
      __syncthreads();
#pragma unroll
      for (int j = 0; j < 4; j++) red[(w * 16 + quad * 4 + j) * 16 + l15] = c[j];
      __syncthreads();
      const float v = red[t] + red[256 + t] + red[512 + t] + red[768 + t];
      GKL[(size_t)item * 256 + t] = v;
    }
  }
}

DI void phase_gla_prep(const Params& p, char* smem, int bid, int nblk) {
  char* ws = opaque_ptr(p.ws);
  const int t = TID, lane = t & 63, w = t >> 6, r = lane & 31, h = lane >> 5;
  const bf16_t* QK = (const bf16_t*)(ws + OFF_QK0);
  const float* GKL = (const float*)(ws + OFF_GKLOW);
  bf16_t* QE = (bf16_t*)(ws + OFF_QE);
  bf16_t* KLT = (bf16_t*)(ws + OFF_KLT);
  bf16_t* AM = (bf16_t*)(ws + OFF_AM);
  float* DEC = (float*)(ws + OFF_DECAY);
  if (bid == 0 && t == 0) { ((int*)(ws + OFF_CTR))[0] = 0; ((int*)(ws + OFF_CTR))[1] = 0; }
  char* lq = smem;
  char* lk = smem + 32768;
  for (int tile = bid; tile < 512; tile += nblk) {
    const int n = tile >> 2, head = tile & 3, t0 = n * 64, d = t, col = head * 256 + d;
    __syncthreads();
    ((float4*)(smem + 65536))[t] = ((const float4*)(GKL + (size_t)t0 * 16))[t];
    __syncthreads();
    float w2[16];
#pragma unroll
    for (int j = 0; j < 16; j++) w2[j] = p.w_gk2[j * 1024 + col];
    const float bias = p.b_gk[col];
    float b = 0.f;
    const int dperm = (d & ~15) | ((d & 3) | ((d & 4) << 1) | ((d & 8) >> 1));
    for (int c16 = 0; c16 < 4; c16++) {
      float bj[16], qv[16], kv[16];
#pragma unroll
      for (int j = 0; j < 16; j++) {
        const int c = c16 * 16 + j;
        const float4* gl = (const float4*)(smem + 65536) + c * 4;
        float4 g0 = gl[0], g1 = gl[1], g2 = gl[2], g3 = gl[3];
        float gk = bias + g0.x * w2[0] + g0.y * w2[1] + g0.z * w2[2] + g0.w * w2[3] + g1.x * w2[4] + g1.y * w2[5] + g1.z * w2[6] + g1.w * w2[7]
                 + g2.x * w2[8] + g2.y * w2[9] + g2.z * w2[10] + g2.w * w2[11] + g3.x * w2[12] + g3.y * w2[13] + g3.z * w2[14] + g3.w * w2[15];
        float la = (fminf(gk, 0.f) - __logf(1.f + __expf(-fabsf(gk)))) * (1.f / 16.f);
        b += la;
        bj[j] = b;
        qv[j] = bf2f(QK[(size_t)(t0 + c) * 2048 + col]);
        kv[j] = bf2f(QK[(size_t)(t0 + c) * 2048 + 1024 + col]);
      }
      unsigned klp[8];
#pragma unroll
      for (int j = 0; j < 16; j++) {
        const int c = c16 * 16 + j;
        const float qe = qv[j] * 0.0625f * __expf(bj[j]);
        const float ke = kv[j] * __expf(-bj[j]);
        const unsigned qeb = f2bf(qe), keb = f2bf(ke), klb = keb;
        const int lo = c * 512 + ((((d >> 3) ^ (c & 15))) << 4) + (d & 7) * 2;
        *(unsigned short*)(lq + lo) = (unsigned short)qeb;
        *(unsigned short*)(lk + lo) = (unsigned short)keb;
        QE[(size_t)(t0 + c) * 1024 + head * 256 + dperm] = (bf16_t)qeb;
        if (j & 1) klp[j >> 1] |= klb << 16; else klp[j >> 1] = klb;
      }
      uint4 o0, o1; o0.x = klp[0]; o0.y = klp[1]; o0.z = klp[2]; o0.w = klp[3]; o1.x = klp[4]; o1.y = klp[5]; o1.z = klp[6]; o1.w = klp[7];
      bf16_t* kdst = KLT + (size_t)(head * 256 + d) * S_ + t0 + c16 * 16;
      *(uint4*)kdst = o0; *(uint4*)(kdst + 8) = o1;
    }
    DEC[(size_t)(n * 4 + head) * 256 + d] = __expf(b);
    __syncthreads();
    {
      const int ct = w >> 1, st = w & 1;
      f32x16 acc;
#pragma unroll
      for (int i = 0; i < 16; i++) acc[i] = 0.f;
      if (!(ct == 0 && st == 1)) {
        const int ra = ct * 32 + r, rb = st * 32 + r;
#pragma unroll
        for (int s = 0; s < 16; s++) {
          bf16x8 a = *(const bf16x8*)(lq + ra * 512 + (((2 * s + h) ^ (ra & 15)) << 4));
          bf16x8 bb = *(const bf16x8*)(lk + rb * 512 + (((2 * s + h) ^ (rb & 15)) << 4));
          acc = MFMA32(a, bb, acc);
        }
      }
      bf16_t* ap = AM + (size_t)(n * 4 + head) * 4096;
#pragma unroll
      for (int i = 0; i < 16; i++) {
        const int c = ct * 32 + crow(i, h), s = st * 32 + r;
        ap[c * 64 + s] = (bf16_t)f2bf(s <= c ? acc[i] : 0.f);
      }
    }
    __syncthreads();
  }
}

constexpr int SCAN_NG = 8, SCAN_GC = 16;
DI void phase_gla_local(const Params& p, char* smem, int bid, int nblk) {
  char* ws = opaque_ptr(p.ws);
  const int t = TID, lane = t & 63, w = t >> 6, r = lane & 31, h = lane >> 5;
  for (int item = bid; item < 64 * (SCAN_NG - 1); item += nblk) {
    const int grp = item >> 6, head = (item >> 4) & 3, dvt = item & 15, dv0 = dvt * 32;
    const int nb = grp * SCAN_GC;
    const bf16_t* v_p = (const bf16_t*)(ws + OFF_V0T) + (size_t)(head * 512 + dv0 + r) * S_ + nb * 64 + 8 * h;
    const bf16_t* kl_p = (const bf16_t*)(ws + OFF_KLT) + (size_t)(head * 256 + 64 * w + r) * S_ + nb * 64 + 8 * h;
    const float* dec_p = (const float*)(ws + OFF_DECAY) + (size_t)nb * 1024 + head * 256 + 64 * w + 4 * h;
    f32x16 St[2];
#pragma unroll
    for (int i = 0; i < 16; i++) { St[0][i] = 0.f; St[1][i] = 0.f; }
    bf16x8 klA[2][4], vfA[4], klB[2][4], vfB[4];
    float4 dcA[2][4], dcB[2][4];
#define LOC_LOAD(KL, VF, DC, n_)                                                                                 \
    {                                                                                                            \
      _Pragma("unroll") for (int s = 0; s < 4; s++) VF[s] = *(const bf16x8*)(v_p + (n_) * 64 + 16 * s);        \
      _Pragma("unroll") for (int dt = 0; dt < 2; dt++) {                                                         \
        _Pragma("unroll") for (int s = 0; s < 4; s++) KL[dt][s] = *(const bf16x8*)(kl_p + (size_t)dt * 32 * S_ + (n_) * 64 + 16 * s); \
        _Pragma("unroll") for (int g4 = 0; g4 < 4; g4++) DC[dt][g4] = *(const float4*)(dec_p + (size_t)(n_) * 1024 + dt * 32 + 8 * g4); \
      }                                                                                                          \
    }
#define LOC_STEP(KL, VF, DC)                                                                                     \
    {                                                                                                            \
      _Pragma("unroll") for (int dt = 0; dt < 2; dt++) {                                                         \
        _Pragma("unroll") for (int s = 0; s < 4; s++) St[dt] = MFMA32(KL[dt][s], VF[s], St[dt]);                 \
        _Pragma("unroll") for (int g4 = 0; g4 < 4; g4++) {                                                       \
          St[dt][4 * g4 + 0] *= DC[dt][g4].x; St[dt][4 * g4 + 1] *= DC[dt][g4].y;                                \
          St[dt][4 * g4 + 2] *= DC[dt][g4].z; St[dt][4 * g4 + 3] *= DC[dt][g4].w;                                \
        }                                                                                                        \
      }                                                                                                          \
    }
    LOC_LOAD(klA, vfA, dcA, 0)
    for (int n = 0; n < SCAN_GC; n += 2) {
      LOC_LOAD(klB, vfB, dcB, n + 1)
      LOC_STEP(klA, vfA, dcA)
      if (n + 2 < SCAN_GC) LOC_LOAD(klA, vfA, dcA, n + 2)
      LOC_STEP(klB, vfB, dcB)
    }
#undef LOC_LOAD
#undef LOC_STEP
    float* sl = (float*)(ws + OFF_SL) + ((size_t)((grp * 4 + head) * 16 + dvt) * 4 + w) * 2048 + lane;
#pragma unroll
    for (int dt = 0; dt < 2; dt++)
#pragma unroll
      for (int i = 0; i < 16; i++) sl[(dt * 16 + i) * 64] = St[dt][i];
    if (dvt == 0) {
      const float* dg = (const float*)(ws + OFF_DECAY) + (size_t)nb * 1024 + head * 256 + t;
      float pr = 1.f;
#pragma unroll 4
      for (int n = 0; n < SCAN_GC; n++) pr *= dg[(size_t)n * 1024];
      ((float*)(ws + OFF_DC))[(grp * 4 + head) * 256 + t] = pr;
    }
  }
}

DI void phase_gla_scan(const Params& p, char* smem, int bid, int nblk) {
  char* ws = opaque_ptr(p.ws);
  const int t = TID, lane = t & 63, w = t >> 6, r = lane & 31, h = lane >> 5;
  float* lo = (float*)smem;
  for (int item = bid; item < 64 * SCAN_NG; item += nblk) {
    const int grp = item >> 6, head = (item >> 4) & 3, dvt = item & 15, dv0 = dvt * 32;
    const int nb = grp * SCAN_GC, ne = nb + SCAN_GC;
    const bf16_t* qe_p = (const bf16_t*)(ws + OFF_QE) + (size_t)r * 1024 + head * 256 + 64 * w + 8 * h;
    const bf16_t* a_p = (const bf16_t*)(ws + OFF_AM) + (size_t)head * 4096 + (size_t)r * 64 + 16 * w + 8 * h;
    const bf16_t* v_p = (const bf16_t*)(ws + OFF_V0T) + (size_t)(head * 512 + dv0 + r) * S_ + 8 * h;
    const bf16_t* kl_p = (const bf16_t*)(ws + OFF_KLT) + (size_t)(head * 256 + 64 * w + r) * S_ + 8 * h;
    bf16_t* o_p = (bf16_t*)(ws + OFF_QK0) + (size_t)(t >> 2) * 2048 + head * 512 + dv0 + (t & 3) * 8;
    f32x16 St[2];
#pragma unroll
    for (int i = 0; i < 16; i++) { St[0][i] = 0.f; St[1][i] = 0.f; }
    for (int j = 0; j < grp; j++) {
      const float* slj = (const float*)(ws + OFF_SL) + ((size_t)((j * 4 + head) * 16 + dvt) * 4 + w) * 2048 + lane;
      const float* dcj = (const float*)(ws + OFF_DC) + (j * 4 + head) * 256 + 64 * w + 4 * h;
#pragma unroll
      for (int dt = 0; dt < 2; dt++)
#pragma unroll
        for (int g4 = 0; g4 < 4; g4++) {
          const float4 dv = *(const float4*)(dcj + 32 * dt + 8 * g4);
          St[dt][4 * g4 + 0] = St[dt][4 * g4 + 0] * dv.x + slj[(dt * 16 + 4 * g4 + 0) * 64];
          St[dt][4 * g4 + 1] = St[dt][4 * g4 + 1] * dv.y + slj[(dt * 16 + 4 * g4 + 1) * 64];
          St[dt][4 * g4 + 2] = St[dt][4 * g4 + 2] * dv.z + slj[(dt * 16 + 4 * g4 + 2) * 64];
          St[dt][4 * g4 + 3] = St[dt][4 * g4 + 3] * dv.w + slj[(dt * 16 + 4 * g4 + 3) * 64];
        }
    }
    qe_p += (size_t)nb * 64 * 1024; a_p += (size_t)nb * 4 * 4096; v_p += nb * 64; kl_p += nb * 64; o_p += (size_t)nb * 64 * 2048;
    bf16x8 qe[2][4], af[2], vf[4], kl[2][4];
    float* ldec = (float*)(smem + 32768);
    const float* dec_g = (const float*)(ws + OFF_DECAY) + (size_t)nb * 1024 + head * 256 + t;
#pragma unroll
    for (int ct = 0; ct < 2; ct++) {
#pragma unroll
      for (int s = 0; s < 4; s++) qe[ct][s] = *(const bf16x8*)(qe_p + (size_t)ct * 32 * 1024 + 16 * s);
      af[ct] = *(const bf16x8*)(a_p + ct * 32 * 64);
    }
#pragma unroll
    for (int s = 0; s < 4; s++) vf[s] = *(const bf16x8*)(v_p + 16 * s);
#pragma unroll
    for (int dt = 0; dt < 2; dt++) {
#pragma unroll
      for (int s = 0; s < 4; s++) kl[dt][s] = *(const bf16x8*)(kl_p + (size_t)dt * 32 * S_ + 16 * s);
    }
    __syncthreads();
    ldec[t] = dec_g[0];
    __syncthreads();
    for (int n = 0; n < SCAN_GC; n++) {
      const bool more = (n + 1 < SCAN_GC);
      float decn = 0.f;
      if (more) decn = dec_g[(size_t)(n + 1) * 1024];
      f32x16 o[2];
#pragma unroll
      for (int i = 0; i < 16; i++) { o[0][i] = 0.f; o[1][i] = 0.f; }
#pragma unroll
      for (int s = 0; s < 4; s++) {
        bf16x8 sb = pack8(St[s >> 1], s & 1);
        o[0] = MFMA32(qe[0][s], sb, o[0]);
        o[1] = MFMA32(qe[1][s], sb, o[1]);
      }
      if (more) {
        const bf16_t* q2 = qe_p + (size_t)(n + 1) * 64 * 1024;
#pragma unroll
        for (int ct = 0; ct < 2; ct++)
#pragma unroll
          for (int s = 0; s < 4; s++) qe[ct][s] = *(const bf16x8*)(q2 + (size_t)ct * 32 * 1024 + 16 * s);
      }
      {
        bf16x8 vw = (w == 0) ? vf[0] : (w == 1) ? vf[1] : (w == 2) ? vf[2] : vf[3];
        o[0] = MFMA32(af[0], vw, o[0]);
        o[1] = MFMA32(af[1], vw, o[1]);
      }
      if (more) {
        const bf16_t* a2 = a_p + (size_t)(n + 1) * 4 * 4096;
        af[0] = *(const bf16x8*)(a2); af[1] = *(const bf16x8*)(a2 + 32 * 64);
      }
#pragma unroll
      for (int dt = 0; dt < 2; dt++) {
#pragma unroll
        for (int s = 0; s < 4; s++) St[dt] = MFMA32(kl[dt][s], vf[s], St[dt]);
#pragma unroll
        for (int g = 0; g < 4; g++) {
          const float4 dv = *(const float4*)(ldec + (n & 1) * 256 + 64 * w + 32 * dt + 8 * g + 4 * h);
          St[dt][4 * g + 0] *= dv.x; St[dt][4 * g + 1] *= dv.y;
          St[dt][4 * g + 2] *= dv.z; St[dt][4 * g + 3] *= dv.w;
        }
      }
      if (more) {
        const int tn = (n + 1) * 64;
#pragma unroll
        for (int s = 0; s < 4; s++) vf[s] = *(const bf16x8*)(v_p + tn + 16 * s);
#pragma unroll
        for (int dt = 0; dt < 2; dt++) {
#pragma unroll
          for (int s = 0; s < 4; s++) kl[dt][s] = *(const bf16x8*)(kl_p + (size_t)dt * 32 * S_ + tn + 16 * s);
        }
      }
      ldec[((n + 1) & 1) * 256 + t] = decn;
#pragma unroll
      for (int ct = 0; ct < 2; ct++)
#pragma unroll
        for (int i = 0; i < 16; i++) lo[(w * 64 + ct * 32 + crow(i, h)) * 32 + r] = o[ct][i];
      __syncthreads();
      {
        const int c = t >> 2, vg = (t & 3) * 8;
        float4 s0 = *(const float4*)(lo + c * 32 + vg), s1 = *(const float4*)(lo + c * 32 + vg + 4);
#pragma unroll
        for (int ww = 1; ww < 4; ww++) {
          float4 x0 = *(const float4*)(lo + (ww * 64 + c) * 32 + vg), x1 = *(const float4*)(lo + (ww * 64 + c) * 32 + vg + 4);
          s0.x += x0.x; s0.y += x0.y; s0.z += x0.z; s0.w += x0.w; s1.x += x1.x; s1.y += x1.y; s1.z += x1.z; s1.w += x1.w;
        }
        uint4 ov; ov.x = pack2(s0.x, s0.y); ov.y = pack2(s0.z, s0.w); ov.z = pack2(s1.x, s1.y); ov.w = pack2(s1.z, s1.w);
        *(uint4*)(o_p + (size_t)n * 64 * 2048) = ov;
      }
      __syncthreads();
    }
  }
}

DI void phase_og(const Params& p, char* smem, int bid, int nblk) {
  char* ws = opaque_ptr(p.ws);
  const int t = TID, lane = t & 63, w = t >> 6;
  const bf16_t* O0 = (const bf16_t*)(ws + OFF_QK0);
  const bf16_t* G0 = (const bf16_t*)(ws + OFF_G0);
  bf16_t* OG = (bf16_t*)(ws + OFF_H);
  const float4* gp = (const float4*)(p.g_onorm + lane * 8);
  const float4 ga = gp[0], gb = gp[1];
  for (int token = bid; token < S_; token += 4 * nblk) {
    uint4 ov[4], gv[4];
#pragma unroll
    for (int u = 0; u < 4; u++) {
      const int tk = token + u * nblk;
      const size_t off = (size_t)(tk < S_ ? tk : token) * 2048 + w * 512 + lane * 8;
      ov[u] = ld_nt((const uint4*)(O0 + off));
      gv[u] = ld_nt((const uint4*)(G0 + off));
    }
#pragma unroll
    for (int u = 0; u < 4; u++) {
      const int tk = token + u * nblk;
      const size_t off = (size_t)tk * 2048 + w * 512 + lane * 8;
      const float f0 = bflo(ov[u].x), f1 = bfhi(ov[u].x), f2 = bflo(ov[u].y), f3 = bfhi(ov[u].y);
      const float f4 = bflo(ov[u].z), f5 = bfhi(ov[u].z), f6 = bflo(ov[u].w), f7 = bfhi(ov[u].w);
      float ss = f0 * f0 + f1 * f1 + f2 * f2 + f3 * f3 + f4 * f4 + f5 * f5 + f6 * f6 + f7 * f7;
      ss = wave_sum(ss);
      const float rinv = rsqrtf(ss * (1.f / 512.f) + 1e-6f);
      uint4 o;
      o.x = pack2(f0 * rinv * ga.x * bflo(gv[u].x), f1 * rinv * ga.y * bfhi(gv[u].x));
      o.y = pack2(f2 * rinv * ga.z * bflo(gv[u].y), f3 * rinv * ga.w * bfhi(gv[u].y));
      o.z = pack2(f4 * rinv * gb.x * bflo(gv[u].z), f5 * rinv * gb.y * bfhi(gv[u].z));
      o.w = pack2(f6 * rinv * gb.z * bflo(gv[u].w), f7 * rinv * gb.w * bfhi(gv[u].w));
      if (tk < S_) *(uint4*)(OG + off) = o;
    }
  }
}

DI void phase_gemm_out(const Params& p, char* smem, int bid, int nblk, size_t off_w) {
  char* ws = opaque_ptr(p.ws);
  const bf16_t* A = (const bf16_t*)(ws + OFF_H);
  const bf16_t* B = (const bf16_t*)(ws + off_w);
  bf16_t* Y = (bf16_t*)(ws + OFF_Y);
  for (int tile = bid; tile < 32 * 16; tile += nblk) {
    const int mi = tile & 31, ni = tile >> 5;
    const int m0 = mi * 256, n0 = ni * 128;
    f32x16 acc[4][2];
    gemm_main<false>(acc, A, 2048, B, 2048, 2048, m0, n0, smem);
    EPI_LOOP_BEGIN EPI_COORD_NS
      Y[(size_t)row * 2048 + col] = (bf16_t)f2bf(v);
    EPI_LOOP_END
  }
}

DI void phase_post0(const Params& p, char* smem, int bid, int nblk) {
  char* ws = opaque_ptr(p.ws);
  const int t = TID, lane = t & 63, w = t >> 6;
  const bf16_t* Y = (const bf16_t*)(ws + OFF_Y);
  const float4* gpo = (const float4*)p.l0_post + lane;
  const float4* gpr = (const float4*)p.l1_pre + lane;
  for (int row0 = bid * 4 + w; row0 < S_; row0 += nblk * 8) {
    const int row1r = row0 + nblk * 4;
    const bool has1 = row1r < S_;
    const int row1 = has1 ? row1r : row0;
    const uint2* yr0 = (const uint2*)(Y + (size_t)row0 * 2048) + lane;
    const uint2* yr1 = (const uint2*)(Y + (size_t)row1 * 2048) + lane;
    const float4* xr0 = (const float4*)(p.x + (size_t)row0 * 2048) + lane;
    const float4* xr1 = (const float4*)(p.x + (size_t)row1 * 2048) + lane;
    uint2 ya[8], yb[8];
    float4 xa[8], xb[8];
#pragma unroll
    for (int j = 0; j < 8; j++) { ya[j] = ld_nt(yr0 + j * 64); xa[j] = ld_nt(xr0 + j * 64); yb[j] = ld_nt(yr1 + j * 64); xb[j] = ld_nt(xr1 + j * 64); }
    float sa = 0.f, sb = 0.f;
#pragma unroll
    for (int j = 0; j < 8; j++) {
      sa += bflo(ya[j].x) * bflo(ya[j].x) + bfhi(ya[j].x) * bfhi(ya[j].x) + bflo(ya[j].y) * bflo(ya[j].y) + bfhi(ya[j].y) * bfhi(ya[j].y);
      sb += bflo(yb[j].x) * bflo(yb[j].x) + bfhi(yb[j].x) * bfhi(yb[j].x) + bflo(yb[j].y) * bflo(yb[j].y) + bfhi(yb[j].y) * bfhi(yb[j].y);
    }
    sa = wave_sum(sa); sb = wave_sum(sb);
    const float ra = rsqrtf(sa * (1.f / 2048.f) + 1e-6f), rb = rsqrtf(sb * (1.f / 2048.f) + 1e-6f);
    float4* out0 = (float4*)(p.out + (size_t)row0 * 2048) + lane;
    float4* out1 = (float4*)(p.out + (size_t)row1 * 2048) + lane;
    float s2a = 0.f, s2b = 0.f;
#pragma unroll
    for (int j = 0; j < 8; j++) {
      const float4 g = gpo[j * 64];
      xa[j].x += bflo(ya[j].x) * ra * g.x; xa[j].y += bfhi(ya[j].x) * ra * g.y; xa[j].z += bflo(ya[j].y) * ra * g.z; xa[j].w += bfhi(ya[j].y) * ra * g.w;
      xb[j].x += bflo(yb[j].x) * rb * g.x; xb[j].y += bfhi(yb[j].x) * rb * g.y; xb[j].z += bflo(yb[j].y) * rb * g.z; xb[j].w += bfhi(yb[j].y) * rb * g.w;
      out0[j * 64] = xa[j];
      if (has1) out1[j * 64] = xb[j];
      s2a += xa[j].x * xa[j].x + xa[j].y * xa[j].y + xa[j].z * xa[j].z + xa[j].w * xa[j].w;
      s2b += xb[j].x * xb[j].x + xb[j].y * xb[j].y + xb[j].z * xb[j].z + xb[j].w * xb[j].w;
    }
    s2a = wave_sum(s2a); s2b = wave_sum(s2b);
    const float r2a = rsqrtf(s2a * (1.f / 2048.f) + 1e-6f), r2b = rsqrtf(s2b * (1.f / 2048.f) + 1e-6f);
    uint2* h0 = (uint2*)(ws + OFF_H + (size_t)row0 * 4096) + lane;
    uint2* h1 = (uint2*)(ws + OFF_H + (size_t)row1 * 4096) + lane;
#pragma unroll
    for (int j = 0; j < 8; j++) {
      const float4 g = gpr[j * 64];
      uint2 o; o.x = pack2(xa[j].x * r2a * g.x, xa[j].y * r2a * g.y); o.y = pack2(xa[j].z * r2a * g.z, xa[j].w * r2a * g.w);
      h0[j * 64] = o;
      if (has1) { uint2 q; q.x = pack2(xb[j].x * r2b * g.x, xb[j].y * r2b * g.y); q.y = pack2(xb[j].z * r2b * g.z, xb[j].w * r2b * g.w); h1[j * 64] = q; }
    }
  }
}

DI void phase_gemm_in1(const Params& p, char* smem, int bid, int nblk) {
  char* ws = opaque_ptr(p.ws);
  const bf16_t* A = (const bf16_t*)(ws + OFF_H);
  const bf16_t* B = (const bf16_t*)(ws + OFF_WIN1T);
  bf16_t* CQ = (bf16_t*)(ws + OFF_CQ);
  bf16_t* CKV = (bf16_t*)(ws + OFF_CKV);
  bf16_t* KR = (bf16_t*)(ws + OFF_KR);
  const float* cs = (const float*)(ws + OFF_CS);
  bf16_t* G1 = (bf16_t*)(ws + OFF_QK0);
  for (int tile = bid; tile < 32 * 25; tile += nblk) {
    const int mi = tile & 31, ni = tile >> 5;
    const int m0 = mi * 256, n0 = ni * 128;
    f32x16 acc[4][2];
    gemm_main<false>(acc, A, 2048, B, 2048, 2048, m0, n0, smem);
    if (ni < 4) {
      EPI_LOOP_BEGIN EPI_COORD_NS
        CQ[(size_t)row * 512 + col] = (bf16_t)f2bf(v);
      EPI_LOOP_END
    } else if (ni < 8) {
      EPI_LOOP_BEGIN EPI_COORD_NS
        CKV[(size_t)row * 512 + (col - 512)] = (bf16_t)f2bf(v);
      EPI_LOOP_END
    } else if (ni == 8 && ((TID >> 6) & 1) == 0) {
      const int lane_ = TID & 63, w_ = TID >> 6, wm_ = w_ >> 1, r_ = lane_ & 31, h_ = lane_ >> 5;
#pragma unroll
      for (int mt = 0; mt < 4; mt++)
#pragma unroll
        for (int i = 0; i < 16; i++) {
          const int row = m0 + wm_ * 128 + mt * 32 + crow(i, h_);
          const float t1 = acc[mt][0][i], t2 = acc[mt][1][i];
          const float c = cs[row * 64 + r_], sn = cs[row * 64 + 32 + r_];
          KR[(size_t)row * 64 + r_] = (bf16_t)f2bf(t1 * c - t2 * sn);
          KR[(size_t)row * 64 + 32 + r_] = (bf16_t)f2bf(t2 * c + t1 * sn);
        }
    } else {
      EPI_LOOP_BEGIN EPI_COORD_NS
        if (col < 3136) G1[(size_t)row * 2048 + (col - 1088)] = (bf16_t)f2bf(silu(v));
      EPI_LOOP_END
    }
  }
}

DI void phase_gemm_qkv(const Params& p, char* smem, int bid, int nblk) {
  char* ws = opaque_ptr(p.ws);
  const bf16_t* CQ = (const bf16_t*)(ws + OFF_CQ);
  const bf16_t* CKV = (const bf16_t*)(ws + OFF_CKV);
  const bf16_t* WQ = (const bf16_t*)(ws + OFF_WQBT);
  const bf16_t* WKV = (const bf16_t*)(ws + OFF_WKVBT);
  const float* cs = (const float*)(ws + OFF_CS);
  bf16_t* Q = (bf16_t*)(ws + OFF_Q);
  bf16_t* KN = (bf16_t*)(ws + OFF_KN);
  bf16_t* VT = (bf16_t*)(ws + OFF_VT);
  const float qscale = 0.07216878364870322f * 1.4426950408889634f;
  const int ntq = 32 * 24, ntkv = 32 * 32;
  for (int tile = bid; tile < ntq + ntkv; tile += nblk) {
    f32x16 acc[4][2];
    if (tile < ntq) {
      const int mi = tile & 31, ni = tile >> 5;
      const int m0 = mi * 256, n0 = ni * 128;
      gemm_main<false, true>(acc, CQ, 512, WQ, 512, 512, m0, n0, smem);
      const float* rf = (const float*)(smem + 49152);
      const int lane_ = TID & 63, w_ = TID >> 6, wm_ = w_ >> 1, wn_ = w_ & 1, r_ = lane_ & 31, h_ = lane_ >> 5;
      const int cb = n0 + wn_ * 64;
      const int head = cb / 192, jb = cb - head * 192;
      if (jb == 128) {
#pragma unroll
        for (int mt = 0; mt < 4; mt++)
#pragma unroll
          for (int i = 0; i < 16; i++) {
            const int row = m0 + wm_ * 128 + mt * 32 + crow(i, h_);
            const float sc = rf[row - m0] * qscale;
            const float t1 = acc[mt][0][i] * sc, t2 = acc[mt][1][i] * sc;
            const float c = cs[row * 64 + r_], s = cs[row * 64 + 32 + r_];
            bf16_t* qp = Q + ((size_t)head * S_ + row) * 192 + 128;
            qp[r_] = (bf16_t)f2bf(t1 * c - t2 * s);
            qp[32 + r_] = (bf16_t)f2bf(t2 * c + t1 * s);
          }
      } else {
#pragma unroll
        for (int mt = 0; mt < 4; mt++)
#pragma unroll
          for (int nt = 0; nt < 2; nt++)
#pragma unroll
            for (int i = 0; i < 16; i++) {
              const int row = m0 + wm_ * 128 + mt * 32 + crow(i, h_);
              const float sc = rf[row - m0] * qscale;
              Q[((size_t)head * S_ + row) * 192 + jb + nt * 32 + r_] = (bf16_t)f2bf(acc[mt][nt][i] * sc);
            }
      }
    } else {
      const int tl = tile - ntq;
      const int mi = tl & 31, ni = tl >> 5;
      const int m0 = mi * 256, n0 = ni * 128;
      const int head = ni >> 1;
      if (ni & 1) {
        gemm_main<true, true>(acc, CKV, 512, WKV, 512, 512, m0, n0, smem);
        const float* rf = (const float*)(smem + 49152);
        EPI_LOOP_BEGIN EPI_COORD_SW
          const int j = col - head * 256 - 128;
          VT[((size_t)head * 128 + j) * S_ + row] = (bf16_t)f2bf(v * rf[row - m0]);
        EPI_LOOP_END
      } else {
        gemm_main<false, true>(acc, CKV, 512, WKV, 512, 512, m0, n0, smem);
        const float* rf = (const float*)(smem + 49152);
        EPI_LOOP_BEGIN EPI_COORD_NS
          const int j = col - head * 256;
          KN[((size_t)head * S_ + row) * 128 + j] = (bf16_t)f2bf(v * rf[row - m0]);
        EPI_LOOP_END
      }
    }
  }
}

DI void phase_attn(const Params& p, char* smem, int bid, int nblk, int rep) {
  char* ws = opaque_ptr(p.ws);
  const int t = TID, lane = t & 63, w = t >> 6, r = lane & 31, h = lane >> 5;
  const bf16_t* Q = (const bf16_t*)(ws + OFF_Q);
  const bf16_t* KN = (const bf16_t*)(ws + OFF_KN);
  const bf16_t* KR = (const bf16_t*)(ws + OFF_KR);
  const bf16_t* VT = (const bf16_t*)(ws + OFF_VT);
  const bf16_t* G1 = (const bf16_t*)(ws + OFF_QK0);
  bf16_t* OG = (bf16_t*)(ws + OFF_H);
  int* ctr = (int*)(ws + OFF_CTR) + rep;
  char* lk = smem;
  char* lv = smem + 25600;
  int* s_item = (int*)(smem + 44032);
  const int k_row = t >> 2, k_c0 = t & 3;
  const int v_row0 = t >> 3, v_kc = t & 7;
  for (;;) {
    __syncthreads();
    if (t == 0) *s_item = atomicAdd(ctr, 1);
    __syncthreads();
    const int item = *s_item;
    if (item >= 1024) break;
    const int qb = 63 - (item >> 4), head = item & 15;
    const int q0w = qb * 128 + w * 32;
    const int ntile = 2 * qb + 2;
    bf16x8 qf[12];
    {
      const bf16_t* qp = Q + ((size_t)head * S_ + q0w + r) * 192 + 8 * h;
#pragma unroll
      for (int s = 0; s < 12; s++) qf[s] = *(const bf16x8*)(qp + 16 * s);
    }
    f32x16 oacc[4];
#pragma unroll
    for (int vt = 0; vt < 4; vt++)
#pragma unroll
      for (int i = 0; i < 16; i++) oacc[vt][i] = 0.f;
    float m_run = -INFINITY, l_run = 0.f;
    uint4 kg0, kg1, kg2, kg3, kg4, kg5, vg0, vg1, vg2, vg3;
    const bf16_t* knp = KN + (size_t)head * S_ * 128;
    const bf16_t* vtp = VT + ((size_t)head * 128 + v_row0) * S_ + v_kc * 8;
#define ATT_LOAD(k0_)                                                                                         \
    {                                                                                                         \
      const bf16_t* kn_ = knp + (size_t)((k0_) + k_row) * 128 + k_c0 * 8;                                     \
      const bf16_t* kr_ = KR + (size_t)((k0_) + k_row) * 64 + k_c0 * 8;                                       \
      const bf16_t* vp_ = vtp + (k0_);                                                                        \
      kg0 = *(const uint4*)(kn_); kg1 = *(const uint4*)(kn_ + 32); kg2 = *(const uint4*)(kn_ + 64); kg3 = *(const uint4*)(kn_ + 96); \
      kg4 = *(const uint4*)(kr_); kg5 = *(const uint4*)(kr_ + 32);                                            \
      vg0 = *(const uint4*)(vp_); vg1 = *(const uint4*)(vp_ + (size_t)32 * S_);                               \
      vg2 = *(const uint4*)(vp_ + (size_t)64 * S_); vg3 = *(const uint4*)(vp_ + (size_t)96 * S_);             \
    }
    ATT_LOAD(0)
    for (int kt = 0; kt < ntile; kt++) {
      const int k0 = kt * 64;
      __syncthreads();
      {
        char* kd = lk + k_row * 400 + k_c0 * 16;
        *(uint4*)(kd) = kg0; *(uint4*)(kd + 64) = kg1; *(uint4*)(kd + 128) = kg2; *(uint4*)(kd + 192) = kg3;
        *(uint4*)(kd + 256) = kg4; *(uint4*)(kd + 320) = kg5;
        char* vd = lv + v_row0 * 144 + (v_kc >> 1) * 32 + (v_kc & 1) * 8;
#define VST(o_, v_) { uint2 u0, u1; u0.x = v_.x; u0.y = v_.y; u1.x = v_.z; u1.y = v_.w; *(uint2*)(vd + (o_)) = u0; *(uint2*)(vd + (o_) + 16) = u1; }
        VST(0, vg0) VST(32 * 144, vg1) VST(64 * 144, vg2) VST(96 * 144, vg3)
#undef VST
      }
      __syncthreads();
      { const int knext = (kt + 1 < ntile) ? k0 + 64 : k0; ATT_LOAD(knext) }
      if (k0 <= q0w + 31) {
        f32x16 sc[2];
#pragma unroll
        for (int i = 0; i < 16; i++) { sc[0][i] = 0.f; sc[1][i] = 0.f; }
        __builtin_amdgcn_s_setprio(1);
#pragma unroll
        for (int s = 0; s < 12; s++) {
          bf16x8 a0 = *(const bf16x8*)(lk + r * 400 + h * 16 + s * 32);
          bf16x8 a1 = *(const bf16x8*)(lk + r * 400 + h * 16 + 32 * 400 + s * 32);
          sc[0] = MFMA32(a0, qf[s], sc[0]);
          sc[1] = MFMA32(a1, qf[s], sc[1]);
        }
        __builtin_amdgcn_s_setprio(0);
        if (k0 + 63 > q0w) {
          const int qg = q0w + r;
#pragma unroll
          for (int mt = 0; mt < 2; mt++)
#pragma unroll
            for (int i = 0; i < 16; i++) {
              const int key = k0 + mt * 32 + crow(i, h);
              if (key > qg) sc[mt][i] = -INFINITY;
            }
        }
        float mx = sc[0][0];
#pragma unroll
        for (int i = 1; i < 16; i++) mx = fmaxf(mx, sc[0][i]);
#pragma unroll
        for (int i = 0; i < 16; i++) mx = fmaxf(mx, sc[1][i]);
        mx = fmaxf(mx, __shfl_xor(mx, 32));
        const float m_new = (mx > m_run + 8.f) ? mx : m_run;
        const bool resc = __any(m_new != m_run);
        const float alpha = __builtin_amdgcn_exp2f(m_run - m_new);
        m_run = m_new;
        float ls = 0.f;
#pragma unroll
        for (int mt = 0; mt < 2; mt++)
#pragma unroll
          for (int i = 0; i < 16; i++) { const float pv = __builtin_amdgcn_exp2f(sc[mt][i] - m_new); sc[mt][i] = pv; ls += pv; }
        l_run = l_run * alpha + ls;
        if (resc) {
#pragma unroll
          for (int vt = 0; vt < 4; vt++)
#pragma unroll
            for (int i = 0; i < 16; i++) oacc[vt][i] *= alpha;
        }
        __builtin_amdgcn_s_setprio(1);
#pragma unroll
        for (int s = 0; s < 4; s++) {
          const bf16x8 pb = pack8(sc[s >> 1], s & 1);
#pragma unroll
          for (int vt = 0; vt < 4; vt++) {
            const bf16x8 a = *(const bf16x8*)(lv + r * 144 + h * 16 + vt * 32 * 144 + s * 32);
            oacc[vt] = MFMA32(a, pb, oacc[vt]);
          }
        }
        __builtin_amdgcn_s_setprio(0);
      }
    }
#undef ATT_LOAD
    const float l_tot = l_run + __shfl_xor(l_run, 32);
    const float inv = 1.f / l_tot;
    const size_t obase = (size_t)(q0w + r) * 2048 + head * 128;
#pragma unroll
    for (int vt = 0; vt < 4; vt++)
#pragma unroll
      for (int g = 0; g < 4; g++) {
        const int v = vt * 32 + 8 * g + 4 * h;
        uint2 gg = *(const uint2*)(G1 + obase + v);
        uint2 o;
        o.x = pack2(oacc[vt][4 * g + 0] * inv * bflo(gg.x), oacc[vt][4 * g + 1] * inv * bfhi(gg.x));
        o.y = pack2(oacc[vt][4 * g + 2] * inv * bflo(gg.y), oacc[vt][4 * g + 3] * inv * bfhi(gg.y));
        *(uint2*)(OG + obase + v) = o;
      }
  }
}

DI void phase_final(const Params& p, char* smem, int bid, int nblk) {
  char* ws = opaque_ptr(p.ws);
  const int t = TID, lane = t & 63, w = t >> 6;
  const bf16_t* Y = (const bf16_t*)(ws + OFF_Y);
  const float4* gpo = (const float4*)p.l1_post + lane;
  for (int row0 = bid * 4 + w; row0 < S_; row0 += nblk * 8) {
    const int row1r = row0 + nblk * 4;
    const bool has1 = row1r < S_;
    const int row1 = has1 ? row1r : row0;
    const uint2* yr0 = (const uint2*)(Y + (size_t)row0 * 2048) + lane;
    const uint2* yr1 = (const uint2*)(Y + (size_t)row1 * 2048) + lane;
    float4* out0 = (float4*)(p.out + (size_t)row0 * 2048) + lane;
    float4* out1 = (float4*)(p.out + (size_t)row1 * 2048) + lane;
    uint2 ya[8], yb[8];
    float4 xa[8], xb[8];
#pragma unroll
    for (int j = 0; j < 8; j++) { ya[j] = ld_nt(yr0 + j * 64); xa[j] = ld_nt((const float4*)out0 + j * 64); yb[j] = ld_nt(yr1 + j * 64); xb[j] = ld_nt((const float4*)out1 + j * 64); }
    float sa = 0.f, sb = 0.f;
#pragma unroll
    for (int j = 0; j < 8; j++) {
      sa += bflo(ya[j].x) * bflo(ya[j].x) + bfhi(ya[j].x) * bfhi(ya[j].x) + bflo(ya[j].y) * bflo(ya[j].y) + bfhi(ya[j].y) * bfhi(ya[j].y);
      sb += bflo(yb[j].x) * bflo(yb[j].x) + bfhi(yb[j].x) * bfhi(yb[j].x) + bflo(yb[j].y) * bflo(yb[j].y) + bfhi(yb[j].y) * bfhi(yb[j].y);
    }
    sa = wave_sum(sa); sb = wave_sum(sb);
    const float ra = rsqrtf(sa * (1.f / 2048.f) + 1e-6f), rb = rsqrtf(sb * (1.f / 2048.f) + 1e-6f);
#pragma unroll
    for (int j = 0; j < 8; j++) {
      const float4 g = gpo[j * 64];
      float4 o = xa[j];
      o.x += bflo(ya[j].x) * ra * g.x; o.y += bfhi(ya[j].x) * ra * g.y; o.z += bflo(ya[j].y) * ra * g.z; o.w += bfhi(ya[j].y) * ra * g.w;
      st_nt(out0 + j * 64, o);
      if (has1) {
        float4 q = xb[j];
        q.x += bflo(yb[j].x) * rb * g.x; q.y += bfhi(yb[j].x) * rb * g.y; q.z += bflo(yb[j].y) * rb * g.z; q.w += bfhi(yb[j].y) * rb * g.w;
        st_nt(out1 + j * 64, q);
      }
    }
  }
}

constexpr int NPHASE = 13;
constexpr unsigned DUP_MASK = 0u;
DI void run_phase(int ph, const Params& p, char* smem, int bid, int nblk, int rep) {
  switch (ph) {
    case 0: phase_prep(p, smem, bid, nblk); break;
    case 1: phase_gemm_in0(p, smem, bid, nblk); break;
    case 2: phase_gla_prep(p, smem, bid, nblk); break;
    case 3: phase_gla_local(p, smem, bid, nblk); break;
    case 4: phase_gla_scan(p, smem, bid, nblk); break;
    case 5: phase_og(p, smem, bid, nblk); break;
    case 6: phase_gemm_out(p, smem, bid, nblk, OFF_WOUT0T); break;
    case 7: phase_post0(p, smem, bid, nblk); break;
    case 8: phase_gemm_in1(p, smem, bid, nblk); break;
    case 9: phase_gemm_qkv(p, smem, bid, nblk); break;
    case 10: phase_attn(p, smem, bid, nblk, rep); break;
    case 11: phase_gemm_out(p, smem, bid, nblk, OFF_WOUT1T); break;
    case 12: phase_final(p, smem, bid, nblk); break;
  }
}

#define XB_TMO      128
#define XB_XCNT(j)  (256  + 64 * (j))
#define XB_XSUB(j)  (1280 + 64 * (j))
#define XB_XGEN(j)  (2304 + 64 * (j))
#define XB_TOP      3328
#define XB_TOPGEN   3392
#define XCD_BAR_WORDS 3456
#define XB_SPIN_CAP (1u << 20)
#define LAS __attribute__((address_space(3)))
DI unsigned xb_ld(unsigned* p) { return __hip_atomic_load(p, __ATOMIC_RELAXED, __HIP_MEMORY_SCOPE_AGENT); }
DI unsigned xb_add(unsigned* p, unsigned v) { return __hip_atomic_fetch_add(p, v, __ATOMIC_RELAXED, __HIP_MEMORY_SCOPE_AGENT); }
DI unsigned xb_xcc_id() { return (unsigned)__builtin_amdgcn_s_getreg((3 << 11) | 20) & 0xFu; }
#define XB_SPIN(cond, bar) do { unsigned _sp = 0; while (cond) { __builtin_amdgcn_s_sleep(1); \
    if ((++_sp & 255u) == 0u) { if (xb_ld(&(bar)[XB_TMO])) break; if (_sp > XB_SPIN_CAP) { atomicAdd(&(bar)[XB_TMO], 1u); break; } } } } while (0)
struct XcdBarrier { unsigned* bar; unsigned x; volatile LAS unsigned* st; };
DI XcdBarrier xcd_barrier_post(unsigned* bar, volatile LAS unsigned* st) {
  XcdBarrier b; b.bar = bar; b.x = xb_xcc_id(); b.st = st;
  if (threadIdx.x == 0) (void)xb_add(&bar[XB_XCNT(b.x)], 1u);
  return b;
}
DI void xcd_barrier_complete(unsigned* bar, unsigned x, unsigned& nloc, unsigned& nx) {
  const unsigned G = gridDim.x * gridDim.y * gridDim.z;
  unsigned sum, cnt, mine, sp = 0u;
  for (;;) {
    sum = 0u; cnt = 0u; mine = 0u;
#pragma unroll
    for (unsigned j = 0; j < 16; ++j) { const unsigned c = xb_ld(&bar[XB_XCNT(j)]); sum += c; cnt += (c > 0u) ? 1u : 0u; mine = (j == x) ? c : mine; }
    if (sum == G) break;
    __builtin_amdgcn_s_sleep(1);
    if ((++sp & 255u) == 0u) { if (xb_ld(&bar[XB_TMO])) break; if (sp > XB_SPIN_CAP) { atomicAdd(&bar[XB_TMO], 1u); break; } }
  }
  nloc = mine > 0u ? mine : 1u; nx = cnt > 0u ? cnt : 1u;
}
DI void xcd_barrier(const XcdBarrier& b) {
  asm volatile("s_waitcnt vmcnt(0)" ::: "memory");
  __syncthreads();
  if (threadIdx.x == 0) {
    unsigned* bar = b.bar;
    __builtin_amdgcn_s_waitcnt(0);
    unsigned nloc, nx;
    xcd_barrier_complete(bar, b.x, nloc, nx);
    const unsigned old = xb_add(&bar[XB_XSUB(b.x)], 1u);
    const unsigned gen = old / nloc;
    if (old + 1u == (gen + 1u) * nloc) {
      __builtin_amdgcn_fence(__ATOMIC_RELEASE, "agent");
      asm volatile("s_waitcnt vmcnt(0)" ::: "memory");
      const unsigned og = xb_add(&bar[XB_TOP], 1u);
      const unsigned tg = og / nx;
      if (og + 1u == (tg + 1u) * nx) xb_add(&bar[XB_TOPGEN], 1u);
      else XB_SPIN(xb_ld(&bar[XB_TOPGEN]) == tg, bar);
      __builtin_amdgcn_fence(__ATOMIC_ACQUIRE, "agent");
      xb_add(&bar[XB_XGEN(b.x)], 1u);
      asm volatile("s_waitcnt vmcnt(0)" ::: "memory");
    } else {
      XB_SPIN(xb_ld(&bar[XB_XGEN(b.x)]) == gen, bar);
      __builtin_amdgcn_fence(__ATOMIC_ACQUIRE, "agent");
      asm volatile("s_waitcnt vmcnt(0)" ::: "memory");
    }
  }
  __syncthreads();
}

#if MEGA
__global__ void __launch_bounds__(256, 2) mega_kernel(Params p) {
  __shared__ __attribute__((aligned(16))) char smem[69632];
  cg::grid_group grid = cg::this_grid();
  const int bid = blockIdx.x, nblk = gridDim.x;
  (void)xcd_barrier_post((unsigned*)(p.ws + OFF_BAR), (volatile LAS unsigned*)0);
#pragma nounroll
  for (int ph = 0; ph < NPHASE; ph++) {
    int phv = ph;
    asm volatile("" : "+s"(phv));
    run_phase(phv, p, smem, bid, nblk, 0);
    if (p.ws == nullptr) grid.sync();
    { XcdBarrier xb; xb.bar = (unsigned*)(opaque_ptr(p.ws) + OFF_BAR); xb.x = xb_xcc_id(); xb.st = (volatile LAS unsigned*)0; xcd_barrier(xb); }
    if ((DUP_MASK >> ph) & 1u) {
      run_phase(phv, p, smem, bid, nblk, 1);
      { XcdBarrier xb; xb.bar = (unsigned*)(opaque_ptr(p.ws) + OFF_BAR); xb.x = xb_xcc_id(); xb.st = (volatile LAS unsigned*)0; xcd_barrier(xb); }
    }
  }
}
#endif

#if !MEGA
template <int PH>
__global__ void __launch_bounds__(256, 2) phase_kernel_t(Params p) {
  __shared__ __attribute__((aligned(16))) char smem[69632];
  run_phase(PH, p, smem, blockIdx.x, gridDim.x, 0);
}
#endif

extern "C" void kernel_launch(void* const* d_in, const int* in_sizes, int n_in, void* d_out, int out_size, void* d_ws,
                              size_t ws_size, hipStream_t stream) {
  Params p{};
  p.x = (const float*)d_in[0]; p.pos = (const int*)d_in[1]; p.l0_pre = (const float*)d_in[2]; p.w_in0 = (const float*)d_in[3];
  p.w_gk2 = (const float*)d_in[4]; p.b_gk = (const float*)d_in[5]; p.g_onorm = (const float*)d_in[6]; p.w_out0 = (const float*)d_in[7];
  p.l0_post = (const float*)d_in[8]; p.l1_pre = (const float*)d_in[9]; p.w_in1 = (const float*)d_in[10]; p.g_qa = (const float*)d_in[11];
  p.w_qb = (const float*)d_in[12]; p.g_kva = (const float*)d_in[13]; p.w_kvb = (const float*)d_in[14]; p.w_out1 = (const float*)d_in[15];
  p.l1_post = (const float*)d_in[16];
  p.out = (float*)d_out; p.ws = (char*)d_ws;
  for (int i = 0; i < 32; i++) p.invf[i] = (float)pow(10000.0, -(double)i / 32.0);
#if MEGA
  static int grid_blocks = 0;
  if (!grid_blocks) {
    int dev = 0, cus = 0, per_cu = 0;
    hipGetDevice(&dev);
    hipDeviceGetAttribute(&cus, hipDeviceAttributeMultiprocessorCount, dev);
    hipOccupancyMaxActiveBlocksPerMultiprocessor(&per_cu, mega_kernel, 256, 0);
    if (per_cu > 2) per_cu = 2;
    if (per_cu < 1) per_cu = 1;
    grid_blocks = cus * per_cu;
  }
  hipMemsetAsync((char*)d_ws + OFF_BAR, 0, XCD_BAR_WORDS * 4, stream);
  void* args[] = {&p};
  hipError_t e = hipLaunchCooperativeKernel((void*)mega_kernel, dim3(grid_blocks), dim3(256), args, 0, stream);
  if (e != hipSuccess) fprintf(stderr, "cooperative launch failed: %s (grid %d)\n", hipGetErrorString(e), grid_blocks);
#else
#define LPH(N) hipLaunchKernelGGL(phase_kernel_t<N>, dim3(512), dim3(256), 0, stream, p);
  LPH(0) LPH(1) LPH(2) LPH(3) LPH(4) LPH(5) LPH(6) LPH(7) LPH(8) LPH(9) LPH(10) LPH(11) LPH(12)
#undef LPH
#endif
}
```

```cpp
#include <hip/hip_runtime.h>
#include <hip/hip_cooperative_groups.h>
#include <stdint.h>
#include <math.h>
#include <stdio.h>
namespace cg = cooperative_groups;

#ifndef MEGA
#define MEGA 1
#endif

typedef __attribute__((ext_vector_type(8))) short bf16x8;
typedef __attribute__((ext_vector_type(4))) short s16x4;
typedef __attribute__((ext_vector_type(16))) float f32x16;
typedef unsigned short bf16_t;
#define DI __device__ __forceinline__
#define MFMA32(a, b, c) __builtin_amdgcn_mfma_f32_32x32x16_bf16((a), (b), (c), 0, 0, 0)

constexpr int S_ = 8192;
constexpr size_t MiB = (size_t)1 << 20;
constexpr size_t OFF_WIN0T = 0;
constexpr size_t OFF_WOUT0T = 25 * MiB;
constexpr size_t OFF_WIN1T = 33 * MiB;
constexpr size_t OFF_WQBT = 46 * MiB;
constexpr size_t OFF_WKVBT = 49 * MiB;
constexpr size_t OFF_WOUT1T = 53 * MiB;
constexpr size_t OFF_GKLOW = 61 * MiB;
constexpr size_t OFF_DECAY = 61 * MiB + 512 * 1024;
constexpr size_t OFF_CS = 62 * MiB;
constexpr size_t OFF_H = 64 * MiB;
constexpr size_t OFF_QK0 = 96 * MiB;
constexpr size_t OFF_V0T = 128 * MiB;
constexpr size_t OFF_G0 = 160 * MiB;
constexpr size_t OFF_Y = 128 * MiB;
constexpr size_t OFF_QE = 192 * MiB;
constexpr size_t OFF_KLT = 208 * MiB;
constexpr size_t OFF_AM = 224 * MiB;
constexpr size_t OFF_CQ = 0;
constexpr size_t OFF_CKV = 8 * MiB;
constexpr size_t OFF_KR = 16 * MiB;
constexpr size_t OFF_RINVQ = 17 * MiB;
constexpr size_t OFF_RINVKV = 17 * MiB + 64 * 1024;
constexpr size_t OFF_KRRAW = 18 * MiB;
constexpr size_t OFF_CTR = 20 * MiB;
constexpr size_t OFF_BAR = 255 * MiB;
constexpr size_t OFF_SL = 64 * MiB;
constexpr size_t OFF_DC = 80 * MiB;
constexpr size_t OFF_Q = 128 * MiB;
constexpr size_t OFF_KN = 176 * MiB;
constexpr size_t OFF_VT = 208 * MiB;

struct Params {
  const float* x; const int* pos; const float* l0_pre; const float* w_in0; const float* w_gk2; const float* b_gk;
  const float* g_onorm; const float* w_out0; const float* l0_post; const float* l1_pre; const float* w_in1;
  const float* g_qa; const float* w_qb; const float* g_kva; const float* w_kvb; const float* w_out1; const float* l1_post;
  float* out; char* ws;
  float invf[32];
};

DI int tid_opaque() { int t = threadIdx.x; asm volatile("" : "+v"(t)); return t; }
#define TID tid_opaque()
typedef __attribute__((address_space(1))) char gchar_t;
DI char* opaque_ptr(char* q) {
  unsigned long long v = (unsigned long long)q;
  unsigned lo = __builtin_amdgcn_readfirstlane((unsigned)v), hi = __builtin_amdgcn_readfirstlane((unsigned)(v >> 32));
  asm volatile("" : "+s"(lo), "+s"(hi));
  return (char*)(gchar_t*)(((unsigned long long)hi << 32) | lo);
}
typedef __bf16 hbf16x2 __attribute__((ext_vector_type(2)));
typedef float hf32x2 __attribute__((ext_vector_type(2)));
DI unsigned pack2(float a, float b) { hf32x2 f = {a, b}; return __builtin_bit_cast(unsigned, __builtin_convertvector(f, hbf16x2)); }
DI unsigned f2bf(float f) { return (unsigned)__builtin_bit_cast(unsigned short, (__bf16)f); }
DI float bf2f(unsigned h) { return __uint_as_float(h << 16); }
DI float bflo(unsigned u) { return __uint_as_float(u << 16); }
DI float bfhi(unsigned u) { return __uint_as_float(u & 0xffff0000u); }
DI int crow(int i, int h) { return (i & 3) + 8 * (i >> 2) + 4 * h; }
typedef float nt_f4 __attribute__((ext_vector_type(4)));
typedef unsigned nt_u4 __attribute__((ext_vector_type(4)));
typedef unsigned nt_u2 __attribute__((ext_vector_type(2)));
DI float4 ld_nt(const float4* p) { nt_f4 v = __builtin_nontemporal_load((const nt_f4*)p); float4 r; r.x = v.x; r.y = v.y; r.z = v.z; r.w = v.w; return r; }
DI uint4 ld_nt(const uint4* p) { nt_u4 v = __builtin_nontemporal_load((const nt_u4*)p); uint4 r; r.x = v.x; r.y = v.y; r.z = v.z; r.w = v.w; return r; }
DI uint2 ld_nt(const uint2* p) { nt_u2 v = __builtin_nontemporal_load((const nt_u2*)p); uint2 r; r.x = v.x; r.y = v.y; return r; }
DI void st_nt(float4* p, const float4& a) { nt_f4 v = {a.x, a.y, a.z, a.w}; __builtin_nontemporal_store(v, (nt_f4*)p); }
DI float silu(float v) { return v / (1.f + __expf(-v)); }
DI float wave_sum(float v) { for (int o = 32; o > 0; o >>= 1) v += __shfl_xor(v, o); return v; }
DI float block_sum(float v, float* red) {
  v = wave_sum(v);
  __syncthreads();
  if ((TID & 63) == 0) red[TID >> 6] = v;
  __syncthreads();
  return red[0] + red[1] + red[2] + red[3];
}
DI bf16x8 pack8(const f32x16& x, int s) {
  union { unsigned u[4]; bf16x8 v; } p;
  p.u[0] = pack2(x[8 * s + 0], x[8 * s + 1]); p.u[1] = pack2(x[8 * s + 2], x[8 * s + 3]);
  p.u[2] = pack2(x[8 * s + 4], x[8 * s + 5]); p.u[3] = pack2(x[8 * s + 6], x[8 * s + 7]);
  return p.v;
}

DI void transpose_tile4(const float* __restrict__ W, int K, int N, int ntN, const float* __restrict__ gain, bf16_t* __restrict__ WT,
                        int id0, char* smem) {
  const int t = TID;
  float v[4][16];
#pragma unroll
  for (int q = 0; q < 4; q++) {
    const int id = id0 + q, k0 = (id / ntN) * 64, n0 = (id % ntN) * 64;
#pragma unroll
    for (int i = 0; i < 16; i++) {
      const int kk = i * 4 + (t >> 6), n = n0 + (t & 63);
      float x = (n < N) ? __builtin_nontemporal_load(&W[(size_t)(k0 + kk) * N + n]) : 0.f;
      if (gain) x *= gain[k0 + kk];
      v[q][i] = x;
    }
  }
#pragma unroll
  for (int q = 0; q < 4; q++) {
    unsigned short (*tile)[72] = (unsigned short (*)[72])(smem + q * 9216);
#pragma unroll
    for (int i = 0; i < 16; i++) tile[t & 63][i * 4 + (t >> 6)] = (unsigned short)f2bf(v[q][i]);
  }
  __syncthreads();
#pragma unroll
  for (int q = 0; q < 4; q++) {
    unsigned short (*tile)[72] = (unsigned short (*)[72])(smem + q * 9216);
    const int id = id0 + q, k0 = (id / ntN) * 64, n0 = (id % ntN) * 64;
    const int nn = t >> 2, kg = (t & 3) * 16;
    uint4 a = *(const uint4*)&tile[nn][kg];
    uint4 b = *(const uint4*)&tile[nn][kg + 8];
    bf16_t* dst = WT + (size_t)(n0 + nn) * K + k0 + kg;
    *(uint4*)dst = a; *(uint4*)(dst + 8) = b;
  }
  __syncthreads();
}

DI void phase_prep(const Params& p, char* smem, int bid, int nblk) {
  const int t = TID;
  char* ws = opaque_ptr(p.ws);
  for (int task = bid; task < 1920 + 3072; task += nblk) {
    if (task < 1920) {
      const int tile0 = task * 4;
      const float* W; const float* gain = nullptr; bf16_t* WT; int K, N, ntN, id;
      if (tile0 < 3136) { id = tile0; W = p.w_in0; K = 2048; N = 6160; ntN = 98; WT = (bf16_t*)(ws + OFF_WIN0T); }
      else if (tile0 < 4160) { id = tile0 - 3136; W = p.w_out0; K = 2048; N = 2048; ntN = 32; WT = (bf16_t*)(ws + OFF_WOUT0T); }
      else if (tile0 < 5760) { id = tile0 - 4160; W = p.w_in1; K = 2048; N = 3136; ntN = 50; WT = (bf16_t*)(ws + OFF_WIN1T); }
      else if (tile0 < 6144) { id = tile0 - 5760; W = p.w_qb; K = 512; N = 3072; ntN = 48; WT = (bf16_t*)(ws + OFF_WQBT); gain = p.g_qa; }
      else if (tile0 < 6656) { id = tile0 - 6144; W = p.w_kvb; K = 512; N = 4096; ntN = 64; WT = (bf16_t*)(ws + OFF_WKVBT); gain = p.g_kva; }
      else { id = tile0 - 6656; W = p.w_out1; K = 2048; N = 2048; ntN = 32; WT = (bf16_t*)(ws + OFF_WOUT1T); }
      transpose_tile4(W, K, N, ntN, gain, WT, id, smem);
    } else if (task < 1920 + 2048) {
      if (task < 1920 + 1024) {
        const int lane = t & 63, row0 = (task - 1920) * 4 + (t >> 6), row1 = row0 + 4096;
        const float4* xr0 = (const float4*)(p.x + (size_t)row0 * 2048) + lane;
        const float4* xr1 = (const float4*)(p.x + (size_t)row1 * 2048) + lane;
        const float4* gr = (const float4*)p.l0_pre + lane;
        float4 xa[8], xb[8];
#pragma unroll
        for (int j = 0; j < 8; j++) { xa[j] = ld_nt(xr0 + j * 64); xb[j] = ld_nt(xr1 + j * 64); }
        float sa = 0.f, sb = 0.f;
#pragma unroll
        for (int j = 0; j < 8; j++) {
          sa += xa[j].x * xa[j].x + xa[j].y * xa[j].y + xa[j].z * xa[j].z + xa[j].w * xa[j].w;
          sb += xb[j].x * xb[j].x + xb[j].y * xb[j].y + xb[j].z * xb[j].z + xb[j].w * xb[j].w;
        }
        sa = wave_sum(sa); sb = wave_sum(sb);
        const float ra = rsqrtf(sa * (1.f / 2048.f) + 1e-6f), rb = rsqrtf(sb * (1.f / 2048.f) + 1e-6f);
        uint2* h0 = (uint2*)(ws + OFF_H + (size_t)row0 * 4096) + lane;
        uint2* h1 = (uint2*)(ws + OFF_H + (size_t)row1 * 4096) + lane;
#pragma unroll
        for (int j = 0; j < 8; j++) {
          const float4 g = gr[j * 64];
          uint2 o; o.x = pack2(xa[j].x * ra * g.x, xa[j].y * ra * g.y); o.y = pack2(xa[j].z * ra * g.z, xa[j].w * ra * g.w);
          h0[j * 64] = o;
          uint2 q; q.x = pack2(xb[j].x * rb * g.x, xb[j].y * rb * g.y); q.y = pack2(xb[j].z * rb * g.z, xb[j].w * rb * g.w);
          h1[j * 64] = q;
        }
      }
    } else {
      const int idx = (task - 3968) * 256 + t;
      const int token = idx >> 5, i = idx & 31;
      double ang = (double)p.pos[token] * (double)p.invf[i];
      double tt = ang * 0.15915494309189535;
      tt -= floor(tt + 0.5);
      float f = (float)tt;
      float* cs = (float*)(ws + OFF_CS);
      cs[token * 64 + i] = __builtin_amdgcn_cosf(f);
      cs[token * 64 + 32 + i] = __builtin_amdgcn_sinf(f);
    }
  }
}

DI float sq8(const uint4& v) {
  return bflo(v.x) * bflo(v.x) + bfhi(v.x) * bfhi(v.x) + bflo(v.y) * bflo(v.y) + bfhi(v.y) * bfhi(v.y) + bflo(v.z) * bflo(v.z) + bfhi(v.z) * bfhi(v.z) +
         bflo(v.w) * bflo(v.w) + bfhi(v.w) * bfhi(v.w);
}
template <bool SWAP, bool SUMSQ = false>
DI void gemm_main(f32x16 (&acc)[4][2], const bf16_t* A, int lda, const bf16_t* B, int ldb, int K,
                  int m0, int n0, char* smem) {
  const int t = TID, lane = t & 63, w = t >> 6, wm = w >> 1, wn = w & 1, r = lane & 31, h = lane >> 5;
#pragma unroll
  for (int a = 0; a < 4; a++)
#pragma unroll
    for (int b = 0; b < 2; b++)
#pragma unroll
      for (int i = 0; i < 16; i++) acc[a][b][i] = 0.f;
  const int lrow = t >> 2, kc = t & 3;
  const bf16_t* ag = A + (size_t)(m0 + lrow) * lda + kc * 8;
  const bf16_t* bg = B + (size_t)(n0 + lrow) * ldb + kc * 8;
  const int lds_w = lrow * 64 + ((kc ^ ((lrow >> 2) & 3)) << 4);
  uint4 pa0, pa1, pa2, pa3, pb0, pb1;
  bf16x8 fa0, fa1, fa2, fa3, fa4, fa5, fb0, fb1, fb2, fb3, fb4, fb5;
#define G_LOAD(X, ko_)                                                                                   \
  X##a0 = *(const uint4*)(ag + (ko_)); X##a1 = *(const uint4*)(ag + (size_t)64 * lda + (ko_));           \
  X##a2 = *(const uint4*)(ag + (size_t)128 * lda + (ko_)); X##a3 = *(const uint4*)(ag + (size_t)192 * lda + (ko_)); \
  X##b0 = *(const uint4*)(bg + (ko_)); X##b1 = *(const uint4*)(bg + (size_t)64 * ldb + (ko_));
#define L_STORE(X, base_)                                                                                \
  *(uint4*)((base_) + lds_w) = X##a0; *(uint4*)((base_) + lds_w + 4096) = X##a1;                         \
  *(uint4*)((base_) + lds_w + 8192) = X##a2; *(uint4*)((base_) + lds_w + 12288) = X##a3;                 \
  *(uint4*)((base_) + 16384 + lds_w) = X##b0; *(uint4*)((base_) + 16384 + lds_w + 4096) = X##b1;         \
  if (SUMSQ) { q0 += sq8(X##a0); q1 += sq8(X##a1); q2 += sq8(X##a2); q3 += sq8(X##a3); }
#define G_READ(F, base_, c_)                                                                             \
  F##0 = *(const bf16x8*)((base_) + a_off + (c_)); F##1 = *(const bf16x8*)((base_) + a_off + 32 * 64 + (c_));              \
  F##2 = *(const bf16x8*)((base_) + a_off + 64 * 64 + (c_)); F##3 = *(const bf16x8*)((base_) + a_off + 96 * 64 + (c_));    \
  F##4 = *(const bf16x8*)((base_) + b_off + (c_)); F##5 = *(const bf16x8*)((base_) + b_off + 32 * 64 + (c_));
#define G_MMA(a0, a1, a2, a3, b0, b1)                                                                    \
    if (SWAP) {                                                                                          \
      acc[0][0] = MFMA32(b0, a0, acc[0][0]); acc[0][1] = MFMA32(b1, a0, acc[0][1]);                      \
      acc[1][0] = MFMA32(b0, a1, acc[1][0]); acc[1][1] = MFMA32(b1, a1, acc[1][1]);                      \
      acc[2][0] = MFMA32(b0, a2, acc[2][0]); acc[2][1] = MFMA32(b1, a2, acc[2][1]);                      \
      acc[3][0] = MFMA32(b0, a3, acc[3][0]); acc[3][1] = MFMA32(b1, a3, acc[3][1]);                      \
    } else {                                                                                             \
      acc[0][0] = MFMA32(a0, b0, acc[0][0]); acc[0][1] = MFMA32(a0, b1, acc[0][1]);                      \
      acc[1][0] = MFMA32(a1, b0, acc[1][0]); acc[1][1] = MFMA32(a1, b1, acc[1][1]);                      \
      acc[2][0] = MFMA32(a2, b0, acc[2][0]); acc[2][1] = MFMA32(a2, b1, acc[2][1]);                      \
      acc[3][0] = MFMA32(a3, b0, acc[3][0]); acc[3][1] = MFMA32(a3, b1, acc[3][1]);                      \
    }
#define G_MMA6(F) G_MMA(F##0, F##1, F##2, F##3, F##4, F##5)
  float q0 = 0.f, q1 = 0.f, q2 = 0.f, q3 = 0.f;
  const int sw = (r >> 2) & 3;
  const int a_off = (wm * 128 + r) * 64, b_off = 16384 + (wn * 64 + r) * 64;
  const int c0 = (h ^ sw) << 4, c1 = ((2 + h) ^ sw) << 4;
  const int nk = K >> 5;
  G_LOAD(p, 0)
  L_STORE(p, smem)
  G_LOAD(p, 32)
  __syncthreads();
  G_READ(fa, smem, c0)
  G_READ(fb, smem, c1)
  G_MMA6(fa)
  asm volatile("" ::: "memory");
  __builtin_amdgcn_sched_barrier(0);
  L_STORE(p, smem + 24576)
  {
    const int kn = ((2 < nk) ? 2 : (nk - 1)) * 32;
    G_LOAD(p, kn)
  }
  __syncthreads();
  for (int kt = 0; kt < nk - 1; kt++) {
    const char* nb = smem + ((kt + 1) & 1) * 24576;
    G_READ(fa, nb, c0)
    G_MMA6(fb)
    G_READ(fb, nb, c1)
    G_MMA6(fa)
    __builtin_amdgcn_sched_group_barrier(0x100, 6, 0);
    __builtin_amdgcn_sched_group_barrier(0x008, 8, 0);
    __builtin_amdgcn_sched_group_barrier(0x100, 6, 0);
    __builtin_amdgcn_sched_group_barrier(0x008, 8, 0);
    asm volatile("" ::: "memory");
    __builtin_amdgcn_sched_barrier(0);
    if (kt + 2 < nk) {
      L_STORE(p, smem + (kt & 1) * 24576)
    }
    {
      const int kn = ((kt + 3 < nk) ? (kt + 3) : (nk - 1)) * 32;
      G_LOAD(p, kn)
    }
    __syncthreads();
  }
  G_MMA6(fb)
#undef G_LOAD
#undef L_STORE
#undef G_READ
#undef G_MMA
#undef G_MMA6
  if (SUMSQ) {
    q0 += __shfl_xor(q0, 1); q1 += __shfl_xor(q1, 1); q2 += __shfl_xor(q2, 1); q3 += __shfl_xor(q3, 1);
    q0 += __shfl_xor(q0, 2); q1 += __shfl_xor(q1, 2); q2 += __shfl_xor(q2, 2); q3 += __shfl_xor(q3, 2);
    if (kc == 0) {
      float* rf = (float*)(smem + 49152);
      const float ik = 1.f / (float)K;
      rf[lrow] = rsqrtf(q0 * ik + 1e-6f); rf[lrow + 64] = rsqrtf(q1 * ik + 1e-6f);
      rf[lrow + 128] = rsqrtf(q2 * ik + 1e-6f); rf[lrow + 192] = rsqrtf(q3 * ik + 1e-6f);
    }
    __syncthreads();
  }
}

#define EPI_LOOP_BEGIN                                                                                           \
  {                                                                                                              \
    const int lane_ = TID & 63, w_ = TID >> 6, wm_ = w_ >> 1, wn_ = w_ & 1, r_ = lane_ & 31, h_ = lane_ >> 5; \
    _Pragma("unroll") for (int mt = 0; mt < 4; mt++) _Pragma("unroll") for (int nt = 0; nt < 2; nt++)          \
        _Pragma("unroll") for (int i = 0; i < 16; i++) {                                                         \
      const float v = acc[mt][nt][i];
#define EPI_COORD_NS const int row = m0 + wm_ * 128 + mt * 32 + crow(i, h_); const int col = n0 + wn_ * 64 + nt * 32 + r_;
#define EPI_COORD_SW const int row = m0 + wm_ * 128 + mt * 32 + r_; const int col = n0 + wn_ * 64 + nt * 32 + crow(i, h_);
#define EPI_LOOP_END }}

DI void phase_gemm_in0(const Params& p, char* smem, int bid, int nblk) {
  char* ws = opaque_ptr(p.ws);
  const bf16_t* A = (const bf16_t*)(ws + OFF_H);
  const bf16_t* B = (const bf16_t*)(ws + OFF_WIN0T);
  bf16_t* QK = (bf16_t*)(ws + OFF_QK0);
  bf16_t* V0T = (bf16_t*)(ws + OFF_V0T);
  bf16_t* G0 = (bf16_t*)(ws + OFF_G0);
  float* GKL = (float*)(ws + OFF_GKLOW);
  for (int tile = bid; tile < 32 * 48; tile += nblk) {
    const int mi = tile & 31, ni = tile >> 5;
    const int m0 = mi * 256, n0 = ni * 128;
    f32x16 acc[4][2];
    if (ni >= 16) {
      if (ni < 32) {
        gemm_main<true>(acc, A, 2048, B, 2048, 2048, m0, n0, smem);
        EPI_LOOP_BEGIN EPI_COORD_SW
          V0T[(size_t)(col - 2048) * S_ + row] = (bf16_t)f2bf(v);
        EPI_LOOP_END
      } else {
        gemm_main<false>(acc, A, 2048, B, 2048, 2048, m0, n0, smem);
        EPI_LOOP_BEGIN EPI_COORD_NS
          G0[(size_t)row * 2048 + (col - 4096)] = (bf16_t)f2bf(silu(v));
        EPI_LOOP_END
      }
    } else {
      gemm_main<false>(acc, A, 2048, B, 2048, 2048, m0, n0, smem);
      EPI_LOOP_BEGIN EPI_COORD_NS
        QK[(size_t)row * 2048 + col] = (bf16_t)f2bf(v);
      EPI_LOOP_END
    }
  }
  {
    typedef __attribute__((ext_vector_type(4))) float f32x4_t;
    const int t = TID, lane = t & 63, w = t >> 6, l15 = lane & 15, quad = lane >> 4;
    float* red = (float*)smem;
    for (int item = bid; item < 512; item += nblk) {
      const bf16_t* ap = A + (size_t)(item * 16 + l15) * 2048 + 512 * w + 8 * quad;
      const bf16_t* bp = B + (size_t)(6144 + l15) * 2048 + 512 * w + 8 * quad;
      f32x4_t c = {0.f, 0.f, 0.f, 0.f};
#pragma unroll
      for (int s = 0; s < 16; s++) {
        const bf16x8 a = *(const bf16x8*)(ap + 32 * s);
        const bf16x8 b = *(const bf16x8*)(bp + 32 * s);
        c = __builtin_amdgcn_mfma_f32_16x16x32_bf16(a, b, c, 0, 0, 0);
      }
      __syncthreads();
#pragma unroll
      for (int j = 0; j < 4; j++) red[(w * 16 + quad * 4 + j) * 16 + l15] = c[j];
      __syncthreads();
      const float v = red[t] + red[256 + t] + red[512 + t] + red[768 + t];
      GKL[(size_t)item * 256 + t] = v;
    }
  }
}

DI void phase_gla_prep(const Params& p, char* smem, int bid, int nblk) {
  char* ws = opaque_ptr(p.ws);
  const int t = TID, lane = t & 63, w = t >> 6, r = lane & 31, h = lane >> 5;
  const bf16_t* QK = (const bf16_t*)(ws + OFF_QK0);
  const float* GKL = (const float*)(ws + OFF_GKLOW);
  bf16_t* QE = (bf16_t*)(ws + OFF_QE);
  bf16_t* KLT = (bf16_t*)(ws + OFF_KLT);
  bf16_t* AM = (bf16_t*)(ws + OFF_AM);
  float* DEC = (float*)(ws + OFF_DECAY);
  if (bid == 0 && t == 0) { ((int*)(ws + OFF_CTR))[0] = 0; ((int*)(ws + OFF_CTR))[1] = 0; }
  char* lq = smem;
  char* lk = smem + 32768;
  for (int tile = bid; tile < 512; tile += nblk) {
    const int n = tile >> 2, head = tile & 3, t0 = n * 64, d = t, col = head * 256 + d;
    __syncthreads();
    ((float4*)(smem + 65536))[t] = ((const float4*)(GKL + (size_t)t0 * 16))[t];
    __syncthreads();
    float w2[16];
#pragma unroll
    for (int j = 0; j < 16; j++) w2[j] = p.w_gk2[j * 1024 + col];
    const float bias = p.b_gk[col];
    float b = 0.f;
    const int dperm = (d & ~15) | ((d & 3) | ((d & 4) << 1) | ((d & 8) >> 1));
    for (int c16 = 0; c16 < 4; c16++) {
      float bj[16], qv[16], kv[16];
#pragma unroll
      for (int j = 0; j < 16; j++) {
        const int c = c16 * 16 + j;
        const float4* gl = (const float4*)(smem + 65536) + c * 4;
        float4 g0 = gl[0], g1 = gl[1], g2 = gl[2], g3 = gl[3];
        float gk = bias + g0.x * w2[0] + g0.y * w2[1] + g0.z * w2[2] + g0.w * w2[3] + g1.x * w2[4] + g1.y * w2[5] + g1.z * w2[6] + g1.w * w2[7]
                 + g2.x * w2[8] + g2.y * w2[9] + g2.z * w2[10] + g2.w * w2[11] + g3.x * w2[12] + g3.y * w2[13] + g3.z * w2[14] + g3.w * w2[15];
        float la = (fminf(gk, 0.f) - __logf(1.f + __expf(-fabsf(gk)))) * (1.f / 16.f);
        b += la;
        bj[j] = b;
        qv[j] = bf2f(QK[(size_t)(t0 + c) * 2048 + col]);
        kv[j] = bf2f(QK[(size_t)(t0 + c) * 2048 + 1024 + col]);
      }
      unsigned klp[8];
#pragma unroll
      for (int j = 0; j < 16; j++) {
        const int c = c16 * 16 + j;
        const float qe = qv[j] * 0.0625f * __expf(bj[j]);
        const float ke = kv[j] * __expf(-bj[j]);
        const unsigned qeb = f2bf(qe), keb = f2bf(ke), klb = keb;
        const int lo = c * 512 + ((((d >> 3) ^ (c & 15))) << 4) + (d & 7) * 2;
        *(unsigned short*)(lq + lo) = (unsigned short)qeb;
        *(unsigned short*)(lk + lo) = (unsigned short)keb;
        QE[(size_t)(t0 + c) * 1024 + head * 256 + dperm] = (bf16_t)qeb;
        if (j & 1) klp[j >> 1] |= klb << 16; else klp[j >> 1] = klb;
      }
      uint4 o0, o1; o0.x = klp[0]; o0.y = klp[1]; o0.z = klp[2]; o0.w = klp[3]; o1.x = klp[4]; o1.y = klp[5]; o1.z = klp[6]; o1.w = klp[7];
      bf16_t* kdst = KLT + (size_t)(head * 256 + d) * S_ + t0 + c16 * 16;
      *(uint4*)kdst = o0; *(uint4*)(kdst + 8) = o1;
    }
    DEC[(size_t)(n * 4 + head) * 256 + d] = __expf(b);
    __syncthreads();
    {
      const int ct = w >> 1, st = w & 1;
      f32x16 acc;
#pragma unroll
      for (int i = 0; i < 16; i++) acc[i] = 0.f;
      if (!(ct == 0 && st == 1)) {
        const int ra = ct * 32 + r, rb = st * 32 + r;
#pragma unroll
        for (int s = 0; s < 16; s++) {
          bf16x8 a = *(const bf16x8*)(lq + ra * 512 + (((2 * s + h) ^ (ra & 15)) << 4));
          bf16x8 bb = *(const bf16x8*)(lk + rb * 512 + (((2 * s + h) ^ (rb & 15)) << 4));
          acc = MFMA32(a, bb, acc);
        }
      }
      bf16_t* ap = AM + (size_t)(n * 4 + head) * 4096;
#pragma unroll
      for (int i = 0; i < 16; i++) {
        const int c = ct * 32 + crow(i, h), s = st * 32 + r;
        ap[c * 64 + s] = (bf16_t)f2bf(s <= c ? acc[i] : 0.f);
      }
    }
    __syncthreads();
  }
}

constexpr int SCAN_NG = 8, SCAN_GC = 16;
DI void phase_gla_local(const Params& p, char* smem, int bid, int nblk) {
  char* ws = opaque_ptr(p.ws);
  const int t = TID, lane = t & 63, w = t >> 6, r = lane & 31, h = lane >> 5;
  for (int item = bid; item < 64 * (SCAN_NG - 1); item += nblk) {
    const int grp = item >> 6, head = (item >> 4) & 3, dvt = item & 15, dv0 = dvt * 32;
    const int nb = grp * SCAN_GC;
    const bf16_t* v_p = (const bf16_t*)(ws + OFF_V0T) + (size_t)(head * 512 + dv0 + r) * S_ + nb * 64 + 8 * h;
    const bf16_t* kl_p = (const bf16_t*)(ws + OFF_KLT) + (size_t)(head * 256 + 64 * w + r) * S_ + nb * 64 + 8 * h;
    const float* dec_p = (const float*)(ws + OFF_DECAY) + (size_t)nb * 1024 + head * 256 + 64 * w + 4 * h;
    f32x16 St[2];
#pragma unroll
    for (int i = 0; i < 16; i++) { St[0][i] = 0.f; St[1][i] = 0.f; }
    bf16x8 klA[2][4], vfA[4], klB[2][4], vfB[4];
    float4 dcA[2][4], dcB[2][4];
#define LOC_LOAD(KL, VF, DC, n_)                                                                                 \
    {                                                                                                            \
      _Pragma("unroll") for (int s = 0; s < 4; s++) VF[s] = *(const bf16x8*)(v_p + (n_) * 64 + 16 * s);        \
      _Pragma("unroll") for (int dt = 0; dt < 2; dt++) {                                                         \
        _Pragma("unroll") for (int s = 0; s < 4; s++) KL[dt][s] = *(const bf16x8*)(kl_p + (size_t)dt * 32 * S_ + (n_) * 64 + 16 * s); \
        _Pragma("unroll") for (int g4 = 0; g4 < 4; g4++) DC[dt][g4] = *(const float4*)(dec_p + (size_t)(n_) * 1024 + dt * 32 + 8 * g4); \
      }                                                                                                          \
    }
#define LOC_STEP(KL, VF, DC)                                                                                     \
    {                                                                                                            \
      _Pragma("unroll") for (int dt = 0; dt < 2; dt++) {                                                         \
        _Pragma("unroll") for (int s = 0; s < 4; s++) St[dt] = MFMA32(KL[dt][s], VF[s], St[dt]);                 \
        _Pragma("unroll") for (int g4 = 0; g4 < 4; g4++) {                                                       \
          St[dt][4 * g4 + 0] *= DC[dt][g4].x; St[dt][4 * g4 + 1] *= DC[dt][g4].y;                                \
          St[dt][4 * g4 + 2] *= DC[dt][g4].z; St[dt][4 * g4 + 3] *= DC[dt][g4].w;                                \
        }                                                                                                        \
      }                                                                                                          \
    }
    LOC_LOAD(klA, vfA, dcA, 0)
    for (int n = 0; n < SCAN_GC; n += 2) {
      LOC_LOAD(klB, vfB, dcB, n + 1)
      LOC_STEP(klA, vfA, dcA)
      if (n + 2 < SCAN_GC) LOC_LOAD(klA, vfA, dcA, n + 2)
      LOC_STEP(klB, vfB, dcB)
    }
#undef LOC_LOAD
#undef LOC_STEP
    float* sl = (float*)(ws + OFF_SL) + ((size_t)((grp * 4 + head) * 16 + dvt) * 4 + w) * 2048 + lane;
#pragma unroll
    for (int dt = 0; dt < 2; dt++)
#pragma unroll
      for (int i = 0; i < 16; i++) sl[(dt * 16 + i) * 64] = St[dt][i];
    if (dvt == 0) {
      const float* dg = (const float*)(ws + OFF_DECAY) + (size_t)nb * 1024 + head * 256 + t;
      float pr = 1.f;
#pragma unroll 4
      for (int n = 0; n < SCAN_GC; n++) pr *= dg[(size_t)n * 1024];
      ((float*)(ws + OFF_DC))[(grp * 4 + head) * 256 + t] = pr;
    }
  }
}

DI void phase_gla_scan(const Params& p, char* smem, int bid, int nblk) {
  char* ws = opaque_ptr(p.ws);
  const int t = TID, lane = t & 63, w = t >> 6, r = lane & 31, h = lane >> 5;
  float* lo = (float*)smem;
  for (int item = bid; item < 64 * SCAN_NG; item += nblk) {
    const int grp = item >> 6, head = (item >> 4) & 3, dvt = item & 15, dv0 = dvt * 32;
    const int nb = grp * SCAN_GC, ne = nb + SCAN_GC;
    const bf16_t* qe_p = (const bf16_t*)(ws + OFF_QE) + (size_t)r * 1024 + head * 256 + 64 * w + 8 * h;
    const bf16_t* a_p = (const bf16_t*)(ws + OFF_AM) + (size_t)head * 4096 + (size_t)r * 64 + 16 * w + 8 * h;
    const bf16_t* v_p = (const bf16_t*)(ws + OFF_V0T) + (size_t)(head * 512 + dv0 + r) * S_ + 8 * h;
    const bf16_t* kl_p = (const bf16_t*)(ws + OFF_KLT) + (size_t)(head * 256 + 64 * w + r) * S_ + 8 * h;
    bf16_t* o_p = (bf16_t*)(ws + OFF_QK0) + (size_t)(t >> 2) * 2048 + head * 512 + dv0 + (t & 3) * 8;
    f32x16 St[2];
#pragma unroll
    for (int i = 0; i < 16; i++) { St[0][i] = 0.f; St[1][i] = 0.f; }
    for (int j = 0; j < grp; j++) {
      const float* slj = (const float*)(ws + OFF_SL) + ((size_t)((j * 4 + head) * 16 + dvt) * 4 + w) * 2048 + lane;
      const float* dcj = (const float*)(ws + OFF_DC) + (j * 4 + head) * 256 + 64 * w + 4 * h;
#pragma unroll
      for (int dt = 0; dt < 2; dt++)
#pragma unroll
        for (int g4 = 0; g4 < 4; g4++) {
          const float4 dv = *(const float4*)(dcj + 32 * dt + 8 * g4);
          St[dt][4 * g4 + 0] = St[dt][4 * g4 + 0] * dv.x + slj[(dt * 16 + 4 * g4 + 0) * 64];
          St[dt][4 * g4 + 1] = St[dt][4 * g4 + 1] * dv.y + slj[(dt * 16 + 4 * g4 + 1) * 64];
          St[dt][4 * g4 + 2] = St[dt][4 * g4 + 2] * dv.z + slj[(dt * 16 + 4 * g4 + 2) * 64];
          St[dt][4 * g4 + 3] = St[dt][4 * g4 + 3] * dv.w + slj[(dt * 16 + 4 * g4 + 3) * 64];
        }
    }
    qe_p += (size_t)nb * 64 * 1024; a_p += (size_t)nb * 4 * 4096; v_p += nb * 64; kl_p += nb * 64; o_p += (size_t)nb * 64 * 2048;
    bf16x8 qe[2][4], af[2], vf[4], kl[2][4];
    float* ldec = (float*)(smem + 32768);
    const float* dec_g = (const float*)(ws + OFF_DECAY) + (size_t)nb * 1024 + head * 256 + t;
#pragma unroll
    for (int ct = 0; ct < 2; ct++) {
#pragma unroll
      for (int s = 0; s < 4; s++) qe[ct][s] = *(const bf16x8*)(qe_p + (size_t)ct * 32 * 1024 + 16 * s);
      af[ct] = *(const bf16x8*)(a_p + ct * 32 * 64);
    }
#pragma unroll
    for (int s = 0; s < 4; s++) vf[s] = *(const bf16x8*)(v_p + 16 * s);
#pragma unroll
    for (int dt = 0; dt < 2; dt++) {
#pragma unroll
      for (int s = 0; s < 4; s++) kl[dt][s] = *(const bf16x8*)(kl_p + (size_t)dt * 32 * S_ + 16 * s);
    }
    __syncthreads();
    ldec[t] = dec_g[0];
    __syncthreads();
    for (int n = 0; n < SCAN_GC; n++) {
      const bool more = (n + 1 < SCAN_GC);
      float decn = 0.f;
      if (more) decn = dec_g[(size_t)(n + 1) * 1024];
      f32x16 o[2];
#pragma unroll
      for (int i = 0; i < 16; i++) { o[0][i] = 0.f; o[1][i] = 0.f; }
#pragma unroll
      for (int s = 0; s < 4; s++) {
        bf16x8 sb = pack8(St[s >> 1], s & 1);
        o[0] = MFMA32(qe[0][s], sb, o[0]);
        o[1] = MFMA32(qe[1][s], sb, o[1]);
      }
      if (more) {
        const bf16_t* q2 = qe_p + (size_t)(n + 1) * 64 * 1024;
#pragma unroll
        for (int ct = 0; ct < 2; ct++)
#pragma unroll
          for (int s = 0; s < 4; s++) qe[ct][s] = *(const bf16x8*)(q2 + (size_t)ct * 32 * 1024 + 16 * s);
      }
      {
        bf16x8 vw = (w == 0) ? vf[0] : (w == 1) ? vf[1] : (w == 2) ? vf[2] : vf[3];
        o[0] = MFMA32(af[0], vw, o[0]);
        o[1] = MFMA32(af[1], vw, o[1]);
      }
      if (more) {
        const bf16_t* a2 = a_p + (size_t)(n + 1) * 4 * 4096;
        af[0] = *(const bf16x8*)(a2); af[1] = *(const bf16x8*)(a2 + 32 * 64);
      }
#pragma unroll
      for (int dt = 0; dt < 2; dt++) {
#pragma unroll
        for (int s = 0; s < 4; s++) St[dt] = MFMA32(kl[dt][s], vf[s], St[dt]);
#pragma unroll
        for (int g = 0; g < 4; g++) {
          const float4 dv = *(const float4*)(ldec + (n & 1) * 256 + 64 * w + 32 * dt + 8 * g + 4 * h);
          St[dt][4 * g + 0] *= dv.x; St[dt][4 * g + 1] *= dv.y;
          St[dt][4 * g + 2] *= dv.z; St[dt][4 * g + 3] *= dv.w;
        }
      }
      if (more) {
        const int tn = (n + 1) * 64;
#pragma unroll
        for (int s = 0; s < 4; s++) vf[s] = *(const bf16x8*)(v_p + tn + 16 * s);
#pragma unroll
        for (int dt = 0; dt < 2; dt++) {
#pragma unroll
          for (int s = 0; s < 4; s++) kl[dt][s] = *(const bf16x8*)(kl_p + (size_t)dt * 32 * S_ + tn + 16 * s);
        }
      }
      ldec[((n + 1) & 1) * 256 + t] = decn;
#pragma unroll
      for (int ct = 0; ct < 2; ct++)
#pragma unroll
        for (int i = 0; i < 16; i++) lo[(w * 64 + ct * 32 + crow(i, h)) * 32 + r] = o[ct][i];
      __syncthreads();
      {
        const int c = t >> 2, vg = (t & 3) * 8;
        float4 s0 = *(const float4*)(lo + c * 32 + vg), s1 = *(const float4*)(lo + c * 32 + vg + 4);
#pragma unroll
        for (int ww = 1; ww < 4; ww++) {
          float4 x0 = *(const float4*)(lo + (ww * 64 + c) * 32 + vg), x1 = *(const float4*)(lo + (ww * 64 + c) * 32 + vg + 4);
          s0.x += x0.x; s0.y += x0.y; s0.z += x0.z; s0.w += x0.w; s1.x += x1.x; s1.y += x1.y; s1.z += x1.z; s1.w += x1.w;
        }
        uint4 ov; ov.x = pack2(s0.x, s0.y); ov.y = pack2(s0.z, s0.w); ov.z = pack2(s1.x, s1.y); ov.w = pack2(s1.z, s1.w);
        *(uint4*)(o_p + (size_t)n * 64 * 2048) = ov;
      }
      __syncthreads();
    }
  }
}

DI void phase_og(const Params& p, char* smem, int bid, int nblk) {
  char* ws = opaque_ptr(p.ws);
  const int t = TID, lane = t & 63, w = t >> 6;
  const bf16_t* O0 = (const bf16_t*)(ws + OFF_QK0);
  const bf16_t* G0 = (const bf16_t*)(ws + OFF_G0);
  bf16_t* OG = (bf16_t*)(ws + OFF_H);
  const float4* gp = (const float4*)(p.g_onorm + lane * 8);
  const float4 ga = gp[0], gb = gp[1];
  for (int token = bid; token < S_; token += 8 * nblk) {
    uint4 ov[8], gv[8];
#pragma unroll
    for (int u = 0; u < 8; u++) {
      const int tk = token + u * nblk;
      const size_t off = (size_t)(tk < S_ ? tk : token) * 2048 + w * 512 + lane * 8;
      ov[u] = ld_nt((const uint4*)(O0 + off));
      gv[u] = ld_nt((const uint4*)(G0 + off));
    }
#pragma unroll
    for (int u = 0; u < 8; u++) {
      const int tk = token + u * nblk;
      const size_t off = (size_t)tk * 2048 + w * 512 + lane * 8;
      const float f0 = bflo(ov[u].x), f1 = bfhi(ov[u].x), f2 = bflo(ov[u].y), f3 = bfhi(ov[u].y);
      const float f4 = bflo(ov[u].z), f5 = bfhi(ov[u].z), f6 = bflo(ov[u].w), f7 = bfhi(ov[u].w);
      float ss = f0 * f0 + f1 * f1 + f2 * f2 + f3 * f3 + f4 * f4 + f5 * f5 + f6 * f6 + f7 * f7;
      ss = wave_sum(ss);
      const float rinv = rsqrtf(ss * (1.f / 512.f) + 1e-6f);
      uint4 o;
      o.x = pack2(f0 * rinv * ga.x * bflo(gv[u].x), f1 * rinv * ga.y * bfhi(gv[u].x));
      o.y = pack2(f2 * rinv * ga.z * bflo(gv[u].y), f3 * rinv * ga.w * bfhi(gv[u].y));
      o.z = pack2(f4 * rinv * gb.x * bflo(gv[u].z), f5 * rinv * gb.y * bfhi(gv[u].z));
      o.w = pack2(f6 * rinv * gb.z * bflo(gv[u].w), f7 * rinv * gb.w * bfhi(gv[u].w));
      if (tk < S_) *(uint4*)(OG + off) = o;
    }
  }
}

DI void phase_gemm_out(const Params& p, char* smem, int bid, int nblk, size_t off_w) {
  char* ws = opaque_ptr(p.ws);
  const bf16_t* A = (const bf16_t*)(ws + OFF_H);
  const bf16_t* B = (const bf16_t*)(ws + off_w);
  bf16_t* Y = (bf16_t*)(ws + OFF_Y);
  for (int tile = bid; tile < 32 * 16; tile += nblk) {
    const int mi = tile & 31, ni = tile >> 5;
    const int m0 = mi * 256, n0 = ni * 128;
    f32x16 acc[4][2];
    gemm_main<false>(acc, A, 2048, B, 2048, 2048, m0, n0, smem);
    EPI_LOOP_BEGIN EPI_COORD_NS
      Y[(size_t)row * 2048 + col] = (bf16_t)f2bf(v);
    EPI_LOOP_END
  }
}

DI void phase_post0(const Params& p, char* smem, int bid, int nblk) {
  char* ws = opaque_ptr(p.ws);
  const int t = TID, lane = t & 63, w = t >> 6;
  const bf16_t* Y = (const bf16_t*)(ws + OFF_Y);
  const float4* gpo = (const float4*)p.l0_post + lane;
  const float4* gpr = (const float4*)p.l1_pre + lane;
  for (int row0 = bid * 4 + w; row0 < S_; row0 += nblk * 8) {
    const int row1r = row0 + nblk * 4;
    const bool has1 = row1r < S_;
    const int row1 = has1 ? row1r : row0;
    const uint2* yr0 = (const uint2*)(Y + (size_t)row0 * 2048) + lane;
    const uint2* yr1 = (const uint2*)(Y + (size_t)row1 * 2048) + lane;
    const float4* xr0 = (const float4*)(p.x + (size_t)row0 * 2048) + lane;
    const float4* xr1 = (const float4*)(p.x + (size_t)row1 * 2048) + lane;
    uint2 ya[8], yb[8];
    float4 xa[8], xb[8];
#pragma unroll
    for (int j = 0; j < 8; j++) { ya[j] = ld_nt(yr0 + j * 64); xa[j] = ld_nt(xr0 + j * 64); yb[j] = ld_nt(yr1 + j * 64); xb[j] = ld_nt(xr1 + j * 64); }
    float sa = 0.f, sb = 0.f;
#pragma unroll
    for (int j = 0; j < 8; j++) {
      sa += bflo(ya[j].x) * bflo(ya[j].x) + bfhi(ya[j].x) * bfhi(ya[j].x) + bflo(ya[j].y) * bflo(ya[j].y) + bfhi(ya[j].y) * bfhi(ya[j].y);
      sb += bflo(yb[j].x) * bflo(yb[j].x) + bfhi(yb[j].x) * bfhi(yb[j].x) + bflo(yb[j].y) * bflo(yb[j].y) + bfhi(yb[j].y) * bfhi(yb[j].y);
    }
    sa = wave_sum(sa); sb = wave_sum(sb);
    const float ra = rsqrtf(sa * (1.f / 2048.f) + 1e-6f), rb = rsqrtf(sb * (1.f / 2048.f) + 1e-6f);
    float4* out0 = (float4*)(p.out + (size_t)row0 * 2048) + lane;
    float4* out1 = (float4*)(p.out + (size_t)row1 * 2048) + lane;
    float s2a = 0.f, s2b = 0.f;
#pragma unroll
    for (int j = 0; j < 8; j++) {
      const float4 g = gpo[j * 64];
      xa[j].x += bflo(ya[j].x) * ra * g.x; xa[j].y += bfhi(ya[j].x) * ra * g.y; xa[j].z += bflo(ya[j].y) * ra * g.z; xa[j].w += bfhi(ya[j].y) * ra * g.w;
      xb[j].x += bflo(yb[j].x) * rb * g.x; xb[j].y += bfhi(yb[j].x) * rb * g.y; xb[j].z += bflo(yb[j].y) * rb * g.z; xb[j].w += bfhi(yb[j].y) * rb * g.w;
      out0[j * 64] = xa[j];
      if (has1) out1[j * 64] = xb[j];
      s2a += xa[j].x * xa[j].x + xa[j].y * xa[j].y + xa[j].z * xa[j].z + xa[j].w * xa[j].w;
      s2b += xb[j].x * xb[j].x + xb[j].y * xb[j].y + xb[j].z * xb[j].z + xb[j].w * xb[j].w;
    }
    s2a = wave_sum(s2a); s2b = wave_sum(s2b);
    const float r2a = rsqrtf(s2a * (1.f / 2048.f) + 1e-6f), r2b = rsqrtf(s2b * (1.f / 2048.f) + 1e-6f);
    uint2* h0 = (uint2*)(ws + OFF_H + (size_t)row0 * 4096) + lane;
    uint2* h1 = (uint2*)(ws + OFF_H + (size_t)row1 * 4096) + lane;
#pragma unroll
    for (int j = 0; j < 8; j++) {
      const float4 g = gpr[j * 64];
      uint2 o; o.x = pack2(xa[j].x * r2a * g.x, xa[j].y * r2a * g.y); o.y = pack2(xa[j].z * r2a * g.z, xa[j].w * r2a * g.w);
      h0[j * 64] = o;
      if (has1) { uint2 q; q.x = pack2(xb[j].x * r2b * g.x, xb[j].y * r2b * g.y); q.y = pack2(xb[j].z * r2b * g.z, xb[j].w * r2b * g.w); h1[j * 64] = q; }
    }
  }
}

DI void phase_gemm_in1(const Params& p, char* smem, int bid, int nblk) {
  char* ws = opaque_ptr(p.ws);
  const bf16_t* A = (const bf16_t*)(ws + OFF_H);
  const bf16_t* B = (const bf16_t*)(ws + OFF_WIN1T);
  bf16_t* CQ = (bf16_t*)(ws + OFF_CQ);
  bf16_t* CKV = (bf16_t*)(ws + OFF_CKV);
  bf16_t* KR = (bf16_t*)(ws + OFF_KR);
  const float* cs = (const float*)(ws + OFF_CS);
  bf16_t* G1 = (bf16_t*)(ws + OFF_QK0);
  for (int tile = bid; tile < 32 * 25; tile += nblk) {
    const int mi = tile & 31, ni = tile >> 5;
    const int m0 = mi * 256, n0 = ni * 128;
    f32x16 acc[4][2];
    gemm_main<false>(acc, A, 2048, B, 2048, 2048, m0, n0, smem);
    if (ni < 4) {
      EPI_LOOP_BEGIN EPI_COORD_NS
        CQ[(size_t)row * 512 + col] = (bf16_t)f2bf(v);
      EPI_LOOP_END
    } else if (ni < 8) {
      EPI_LOOP_BEGIN EPI_COORD_NS
        CKV[(size_t)row * 512 + (col - 512)] = (bf16_t)f2bf(v);
      EPI_LOOP_END
    } else if (ni == 8 && ((TID >> 6) & 1) == 0) {
      const int lane_ = TID & 63, w_ = TID >> 6, wm_ = w_ >> 1, r_ = lane_ & 31, h_ = lane_ >> 5;
#pragma unroll
      for (int mt = 0; mt < 4; mt++)
#pragma unroll
        for (int i = 0; i < 16; i++) {
          const int row = m0 + wm_ * 128 + mt * 32 + crow(i, h_);
          const float t1 = acc[mt][0][i], t2 = acc[mt][1][i];
          const float c = cs[row * 64 + r_], sn = cs[row * 64 + 32 + r_];
          KR[(size_t)row * 64 + r_] = (bf16_t)f2bf(t1 * c - t2 * sn);
          KR[(size_t)row * 64 + 32 + r_] = (bf16_t)f2bf(t2 * c + t1 * sn);
        }
    } else {
      EPI_LOOP_BEGIN EPI_COORD_NS
        if (col < 3136) G1[(size_t)row * 2048 + (col - 1088)] = (bf16_t)f2bf(silu(v));
      EPI_LOOP_END
    }
  }
}

DI void phase_gemm_qkv(const Params& p, char* smem, int bid, int nblk) {
  char* ws = opaque_ptr(p.ws);
  const bf16_t* CQ = (const bf16_t*)(ws + OFF_CQ);
  const bf16_t* CKV = (const bf16_t*)(ws + OFF_CKV);
  const bf16_t* WQ = (const bf16_t*)(ws + OFF_WQBT);
  const bf16_t* WKV = (const bf16_t*)(ws + OFF_WKVBT);
  const float* cs = (const float*)(ws + OFF_CS);
  bf16_t* Q = (bf16_t*)(ws + OFF_Q);
  bf16_t* KN = (bf16_t*)(ws + OFF_KN);
  bf16_t* VT = (bf16_t*)(ws + OFF_VT);
  const float qscale = 0.07216878364870322f * 1.4426950408889634f;
  const int ntq = 32 * 24, ntkv = 32 * 32;
  for (int tile = bid; tile < ntq + ntkv; tile += nblk) {
    f32x16 acc[4][2];
    if (tile < ntq) {
      const int mi = tile & 31, ni = tile >> 5;
      const int m0 = mi * 256, n0 = ni * 128;
      gemm_main<false, true>(acc, CQ, 512, WQ, 512, 512, m0, n0, smem);
      const float* rf = (const float*)(smem + 49152);
      const int lane_ = TID & 63, w_ = TID >> 6, wm_ = w_ >> 1, wn_ = w_ & 1, r_ = lane_ & 31, h_ = lane_ >> 5;
      const int cb = n0 + wn_ * 64;
      const int head = cb / 192, jb = cb - head * 192;
      if (jb == 128) {
#pragma unroll
        for (int mt = 0; mt < 4; mt++)
#pragma unroll
          for (int i = 0; i < 16; i++) {
            const int row = m0 + wm_ * 128 + mt * 32 + crow(i, h_);
            const float sc = rf[row - m0] * qscale;
            const float t1 = acc[mt][0][i] * sc, t2 = acc[mt][1][i] * sc;
            const float c = cs[row * 64 + r_], s = cs[row * 64 + 32 + r_];
            bf16_t* qp = Q + ((size_t)head * S_ + row) * 192 + 128;
            qp[r_] = (bf16_t)f2bf(t1 * c - t2 * s);
            qp[32 + r_] = (bf16_t)f2bf(t2 * c + t1 * s);
          }
      } else {
#pragma unroll
        for (int mt = 0; mt < 4; mt++)
#pragma unroll
          for (int nt = 0; nt < 2; nt++)
#pragma unroll
            for (int i = 0; i < 16; i++) {
              const int row = m0 + wm_ * 128 + mt * 32 + crow(i, h_);
              const float sc = rf[row - m0] * qscale;
              Q[((size_t)head * S_ + row) * 192 + jb + nt * 32 + r_] = (bf16_t)f2bf(acc[mt][nt][i] * sc);
            }
      }
    } else {
      const int tl = tile - ntq;
      const int mi = tl & 31, ni = tl >> 5;
      const int m0 = mi * 256, n0 = ni * 128;
      const int head = ni >> 1;
      if (ni & 1) {
        gemm_main<true, true>(acc, CKV, 512, WKV, 512, 512, m0, n0, smem);
        const float* rf = (const float*)(smem + 49152);
        EPI_LOOP_BEGIN EPI_COORD_SW
          const int j = col - head * 256 - 128;
          VT[((size_t)head * 128 + j) * S_ + row] = (bf16_t)f2bf(v * rf[row - m0]);
        EPI_LOOP_END
      } else {
        gemm_main<false, true>(acc, CKV, 512, WKV, 512, 512, m0, n0, smem);
        const float* rf = (const float*)(smem + 49152);
        EPI_LOOP_BEGIN EPI_COORD_NS
          const int j = col - head * 256;
          KN[((size_t)head * S_ + row) * 128 + j] = (bf16_t)f2bf(v * rf[row - m0]);
        EPI_LOOP_END
      }
    }
  }
}

DI void phase_attn(const Params& p, char* smem, int bid, int nblk, int rep) {
  char* ws = opaque_ptr(p.ws);
  const int t = TID, lane = t & 63, w = t >> 6, r = lane & 31, h = lane >> 5;
  const bf16_t* Q = (const bf16_t*)(ws + OFF_Q);
  const bf16_t* KN = (const bf16_t*)(ws + OFF_KN);
  const bf16_t* KR = (const bf16_t*)(ws + OFF_KR);
  const bf16_t* VT = (const bf16_t*)(ws + OFF_VT);
  const bf16_t* G1 = (const bf16_t*)(ws + OFF_QK0);
  bf16_t* OG = (bf16_t*)(ws + OFF_H);
  int* ctr = (int*)(ws + OFF_CTR) + rep;
  char* lk = smem;
  char* lv = smem + 25600;
  int* s_item = (int*)(smem + 44032);
  const int k_row = t >> 2, k_c0 = t & 3;
  const int v_row0 = t >> 3, v_kc = t & 7;
  for (;;) {
    __syncthreads();
    if (t == 0) *s_item = atomicAdd(ctr, 1);
    __syncthreads();
    const int item = *s_item;
    if (item >= 1024) break;
    const int qb = 63 - (item >> 4), head = item & 15;
    const int q0w = qb * 128 + w * 32;
    const int ntile = 2 * qb + 2;
    bf16x8 qf[12];
    {
      const bf16_t* qp = Q + ((size_t)head * S_ + q0w + r) * 192 + 8 * h;
#pragma unroll
      for (int s = 0; s < 12; s++) qf[s] = *(const bf16x8*)(qp + 16 * s);
    }
    f32x16 oacc[4];
#pragma unroll
    for (int vt = 0; vt < 4; vt++)
#pragma unroll
      for (int i = 0; i < 16; i++) oacc[vt][i] = 0.f;
    float m_run = -INFINITY, l_run = 0.f;
    uint4 kg0, kg1, kg2, kg3, kg4, kg5, vg0, vg1, vg2, vg3;
    const bf16_t* knp = KN + (size_t)head * S_ * 128;
    const bf16_t* vtp = VT + ((size_t)head * 128 + v_row0) * S_ + v_kc * 8;
#define ATT_LOAD(k0_)                                                                                         \
    {                                                                                                         \
      const bf16_t* kn_ = knp + (size_t)((k0_) + k_row) * 128 + k_c0 * 8;                                     \
      const bf16_t* kr_ = KR + (size_t)((k0_) + k_row) * 64 + k_c0 * 8;                                       \
      const bf16_t* vp_ = vtp + (k0_);                                                                        \
      kg0 = *(const uint4*)(kn_); kg1 = *(const uint4*)(kn_ + 32); kg2 = *(const uint4*)(kn_ + 64); kg3 = *(const uint4*)(kn_ + 96); \
      kg4 = *(const uint4*)(kr_); kg5 = *(const uint4*)(kr_ + 32);                                            \
      vg0 = *(const uint4*)(vp_); vg1 = *(const uint4*)(vp_ + (size_t)32 * S_);                               \
      vg2 = *(const uint4*)(vp_ + (size_t)64 * S_); vg3 = *(const uint4*)(vp_ + (size_t)96 * S_);             \
    }
    ATT_LOAD(0)
    for (int kt = 0; kt < ntile; kt++) {
      const int k0 = kt * 64;
      __syncthreads();
      {
        char* kd = lk + k_row * 400 + k_c0 * 16;
        *(uint4*)(kd) = kg0; *(uint4*)(kd + 64) = kg1; *(uint4*)(kd + 128) = kg2; *(uint4*)(kd + 192) = kg3;
        *(uint4*)(kd + 256) = kg4; *(uint4*)(kd + 320) = kg5;
        char* vd = lv + v_row0 * 144 + (v_kc >> 1) * 32 + (v_kc & 1) * 8;
#define VST(o_, v_) { uint2 u0, u1; u0.x = v_.x; u0.y = v_.y; u1.x = v_.z; u1.y = v_.w; *(uint2*)(vd + (o_)) = u0; *(uint2*)(vd + (o_) + 16) = u1; }
        VST(0, vg0) VST(32 * 144, vg1) VST(64 * 144, vg2) VST(96 * 144, vg3)
#undef VST
      }
      __syncthreads();
      { const int knext = (kt + 1 < ntile) ? k0 + 64 : k0; ATT_LOAD(knext) }
      if (k0 <= q0w + 31) {
        f32x16 sc[2];
#pragma unroll
        for (int i = 0; i < 16; i++) { sc[0][i] = 0.f; sc[1][i] = 0.f; }
        __builtin_amdgcn_s_setprio(1);
#pragma unroll
        for (int s = 0; s < 12; s++) {
          bf16x8 a0 = *(const bf16x8*)(lk + r * 400 + h * 16 + s * 32);
          bf16x8 a1 = *(const bf16x8*)(lk + r * 400 + h * 16 + 32 * 400 + s * 32);
          sc[0] = MFMA32(a0, qf[s], sc[0]);
          sc[1] = MFMA32(a1, qf[s], sc[1]);
        }
        __builtin_amdgcn_s_setprio(0);
        if (k0 + 63 > q0w) {
          const int qg = q0w + r;
#pragma unroll
          for (int mt = 0; mt < 2; mt++)
#pragma unroll
            for (int i = 0; i < 16; i++) {
              const int key = k0 + mt * 32 + crow(i, h);
              if (key > qg) sc[mt][i] = -INFINITY;
            }
        }
        float mx = sc[0][0];
#pragma unroll
        for (int i = 1; i < 16; i++) mx = fmaxf(mx, sc[0][i]);
#pragma unroll
        for (int i = 0; i < 16; i++) mx = fmaxf(mx, sc[1][i]);
        mx = fmaxf(mx, __shfl_xor(mx, 32));
        const float m_new = (mx > m_run + 8.f) ? mx : m_run;
        const bool resc = __any(m_new != m_run);
        const float alpha = __builtin_amdgcn_exp2f(m_run - m_new);
        m_run = m_new;
        float ls = 0.f;
#pragma unroll
        for (int mt = 0; mt < 2; mt++)
#pragma unroll
          for (int i = 0; i < 16; i++) { const float pv = __builtin_amdgcn_exp2f(sc[mt][i] - m_new); sc[mt][i] = pv; ls += pv; }
        l_run = l_run * alpha + ls;
        if (resc) {
#pragma unroll
          for (int vt = 0; vt < 4; vt++)
#pragma unroll
            for (int i = 0; i < 16; i++) oacc[vt][i] *= alpha;
        }
        __builtin_amdgcn_s_setprio(1);
#pragma unroll
        for (int s = 0; s < 4; s++) {
          const bf16x8 pb = pack8(sc[s >> 1], s & 1);
#pragma unroll
          for (int vt = 0; vt < 4; vt++) {
            const bf16x8 a = *(const bf16x8*)(lv + r * 144 + h * 16 + vt * 32 * 144 + s * 32);
            oacc[vt] = MFMA32(a, pb, oacc[vt]);
          }
        }
        __builtin_amdgcn_s_setprio(0);
      }
    }
#undef ATT_LOAD
    const float l_tot = l_run + __shfl_xor(l_run, 32);
    const float inv = 1.f / l_tot;
    const size_t obase = (size_t)(q0w + r) * 2048 + head * 128;
#pragma unroll
    for (int vt = 0; vt < 4; vt++)
#pragma unroll
      for (int g = 0; g < 4; g++) {
        const int v = vt * 32 + 8 * g + 4 * h;
        uint2 gg = *(const uint2*)(G1 + obase + v);
        uint2 o;
        o.x = pack2(oacc[vt][4 * g + 0] * inv * bflo(gg.x), oacc[vt][4 * g + 1] * inv * bfhi(gg.x));
        o.y = pack2(oacc[vt][4 * g + 2] * inv * bflo(gg.y), oacc[vt][4 * g + 3] * inv * bfhi(gg.y));
        *(uint2*)(OG + obase + v) = o;
      }
  }
}

DI void phase_final(const Params& p, char* smem, int bid, int nblk) {
  char* ws = opaque_ptr(p.ws);
  const int t = TID, lane = t & 63, w = t >> 6;
  const bf16_t* Y = (const bf16_t*)(ws + OFF_Y);
  const float4* gpo = (const float4*)p.l1_post + lane;
  for (int row0 = bid * 4 + w; row0 < S_; row0 += nblk * 8) {
    const int row1r = row0 + nblk * 4;
    const bool has1 = row1r < S_;
    const int row1 = has1 ? row1r : row0;
    const uint2* yr0 = (const uint2*)(Y + (size_t)row0 * 2048) + lane;
    const uint2* yr1 = (const uint2*)(Y + (size_t)row1 * 2048) + lane;
    float4* out0 = (float4*)(p.out + (size_t)row0 * 2048) + lane;
    float4* out1 = (float4*)(p.out + (size_t)row1 * 2048) + lane;
    uint2 ya[8], yb[8];
    float4 xa[8], xb[8];
#pragma unroll
    for (int j = 0; j < 8; j++) { ya[j] = ld_nt(yr0 + j * 64); xa[j] = ld_nt((const float4*)out0 + j * 64); yb[j] = ld_nt(yr1 + j * 64); xb[j] = ld_nt((const float4*)out1 + j * 64); }
    float sa = 0.f, sb = 0.f;
#pragma unroll
    for (int j = 0; j < 8; j++) {
      sa += bflo(ya[j].x) * bflo(ya[j].x) + bfhi(ya[j].x) * bfhi(ya[j].x) + bflo(ya[j].y) * bflo(ya[j].y) + bfhi(ya[j].y) * bfhi(ya[j].y);
      sb += bflo(yb[j].x) * bflo(yb[j].x) + bfhi(yb[j].x) * bfhi(yb[j].x) + bflo(yb[j].y) * bflo(yb[j].y) + bfhi(yb[j].y) * bfhi(yb[j].y);
    }
    sa = wave_sum(sa); sb = wave_sum(sb);
    const float ra = rsqrtf(sa * (1.f / 2048.f) + 1e-6f), rb = rsqrtf(sb * (1.f / 2048.f) + 1e-6f);
#pragma unroll
    for (int j = 0; j < 8; j++) {
      const float4 g = gpo[j * 64];
      float4 o = xa[j];
      o.x += bflo(ya[j].x) * ra * g.x; o.y += bfhi(ya[j].x) * ra * g.y; o.z += bflo(ya[j].y) * ra * g.z; o.w += bfhi(ya[j].y) * ra * g.w;
      st_nt(out0 + j * 64, o);
      if (has1) {
        float4 q = xb[j];
        q.x += bflo(yb[j].x) * rb * g.x; q.y += bfhi(yb[j].x) * rb * g.y; q.z += bflo(yb[j].y) * rb * g.z; q.w += bfhi(yb[j].y) * rb * g.w;
        st_nt(out1 + j * 64, q);
      }
    }
  }
}

constexpr int NPHASE = 13;
constexpr unsigned DUP_MASK = 0u;
DI void run_phase(int ph, const Params& p, char* smem, int bid, int nblk, int rep) {
  switch (ph) {
    case 0: phase_prep(p, smem, bid, nblk); break;
    case 1: phase_gemm_in0(p, smem, bid, nblk); break;
    case 2: phase_gla_prep(p, smem, bid, nblk); break;
    case 3: phase_gla_local(p, smem, bid, nblk); break;
    case 4: phase_gla_scan(p, smem, bid, nblk); break;
    case 5: phase_og(p, smem, bid, nblk); break;
    case 6: phase_gemm_out(p, smem, bid, nblk, OFF_WOUT0T); break;
    case 7: phase_post0(p, smem, bid, nblk); break;
    case 8: phase_gemm_in1(p, smem, bid, nblk); break;
    case 9: phase_gemm_qkv(p, smem, bid, nblk); break;
    case 10: phase_attn(p, smem, bid, nblk, rep); break;
    case 11: phase_gemm_out(p, smem, bid, nblk, OFF_WOUT1T); break;
    case 12: phase_final(p, smem, bid, nblk); break;
  }
}

#define XB_TMO      128
#define XB_XCNT(j)  (256  + 64 * (j))
#define XB_XSUB(j)  (1280 + 64 * (j))
#define XB_XGEN(j)  (2304 + 64 * (j))
#define XB_TOP      3328
#define XB_TOPGEN   3392
#define XCD_BAR_WORDS 3456
#define XB_SPIN_CAP (1u << 20)
#define LAS __attribute__((address_space(3)))
DI unsigned xb_ld(unsigned* p) { return __hip_atomic_load(p, __ATOMIC_RELAXED, __HIP_MEMORY_SCOPE_AGENT); }
DI unsigned xb_add(unsigned* p, unsigned v) { return __hip_atomic_fetch_add(p, v, __ATOMIC_RELAXED, __HIP_MEMORY_SCOPE_AGENT); }
DI unsigned xb_xcc_id() { return (unsigned)__builtin_amdgcn_s_getreg((3 << 11) | 20) & 0xFu; }
#define XB_SPIN(cond, bar) do { unsigned _sp = 0; while (cond) { __builtin_amdgcn_s_sleep(1); \
    if ((++_sp & 255u) == 0u) { if (xb_ld(&(bar)[XB_TMO])) break; if (_sp > XB_SPIN_CAP) { atomicAdd(&(bar)[XB_TMO], 1u); break; } } } } while (0)
struct XcdBarrier { unsigned* bar; unsigned x; volatile LAS unsigned* st; };
DI XcdBarrier xcd_barrier_post(unsigned* bar, volatile LAS unsigned* st) {
  XcdBarrier b; b.bar = bar; b.x = xb_xcc_id(); b.st = st;
  if (threadIdx.x == 0) (void)xb_add(&bar[XB_XCNT(b.x)], 1u);
  return b;
}
DI void xcd_barrier_complete(unsigned* bar, unsigned x, unsigned& nloc, unsigned& nx) {
  const unsigned G = gridDim.x * gridDim.y * gridDim.z;
  unsigned sum, cnt, mine, sp = 0u;
  for (;;) {
    sum = 0u; cnt = 0u; mine = 0u;
#pragma unroll
    for (unsigned j = 0; j < 16; ++j) { const unsigned c = xb_ld(&bar[XB_XCNT(j)]); sum += c; cnt += (c > 0u) ? 1u : 0u; mine = (j == x) ? c : mine; }
    if (sum == G) break;
    __builtin_amdgcn_s_sleep(1);
    if ((++sp & 255u) == 0u) { if (xb_ld(&bar[XB_TMO])) break; if (sp > XB_SPIN_CAP) { atomicAdd(&bar[XB_TMO], 1u); break; } }
  }
  nloc = mine > 0u ? mine : 1u; nx = cnt > 0u ? cnt : 1u;
}
DI void xcd_barrier(const XcdBarrier& b) {
  asm volatile("s_waitcnt vmcnt(0)" ::: "memory");
  __syncthreads();
  if (threadIdx.x == 0) {
    unsigned* bar = b.bar;
    __builtin_amdgcn_s_waitcnt(0);
    unsigned nloc, nx;
    xcd_barrier_complete(bar, b.x, nloc, nx);
    const unsigned old = xb_add(&bar[XB_XSUB(b.x)], 1u);
    const unsigned gen = old / nloc;
    if (old + 1u == (gen + 1u) * nloc) {
      __builtin_amdgcn_fence(__ATOMIC_RELEASE, "agent");
      asm volatile("s_waitcnt vmcnt(0)" ::: "memory");
      const unsigned og = xb_add(&bar[XB_TOP], 1u);
      const unsigned tg = og / nx;
      if (og + 1u == (tg + 1u) * nx) xb_add(&bar[XB_TOPGEN], 1u);
      else XB_SPIN(xb_ld(&bar[XB_TOPGEN]) == tg, bar);
      __builtin_amdgcn_fence(__ATOMIC_ACQUIRE, "agent");
      xb_add(&bar[XB_XGEN(b.x)], 1u);
      asm volatile("s_waitcnt vmcnt(0)" ::: "memory");
    } else {
      XB_SPIN(xb_ld(&bar[XB_XGEN(b.x)]) == gen, bar);
      __builtin_amdgcn_fence(__ATOMIC_ACQUIRE, "agent");
      asm volatile("s_waitcnt vmcnt(0)" ::: "memory");
    }
  }
  __syncthreads();
}

#if MEGA
__global__ void __launch_bounds__(256, 2) mega_kernel(Params p) {
  __shared__ __attribute__((aligned(16))) char smem[69632];
  cg::grid_group grid = cg::this_grid();
  const int bid = blockIdx.x, nblk = gridDim.x;
  (void)xcd_barrier_post((unsigned*)(p.ws + OFF_BAR), (volatile LAS unsigned*)0);
#pragma nounroll
  for (int ph = 0; ph < NPHASE; ph++) {
    int phv = ph;
    asm volatile("" : "+s"(phv));
    run_phase(phv, p, smem, bid, nblk, 0);
    if (p.ws == nullptr) grid.sync();
    { XcdBarrier xb; xb.bar = (unsigned*)(opaque_ptr(p.ws) + OFF_BAR); xb.x = xb_xcc_id(); xb.st = (volatile LAS unsigned*)0; xcd_barrier(xb); }
    if ((DUP_MASK >> ph) & 1u) {
      run_phase(phv, p, smem, bid, nblk, 1);
      { XcdBarrier xb; xb.bar = (unsigned*)(opaque_ptr(p.ws) + OFF_BAR); xb.x = xb_xcc_id(); xb.st = (volatile LAS unsigned*)0; xcd_barrier(xb); }
    }
  }
}
#endif

#if !MEGA
template <int PH>
__global__ void __launch_bounds__(256, 2) phase_kernel_t(Params p) {
  __shared__ __attribute__((aligned(16))) char smem[69632];
  run_phase(PH, p, smem, blockIdx.x, gridDim.x, 0);
}
#endif

extern "C" void kernel_launch(void* const* d_in, const int* in_sizes, int n_in, void* d_out, int out_size, void* d_ws,
                              size_t ws_size, hipStream_t stream) {
  Params p{};
  p.x = (const float*)d_in[0]; p.pos = (const int*)d_in[1]; p.l0_pre = (const float*)d_in[2]; p.w_in0 = (const float*)d_in[3];
  p.w_gk2 = (const float*)d_in[4]; p.b_gk = (const float*)d_in[5]; p.g_onorm = (const float*)d_in[6]; p.w_out0 = (const float*)d_in[7];
  p.l0_post = (const float*)d_in[8]; p.l1_pre = (const float*)d_in[9]; p.w_in1 = (const float*)d_in[10]; p.g_qa = (const float*)d_in[11];
  p.w_qb = (const float*)d_in[12]; p.g_kva = (const float*)d_in[13]; p.w_kvb = (const float*)d_in[14]; p.w_out1 = (const float*)d_in[15];
  p.l1_post = (const float*)d_in[16];
  p.out = (float*)d_out; p.ws = (char*)d_ws;
  for (int i = 0; i < 32; i++) p.invf[i] = (float)pow(10000.0, -(double)i / 32.0);
#if MEGA
  static int grid_blocks = 0;
  if (!grid_blocks) {
    int dev = 0, cus = 0, per_cu = 0;
    hipGetDevice(&dev);
    hipDeviceGetAttribute(&cus, hipDeviceAttributeMultiprocessorCount, dev);
    hipOccupancyMaxActiveBlocksPerMultiprocessor(&per_cu, mega_kernel, 256, 0);
    if (per_cu > 2) per_cu = 2;
    if (per_cu < 1) per_cu = 1;
    grid_blocks = cus * per_cu;
  }
  hipMemsetAsync((char*)d_ws + OFF_BAR, 0, XCD_BAR_WORDS * 4, stream);
  void* args[] = {&p};
  hipError_t e = hipLaunchCooperativeKernel((void*)mega_kernel, dim3(grid_blocks), dim3(256), args, 0, stream);
  if (e != hipSuccess) fprintf(stderr, "cooperative launch failed: %s (grid %d)\n", hipGetErrorString(e), grid_blocks);
#else
#define LPH(N) hipLaunchKernelGGL(phase_kernel_t<N>, dim3(512), dim3(256), 0, stream, p);
  LPH(0) LPH(1) LPH(2) LPH(3) LPH(4) LPH(5) LPH(6) LPH(7) LPH(8) LPH(9) LPH(10) LPH(11) LPH(12)
#undef LPH
#endif
}
```
